# Optimizing an MI355X kernel written in HIP

```python
import math
import jax, jax.numpy as jnp
from jax import lax
import numpy as np

D_MODEL = 1024
BATCH = 8
SEQ = 2048
DEPTH = 2
DEC_BATCH = 128
DEC_SEQ = 4
PAST_LEN = 16384
PAGE_SIZE = 128

N_MIXERS = 2
N_RET_LAYERS = (DEPTH + 1) // 2
N_SWA_LAYERS = DEPTH // 2
RET_HEADS = 4
RET_DK = 256
RET_DV = 512
RET_CHUNK = 128
SWA_Q_HEADS = 16
SWA_KV_HEADS = 4
SWA_GROUP = SWA_Q_HEADS // SWA_KV_HEADS
SWA_HEAD_DIM = 64
WINDOW = 128
SWA_BLOCK = 128
ROPE_THETA = 10000.0
D_FF = -(-8 * D_MODEL // (3 * 256)) * 256
EPS = 1e-6

kernel_name = "retnet_swa_sink_hybrid_step"

F32 = jnp.float32


def rms_norm(x, gain=None):
    xf = x.astype(F32)
    y = xf * lax.rsqrt(jnp.mean(xf * xf, axis=-1, keepdims=True) + EPS)
    if gain is not None:
        y = y * gain.astype(F32)
    return y.astype(x.dtype)


def rope(x, pos, inv_freq):
    ang = pos[:, None] * inv_freq[None, :]
    cos = jnp.cos(ang)[:, None, :]
    sin = jnp.sin(ang)[:, None, :]
    xf = x.astype(F32)
    half = xf.shape[-1] // 2
    x1, x2 = xf[..., :half], xf[..., half:]
    return jnp.concatenate([x1 * cos - x2 * sin, x2 * cos + x1 * sin], axis=-1).astype(x.dtype)


def ret_inv_freq():
    return 1.0 / (ROPE_THETA ** jnp.linspace(0.0, 1.0, RET_DK // 2, dtype=F32))


def swa_inv_freq():
    return 1.0 / (ROPE_THETA ** (jnp.arange(0, SWA_HEAD_DIM, 2, dtype=F32) / SWA_HEAD_DIM))


def ret_log_decay():
    return jnp.log(1.0 - 2.0 ** (-5.0 - jnp.arange(RET_HEADS, dtype=F32)))


def retention_chunk(S, q, k, v, lg):
    C = q.shape[1]
    idx = jnp.arange(C, dtype=F32)
    diff = idx[:, None] - idx[None, :]
    decay = jnp.where(diff >= 0, jnp.exp(jnp.maximum(diff, 0.0)[None] * lg[:, None, None]), 0.0)
    scores = jnp.einsum('bihd,bjhd->bhij', q, k) * decay
    o = jnp.einsum('bhij,bjhe->bihe', scores, v)
    q_dec = q * jnp.exp((idx + 1.0)[:, None] * lg[None, :])[None, :, :, None]
    o = o + jnp.einsum('bihd,bhde->bihe', q_dec, S)
    k_dec = k * jnp.exp((C - 1.0 - idx)[:, None] * lg[None, :])[None, :, :, None]
    S_new = jnp.exp(C * lg)[None, :, None, None] * S + jnp.einsum('bjhd,bjhe->bhde', k_dec, v)
    return S_new, o


def retention_mixer(h, S0, w_in, w_out, pos0):
    B, T, _ = h.shape
    hk, hv = RET_HEADS * RET_DK, RET_HEADS * RET_DV
    proj = h @ w_in
    q = proj[..., :hk].reshape(B, T, RET_HEADS, RET_DK)
    k = proj[..., hk:2 * hk].reshape(B, T, RET_HEADS, RET_DK)
    v = proj[..., 2 * hk:2 * hk + hv].reshape(B, T, RET_HEADS, RET_DV)
    g = proj[..., 2 * hk + hv:]
    pos = pos0 + jnp.arange(T, dtype=F32)
    inv = ret_inv_freq()
    q = rope(q, pos, inv).astype(F32)
    k = rope(k, pos, inv).astype(F32) * (RET_DK ** -0.5)
    v = v.astype(F32)
    lg = ret_log_decay()
    C = RET_CHUNK if T % RET_CHUNK == 0 else T
    nc = T // C
    to_chunks = lambda a: jnp.moveaxis(a.reshape(B, nc, C, *a.shape[2:]), 1, 0)

    def step(S, xs):
        qc, kc, vc = xs
        return retention_chunk(S, qc, kc, vc, lg)

    S_fin, o = lax.scan(step, S0.astype(F32), (to_chunks(q), to_chunks(k), to_chunks(v)))
    o = jnp.moveaxis(o, 0, 1).reshape(B, T, RET_HEADS, RET_DV)
    o = rms_norm(o).reshape(B, T, hv)
    y = (jax.nn.silu(g.astype(F32)) * o).astype(h.dtype) @ w_out
    return y, S_fin


def swa_qkv(h, w_in, q_gain, k_gain, pos):
    B, T, _ = h.shape
    nq, nk = SWA_Q_HEADS * SWA_HEAD_DIM, SWA_KV_HEADS * SWA_HEAD_DIM
    proj = h @ w_in
    q = proj[..., :nq].reshape(B, T, SWA_Q_HEADS, SWA_HEAD_DIM)
    k = proj[..., nq:nq + nk].reshape(B, T, SWA_KV_HEADS, SWA_HEAD_DIM)
    v = proj[..., nq + nk:].reshape(B, T, SWA_KV_HEADS, SWA_HEAD_DIM)
    inv = swa_inv_freq()
    q = rope(rms_norm(q, q_gain), pos, inv)
    k = rope(rms_norm(k, k_gain), pos, inv)
    return q, k, v


def sink_attention(q, k, v, mask, sinks):
    s = jnp.einsum('bnqhgd,bnkhd->bnhgqk', q, k).astype(F32) * (SWA_HEAD_DIM ** -0.5)
    s = jnp.where(mask[None, :, None, None], s, -jnp.inf)
    sink = jnp.broadcast_to(sinks.astype(F32).reshape(SWA_KV_HEADS, SWA_GROUP)[None, None, :, :, None, None],
                            s.shape[:-1] + (1,))
    p = jax.nn.softmax(jnp.concatenate([s, sink], axis=-1), axis=-1)[..., :-1]
    return jnp.einsum('bnhgqk,bnkhd->bnqhgd', p.astype(v.dtype), v)


def swa_prompt(h, w_in, w_out, q_gain, k_gain, sinks):
    B, T, _ = h.shape
    q, k, v = swa_qkv(h, w_in, q_gain, k_gain, jnp.arange(T, dtype=F32))
    nb = T // SWA_BLOCK
    qb = q.reshape(B, nb, SWA_BLOCK, SWA_KV_HEADS, SWA_GROUP, SWA_HEAD_DIM)
    kb = k.reshape(B, nb, SWA_BLOCK, SWA_KV_HEADS, SWA_HEAD_DIM)
    vb = v.reshape(B, nb, SWA_BLOCK, SWA_KV_HEADS, SWA_HEAD_DIM)
    band = lambda a: jnp.concatenate([jnp.concatenate([jnp.zeros_like(a[:, :1]), a[:, :-1]], axis=1), a], axis=2)
    kband, vband = band(kb), band(vb)
    i = jnp.arange(SWA_BLOCK)[:, None]
    j = jnp.arange(2 * SWA_BLOCK)[None, :]
    d = SWA_BLOCK + i - j
    n = jnp.arange(nb)[:, None, None]
    mask = (d >= 0) & (d <= WINDOW) & ((n > 0) | (j >= SWA_BLOCK))
    o = sink_attention(qb, kband, vband, mask, sinks).reshape(B, T, SWA_Q_HEADS * SWA_HEAD_DIM)
    L = min(WINDOW, T)
    return o @ w_out, k[:, T - L:], v[:, T - L:]


def swa_sample(h, cache_k, cache_v, w_in, w_out, q_gain, k_gain, sinks):
    B, T, _ = h.shape
    q, k, v = swa_qkv(h, w_in, q_gain, k_gain, PAST_LEN + jnp.arange(T, dtype=F32))
    L = cache_k.shape[1]
    kall = jnp.concatenate([cache_k.astype(k.dtype), k], axis=1)
    vall = jnp.concatenate([cache_v.astype(v.dtype), v], axis=1)
    i = jnp.arange(T)[:, None]
    j = jnp.arange(L + T)[None, :]
    d = i - j + L
    mask = ((d >= 0) & (d <= WINDOW))[None]
    qb = q.reshape(B, 1, T, SWA_KV_HEADS, SWA_GROUP, SWA_HEAD_DIM)
    o = sink_attention(qb, kall[:, None], vall[:, None], mask, sinks).reshape(B, T, SWA_Q_HEADS * SWA_HEAD_DIM)
    return o @ w_out, kall[:, T:], vall[:, T:]


def swiglu(h, w_in, w_out):
    gu = h @ w_in
    g, u = gu[..., :D_FF], gu[..., D_FF:]
    return (jax.nn.silu(g.astype(F32)) * u.astype(F32)).astype(h.dtype) @ w_out


def setup_inputs(seed: int = 0) -> dict:
    key = jax.random.key(seed)
    ks = jax.random.split(key, 16)
    nrm = lambda k, shape, scale: jax.random.normal(k, shape, F32) * scale
    ret_in_w = 2 * RET_HEADS * RET_DK + 2 * RET_HEADS * RET_DV
    swa_in_w = (SWA_Q_HEADS + 2 * SWA_KV_HEADS) * SWA_HEAD_DIM
    buf = min(WINDOW, PAST_LEN)
    return {
        "x_prompt": nrm(ks[0], (BATCH, SEQ, D_MODEL), 1.0),
        "x_sample": nrm(ks[1], (DEC_BATCH, DEC_SEQ, D_MODEL), 1.0),
        "state_ret": nrm(ks[2], (N_RET_LAYERS, DEC_BATCH, RET_HEADS, RET_DK, RET_DV), 0.3),
        "cache_swa_k": nrm(ks[3], (N_SWA_LAYERS, DEC_BATCH, buf, SWA_KV_HEADS, SWA_HEAD_DIM), 1.0),
        "cache_swa_v": nrm(ks[4], (N_SWA_LAYERS, DEC_BATCH, buf, SWA_KV_HEADS, SWA_HEAD_DIM), 1.0),
        "norm_mix": 1.0 + nrm(ks[5], (DEPTH, D_MODEL), 0.02),
        "norm_ffn": 1.0 + nrm(ks[6], (DEPTH, D_MODEL), 0.02),
        "w_ret_in": nrm(ks[7], (N_RET_LAYERS, D_MODEL, ret_in_w), D_MODEL ** -0.5),
        "w_ret_out": nrm(ks[8], (N_RET_LAYERS, RET_HEADS * RET_DV, D_MODEL), (RET_HEADS * RET_DV) ** -0.5),
        "w_swa_in": nrm(ks[9], (N_SWA_LAYERS, D_MODEL, swa_in_w), D_MODEL ** -0.5),
        "w_swa_out": nrm(ks[10], (N_SWA_LAYERS, SWA_Q_HEADS * SWA_HEAD_DIM, D_MODEL), (SWA_Q_HEADS * SWA_HEAD_DIM) ** -0.5),
        "swa_q_norm": 1.0 + nrm(ks[11], (N_SWA_LAYERS, SWA_HEAD_DIM), 0.02),
        "swa_k_norm": 1.0 + nrm(ks[12], (N_SWA_LAYERS, SWA_HEAD_DIM), 0.02),
        "swa_sinks": nrm(ks[13], (N_SWA_LAYERS, SWA_Q_HEADS), 1.0),
        "w_ffn_in": nrm(ks[14], (DEPTH, D_MODEL, 2 * D_FF), D_MODEL ** -0.5),
        "w_ffn_out": nrm(ks[15], (DEPTH, D_FF, D_MODEL), D_FF ** -0.5),
    }


def reference(x_prompt, x_sample, state_ret, cache_swa_k, cache_swa_v, norm_mix, norm_ffn,
              w_ret_in, w_ret_out, w_swa_in, w_swa_out, swa_q_norm, swa_k_norm, swa_sinks,
              w_ffn_in, w_ffn_out):
    xp, xs = x_prompt, x_sample
    ret_p, ret_s, kp, vp, ksn, vsn = [], [], [], [], [], []
    for layer in range(DEPTH):
        hp = rms_norm(xp, norm_mix[layer])
        hs = rms_norm(xs, norm_mix[layer])
        if layer % N_MIXERS == 0:
            r = layer // N_MIXERS
            S0 = jnp.zeros((xp.shape[0], RET_HEADS, RET_DK, RET_DV), F32)
            yp, Sp = retention_mixer(hp, S0, w_ret_in[r], w_ret_out[r], 0.0)
            ys, Ss = retention_mixer(hs, state_ret[r], w_ret_in[r], w_ret_out[r], float(PAST_LEN))
            ret_p.append(Sp)
            ret_s.append(Ss)
        else:
            a = layer // N_MIXERS
            yp, k_p, v_p = swa_prompt(hp, w_swa_in[a], w_swa_out[a], swa_q_norm[a], swa_k_norm[a], swa_sinks[a])
            ys, k_s, v_s = swa_sample(hs, cache_swa_k[a], cache_swa_v[a], w_swa_in[a], w_swa_out[a],
                                      swa_q_norm[a], swa_k_norm[a], swa_sinks[a])
            kp.append(k_p)
            vp.append(v_p)
            ksn.append(k_s)
            vsn.append(v_s)
        xp = xp + yp
        xs = xs + ys
        xp = xp + swiglu(rms_norm(xp, norm_ffn[layer]), w_ffn_in[layer], w_ffn_out[layer])
        xs = xs + swiglu(rms_norm(xs, norm_ffn[layer]), w_ffn_in[layer], w_ffn_out[layer])
    new_state_ret_p = jnp.stack(ret_p, 0)
    new_state_ret_s = jnp.stack(ret_s, 0)
    new_cache_swa_k_p = jnp.stack(kp, 0)
    new_cache_swa_v_p = jnp.stack(vp, 0)
    new_cache_swa_k_s = jnp.stack(ksn, 0)
    new_cache_swa_v_s = jnp.stack(vsn, 0)
    return (xp, xs, new_state_ret_p, new_state_ret_s, new_cache_swa_k_p, new_cache_swa_v_p, new_cache_swa_k_s, new_cache_swa_v_s)
```

```cpp
#include <hip/hip_runtime.h>
#include <hip/hip_cooperative_groups.h>
#include <cstdio>
#include <cstdint>
#include <cmath>
#include <cstring>
namespace cg = cooperative_groups;
namespace pg8 {
#define PG8_LAS __attribute__((address_space(3)))
typedef unsigned short bf16_t;
typedef short bf16x8 __attribute__((ext_vector_type(8)));
typedef float f32x4 __attribute__((ext_vector_type(4)));
typedef unsigned u32x4 __attribute__((ext_vector_type(4)));
constexpr int BM = 256, BK = 64, HALF = 128, HTB = HALF * BK * 2  , STAGE_BYTES = 8 * HTB, NXCD = 8, WGM = 8;

__host__ __device__ __forceinline__ int lds_byte(int r, int c) { const int st = (r >> 4) * 2 + (c >> 5), rr = r & 15, cc = c & 31, ob = rr * 64 + cc * 2; return st * 1024 + (ob ^ (((ob >> 9) & 1) << 5)); }
__host__ __device__ __forceinline__ void stage_rc(int b, int& R, int& C) { const int st = b / 1024, sb = b % 1024, swz = sb ^ (((sb >> 9) & 1) << 5); R = (st >> 1) * 16 + swz / 64; C = (st & 1) * 32 + (swz % 64) / 2; }
__host__ __device__ __forceinline__ int perm32(int rho) { const int n = rho >> 4, i = rho & 15; return 8 * (i >> 2) + 4 * n + (i & 3); }

struct Unit { int pm, pn; };
struct Gemm { const bf16_t* A; const bf16_t* Bt; int M, N, K; };

struct StaticOrder {
    int nM, nN, nwg, G, c;
    __host__ __device__ void init(int M, int N, int G_, int c_) { nM = M / BM; nN = N / BM; nwg = nM * nN; G = G_; c = c_; }
    __host__ __device__ bool next(int i, Unit& u) const {
        const long L = (long)i * G + c; if (L >= nwg) return false;
        int wgid = (int)L; { const int q = nwg / NXCD, r = nwg % NXCD, xcd = wgid % NXCD, off = wgid / NXCD; wgid = (xcd < r ? xcd * (q + 1) : r * (q + 1) + (xcd - r) * q) + off; }
        const int nig = WGM * nN, gid = wgid / nig, fm = gid * WGM, gsz = (nM - fm) < WGM ? (nM - fm) : WGM;
        u.pm = fm + ((wgid % nig) % gsz); u.pn = (wgid % nig) / gsz; return true;
    }
    __device__ __forceinline__ void a_ready(const Unit&) const {}
    __device__ __forceinline__ void done(const Unit&) const {}
};

__device__ __forceinline__ unsigned cvt_pk_bf16(float lo, float hi) { unsigned r; asm volatile("v_cvt_pk_bf16_f32 %0, %1, %2" : "=v"(r) : "v"(lo), "v"(hi)); return r; }
typedef float f32x2 __attribute__((ext_vector_type(2)));
constexpr int P_NP = 16384, P_D = 1024;
constexpr float P_EPS = 1e-6f;
__device__ __forceinline__ float silu_f(float x) { return x * __builtin_amdgcn_rcpf(1.0f + __expf(-x)); }
__device__ __forceinline__ int pos_index(int row) { return row < P_NP ? (row & 2047) : 2048 + (row & 3); }
__device__ __forceinline__ u32x4 pack8(const f32x4 a, const f32x4 b) { u32x4 w; w.x = cvt_pk_bf16(a[0], a[1]); w.y = cvt_pk_bf16(a[2], a[3]); w.z = cvt_pk_bf16(b[0], b[1]); w.w = cvt_pk_bf16(b[2], b[3]); return w; }

struct EpiRetIn {
    static constexpr bool PERM = true, AFTER_DRAIN = false;
    bf16_t* O; const float* ss; const float* cosT; const float* sinT;
    __device__ __forceinline__ void operator()(const f32x4 (&acc)[2][2][4][2], const Unit& u, int wr, int wc, int fr, int fq) const {
        const int pn = u.pn, ci = wc * 32 + 8 * fq;
#pragma unroll
        for (int ai = 0; ai < 2; ++ai)
#pragma unroll
            for (int m = 0; m < 4; ++m) {
                const int row = u.pm * BM + ai * HALF + wr * 64 + m * 16 + fr;
                const float rstd = __builtin_amdgcn_rsqf(ss[row] * (1.0f / 1024.0f) + P_EPS);
                bf16_t* rowp = O + (size_t)row * 6144 + pn * 256 + ci;
                if (pn < 8) {
                    const int pidx = pos_index(row);
                    const f32x4* cp = (const f32x4*)(cosT + pidx * 128 + ci); const f32x4* sp = (const f32x4*)(sinT + pidx * 128 + ci);
                    const float sc = (pn >= 4) ? rstd * 0.0625f : rstd;
                    f32x4 o1[2], o2[2];
#pragma unroll
                    for (int n = 0; n < 2; ++n) { const f32x4 c = cp[n], s = sp[n]; const f32x4 x1 = acc[ai][0][m][n] * sc, x2 = acc[ai][1][m][n] * sc; o1[n] = x1 * c - x2 * s; o2[n] = x2 * c + x1 * s; }
                    *(u32x4*)(rowp) = pack8(o1[0], o1[1]); *(u32x4*)(rowp + HALF) = pack8(o2[0], o2[1]);
                } else if (pn < 16) {
#pragma unroll
                    for (int bj = 0; bj < 2; ++bj) *(u32x4*)(rowp + bj * HALF) = pack8(acc[ai][bj][m][0] * rstd, acc[ai][bj][m][1] * rstd);
                } else {
#pragma unroll
                    for (int bj = 0; bj < 2; ++bj) { f32x4 a = acc[ai][bj][m][0] * rstd, b = acc[ai][bj][m][1] * rstd;
#pragma unroll
                        for (int j = 0; j < 4; ++j) { a[j] = silu_f(a[j]); b[j] = silu_f(b[j]); }
                        *(u32x4*)(rowp + bj * HALF) = pack8(a, b); }
                }
            }
    }
};
struct EpiRes {
    static constexpr bool PERM = true, AFTER_DRAIN = false;
    const float* resP; const float* resS; float* out; bf16_t* xb; float* ssn;
    __device__ __forceinline__ void operator()(const f32x4 (&acc)[2][2][4][2], const Unit& u, int wr, int wc, int fr, int fq) const {
        const int col0 = u.pn * BM + wc * 32 + 8 * fq;
#pragma unroll
        for (int ai = 0; ai < 2; ++ai)
#pragma unroll
            for (int m = 0; m < 4; ++m) {
                const int row = u.pm * BM + ai * HALF + wr * 64 + m * 16 + fr;
                const float* rp = (row < P_NP ? resP + (size_t)row * P_D : resS + (size_t)(row - P_NP) * P_D) + col0;
                float* op = out + (size_t)row * P_D + col0; float s = 0.f;
#pragma unroll
                for (int bj = 0; bj < 2; ++bj) {
                    const f32x4 v0 = *(const f32x4*)(rp + bj * HALF) + acc[ai][bj][m][0], v1 = *(const f32x4*)(rp + bj * HALF + 4) + acc[ai][bj][m][1];
                    *(f32x4*)(op + bj * HALF) = v0; *(f32x4*)(op + bj * HALF + 4) = v1;
                    s += (v0[0] * v0[0] + v0[1] * v0[1]) + (v0[2] * v0[2] + v0[3] * v0[3]) + (v1[0] * v1[0] + v1[1] * v1[1]) + (v1[2] * v1[2] + v1[3] * v1[3]);
                    if (xb) *(u32x4*)(xb + (size_t)row * P_D + col0 + bj * HALF) = pack8(v0, v1);
                }
                if (ssn) { s += __shfl_xor(s, 16); s += __shfl_xor(s, 32); if (fq == 0) atomicAdd(ssn + row, s); }
            }
    }
};
struct EpiSwiglu {
    static constexpr bool PERM = true, AFTER_DRAIN = false;
    bf16_t* H; const float* ss;
    __device__ __forceinline__ void operator()(const f32x4 (&acc)[2][2][4][2], const Unit& u, int wr, int wc, int fr, int fq) const {
        const int col0 = u.pn * HALF + wc * 32 + 8 * fq;
#pragma unroll
        for (int ai = 0; ai < 2; ++ai)
#pragma unroll
            for (int m = 0; m < 4; ++m) {
                const int row = u.pm * BM + ai * HALF + wr * 64 + m * 16 + fr;
                const float rstd = __builtin_amdgcn_rsqf(ss[row] * (1.0f / 1024.0f) + P_EPS);
                f32x4 h[2];
#pragma unroll
                for (int n = 0; n < 2; ++n) { const f32x4 g = acc[ai][0][m][n] * rstd, uu = acc[ai][1][m][n] * rstd;
#pragma unroll
                    for (int j = 0; j < 4; ++j) h[n][j] = silu_f(g[j]) * uu[j]; }
                *(u32x4*)(H + (size_t)row * 2816 + col0) = pack8(h[0], h[1]);
            }
    }
};
struct EpiSwaIn {
    static constexpr bool PERM = true, AFTER_DRAIN = false;
    bf16_t* O; const float* ss; const float* cosT; const float* sinT; const float* qg; const float* kg; float* kc_p; float* vc_p; float* kc_s; float* vc_s;
    __device__ __forceinline__ void operator()(const f32x4 (&acc)[2][2][4][2], const Unit& u, int wr, int wc, int fr, int fq) const {
        const int pn = u.pn;
        const float* G = (pn < 4) ? qg : kg;
        f32x4 g1[2], g2[2];
#pragma unroll
        for (int n = 0; n < 2; ++n) { g1[n] = *(const f32x4*)(G + 8 * fq + 4 * n); g2[n] = *(const f32x4*)(G + 32 + 8 * fq + 4 * n); }
        const int cbase = (pn < 4 ? (pn * 4 + wc) * 64 : (pn == 4 ? 1024 : 1280) + wc * 64) + 8 * fq;
#pragma unroll
        for (int ai = 0; ai < 2; ++ai)
#pragma unroll
            for (int m = 0; m < 4; ++m) {
                const int row = u.pm * BM + ai * HALF + wr * 64 + m * 16 + fr;
                const float rstd = __builtin_amdgcn_rsqf(ss[row] * (1.0f / 1024.0f) + P_EPS);
                bf16_t* rowp = O + (size_t)row * 1536 + cbase;
                float* cdst = nullptr;
                if (pn >= 4) {
                    float* cp_ = (pn == 4) ? kc_p : vc_p; float* cs_ = (pn == 4) ? kc_s : vc_s;
                    if (row < P_NP) { const int b = row >> 11, t = row & 2047; if (t >= 1920) cdst = cp_ + ((size_t)(b * 128 + (t - 1920)) * 4 + wc) * 64 + 8 * fq; }
                    else { const int s_ = row - P_NP, b = s_ >> 2, t = s_ & 3; cdst = cs_ + ((size_t)(b * 128 + 124 + t) * 4 + wc) * 64 + 8 * fq; }
                }
                f32x4 o1[2], o2[2];
                if (pn < 5) {
                    f32x4 x1[2], x2[2]; float q = 0.f;
#pragma unroll
                    for (int n = 0; n < 2; ++n) { x1[n] = acc[ai][0][m][n] * rstd; x2[n] = acc[ai][1][m][n] * rstd;
                        q += (x1[n][0] * x1[n][0] + x1[n][1] * x1[n][1]) + (x1[n][2] * x1[n][2] + x1[n][3] * x1[n][3]) + (x2[n][0] * x2[n][0] + x2[n][1] * x2[n][1]) + (x2[n][2] * x2[n][2] + x2[n][3] * x2[n][3]); }
                    q += __shfl_xor(q, 16); q += __shfl_xor(q, 32);
                    const float hr = __builtin_amdgcn_rsqf(q * (1.0f / 64.0f) + P_EPS);
                    const int pidx = pos_index(row);
                    const f32x4* cp = (const f32x4*)(cosT + pidx * 32 + 8 * fq); const f32x4* sp = (const f32x4*)(sinT + pidx * 32 + 8 * fq);
                    const float osc = (pn < 4) ? 0.125f : 1.0f;
#pragma unroll
                    for (int n = 0; n < 2; ++n) { const f32x4 c = cp[n], s = sp[n]; const f32x4 a = x1[n] * hr * g1[n], b = x2[n] * hr * g2[n]; o1[n] = (a * c - b * s) * osc; o2[n] = (b * c + a * s) * osc; }
                } else {
#pragma unroll
                    for (int n = 0; n < 2; ++n) { o1[n] = acc[ai][0][m][n] * rstd; o2[n] = acc[ai][1][m][n] * rstd; }
                }
                *(u32x4*)(rowp) = pack8(o1[0], o1[1]); *(u32x4*)(rowp + 32) = pack8(o2[0], o2[1]);
                if (cdst) { *(f32x4*)(cdst) = o1[0]; *(f32x4*)(cdst + 4) = o1[1]; *(f32x4*)(cdst + 32) = o2[0]; *(f32x4*)(cdst + 36) = o2[1]; }
            }
    }
};

template <class Epi, class Sched, bool ALIGN_EPI = false, bool SP2 = false>
__device__ __forceinline__ void gemm_phase(PG8_LAS unsigned char* lds, const Gemm g, const Sched& S, const Epi& E) {
    const int tid = threadIdx.x, wid = __builtin_amdgcn_readfirstlane(tid >> 6), lane = tid & 63, wr = wid >> 2, wc = wid & 3, fr = lane & 15, fq = lane >> 4;
    const int K = g.K, nt = K / BK;
    unsigned voffA[2], voffB[2];
#pragma unroll
    for (int i = 0; i < 2; ++i) { int R, C; stage_rc(tid * 16 + i * 8192, R, C); const int Rb = Epi::PERM ? ((R & ~31) + perm32(R & 31)) : R;
        voffA[i] = (unsigned)(R * K + C) * 2u; voffB[i] = (unsigned)(Rb * K + C) * 2u; }
    const size_t kstep = (size_t)(BK * 2);
    const size_t hstep = (size_t)HALF * K * 2;
    const size_t tstep = 2 * hstep;
    const unsigned ldsw = (unsigned)wid * 1024u;
    const int aoff = lds_byte(wr * 64 + fr, fq * 8), boff = lds_byte(wc * 32 + fr, fq * 8);
#define PG8_SA(b, h) (((b) * 2 + (h)) * HTB)
#define PG8_SB(b, h) ((4 + (b) * 2 + (h)) * HTB)
#define PG8_STAGE(bufoff, gbase, voff) do { _Pragma("unroll") for (int _i = 0; _i < 2; ++_i) \
        __builtin_amdgcn_global_load_lds((const unsigned*)((const char*)(gbase) + (voff)[_i]), (PG8_LAS unsigned*)(lds + (bufoff) + ldsw + _i * 8192), 16, 0, 0); } while (0)
#define PG8_LDA(dst, b, h) do { _Pragma("unroll") for (int m = 0; m < 4; ++m) _Pragma("unroll") for (int k = 0; k < 2; ++k) dst[m][k] = *(const PG8_LAS bf16x8*)(lds + PG8_SA(b, h) + aoff + m * 2048 + k * 1024); } while (0)
#define PG8_LDB(dst, b, h) do { _Pragma("unroll") for (int n = 0; n < 2; ++n) _Pragma("unroll") for (int k = 0; k < 2; ++k) dst[n][k] = *(const PG8_LAS bf16x8*)(lds + PG8_SB(b, h) + boff + n * 2048 + k * 1024); } while (0)
#define PG8_MMA(ai, bj, At, Bt) do { __builtin_amdgcn_s_setprio(1); _Pragma("unroll") for (int m = 0; m < 4; ++m) _Pragma("unroll") for (int n = 0; n < 2; ++n) _Pragma("unroll") for (int k = 0; k < 2; ++k) \
        acc[ai][bj][m][n] = __builtin_amdgcn_mfma_f32_16x16x32_bf16(Bt[n][k], At[m][k], acc[ai][bj][m][n], 0, 0, 0); __builtin_amdgcn_s_setprio(0); } while (0)
#define PG8_WAIT_V(n) asm volatile("s_waitcnt vmcnt(" #n ")" ::: "memory")
#define PG8_WAIT_L(n) asm volatile("s_waitcnt lgkmcnt(" #n ")" ::: "memory")
#define PG8_BAR __builtin_amdgcn_s_barrier()
#define PG8_SCHED __builtin_amdgcn_sched_barrier(0)
    Unit cur, nxt; int ui = 0;
    if (!S.next(0, cur)) return;
    f32x4 acc[2][2][4][2];
#pragma unroll
    for (int a = 0; a < 2; ++a)
#pragma unroll
        for (int b = 0; b < 2; ++b)
#pragma unroll
            for (int m = 0; m < 4; ++m)
#pragma unroll
                for (int n = 0; n < 2; ++n) acc[a][b][m][n] = (f32x4){0.f, 0.f, 0.f, 0.f};
    bf16x8 At[4][2], B0[2][2], B1[2][2];
    const char* cA = (const char*)g.A + (size_t)cur.pm * tstep; const char* cB = (const char*)g.Bt + (size_t)cur.pn * tstep;
    S.a_ready(cur);
    if constexpr (SP2) {
        PG8_STAGE(PG8_SB(0, 0), cB, voffB); PG8_STAGE(PG8_SB(0, 1), cB + hstep, voffB); PG8_STAGE(PG8_SA(0, 0), cA, voffA); PG8_STAGE(PG8_SA(0, 1), cA + hstep, voffA);
        if (wr == 1) PG8_BAR;
        PG8_WAIT_V(2); PG8_BAR;
        PG8_STAGE(PG8_SB(1, 0), cB + kstep, voffB); PG8_STAGE(PG8_SA(1, 0), cA + kstep, voffA); PG8_STAGE(PG8_SB(1, 1), cB + hstep + kstep, voffB);
        PG8_WAIT_V(6); PG8_BAR;
    } else {
        PG8_STAGE(PG8_SB(0, 0), cB, voffB); PG8_STAGE(PG8_SA(0, 0), cA, voffA); PG8_STAGE(PG8_SB(0, 1), cB + hstep, voffB); PG8_STAGE(PG8_SA(0, 1), cA + hstep, voffA);
        if (wr == 1) PG8_BAR;
        PG8_WAIT_V(4); PG8_BAR;
        PG8_STAGE(PG8_SB(1, 0), cB + kstep, voffB); PG8_STAGE(PG8_SA(1, 0), cA + kstep, voffA); PG8_STAGE(PG8_SB(1, 1), cB + hstep + kstep, voffB);
        PG8_WAIT_V(6); PG8_BAR;
    }
    for (;;) {
        const bool has_next = S.next(ui + 1, nxt);
        const char* nA = has_next ? (const char*)g.A + (size_t)nxt.pm * tstep : cA; const char* nB = has_next ? (const char*)g.Bt + (size_t)nxt.pn * tstep : cB;
        for (int t = 0; t < nt; t += 2) {
            const bool last = (t == nt - 2);
            const char* a1 = cA + (size_t)(t + 1) * kstep;
            const char* a2 = last ? nA : cA + (size_t)(t + 2) * kstep; const char* b2 = last ? nB : cB + (size_t)(t + 2) * kstep;
            const char* a3 = a2 + kstep; const char* b3 = b2 + kstep;
            if (last && has_next) S.a_ready(nxt);
            if constexpr (SP2) {
            PG8_LDB(B0, 0, 0); PG8_LDB(B1, 0, 1); PG8_SCHED; PG8_LDA(At, 0, 0); PG8_STAGE(PG8_SA(1, 1), a1 + hstep, voffA);
            PG8_WAIT_V(8); PG8_WAIT_L(0); PG8_BAR; PG8_MMA(0, 0, At, B0); PG8_MMA(0, 1, At, B1); PG8_BAR; PG8_SCHED;
            PG8_LDA(At, 0, 1); PG8_STAGE(PG8_SB(0, 0), b2, voffB); PG8_STAGE(PG8_SB(0, 1), b2 + hstep, voffB); PG8_STAGE(PG8_SA(0, 0), a2, voffA);
            PG8_WAIT_V(8); PG8_WAIT_L(0); PG8_BAR; PG8_MMA(1, 0, At, B0); PG8_MMA(1, 1, At, B1); PG8_BAR; PG8_SCHED;
            PG8_LDB(B0, 1, 0); PG8_LDB(B1, 1, 1); PG8_SCHED; PG8_LDA(At, 1, 0); PG8_STAGE(PG8_SA(0, 1), a2 + hstep, voffA);
            PG8_WAIT_V(8); PG8_WAIT_L(0); PG8_BAR; PG8_MMA(0, 0, At, B0); PG8_MMA(0, 1, At, B1); PG8_BAR; PG8_SCHED;
            PG8_LDA(At, 1, 1); PG8_STAGE(PG8_SB(1, 0), b3, voffB); PG8_STAGE(PG8_SB(1, 1), b3 + hstep, voffB); PG8_STAGE(PG8_SA(1, 0), a3, voffA);
            PG8_WAIT_V(8); PG8_WAIT_L(0); PG8_BAR; PG8_MMA(1, 0, At, B0); PG8_MMA(1, 1, At, B1); PG8_BAR; PG8_SCHED;
            } else {
            PG8_LDB(B0, 0, 0); PG8_SCHED; PG8_LDA(At, 0, 0); PG8_STAGE(PG8_SA(1, 1), a1 + hstep, voffA);
            PG8_WAIT_L(8); PG8_BAR; PG8_WAIT_L(0); PG8_MMA(0, 0, At, B0); PG8_BAR; PG8_SCHED;
            PG8_LDB(B1, 0, 1); PG8_STAGE(PG8_SB(0, 0), b2, voffB);
            PG8_BAR; PG8_WAIT_L(0); PG8_MMA(0, 1, At, B1); PG8_BAR;
            PG8_LDA(At, 0, 1); PG8_STAGE(PG8_SA(0, 0), a2, voffA);
            PG8_BAR; PG8_WAIT_L(0); PG8_MMA(1, 0, At, B0); PG8_BAR; PG8_SCHED;
            PG8_STAGE(PG8_SB(0, 1), b2 + hstep, voffB);
            PG8_WAIT_V(6); PG8_BAR; PG8_MMA(1, 1, At, B1); PG8_BAR;
            PG8_LDB(B0, 1, 0); PG8_SCHED; PG8_LDA(At, 1, 0); PG8_STAGE(PG8_SA(0, 1), a2 + hstep, voffA);
            PG8_WAIT_L(8); PG8_BAR; PG8_WAIT_L(0); PG8_MMA(0, 0, At, B0); PG8_BAR; PG8_SCHED;
            PG8_LDB(B1, 1, 1); PG8_STAGE(PG8_SB(1, 0), b3, voffB);
            PG8_BAR; PG8_WAIT_L(0); PG8_MMA(0, 1, At, B1); PG8_BAR;
            PG8_LDA(At, 1, 1); PG8_STAGE(PG8_SA(1, 0), a3, voffA);
            PG8_BAR; PG8_WAIT_L(0); PG8_MMA(1, 0, At, B0); PG8_BAR; PG8_SCHED;
            PG8_STAGE(PG8_SB(1, 1), b3 + hstep, voffB);
            PG8_WAIT_V(6); PG8_BAR; PG8_MMA(1, 1, At, B1); PG8_BAR;
            }
        }
        if constexpr (ALIGN_EPI) { if (wr == 0) PG8_BAR; }
        if constexpr (!Epi::AFTER_DRAIN) { E(acc, cur, wr, wc, fr, fq); S.done(cur); }
        if (!has_next) break;
#pragma unroll
        for (int a = 0; a < 2; ++a)
#pragma unroll
            for (int b = 0; b < 2; ++b)
#pragma unroll
                for (int m = 0; m < 4; ++m)
#pragma unroll
                    for (int n = 0; n < 2; ++n) acc[a][b][m][n] = (f32x4){0.f, 0.f, 0.f, 0.f};
        cur = nxt; cA = nA; cB = nB; ++ui;
        if constexpr (ALIGN_EPI) { if (wr == 1) PG8_BAR; }
    }
    PG8_WAIT_V(0);
    if constexpr (!ALIGN_EPI) { if (wr == 0) PG8_BAR; }
    PG8_BAR;
    if constexpr (Epi::AFTER_DRAIN) { E.fused(acc, cur, wr, wc, fr, fq, lds, wid, lane); S.done(cur); }
#undef PG8_SA
#undef PG8_SB
#undef PG8_STAGE
#undef PG8_LDA
#undef PG8_LDB
#undef PG8_MMA
#undef PG8_WAIT_V
#undef PG8_WAIT_L
#undef PG8_BAR
#undef PG8_SCHED
}
}
#define LAS __attribute__((address_space(3)))
typedef unsigned short bf16;
typedef unsigned u32x4 __attribute__((ext_vector_type(4)));
typedef unsigned u32x2 __attribute__((ext_vector_type(2)));
typedef float f32x4 __attribute__((ext_vector_type(4)));
typedef short bf16x8 __attribute__((ext_vector_type(8)));
#define LDS_WAIT() asm volatile("s_waitcnt lgkmcnt(0)" ::: "memory")

constexpr int NWAVES = 8, NTHR = 512;
constexpr int DM = 1024, NP = 16384, NS = 512, MT = NP + NS, SEQ = 2048, DFF = 2816;
constexpr float EPS = 1e-6f;
constexpr int LDS_BYTES = 147456;

constexpr size_t al256(size_t x) { return (x + 255) & ~(size_t)255; }
constexpr size_t WS_WRI = 0;
constexpr size_t WS_WRO = WS_WRI + al256(6144ull * 1024 * 2);
constexpr size_t WS_WFI0 = WS_WRO + al256(1024ull * 2048 * 2);
constexpr size_t WS_WFO0 = WS_WFI0 + al256(5632ull * 1024 * 2);
constexpr size_t WS_WFI1 = WS_WFO0 + al256(1024ull * 2816 * 2);
constexpr size_t WS_WFO1 = WS_WFI1 + al256(5632ull * 1024 * 2);
constexpr size_t WS_WSI = WS_WFO1 + al256(1024ull * 2816 * 2);
constexpr size_t WS_WSO = WS_WSI + al256(1536ull * 1024 * 2);
constexpr size_t WS_XB = WS_WSO + al256(1024ull * 1024 * 2);
constexpr size_t WS_BIG = WS_XB + al256((size_t)MT * 1024 * 2);
constexpr size_t WS_OB = WS_BIG + al256((size_t)MT * 6144 * 2);
constexpr size_t WS_SS = WS_OB + al256((size_t)MT * 2048 * 2);
constexpr size_t WS_SSO = WS_SS + al256(4ull * MT * 4);
constexpr size_t WS_TRC = WS_SSO + al256((size_t)MT * 4 * 4);
constexpr size_t WS_TRS = WS_TRC + al256(2052ull * 128 * 4);
constexpr size_t WS_TSC = WS_TRS + al256(2052ull * 128 * 4);
constexpr size_t WS_TSS = WS_TSC + al256(2052ull * 32 * 4);
constexpr size_t WS_END = WS_TSS + al256(2052ull * 32 * 4);
constexpr size_t OUT_Y = 0, OUT_SP = (size_t)MT * 1024, OUT_SS = OUT_SP + 8ull * 4 * 256 * 512, OUT_KP = OUT_SS + 128ull * 4 * 256 * 512,
                 OUT_VP = OUT_KP + 8ull * 128 * 256, OUT_KS = OUT_VP + 8ull * 128 * 256, OUT_VS = OUT_KS + 128ull * 128 * 256, OUT_END = OUT_VS + 128ull * 128 * 256;

struct Params {
    const float* in[16]; float* out; unsigned char* ws;
    double invR[128]; double invS[32];
    float lg2[4];
    int ph_lo, ph_hi;
};

__device__ __forceinline__ unsigned f2bf(float f) { unsigned u = __builtin_bit_cast(unsigned, f); return (u + 0x7fffu + ((u >> 16) & 1u)) >> 16; }
__device__ __forceinline__ unsigned pk2(float lo, float hi) { return pg8::cvt_pk_bf16(lo, hi); }
__device__ __forceinline__ float bf2f(unsigned short b) { return __builtin_bit_cast(float, (unsigned)b << 16); }
__device__ __forceinline__ float bflo(unsigned w) { return __builtin_bit_cast(float, w << 16); }
__device__ __forceinline__ float bfhi(unsigned w) { return __builtin_bit_cast(float, w & 0xffff0000u); }
__device__ __forceinline__ float wave_sum(float v) {
#pragma unroll
    for (int o = 1; o < 64; o <<= 1) v += __shfl_xor(v, o);
    return v;
}
__device__ __forceinline__ f32x4 mfma16(bf16x8 a, bf16x8 b, f32x4 c) { return __builtin_amdgcn_mfma_f32_16x16x32_bf16(a, b, c, 0, 0, 0); }

__device__ __forceinline__ void transpose_item(const float* W, int K, int N, const float* gain, bf16* WT, int n0, int drow0, int k0, LAS float* scr, int lane) {
#pragma unroll 8
    for (int i = 0; i < 32; ++i) { const int kk = 2 * i + (lane >> 5); const float g = gain ? gain[k0 + kk] : 1.0f; scr[kk * 33 + (lane & 31)] = W[(size_t)(k0 + kk) * N + n0 + (lane & 31)] * g; }
    LDS_WAIT();
    const int c = lane & 7;
#pragma unroll
    for (int j = 0; j < 4; ++j) { const int n = (lane >> 3) + 8 * j; const LAS float* s = scr + (8 * c) * 33 + n;
        u32x4 o; o.x = pk2(s[0 * 33], s[1 * 33]); o.y = pk2(s[2 * 33], s[3 * 33]); o.z = pk2(s[4 * 33], s[5 * 33]); o.w = pk2(s[6 * 33], s[7 * 33]);
        *(u32x4*)(WT + (size_t)(drow0 + n) * K + k0 + 8 * c) = o; }
    LDS_WAIT();
}
__device__ __forceinline__ void transpose_mat(const float* W, int K, int N, const float* gain, bf16* WT, int mode, int r, LAS float* scr, int lane) {
    const int nblk = N / 32, kb = r / nblk, nb = r % nblk, n0 = 32 * nb; int d0 = n0;
    if (mode == 1) { d0 = (n0 < DFF) ? (n0 / 128) * 256 + (n0 % 128) : ((n0 - DFF) / 128) * 256 + 128 + ((n0 - DFF) % 128); }
    else if (mode == 2) { const int pn = n0 / 256, r256 = n0 % 256, wc = r256 / 64, bj = (r256 % 64) / 32; d0 = 256 * pn + 128 * bj + 32 * wc; }
    transpose_item(W, K, N, gain, WT, n0, d0, 64 * kb, scr, lane);
}
__device__ __forceinline__ void p0_prologue(const Params& p, LAS unsigned char* lds, int tid, int lane, int wave, int vcu, int G) {
    unsigned char* ws = p.ws;
    LAS float* scr = (LAS float*)(lds + wave * 16384);
    const int gw = vcu * NWAVES + wave, NGW = G * NWAVES;
    constexpr int I_RI = 16 * 192, I_RO = 32 * 32, I_FI = 16 * 176, I_FO = 44 * 32, I_SI = 16 * 48, I_SO = 16 * 32;
    constexpr int NITEMS = I_RI + I_RO + 2 * I_FI + 2 * I_FO + I_SI + I_SO;
    const float* nmix = p.in[5]; const float* nffn = p.in[6];
    for (int it = gw; it < NITEMS; it += NGW) {
        int r = it;
        if (r < I_RI) { transpose_mat(p.in[7], 1024, 6144, nmix, (bf16*)(ws + WS_WRI), 0, r, scr, lane); continue; } r -= I_RI;
        if (r < I_RO) { transpose_mat(p.in[8], 2048, 1024, nullptr, (bf16*)(ws + WS_WRO), 0, r, scr, lane); continue; } r -= I_RO;
        if (r < I_FI) { transpose_mat(p.in[14], 1024, 5632, nffn, (bf16*)(ws + WS_WFI0), 1, r, scr, lane); continue; } r -= I_FI;
        if (r < I_FO) { transpose_mat(p.in[15], 2816, 1024, nullptr, (bf16*)(ws + WS_WFO0), 0, r, scr, lane); continue; } r -= I_FO;
        if (r < I_SI) { transpose_mat(p.in[9], 1024, 1536, nmix + 1024, (bf16*)(ws + WS_WSI), 2, r, scr, lane); continue; } r -= I_SI;
        if (r < I_SO) { transpose_mat(p.in[10], 1024, 1024, nullptr, (bf16*)(ws + WS_WSO), 0, r, scr, lane); continue; } r -= I_SO;
        if (r < I_FI) { transpose_mat(p.in[14] + (size_t)1024 * 5632, 1024, 5632, nffn + 1024, (bf16*)(ws + WS_WFI1), 1, r, scr, lane); continue; } r -= I_FI;
        transpose_mat(p.in[15] + (size_t)2816 * 1024, 2816, 1024, nullptr, (bf16*)(ws + WS_WFO1), 0, r, scr, lane);
    }
    float* cR = (float*)(ws + WS_TRC); float* sR = (float*)(ws + WS_TRS); float* cS = (float*)(ws + WS_TSC); float* sS = (float*)(ws + WS_TSS);
    for (int idx = vcu * NTHR + tid; idx < 2052 * 160; idx += G * NTHR) {
        const int pi = idx / 160, c = idx % 160; const double pos = (pi < 2048) ? (double)pi : (double)(16384 + (pi - 2048));
        double rev = pos * ((c < 128) ? p.invR[c] : p.invS[c - 128]); rev -= __builtin_rint(rev);
        const float cv = __builtin_amdgcn_cosf((float)rev), sv = __builtin_amdgcn_sinf((float)rev);
        if (c < 128) { cR[pi * 128 + c] = cv; sR[pi * 128 + c] = sv; } else { cS[pi * 32 + c - 128] = cv; sS[pi * 32 + c - 128] = sv; }
    }
    bf16* XB = (bf16*)(ws + WS_XB); float* ss = (float*)(ws + WS_SS); float* sso = (float*)(ws + WS_SSO);
    for (int m = gw; m < MT; m += NGW) {
        const float* xr = (m < NP) ? p.in[0] + (size_t)m * DM : p.in[1] + (size_t)(m - NP) * DM;
        f32x4 v[4]; float s = 0.f;
#pragma unroll
        for (int j = 0; j < 4; ++j) { v[j] = ((const f32x4*)xr)[lane + 64 * j]; s += (v[j][0] * v[j][0] + v[j][1] * v[j][1]) + (v[j][2] * v[j][2] + v[j][3] * v[j][3]); }
        s = wave_sum(s);
#pragma unroll
        for (int j = 0; j < 4; ++j) { u32x2 o; o.x = pk2(v[j][0], v[j][1]); o.y = pk2(v[j][2], v[j][3]); ((u32x2*)(XB + (size_t)m * DM))[lane + 64 * j] = o; }
        if (lane == 0) { ss[m] = s; ss[MT + m] = 0.f; ss[2 * MT + m] = 0.f; ss[3 * MT + m] = 0.f; }
        if (lane < 4) sso[m * 4 + lane] = 0.f;
    }
}

constexpr int RQ_STR = 264, RV_STR = 72;
constexpr int RL_Q = 0, RL_K = 33792, RL_VT = 67584, RL_VD = 76800, RL_P = 86016, RL_ST = 95232;
__device__ __forceinline__ void ret_prompt_unit(LAS unsigned char* lds, const bf16* QKVG, bf16* OB, float* sso, float* state_out, int bh, int es, float lg2, int tid) {
    const int lane = tid & 63, w = __builtin_amdgcn_readfirstlane(tid >> 6), li = lane & 15, lq = lane >> 4;
    const int b = bh >> 2, h = bh & 3;
    LAS bf16* Ql = (LAS bf16*)(lds + RL_Q); LAS bf16* Kl = (LAS bf16*)(lds + RL_K); LAS bf16* VT = (LAS bf16*)(lds + RL_VT);
    LAS bf16* VD = (LAS bf16*)(lds + RL_VD); LAS bf16* PP = (LAS bf16*)(lds + RL_P); LAS bf16* ST = (LAS bf16*)(lds + RL_ST);
    for (int i = tid; i < 33792 / 16; i += NTHR) ((LAS u32x4*)ST)[i] = (u32x4){0u, 0u, 0u, 0u};
    f32x4 S[2][4];
#pragma unroll
    for (int a = 0; a < 2; ++a)
#pragma unroll
        for (int e = 0; e < 4; ++e) S[a][e] = (f32x4){0.f, 0.f, 0.f, 0.f};
    const size_t rowbase = (size_t)b * SEQ;
    const bf16* qg = QKVG + rowbase * 6144 + h * 256;
    const bf16* kg = qg + 1024;
    const bf16* vg = QKVG + rowbase * 6144 + 2048 + h * 512 + es * 64;
    const int srow = tid >> 5, sch = tid & 31;
    const int vrow = tid >> 3, vch = tid & 7;
    u32x4 rq[4], rk[4], rv;
#define RET_LOAD(t0_) do { _Pragma("unroll") for (int i_ = 0; i_ < 4; ++i_) { const size_t o_ = (size_t)((t0_) + srow + 16 * i_) * 6144 + sch * 8; rq[i_] = *(const u32x4*)(qg + o_); rk[i_] = *(const u32x4*)(kg + o_); } \
        rv = *(const u32x4*)(vg + (size_t)((t0_) + vrow) * 6144 + vch * 8); } while (0)
    RET_LOAD(0);
    const int ib = w >> 1, nh = w & 1;
    const float dS = __builtin_amdgcn_exp2f(64.0f * lg2);
    for (int c = 0; c < 32; ++c) {
        const int t0 = c * 64;
#pragma unroll
        for (int i = 0; i < 4; ++i) { *(LAS u32x4*)(Ql + (srow + 16 * i) * RQ_STR + sch * 8) = rq[i]; *(LAS u32x4*)(Kl + (srow + 16 * i) * RQ_STR + sch * 8) = rk[i]; }
        { const float dec = __builtin_amdgcn_exp2f((float)(63 - vrow) * lg2);
#pragma unroll
          for (int j = 0; j < 4; ++j) { const unsigned wv = rv[j]; const int e0 = vch * 8 + 2 * j;
              VT[e0 * RV_STR + vrow] = (bf16)(wv & 0xffffu); VT[(e0 + 1) * RV_STR + vrow] = (bf16)(wv >> 16);
              VD[e0 * RV_STR + vrow] = (bf16)f2bf(bflo(wv) * dec); VD[(e0 + 1) * RV_STR + vrow] = (bf16)f2bf(bfhi(wv) * dec); } }
        __syncthreads();
        if (c + 1 < 32) RET_LOAD(t0 + 64);
        f32x4 accS[2], accO[2];
#pragma unroll
        for (int t = 0; t < 2; ++t) { accS[t] = (f32x4){0.f, 0.f, 0.f, 0.f}; accO[t] = (f32x4){0.f, 0.f, 0.f, 0.f}; }
#pragma unroll
        for (int ks = 0; ks < 8; ++ks) {
            const bf16x8 a = *(const LAS bf16x8*)(Ql + (16 * ib + li) * RQ_STR + 32 * ks + 8 * lq);
#pragma unroll
            for (int t = 0; t < 2; ++t) {
                const bf16x8 bs = *(const LAS bf16x8*)(ST + (16 * (2 * nh + t) + li) * RQ_STR + 32 * ks + 8 * lq);
                accO[t] = mfma16(a, bs, accO[t]);
                if (2 * nh + t <= ib) { const bf16x8 bk = *(const LAS bf16x8*)(Kl + (16 * (2 * nh + t) + li) * RQ_STR + 32 * ks + 8 * lq); accS[t] = mfma16(a, bk, accS[t]); }
            }
        }
#pragma unroll
        for (int t = 0; t < 2; ++t) { const int jb = 2 * nh + t, j = 16 * jb + li;
#pragma unroll
            for (int r = 0; r < 4; ++r) { const int i = 16 * ib + 4 * lq + r;
                const float val = (j <= i) ? accS[t][r] * __builtin_amdgcn_exp2f((float)(i - j) * lg2) : 0.f;
                PP[i * RV_STR + j] = (bf16)f2bf(val); } }
        __syncthreads();
        f32x4 accA[2];
#pragma unroll
        for (int t = 0; t < 2; ++t) accA[t] = (f32x4){0.f, 0.f, 0.f, 0.f};
#pragma unroll
        for (int ks = 0; ks < 2; ++ks) {
            const bf16x8 a = *(const LAS bf16x8*)(PP + (16 * ib + li) * RV_STR + 32 * ks + 8 * lq);
#pragma unroll
            for (int t = 0; t < 2; ++t) { const bf16x8 bv = *(const LAS bf16x8*)(VT + (16 * (2 * nh + t) + li) * RV_STR + 32 * ks + 8 * lq); accA[t] = mfma16(a, bv, accA[t]); }
        }
#pragma unroll
        for (int r = 0; r < 4; ++r) { const int i = 16 * ib + 4 * lq + r; const float f = __builtin_amdgcn_exp2f((float)(i + 1) * lg2);
            const size_t row = rowbase + t0 + i; float q2 = 0.f;
#pragma unroll
            for (int t = 0; t < 2; ++t) { const float o = accA[t][r] + f * accO[t][r]; q2 += o * o; OB[row * 2048 + h * 512 + es * 64 + 16 * (2 * nh + t) + li] = (bf16)f2bf(o); }
            q2 += __shfl_xor(q2, 1); q2 += __shfl_xor(q2, 2); q2 += __shfl_xor(q2, 4); q2 += __shfl_xor(q2, 8);
            if (li == 0) atomicAdd(sso + row * 4 + h, q2); }
#pragma unroll
        for (int a = 0; a < 2; ++a)
#pragma unroll
            for (int e = 0; e < 4; ++e) S[a][e] = S[a][e] * dS;
#pragma unroll
        for (int ks = 0; ks < 2; ++ks) {
            bf16x8 ka[2];
#pragma unroll
            for (int dm = 0; dm < 2; ++dm)
#pragma unroll
                for (int jj = 0; jj < 8; ++jj) ka[dm][jj] = (short)Kl[(32 * ks + 8 * lq + jj) * RQ_STR + 32 * w + 16 * dm + li];
#pragma unroll
            for (int en = 0; en < 4; ++en) { const bf16x8 bv = *(const LAS bf16x8*)(VD + (16 * en + li) * RV_STR + 32 * ks + 8 * lq);
#pragma unroll
                for (int dm = 0; dm < 2; ++dm) S[dm][en] = mfma16(ka[dm], bv, S[dm][en]); }
        }
#pragma unroll
        for (int dm = 0; dm < 2; ++dm)
#pragma unroll
            for (int en = 0; en < 4; ++en) { u32x2 o; o.x = pk2(S[dm][en][0], S[dm][en][1]); o.y = pk2(S[dm][en][2], S[dm][en][3]);
                *(LAS u32x2*)(ST + (16 * en + li) * RQ_STR + 32 * w + 16 * dm + 4 * lq) = o; }
        __syncthreads();
    }
#undef RET_LOAD
    float* so = state_out + ((size_t)bh * 256) * 512 + es * 64;
#pragma unroll
    for (int dm = 0; dm < 2; ++dm)
#pragma unroll
        for (int en = 0; en < 4; ++en)
#pragma unroll
            for (int r = 0; r < 4; ++r) so[(size_t)(32 * w + 16 * dm + 4 * lq + r) * 512 + 16 * en + li] = S[dm][en][r];
}

__device__ __forceinline__ void ret_sample_unit(LAS unsigned char* lds, const bf16* QKVG, bf16* OB, const float* state_in, float* state_out, int bh, float lg2, int tid) {
    const int lane = tid & 63, w = __builtin_amdgcn_readfirstlane(tid >> 6);
    const int b = bh >> 2, h = bh & 3;
    LAS float* qk8 = (LAS float*)lds;
    LAS float* qkd = qk8 + 2048;
    LAS float* red = qkd + 16;
    LAS float* wsm = red + 8192;
    const size_t r0 = (size_t)(NP + b * 4);
    {
        const int idx = tid * 4, which = idx >> 10, t = (idx >> 8) & 3, d = idx & 255;
        const u32x2 v = *(const u32x2*)(QKVG + (r0 + t) * 6144 + which * 1024 + h * 256 + d);
        LAS float* dst = qk8 + d * 8 + which * 4 + t;
        dst[0] = bflo(v.x); dst[8] = bfhi(v.x); dst[16] = bflo(v.y); dst[24] = bfhi(v.y);
    }
    __syncthreads();
    {
#pragma unroll
        for (int pp = 0; pp < 2; ++pp) { const int pr = 2 * w + pp, i = pr >> 2, j = pr & 3; float s = 0.f;
#pragma unroll
            for (int dd = 0; dd < 4; ++dd) { const int d = lane * 4 + dd; s += qk8[d * 8 + i] * qk8[d * 8 + 4 + j]; }
            s = wave_sum(s); if (lane == 0) qkd[pr] = s; }
    }
    const float g1 = __builtin_amdgcn_exp2f(lg2), g2 = g1 * g1, g3 = g2 * g1, g4 = g2 * g2;
    const int ec = tid & 127, dg = tid >> 7;
    f32x4 vv[4];
#pragma unroll
    for (int j = 0; j < 4; ++j) { const u32x2 v = *(const u32x2*)(QKVG + (r0 + j) * 6144 + 2048 + h * 512 + 4 * ec); vv[j] = (f32x4){bflo(v.x), bfhi(v.x), bflo(v.y), bfhi(v.y)}; }
    vv[0] = vv[0] * g3; vv[1] = vv[1] * g2; vv[2] = vv[2] * g1;
    f32x4 oa[4];
#pragma unroll
    for (int i = 0; i < 4; ++i) oa[i] = (f32x4){0.f, 0.f, 0.f, 0.f};
    const float* sin_ = state_in + ((size_t)bh * 256 + dg * 64) * 512 + 4 * ec;
    float* sout = state_out + ((size_t)bh * 256 + dg * 64) * 512 + 4 * ec;
#pragma unroll 8
    for (int dd = 0; dd < 64; ++dd) {
        const f32x4 s = *(const f32x4*)(sin_ + (size_t)dd * 512);
        const f32x4 q4 = *(const LAS f32x4*)(qk8 + (dg * 64 + dd) * 8), k4 = *(const LAS f32x4*)(qk8 + (dg * 64 + dd) * 8 + 4);
        const f32x4 sn = s * g4 + vv[0] * k4[0] + vv[1] * k4[1] + vv[2] * k4[2] + vv[3] * k4[3];
        __builtin_nontemporal_store(sn, (f32x4*)(sout + (size_t)dd * 512));
        oa[0] += s * q4[0]; oa[1] += s * q4[1]; oa[2] += s * q4[2]; oa[3] += s * q4[3];
    }
#pragma unroll
    for (int i = 0; i < 4; ++i) *(LAS f32x4*)(red + (dg * 4 + i) * 512 + 4 * ec) = oa[i];
    __syncthreads();
    {
        const int e = tid; float vj[4], o[4], q2[4];
#pragma unroll
        for (int j = 0; j < 4; ++j) vj[j] = bf2f(QKVG[(r0 + j) * 6144 + 2048 + h * 512 + e]);
        const float gp[4] = {1.0f, g1, g2, g3};
#pragma unroll
        for (int i = 0; i < 4; ++i) { float ob = (red[(0 * 4 + i) * 512 + e] + red[(1 * 4 + i) * 512 + e]) + (red[(2 * 4 + i) * 512 + e] + red[(3 * 4 + i) * 512 + e]);
            float acc = ob * gp[i] * g1;
#pragma unroll
            for (int j = 0; j < 4; ++j) if (j <= i) acc += gp[i - j] * qkd[i * 4 + j] * vj[j];
            o[i] = acc; q2[i] = wave_sum(acc * acc); }
        if (lane == 0) {
#pragma unroll
            for (int i = 0; i < 4; ++i) wsm[w * 4 + i] = q2[i]; }
        __syncthreads();
#pragma unroll
        for (int i = 0; i < 4; ++i) { float t = 0.f;
#pragma unroll
            for (int ww = 0; ww < 8; ++ww) t += wsm[ww * 4 + i];
            const float rstd = __builtin_amdgcn_rsqf(t * (1.0f / 512.0f) + EPS);
            const float sg = bf2f(QKVG[(r0 + i) * 6144 + 4096 + h * 512 + e]);
            OB[(r0 + i) * 2048 + h * 512 + e] = (bf16)f2bf(o[i] * rstd * sg); }
    }
    __syncthreads();
}

__device__ __forceinline__ void ret_norm_pass(const bf16* QKVG, bf16* OB, const float* sso, int gw, int NGW, int lane) {
    for (int m = gw; m < NP; m += NGW) {
        const f32x4 s4 = *(const f32x4*)(sso + (size_t)m * 4);
#pragma unroll
        for (int j = 0; j < 4; ++j) {
            const float rstd = __builtin_amdgcn_rsqf(s4[j] * (1.0f / 512.0f) + EPS);
            u32x4 o = *(const u32x4*)(OB + (size_t)m * 2048 + 512 * j + lane * 8); const u32x4 g = *(const u32x4*)(QKVG + (size_t)m * 6144 + 4096 + 512 * j + lane * 8);
#pragma unroll
            for (int k = 0; k < 4; ++k) o[k] = pk2(bflo(o[k]) * rstd * bflo(g[k]), bfhi(o[k]) * rstd * bfhi(g[k]));
            *(u32x4*)(OB + (size_t)m * 2048 + 512 * j + lane * 8) = o;
        }
    }
}

constexpr int AK_STR = 72, AV_STR = 264, AP_STR = 168;
constexpr int AL_K = 0, AL_VT = 36864, AL_P = 70656;
__device__ __forceinline__ void attn_item(const LAS bf16* Kl, const LAS bf16* VT, LAS bf16* Pw, const bf16* qp, int jt0, const int (&lo)[4], const int (&hi)[4], const float (&sink)[4], bf16* const (&outp)[4], int li, int lq) {
    bf16x8 qa[2];
#pragma unroll
    for (int ks = 0; ks < 2; ++ks) qa[ks] = *(const bf16x8*)(qp + 32 * ks + 8 * lq);
    f32x4 sc[10];
#pragma unroll
    for (int jt = 0; jt < 10; ++jt) { sc[jt] = (f32x4){0.f, 0.f, 0.f, 0.f};
#pragma unroll
        for (int ks = 0; ks < 2; ++ks) { const bf16x8 bk = *(const LAS bf16x8*)(Kl + (16 * (jt0 + jt) + li) * AK_STR + 32 * ks + 8 * lq); sc[jt] = mfma16(qa[ks], bk, sc[jt]); } }
    float mx[4], den[4];
#pragma unroll
    for (int r = 0; r < 4; ++r) { float m = sink[r];
#pragma unroll
        for (int jt = 0; jt < 10; ++jt) { const int j = 16 * (jt0 + jt) + li; const bool ok = (j >= lo[r]) && (j <= hi[r]); sc[jt][r] = ok ? sc[jt][r] : -INFINITY; m = fmaxf(m, sc[jt][r]); }
        m = fmaxf(m, __shfl_xor(m, 1)); m = fmaxf(m, __shfl_xor(m, 2)); m = fmaxf(m, __shfl_xor(m, 4)); m = fmaxf(m, __shfl_xor(m, 8));
        float s = 0.f;
#pragma unroll
        for (int jt = 0; jt < 10; ++jt) { const float e = __expf(sc[jt][r] - m); sc[jt][r] = e; s += e; }
        s += __shfl_xor(s, 1); s += __shfl_xor(s, 2); s += __shfl_xor(s, 4); s += __shfl_xor(s, 8);
        mx[r] = m; den[r] = __builtin_amdgcn_rcpf(s + __expf(sink[r] - m)); }
#pragma unroll
    for (int jt = 0; jt < 10; ++jt)
#pragma unroll
        for (int r = 0; r < 4; ++r) Pw[(4 * lq + r) * AP_STR + 16 * jt + li] = (bf16)f2bf(sc[jt][r] * den[r]);
    LDS_WAIT();
    f32x4 oc[4];
#pragma unroll
    for (int dn = 0; dn < 4; ++dn) oc[dn] = (f32x4){0.f, 0.f, 0.f, 0.f};
#pragma unroll
    for (int ks = 0; ks < 5; ++ks) { const bf16x8 pa = *(const LAS bf16x8*)(Pw + li * AP_STR + 32 * ks + 8 * lq);
#pragma unroll
        for (int dn = 0; dn < 4; ++dn) { const bf16x8 bv = *(const LAS bf16x8*)(VT + (16 * dn + li) * AV_STR + 16 * jt0 + 32 * ks + 8 * lq); oc[dn] = mfma16(pa, bv, oc[dn]); } }
#pragma unroll
    for (int r = 0; r < 4; ++r)
#pragma unroll
        for (int dn = 0; dn < 4; ++dn) outp[r][16 * dn + li] = (bf16)f2bf(oc[dn][r]);
    LDS_WAIT();
    (void)mx;
}
__device__ __forceinline__ void attn_prompt_unit(LAS unsigned char* lds, const bf16* QKV, bf16* AO, const float* sinks, int unit, int tid) {
    const int lane = tid & 63, w = __builtin_amdgcn_readfirstlane(tid >> 6), li = lane & 15, lq = lane >> 4;
    const int kvh = unit & 3, nb = (unit >> 2) & 15, b = unit >> 6;
    LAS bf16* Kl = (LAS bf16*)(lds + AL_K); LAS bf16* VT = (LAS bf16*)(lds + AL_VT); LAS bf16* Pw = (LAS bf16*)(lds + AL_P + w * 5376);
    const size_t rowbase = (size_t)b * SEQ; const int tb = nb * 128 - 128;
#pragma unroll
    for (int i = 0; i < 4; ++i) { const int id = tid + NTHR * i, j = id >> 3, ch = id & 7; const int t = tb + j;
        u32x4 kv = (u32x4){0u, 0u, 0u, 0u}, vv = (u32x4){0u, 0u, 0u, 0u};
        if (t >= 0) { const bf16* src = QKV + (rowbase + t) * 1536 + 1024 + kvh * 64 + ch * 8; kv = *(const u32x4*)src; vv = *(const u32x4*)(src + 256); }
        *(LAS u32x4*)(Kl + j * AK_STR + ch * 8) = kv;
#pragma unroll
        for (int k = 0; k < 4; ++k) { VT[(ch * 8 + 2 * k) * AV_STR + j] = (bf16)(vv[k] & 0xffffu); VT[(ch * 8 + 2 * k + 1) * AV_STR + j] = (bf16)(vv[k] >> 16); } }
    __syncthreads();
#pragma unroll 1
    for (int it = 0; it < 4; ++it) { const int id = w * 4 + it, g = id >> 3, qt = id & 7, hq = kvh * 4 + g;
        const size_t qrow0 = rowbase + nb * 128 + 16 * qt;
        const bf16* qp = QKV + (qrow0 + li) * 1536 + hq * 64;
        int lo[4], hi[4]; float sk[4]; bf16* op[4]; const float sv = sinks[hq];
#pragma unroll
        for (int r = 0; r < 4; ++r) { const int i = 16 * qt + 4 * lq + r; lo[r] = (nb > 0) ? i : (i > 128 ? i : 128); hi[r] = i + 128; sk[r] = sv; op[r] = AO + (qrow0 + 4 * lq + r) * 1024 + hq * 64; }
        attn_item(Kl, VT, Pw, qp, qt & ~1, lo, hi, sk, op, li, lq); }
    __syncthreads();
}
__device__ __forceinline__ void attn_sample_unit(LAS unsigned char* lds, const bf16* QKV, bf16* AO, const float* sinks, const float* ck, const float* cv, float* ok, float* ov, int unit, int tid) {
    const int lane = tid & 63, w = __builtin_amdgcn_readfirstlane(tid >> 6), li = lane & 15, lq = lane >> 4;
    const int kvh = unit & 3, b = unit >> 2;
    LAS bf16* Kl = (LAS bf16*)(lds + AL_K); LAS bf16* VT = (LAS bf16*)(lds + AL_VT); LAS bf16* Pw = (LAS bf16*)(lds + AL_P);
#pragma unroll
    for (int i = 0; i < 4; ++i) { const int id = tid + NTHR * i, j = id >> 4, ch = id & 15;
        const size_t so = ((size_t)(b * 128 + j) * 4 + kvh) * 64 + ch * 4;
        const f32x4 kf = *(const f32x4*)(ck + so), vf = *(const f32x4*)(cv + so);
        if (j >= 4) { const size_t d_ = ((size_t)(b * 128 + j - 4) * 4 + kvh) * 64 + ch * 4; *(f32x4*)(ok + d_) = kf; *(f32x4*)(ov + d_) = vf; }
        u32x2 kb; kb.x = pk2(kf[0], kf[1]); kb.y = pk2(kf[2], kf[3]); *(LAS u32x2*)(Kl + j * AK_STR + ch * 4) = kb;
#pragma unroll
        for (int k = 0; k < 4; ++k) VT[(ch * 4 + k) * AV_STR + j] = (bf16)f2bf(vf[k]); }
    if (tid < 256) { const int j = 128 + (tid >> 3), ch = tid & 7;
        u32x4 kv = (u32x4){0u, 0u, 0u, 0u}, vv = (u32x4){0u, 0u, 0u, 0u};
        if (j < 132) { const bf16* src = QKV + (size_t)(NP + b * 4 + (j - 128)) * 1536 + 1024 + kvh * 64 + ch * 8; kv = *(const u32x4*)src; vv = *(const u32x4*)(src + 256); }
        *(LAS u32x4*)(Kl + j * AK_STR + ch * 8) = kv;
#pragma unroll
        for (int k = 0; k < 4; ++k) { VT[(ch * 8 + 2 * k) * AV_STR + j] = (bf16)(vv[k] & 0xffffu); VT[(ch * 8 + 2 * k + 1) * AV_STR + j] = (bf16)(vv[k] >> 16); } }
    __syncthreads();
    if (w == 0) {
        const int gA = li >> 2, tA = li & 3;
        const bf16* qp = QKV + (size_t)(NP + b * 4 + tA) * 1536 + (kvh * 4 + gA) * 64;
        int lo[4], hi[4]; float sk[4]; bf16* op[4];
#pragma unroll
        for (int r = 0; r < 4; ++r) { const int rr = 4 * lq + r, g = rr >> 2, t = rr & 3; lo[r] = t; hi[r] = t + 128; sk[r] = sinks[kvh * 4 + g]; op[r] = AO + (size_t)(NP + b * 4 + t) * 1024 + (kvh * 4 + g) * 64; }
        attn_item(Kl, VT, Pw, qp, 0, lo, hi, sk, op, li, lq);
    }
    __syncthreads();
}

__global__ void __launch_bounds__(NTHR) hybrid_fwd(Params p) {
    extern __shared__ __attribute__((aligned(16))) unsigned char lds_raw[];
    LAS unsigned char* lds = (LAS unsigned char*)lds_raw;
    cg::grid_group grid = cg::this_grid();
    const int tid = threadIdx.x, lane = tid & 63, wave = __builtin_amdgcn_readfirstlane(tid >> 6);
    const int G = gridDim.x, bx = blockIdx.x, vcu = (G % 8 == 0) ? (bx % 8) * (G / 8) + bx / 8 : bx;
    unsigned char* ws = p.ws; float* out = p.out;
    bf16* XB = (bf16*)(ws + WS_XB); bf16* BIG = (bf16*)(ws + WS_BIG); bf16* OB = (bf16*)(ws + WS_OB);
    float* ss = (float*)(ws + WS_SS); float* sso = (float*)(ws + WS_SSO);
    const int lo = p.ph_lo, hi = p.ph_hi;
#define IN(k) (lo <= (k) && (k) < hi)
#define SEAM(k) do { if (IN(k) && IN((k) + 1)) grid.sync(); } while (0)
    if (IN(0)) p0_prologue(p, lds, tid, lane, wave, vcu, G);
    SEAM(0);
    if (IN(1)) {
        pg8::Gemm g{XB, (const bf16*)(ws + WS_WRI), MT, 6144, 1024}; pg8::StaticOrder S; S.init(MT, 6144, G, bx);
        pg8::EpiRetIn E{BIG, ss, (const float*)(ws + WS_TRC), (const float*)(ws + WS_TRS)};
        pg8::gemm_phase<pg8::EpiRetIn, pg8::StaticOrder, true, true>(lds, g, S, E);
    }
    SEAM(1);
    if (IN(2)) {
        for (int u = vcu; u < 256; u += G) ret_prompt_unit(lds, BIG, OB, sso, out + OUT_SP, u >> 3, u & 7, p.lg2[(u >> 3) & 3], tid);
        __syncthreads();
        for (int u = vcu; u < 512; u += G) ret_sample_unit(lds, BIG, OB, p.in[2], out + OUT_SS, u, p.lg2[u & 3], tid);
    }
    SEAM(2);
    if (IN(3)) ret_norm_pass(BIG, OB, sso, vcu * NWAVES + wave, G * NWAVES, lane);
    SEAM(3);
    if (IN(4)) {
        pg8::Gemm g{OB, (const bf16*)(ws + WS_WRO), MT, 1024, 2048}; pg8::StaticOrder S; S.init(MT, 1024, G, bx);
        pg8::EpiRes E{p.in[0], p.in[1], out, XB, ss + MT};
        pg8::gemm_phase<pg8::EpiRes, pg8::StaticOrder, true, true>(lds, g, S, E);
    }
    SEAM(4);
    if (IN(5)) {
        pg8::Gemm g{XB, (const bf16*)(ws + WS_WFI0), MT, 5632, 1024}; pg8::StaticOrder S; S.init(MT, 5632, G, bx);
        pg8::EpiSwiglu E{BIG, ss + MT};
        pg8::gemm_phase<pg8::EpiSwiglu, pg8::StaticOrder, true, true>(lds, g, S, E);
    }
    SEAM(5);
    if (IN(6)) {
        pg8::Gemm g{BIG, (const bf16*)(ws + WS_WFO0), MT, 1024, 2816}; pg8::StaticOrder S; S.init(MT, 1024, G, bx);
        pg8::EpiRes E{out, out + (size_t)NP * DM, out, XB, ss + 2 * MT};
        pg8::gemm_phase<pg8::EpiRes, pg8::StaticOrder, true, true>(lds, g, S, E);
    }
    SEAM(6);
    if (IN(7)) {
        pg8::Gemm g{XB, (const bf16*)(ws + WS_WSI), MT, 1536, 1024}; pg8::StaticOrder S; S.init(MT, 1536, G, bx);
        pg8::EpiSwaIn E{BIG, ss + 2 * MT, (const float*)(ws + WS_TSC), (const float*)(ws + WS_TSS), p.in[11], p.in[12], out + OUT_KP, out + OUT_VP, out + OUT_KS, out + OUT_VS};
        pg8::gemm_phase<pg8::EpiSwaIn, pg8::StaticOrder, true, true>(lds, g, S, E);
    }
    SEAM(7);
    if (IN(8)) {
        for (int u = vcu; u < 512; u += G) attn_prompt_unit(lds, BIG, OB, p.in[13], u, tid);
        for (int u = vcu; u < 512; u += G) attn_sample_unit(lds, BIG, OB, p.in[13], p.in[3], p.in[4], out + OUT_KS, out + OUT_VS, u, tid);
    }
    SEAM(8);
    if (IN(9)) {
        pg8::Gemm g{OB, (const bf16*)(ws + WS_WSO), MT, 1024, 1024}; pg8::StaticOrder S; S.init(MT, 1024, G, bx);
        pg8::EpiRes E{out, out + (size_t)NP * DM, out, XB, ss + 3 * MT};
        pg8::gemm_phase<pg8::EpiRes, pg8::StaticOrder, true, true>(lds, g, S, E);
    }
    SEAM(9);
    if (IN(10)) {
        pg8::Gemm g{XB, (const bf16*)(ws + WS_WFI1), MT, 5632, 1024}; pg8::StaticOrder S; S.init(MT, 5632, G, bx);
        pg8::EpiSwiglu E{BIG, ss + 3 * MT};
        pg8::gemm_phase<pg8::EpiSwiglu, pg8::StaticOrder, true, true>(lds, g, S, E);
    }
    SEAM(10);
    if (IN(11)) {
        pg8::Gemm g{BIG, (const bf16*)(ws + WS_WFO1), MT, 1024, 2816}; pg8::StaticOrder S; S.init(MT, 1024, G, bx);
        pg8::EpiRes E{out, out + (size_t)NP * DM, out, nullptr, nullptr};
        pg8::gemm_phase<pg8::EpiRes, pg8::StaticOrder, true, true>(lds, g, S, E);
    }
#undef IN
#undef SEAM
}

#ifndef N_LAUNCHES
#define N_LAUNCHES 1
#endif
extern "C" void kernel_launch(void* const* d_in, const int* in_sizes, int n_in, void* d_out, int out_size, void* d_ws, size_t ws_size, hipStream_t stream) {
    static int grid = 0;
    if (grid == 0) {
        if (n_in != 16 || (size_t)out_size != OUT_END || ws_size < WS_END) { fprintf(stderr, "kernel_launch: unexpected shapes (n_in %d out %d ws %zu need %zu)\n", n_in, out_size, ws_size, (size_t)WS_END); grid = -1; return; }
        int dev = 0, cus = 0, per_cu = 0;
        (void)hipGetDevice(&dev); (void)hipDeviceGetAttribute(&cus, hipDeviceAttributeMultiprocessorCount, dev);
        if (hipFuncSetAttribute((const void*)hybrid_fwd, hipFuncAttributeMaxDynamicSharedMemorySize, LDS_BYTES) != hipSuccess) { fprintf(stderr, "kernel_launch: hipFuncSetAttribute failed\n"); grid = -1; return; }
        if (hipOccupancyMaxActiveBlocksPerMultiprocessor(&per_cu, (const void*)hybrid_fwd, NTHR, LDS_BYTES) != hipSuccess || per_cu < 1) { fprintf(stderr, "kernel_launch: occupancy query says %d\n", per_cu); per_cu = 1; }
        (void)hipGetLastError();
        grid = cus * 1;
        if (grid <= 0) grid = 256;
    }
    if (grid < 0) return;
    Params p; memset(&p, 0, sizeof(p));
    for (int i = 0; i < 16; ++i) p.in[i] = (const float*)d_in[i];
    p.out = (float*)d_out; p.ws = (unsigned char*)d_ws;
    const double two_pi = 6.283185307179586476925286766559;
    for (int i = 0; i < 128; ++i) p.invR[i] = 1.0 / std::pow(10000.0, (double)i / 127.0) / two_pi;
    for (int i = 0; i < 32; ++i) p.invS[i] = 1.0 / std::pow(10000.0, (double)(2 * i) / 64.0) / two_pi;
    for (int h = 0; h < 4; ++h) p.lg2[h] = (float)std::log2(1.0 - std::ldexp(1.0, -5 - h));
#if N_LAUNCHES == 1
    p.ph_lo = 0; p.ph_hi = 12;
    void* args[] = {&p};
    hipError_t e = hipLaunchCooperativeKernel((const void*)hybrid_fwd, dim3(grid), dim3(NTHR), args, LDS_BYTES, stream);
    if (e != hipSuccess) fprintf(stderr, "kernel_launch: cooperative launch failed: %s (grid %d)\n", hipGetErrorString(e), grid);
#else
    for (int ph = 0; ph < 12; ++ph) { p.ph_lo = ph; p.ph_hi = ph + 1; hipLaunchKernelGGL(hybrid_fwd, dim3(grid), dim3(NTHR), LDS_BYTES, stream, p); }
#endif
}
```

```cpp
#include <hip/hip_runtime.h>
#include <hip/hip_cooperative_groups.h>
#include <cstdio>
#include <cstdint>
#include <cmath>
#include <cstring>
namespace cg = cooperative_groups;
namespace pg8 {
#define PG8_LAS __attribute__((address_space(3)))
typedef unsigned short bf16_t;
typedef short bf16x8 __attribute__((ext_vector_type(8)));
typedef float f32x4 __attribute__((ext_vector_type(4)));
typedef unsigned u32x4 __attribute__((ext_vector_type(4)));
constexpr int BM = 256, BK = 64, HALF = 128, HTB = HALF * BK * 2  , STAGE_BYTES = 8 * HTB, NXCD = 8, WGM = 8;

__host__ __device__ __forceinline__ int lds_byte(int r, int c) { const int st = (r >> 4) * 2 + (c >> 5), rr = r & 15, cc = c & 31, ob = rr * 64 + cc * 2; return st * 1024 + (ob ^ (((ob >> 9) & 1) << 5)); }
__host__ __device__ __forceinline__ void stage_rc(int b, int& R, int& C) { const int st = b / 1024, sb = b % 1024, swz = sb ^ (((sb >> 9) & 1) << 5); R = (st >> 1) * 16 + swz / 64; C = (st & 1) * 32 + (swz % 64) / 2; }
__host__ __device__ __forceinline__ int perm32(int rho) { const int n = rho >> 4, i = rho & 15; return 8 * (i >> 2) + 4 * n + (i & 3); }

struct Unit { int pm, pn; };
struct Gemm { const bf16_t* A; const bf16_t* Bt; int M, N, K; };

struct StaticOrder {
    int nM, nN, nwg, G, c;
    __host__ __device__ void init(int M, int N, int G_, int c_) { nM = M / BM; nN = N / BM; nwg = nM * nN; G = G_; c = c_; }
    __host__ __device__ bool next(int i, Unit& u) const {
        const long L = (long)i * G + c; if (L >= nwg) return false;
        int wgid = (int)L; { const int q = nwg / NXCD, r = nwg % NXCD, xcd = wgid % NXCD, off = wgid / NXCD; wgid = (xcd < r ? xcd * (q + 1) : r * (q + 1) + (xcd - r) * q) + off; }
        const int nig = WGM * nN, gid = wgid / nig, fm = gid * WGM, gsz = (nM - fm) < WGM ? (nM - fm) : WGM;
        u.pm = fm + ((wgid % nig) % gsz); u.pn = (wgid % nig) / gsz; return true;
    }
    __device__ __forceinline__ void a_ready(const Unit&) const {}
    __device__ __forceinline__ void done(const Unit&) const {}
};

__device__ __forceinline__ unsigned cvt_pk_bf16(float lo, float hi) { unsigned r; asm volatile("v_cvt_pk_bf16_f32 %0, %1, %2" : "=v"(r) : "v"(lo), "v"(hi)); return r; }
typedef float f32x2 __attribute__((ext_vector_type(2)));
constexpr int P_NP = 16384, P_D = 1024;
constexpr float P_EPS = 1e-6f;
__device__ __forceinline__ float silu_f(float x) { return x * __builtin_amdgcn_rcpf(1.0f + __expf(-x)); }
__device__ __forceinline__ int pos_index(int row) { return row < P_NP ? (row & 2047) : 2048 + (row & 3); }
__device__ __forceinline__ u32x4 pack8(const f32x4 a, const f32x4 b) { u32x4 w; w.x = cvt_pk_bf16(a[0], a[1]); w.y = cvt_pk_bf16(a[2], a[3]); w.z = cvt_pk_bf16(b[0], b[1]); w.w = cvt_pk_bf16(b[2], b[3]); return w; }

struct EpiRetIn {
    static constexpr bool PERM = true, AFTER_DRAIN = false;
    bf16_t* O; const float* ss; const float* cosT; const float* sinT;
    __device__ __forceinline__ void operator()(const f32x4 (&acc)[2][2][4][2], const Unit& u, int wr, int wc, int fr, int fq) const {
        const int pn = u.pn, ci = wc * 32 + 8 * fq;
#pragma unroll
        for (int ai = 0; ai < 2; ++ai)
#pragma unroll
            for (int m = 0; m < 4; ++m) {
                const int row = u.pm * BM + ai * HALF + wr * 64 + m * 16 + fr;
                const float rstd = __builtin_amdgcn_rsqf(ss[row] * (1.0f / 1024.0f) + P_EPS);
                bf16_t* rowp = O + (size_t)row * 6144 + pn * 256 + ci;
                if (pn < 8) {
                    const int pidx = pos_index(row);
                    const f32x4* cp = (const f32x4*)(cosT + pidx * 128 + ci); const f32x4* sp = (const f32x4*)(sinT + pidx * 128 + ci);
                    const float sc = (pn >= 4) ? rstd * 0.0625f : rstd;
                    f32x4 o1[2], o2[2];
#pragma unroll
                    for (int n = 0; n < 2; ++n) { const f32x4 c = cp[n], s = sp[n]; const f32x4 x1 = acc[ai][0][m][n] * sc, x2 = acc[ai][1][m][n] * sc; o1[n] = x1 * c - x2 * s; o2[n] = x2 * c + x1 * s; }
                    *(u32x4*)(rowp) = pack8(o1[0], o1[1]); *(u32x4*)(rowp + HALF) = pack8(o2[0], o2[1]);
                } else if (pn < 16) {
#pragma unroll
                    for (int bj = 0; bj < 2; ++bj) *(u32x4*)(rowp + bj * HALF) = pack8(acc[ai][bj][m][0] * rstd, acc[ai][bj][m][1] * rstd);
                } else {
#pragma unroll
                    for (int bj = 0; bj < 2; ++bj) { f32x4 a = acc[ai][bj][m][0] * rstd, b = acc[ai][bj][m][1] * rstd;
#pragma unroll
                        for (int j = 0; j < 4; ++j) { a[j] = silu_f(a[j]); b[j] = silu_f(b[j]); }
                        *(u32x4*)(rowp + bj * HALF) = pack8(a, b); }
                }
            }
    }
};
struct EpiRes {
    static constexpr bool PERM = true, AFTER_DRAIN = false;
    const float* resP; const float* resS; float* out; bf16_t* xb; float* ssn;
    __device__ __forceinline__ void operator()(const f32x4 (&acc)[2][2][4][2], const Unit& u, int wr, int wc, int fr, int fq) const {
        const int col0 = u.pn * BM + wc * 32 + 8 * fq;
#pragma unroll
        for (int ai = 0; ai < 2; ++ai)
#pragma unroll
            for (int m = 0; m < 4; ++m) {
                const int row = u.pm * BM + ai * HALF + wr * 64 + m * 16 + fr;
                const float* rp = (row < P_NP ? resP + (size_t)row * P_D : resS + (size_t)(row - P_NP) * P_D) + col0;
                float* op = out + (size_t)row * P_D + col0; float s = 0.f;
#pragma unroll
                for (int bj = 0; bj < 2; ++bj) {
                    const f32x4 v0 = *(const f32x4*)(rp + bj * HALF) + acc[ai][bj][m][0], v1 = *(const f32x4*)(rp + bj * HALF + 4) + acc[ai][bj][m][1];
                    *(f32x4*)(op + bj * HALF) = v0; *(f32x4*)(op + bj * HALF + 4) = v1;
                    s += (v0[0] * v0[0] + v0[1] * v0[1]) + (v0[2] * v0[2] + v0[3] * v0[3]) + (v1[0] * v1[0] + v1[1] * v1[1]) + (v1[2] * v1[2] + v1[3] * v1[3]);
                    if (xb) *(u32x4*)(xb + (size_t)row * P_D + col0 + bj * HALF) = pack8(v0, v1);
                }
                if (ssn) { s += __shfl_xor(s, 16); s += __shfl_xor(s, 32); if (fq == 0) atomicAdd(ssn + row, s); }
            }
    }
};
struct EpiSwiglu {
    static constexpr bool PERM = true, AFTER_DRAIN = false;
    bf16_t* H; const float* ss;
    __device__ __forceinline__ void operator()(const f32x4 (&acc)[2][2][4][2], const Unit& u, int wr, int wc, int fr, int fq) const {
        const int col0 = u.pn * HALF + wc * 32 + 8 * fq;
#pragma unroll
        for (int ai = 0; ai < 2; ++ai)
#pragma unroll
            for (int m = 0; m < 4; ++m) {
                const int row = u.pm * BM + ai * HALF + wr * 64 + m * 16 + fr;
                const float rstd = __builtin_amdgcn_rsqf(ss[row] * (1.0f / 1024.0f) + P_EPS);
                f32x4 h[2];
#pragma unroll
                for (int n = 0; n < 2; ++n) { const f32x4 g = acc[ai][0][m][n] * rstd, uu = acc[ai][1][m][n] * rstd;
#pragma unroll
                    for (int j = 0; j < 4; ++j) h[n][j] = silu_f(g[j]) * uu[j]; }
                *(u32x4*)(H + (size_t)row * 2816 + col0) = pack8(h[0], h[1]);
            }
    }
};
struct EpiSwaIn {
    static constexpr bool PERM = true, AFTER_DRAIN = false;
    bf16_t* O; const float* ss; const float* cosT; const float* sinT; const float* qg; const float* kg; float* kc_p; float* vc_p; float* kc_s; float* vc_s;
    __device__ __forceinline__ void operator()(const f32x4 (&acc)[2][2][4][2], const Unit& u, int wr, int wc, int fr, int fq) const {
        const int pn = u.pn;
        const float* G = (pn < 4) ? qg : kg;
        f32x4 g1[2], g2[2];
#pragma unroll
        for (int n = 0; n < 2; ++n) { g1[n] = *(const f32x4*)(G + 8 * fq + 4 * n); g2[n] = *(const f32x4*)(G + 32 + 8 * fq + 4 * n); }
        const int cbase = (pn < 4 ? (pn * 4 + wc) * 64 : (pn == 4 ? 1024 : 1280) + wc * 64) + 8 * fq;
#pragma unroll
        for (int ai = 0; ai < 2; ++ai)
#pragma unroll
            for (int m = 0; m < 4; ++m) {
                const int row = u.pm * BM + ai * HALF + wr * 64 + m * 16 + fr;
                const float rstd = __builtin_amdgcn_rsqf(ss[row] * (1.0f / 1024.0f) + P_EPS);
                bf16_t* rowp = O + (size_t)row * 1536 + cbase;
                float* cdst = nullptr;
                if (pn >= 4) {
                    float* cp_ = (pn == 4) ? kc_p : vc_p; float* cs_ = (pn == 4) ? kc_s : vc_s;
                    if (row < P_NP) { const int b = row >> 11, t = row & 2047; if (t >= 1920) cdst = cp_ + ((size_t)(b * 128 + (t - 1920)) * 4 + wc) * 64 + 8 * fq; }
                    else { const int s_ = row - P_NP, b = s_ >> 2, t = s_ & 3; cdst = cs_ + ((size_t)(b * 128 + 124 + t) * 4 + wc) * 64 + 8 * fq; }
                }
                f32x4 o1[2], o2[2];
                if (pn < 5) {
                    f32x4 x1[2], x2[2]; float q = 0.f;
#pragma unroll
                    for (int n = 0; n < 2; ++n) { x1[n] = acc[ai][0][m][n] * rstd; x2[n] = acc[ai][1][m][n] * rstd;
                        q += (x1[n][0] * x1[n][0] + x1[n][1] * x1[n][1]) + (x1[n][2] * x1[n][2] + x1[n][3] * x1[n][3]) + (x2[n][0] * x2[n][0] + x2[n][1] * x2[n][1]) + (x2[n][2] * x2[n][2] + x2[n][3] * x2[n][3]); }
                    q += __shfl_xor(q, 16); q += __shfl_xor(q, 32);
                    const float hr = __builtin_amdgcn_rsqf(q * (1.0f / 64.0f) + P_EPS);
                    const int pidx = pos_index(row);
                    const f32x4* cp = (const f32x4*)(cosT + pidx * 32 + 8 * fq); const f32x4* sp = (const f32x4*)(sinT + pidx * 32 + 8 * fq);
                    const float osc = (pn < 4) ? 0.125f : 1.0f;
#pragma unroll
                    for (int n = 0; n < 2; ++n) { const f32x4 c = cp[n], s = sp[n]; const f32x4 a = x1[n] * hr * g1[n], b = x2[n] * hr * g2[n]; o1[n] = (a * c - b * s) * osc; o2[n] = (b * c + a * s) * osc; }
                } else {
#pragma unroll
                    for (int n = 0; n < 2; ++n) { o1[n] = acc[ai][0][m][n] * rstd; o2[n] = acc[ai][1][m][n] * rstd; }
                }
                *(u32x4*)(rowp) = pack8(o1[0], o1[1]); *(u32x4*)(rowp + 32) = pack8(o2[0], o2[1]);
                if (cdst) { *(f32x4*)(cdst) = o1[0]; *(f32x4*)(cdst + 4) = o1[1]; *(f32x4*)(cdst + 32) = o2[0]; *(f32x4*)(cdst + 36) = o2[1]; }
            }
    }
};

template <class Epi, class Sched, bool ALIGN_EPI = false, bool SP2 = false>
__device__ __forceinline__ void gemm_phase(PG8_LAS unsigned char* lds, const Gemm g, const Sched& S, const Epi& E) {
    const int tid = threadIdx.x, wid = __builtin_amdgcn_readfirstlane(tid >> 6), lane = tid & 63, wr = wid >> 2, wc = wid & 3, fr = lane & 15, fq = lane >> 4;
    const int K = g.K, nt = K / BK;
    unsigned voffA[2], voffB[2];
#pragma unroll
    for (int i = 0; i < 2; ++i) { int R, C; stage_rc(tid * 16 + i * 8192, R, C); const int Rb = Epi::PERM ? ((R & ~31) + perm32(R & 31)) : R;
        voffA[i] = (unsigned)(R * K + C) * 2u; voffB[i] = (unsigned)(Rb * K + C) * 2u; }
    const size_t kstep = (size_t)(BK * 2);
    const size_t hstep = (size_t)HALF * K * 2;
    const size_t tstep = 2 * hstep;
    const unsigned ldsw = (unsigned)wid * 1024u;
    const int aoff = lds_byte(wr * 64 + fr, fq * 8), boff = lds_byte(wc * 32 + fr, fq * 8);
#define PG8_SA(b, h) (((b) * 2 + (h)) * HTB)
#define PG8_SB(b, h) ((4 + (b) * 2 + (h)) * HTB)
#define PG8_STAGE(bufoff, gbase, voff) do { _Pragma("unroll") for (int _i = 0; _i < 2; ++_i) \
        __builtin_amdgcn_global_load_lds((const unsigned*)((const char*)(gbase) + (voff)[_i]), (PG8_LAS unsigned*)(lds + (bufoff) + ldsw + _i * 8192), 16, 0, 0); } while (0)
#define PG8_LDA(dst, b, h) do { _Pragma("unroll") for (int m = 0; m < 4; ++m) _Pragma("unroll") for (int k = 0; k < 2; ++k) dst[m][k] = *(const PG8_LAS bf16x8*)(lds + PG8_SA(b, h) + aoff + m * 2048 + k * 1024); } while (0)
#define PG8_LDB(dst, b, h) do { _Pragma("unroll") for (int n = 0; n < 2; ++n) _Pragma("unroll") for (int k = 0; k < 2; ++k) dst[n][k] = *(const PG8_LAS bf16x8*)(lds + PG8_SB(b, h) + boff + n * 2048 + k * 1024); } while (0)
#define PG8_MMA(ai, bj, At, Bt) do { __builtin_amdgcn_s_setprio(1); _Pragma("unroll") for (int m = 0; m < 4; ++m) _Pragma("unroll") for (int n = 0; n < 2; ++n) _Pragma("unroll") for (int k = 0; k < 2; ++k) \
        acc[ai][bj][m][n] = __builtin_amdgcn_mfma_f32_16x16x32_bf16(Bt[n][k], At[m][k], acc[ai][bj][m][n], 0, 0, 0); __builtin_amdgcn_s_setprio(0); } while (0)
#define PG8_WAIT_V(n) asm volatile("s_waitcnt vmcnt(" #n ")" ::: "memory")
#define PG8_WAIT_L(n) asm volatile("s_waitcnt lgkmcnt(" #n ")" ::: "memory")
#define PG8_BAR __builtin_amdgcn_s_barrier()
#define PG8_SCHED __builtin_amdgcn_sched_barrier(0)
    Unit cur, nxt; int ui = 0;
    if (!S.next(0, cur)) return;
    f32x4 acc[2][2][4][2];
#pragma unroll
    for (int a = 0; a < 2; ++a)
#pragma unroll
        for (int b = 0; b < 2; ++b)
#pragma unroll
            for (int m = 0; m < 4; ++m)
#pragma unroll
                for (int n = 0; n < 2; ++n) acc[a][b][m][n] = (f32x4){0.f, 0.f, 0.f, 0.f};
    bf16x8 At[4][2], B0[2][2], B1[2][2];
    const char* cA = (const char*)g.A + (size_t)cur.pm * tstep; const char* cB = (const char*)g.Bt + (size_t)cur.pn * tstep;
    S.a_ready(cur);
    if constexpr (SP2) {
        PG8_STAGE(PG8_SB(0, 0), cB, voffB); PG8_STAGE(PG8_SB(0, 1), cB + hstep, voffB); PG8_STAGE(PG8_SA(0, 0), cA, voffA); PG8_STAGE(PG8_SA(0, 1), cA + hstep, voffA);
        if (wr == 1) PG8_BAR;
        PG8_WAIT_V(2); PG8_BAR;
        PG8_STAGE(PG8_SB(1, 0), cB + kstep, voffB); PG8_STAGE(PG8_SA(1, 0), cA + kstep, voffA); PG8_STAGE(PG8_SB(1, 1), cB + hstep + kstep, voffB);
        PG8_WAIT_V(6); PG8_BAR;
    } else {
        PG8_STAGE(PG8_SB(0, 0), cB, voffB); PG8_STAGE(PG8_SA(0, 0), cA, voffA); PG8_STAGE(PG8_SB(0, 1), cB + hstep, voffB); PG8_STAGE(PG8_SA(0, 1), cA + hstep, voffA);
        if (wr == 1) PG8_BAR;
        PG8_WAIT_V(4); PG8_BAR;
        PG8_STAGE(PG8_SB(1, 0), cB + kstep, voffB); PG8_STAGE(PG8_SA(1, 0), cA + kstep, voffA); PG8_STAGE(PG8_SB(1, 1), cB + hstep + kstep, voffB);
        PG8_WAIT_V(6); PG8_BAR;
    }
    for (;;) {
        const bool has_next = S.next(ui + 1, nxt);
        const char* nA = has_next ? (const char*)g.A + (size_t)nxt.pm * tstep : cA; const char* nB = has_next ? (const char*)g.Bt + (size_t)nxt.pn * tstep : cB;
        for (int t = 0; t < nt; t += 2) {
            const bool last = (t == nt - 2);
            const char* a1 = cA + (size_t)(t + 1) * kstep;
            const char* a2 = last ? nA : cA + (size_t)(t + 2) * kstep; const char* b2 = last ? nB : cB + (size_t)(t + 2) * kstep;
            const char* a3 = a2 + kstep; const char* b3 = b2 + kstep;
            if (last && has_next) S.a_ready(nxt);
            if constexpr (SP2) {
            PG8_LDB(B0, 0, 0); PG8_LDB(B1, 0, 1); PG8_SCHED; PG8_LDA(At, 0, 0); PG8_STAGE(PG8_SA(1, 1), a1 + hstep, voffA);
            PG8_WAIT_V(8); PG8_WAIT_L(0); PG8_BAR; PG8_MMA(0, 0, At, B0); PG8_MMA(0, 1, At, B1); PG8_BAR; PG8_SCHED;
            PG8_LDA(At, 0, 1); PG8_STAGE(PG8_SB(0, 0), b2, voffB); PG8_STAGE(PG8_SB(0, 1), b2 + hstep, voffB); PG8_STAGE(PG8_SA(0, 0), a2, voffA);
            PG8_WAIT_V(8); PG8_WAIT_L(0); PG8_BAR; PG8_MMA(1, 0, At, B0); PG8_MMA(1, 1, At, B1); PG8_BAR; PG8_SCHED;
            PG8_LDB(B0, 1, 0); PG8_LDB(B1, 1, 1); PG8_SCHED; PG8_LDA(At, 1, 0); PG8_STAGE(PG8_SA(0, 1), a2 + hstep, voffA);
            PG8_WAIT_V(8); PG8_WAIT_L(0); PG8_BAR; PG8_MMA(0, 0, At, B0); PG8_MMA(0, 1, At, B1); PG8_BAR; PG8_SCHED;
            PG8_LDA(At, 1, 1); PG8_STAGE(PG8_SB(1, 0), b3, voffB); PG8_STAGE(PG8_SB(1, 1), b3 + hstep, voffB); PG8_STAGE(PG8_SA(1, 0), a3, voffA);
            PG8_WAIT_V(8); PG8_WAIT_L(0); PG8_BAR; PG8_MMA(1, 0, At, B0); PG8_MMA(1, 1, At, B1); PG8_BAR; PG8_SCHED;
            } else {
            PG8_LDB(B0, 0, 0); PG8_SCHED; PG8_LDA(At, 0, 0); PG8_STAGE(PG8_SA(1, 1), a1 + hstep, voffA);
            PG8_WAIT_L(8); PG8_BAR; PG8_WAIT_L(0); PG8_MMA(0, 0, At, B0); PG8_BAR; PG8_SCHED;
            PG8_LDB(B1, 0, 1); PG8_STAGE(PG8_SB(0, 0), b2, voffB);
            PG8_BAR; PG8_WAIT_L(0); PG8_MMA(0, 1, At, B1); PG8_BAR;
            PG8_LDA(At, 0, 1); PG8_STAGE(PG8_SA(0, 0), a2, voffA);
            PG8_BAR; PG8_WAIT_L(0); PG8_MMA(1, 0, At, B0); PG8_BAR; PG8_SCHED;
            PG8_STAGE(PG8_SB(0, 1), b2 + hstep, voffB);
            PG8_WAIT_V(6); PG8_BAR; PG8_MMA(1, 1, At, B1); PG8_BAR;
            PG8_LDB(B0, 1, 0); PG8_SCHED; PG8_LDA(At, 1, 0); PG8_STAGE(PG8_SA(0, 1), a2 + hstep, voffA);
            PG8_WAIT_L(8); PG8_BAR; PG8_WAIT_L(0); PG8_MMA(0, 0, At, B0); PG8_BAR; PG8_SCHED;
            PG8_LDB(B1, 1, 1); PG8_STAGE(PG8_SB(1, 0), b3, voffB);
            PG8_BAR; PG8_WAIT_L(0); PG8_MMA(0, 1, At, B1); PG8_BAR;
            PG8_LDA(At, 1, 1); PG8_STAGE(PG8_SA(1, 0), a3, voffA);
            PG8_BAR; PG8_WAIT_L(0); PG8_MMA(1, 0, At, B0); PG8_BAR; PG8_SCHED;
            PG8_STAGE(PG8_SB(1, 1), b3 + hstep, voffB);
            PG8_WAIT_V(6); PG8_BAR; PG8_MMA(1, 1, At, B1); PG8_BAR;
            }
        }
        if constexpr (ALIGN_EPI) { if (wr == 0) PG8_BAR; }
        if constexpr (!Epi::AFTER_DRAIN) { E(acc, cur, wr, wc, fr, fq); S.done(cur); }
        if (!has_next) break;
#pragma unroll
        for (int a = 0; a < 2; ++a)
#pragma unroll
            for (int b = 0; b < 2; ++b)
#pragma unroll
                for (int m = 0; m < 4; ++m)
#pragma unroll
                    for (int n = 0; n < 2; ++n) acc[a][b][m][n] = (f32x4){0.f, 0.f, 0.f, 0.f};
        cur = nxt; cA = nA; cB = nB; ++ui;
        if constexpr (ALIGN_EPI) { if (wr == 1) PG8_BAR; }
    }
    PG8_WAIT_V(0);
    if constexpr (!ALIGN_EPI) { if (wr == 0) PG8_BAR; }
    PG8_BAR;
    if constexpr (Epi::AFTER_DRAIN) { E.fused(acc, cur, wr, wc, fr, fq, lds, wid, lane); S.done(cur); }
#undef PG8_SA
#undef PG8_SB
#undef PG8_STAGE
#undef PG8_LDA
#undef PG8_LDB
#undef PG8_MMA
#undef PG8_WAIT_V
#undef PG8_WAIT_L
#undef PG8_BAR
#undef PG8_SCHED
}
}
#define LAS __attribute__((address_space(3)))
typedef unsigned short bf16;
typedef unsigned u32x4 __attribute__((ext_vector_type(4)));
typedef unsigned u32x2 __attribute__((ext_vector_type(2)));
typedef float f32x4 __attribute__((ext_vector_type(4)));
typedef short bf16x8 __attribute__((ext_vector_type(8)));
#define LDS_WAIT() asm volatile("s_waitcnt lgkmcnt(0)" ::: "memory")

constexpr int NWAVES = 8, NTHR = 512;
constexpr int DM = 1024, NP = 16384, NS = 512, MT = NP + NS, SEQ = 2048, DFF = 2816;
constexpr float EPS = 1e-6f;
constexpr int LDS_BYTES = 147456;

constexpr size_t al256(size_t x) { return (x + 255) & ~(size_t)255; }
constexpr size_t WS_WRI = 0;
constexpr size_t WS_WRO = WS_WRI + al256(6144ull * 1024 * 2);
constexpr size_t WS_WFI0 = WS_WRO + al256(1024ull * 2048 * 2);
constexpr size_t WS_WFO0 = WS_WFI0 + al256(5632ull * 1024 * 2);
constexpr size_t WS_WFI1 = WS_WFO0 + al256(1024ull * 2816 * 2);
constexpr size_t WS_WFO1 = WS_WFI1 + al256(5632ull * 1024 * 2);
constexpr size_t WS_WSI = WS_WFO1 + al256(1024ull * 2816 * 2);
constexpr size_t WS_WSO = WS_WSI + al256(1536ull * 1024 * 2);
constexpr size_t WS_XB = WS_WSO + al256(1024ull * 1024 * 2);
constexpr size_t WS_BIG = WS_XB + al256((size_t)MT * 1024 * 2);
constexpr size_t WS_OB = WS_BIG + al256((size_t)MT * 6144 * 2);
constexpr size_t WS_SS = WS_OB + al256((size_t)MT * 2048 * 2);
constexpr size_t WS_SSO = WS_SS + al256(4ull * MT * 4);
constexpr size_t WS_TRC = WS_SSO + al256((size_t)MT * 4 * 4);
constexpr size_t WS_TRS = WS_TRC + al256(2052ull * 128 * 4);
constexpr size_t WS_TSC = WS_TRS + al256(2052ull * 128 * 4);
constexpr size_t WS_TSS = WS_TSC + al256(2052ull * 32 * 4);
constexpr size_t WS_END = WS_TSS + al256(2052ull * 32 * 4);
constexpr size_t WS_CTL = WS_END, CTL_BYTES = 65536;
constexpr size_t WS_SCR = WS_CTL + CTL_BYTES;
constexpr size_t WS_TOTAL = WS_SCR;
constexpr size_t OUT_Y = 0, OUT_SP = (size_t)MT * 1024, OUT_SS = OUT_SP + 8ull * 4 * 256 * 512, OUT_KP = OUT_SS + 128ull * 4 * 256 * 512,
                 OUT_VP = OUT_KP + 8ull * 128 * 256, OUT_KS = OUT_VP + 8ull * 128 * 256, OUT_VS = OUT_KS + 128ull * 128 * 256, OUT_END = OUT_VS + 128ull * 128 * 256;

struct Params {
    const float* in[16]; float* out; unsigned char* ws;
    double invR[128]; double invS[32];
    float lg2[4];
    int ph_lo, ph_hi;
};

__device__ __forceinline__ unsigned f2bf(float f) { unsigned u = __builtin_bit_cast(unsigned, f); return (u + 0x7fffu + ((u >> 16) & 1u)) >> 16; }
__device__ __forceinline__ unsigned pk2(float lo, float hi) { return pg8::cvt_pk_bf16(lo, hi); }
__device__ __forceinline__ float bf2f(unsigned short b) { return __builtin_bit_cast(float, (unsigned)b << 16); }
__device__ __forceinline__ float bflo(unsigned w) { return __builtin_bit_cast(float, w << 16); }
__device__ __forceinline__ float bfhi(unsigned w) { return __builtin_bit_cast(float, w & 0xffff0000u); }
__device__ __forceinline__ float wave_sum(float v) {
#pragma unroll
    for (int o = 1; o < 64; o <<= 1) v += __shfl_xor(v, o);
    return v;
}
__device__ __forceinline__ f32x4 mfma16(bf16x8 a, bf16x8 b, f32x4 c) { return __builtin_amdgcn_mfma_f32_16x16x32_bf16(a, b, c, 0, 0, 0); }

__device__ __forceinline__ void transpose_item(const float* W, int K, int N, const float* gain, bf16* WT, int n0, int drow0, int k0, LAS float* scr, int lane) {
#pragma unroll 8
    for (int i = 0; i < 32; ++i) { const int kk = 2 * i + (lane >> 5); const float g = gain ? gain[k0 + kk] : 1.0f; scr[kk * 33 + (lane & 31)] = W[(size_t)(k0 + kk) * N + n0 + (lane & 31)] * g; }
    LDS_WAIT();
    const int c = lane & 7;
#pragma unroll
    for (int j = 0; j < 4; ++j) { const int n = (lane >> 3) + 8 * j; const LAS float* s = scr + (8 * c) * 33 + n;
        u32x4 o; o.x = pk2(s[0 * 33], s[1 * 33]); o.y = pk2(s[2 * 33], s[3 * 33]); o.z = pk2(s[4 * 33], s[5 * 33]); o.w = pk2(s[6 * 33], s[7 * 33]);
        *(u32x4*)(WT + (size_t)(drow0 + n) * K + k0 + 8 * c) = o; }
    LDS_WAIT();
}
__device__ __forceinline__ void transpose_mat(const float* W, int K, int N, const float* gain, bf16* WT, int mode, int r, LAS float* scr, int lane) {
    const int nblk = N / 32, kb = r / nblk, nb = r % nblk, n0 = 32 * nb; int d0 = n0;
    if (mode == 1) { d0 = (n0 < DFF) ? (n0 / 128) * 256 + (n0 % 128) : ((n0 - DFF) / 128) * 256 + 128 + ((n0 - DFF) % 128); }
    else if (mode == 2) { const int pn = n0 / 256, r256 = n0 % 256, wc = r256 / 64, bj = (r256 % 64) / 32; d0 = 256 * pn + 128 * bj + 32 * wc; }
    transpose_item(W, K, N, gain, WT, n0, d0, 64 * kb, scr, lane);
}
__device__ __forceinline__ void p0_prologue(const Params& p, LAS unsigned char* lds, int tid, int lane, int wave, int vcu, int G) {
    unsigned char* ws = p.ws;
    LAS float* scr = (LAS float*)(lds + wave * 16384);
    const int gw = vcu * NWAVES + wave, NGW = G * NWAVES;
    constexpr int I_RI = 16 * 192, I_RO = 32 * 32, I_FI = 16 * 176, I_FO = 44 * 32, I_SI = 16 * 48, I_SO = 16 * 32;
    constexpr int NITEMS = I_RI + I_RO + 2 * I_FI + 2 * I_FO + I_SI + I_SO;
    const float* nmix = p.in[5]; const float* nffn = p.in[6];
    for (int it = gw; it < NITEMS; it += NGW) {
        int r = it;
        if (r < I_RI) { transpose_mat(p.in[7], 1024, 6144, nmix, (bf16*)(ws + WS_WRI), 0, r, scr, lane); continue; } r -= I_RI;
        if (r < I_RO) { transpose_mat(p.in[8], 2048, 1024, nullptr, (bf16*)(ws + WS_WRO), 0, r, scr, lane); continue; } r -= I_RO;
        if (r < I_FI) { transpose_mat(p.in[14], 1024, 5632, nffn, (bf16*)(ws + WS_WFI0), 1, r, scr, lane); continue; } r -= I_FI;
        if (r < I_FO) { transpose_mat(p.in[15], 2816, 1024, nullptr, (bf16*)(ws + WS_WFO0), 0, r, scr, lane); continue; } r -= I_FO;
        if (r < I_SI) { transpose_mat(p.in[9], 1024, 1536, nmix + 1024, (bf16*)(ws + WS_WSI), 2, r, scr, lane); continue; } r -= I_SI;
        if (r < I_SO) { transpose_mat(p.in[10], 1024, 1024, nullptr, (bf16*)(ws + WS_WSO), 0, r, scr, lane); continue; } r -= I_SO;
        if (r < I_FI) { transpose_mat(p.in[14] + (size_t)1024 * 5632, 1024, 5632, nffn + 1024, (bf16*)(ws + WS_WFI1), 1, r, scr, lane); continue; } r -= I_FI;
        transpose_mat(p.in[15] + (size_t)2816 * 1024, 2816, 1024, nullptr, (bf16*)(ws + WS_WFO1), 0, r, scr, lane);
    }
    float* cR = (float*)(ws + WS_TRC); float* sR = (float*)(ws + WS_TRS); float* cS = (float*)(ws + WS_TSC); float* sS = (float*)(ws + WS_TSS);
    for (int idx = vcu * NTHR + tid; idx < 2052 * 160; idx += G * NTHR) {
        const int pi = idx / 160, c = idx % 160; const double pos = (pi < 2048) ? (double)pi : (double)(16384 + (pi - 2048));
        double rev = pos * ((c < 128) ? p.invR[c] : p.invS[c - 128]); rev -= __builtin_rint(rev);
        const float cv = __builtin_amdgcn_cosf((float)rev), sv = __builtin_amdgcn_sinf((float)rev);
        if (c < 128) { cR[pi * 128 + c] = cv; sR[pi * 128 + c] = sv; } else { cS[pi * 32 + c - 128] = cv; sS[pi * 32 + c - 128] = sv; }
    }
    bf16* XB = (bf16*)(ws + WS_XB); float* ss = (float*)(ws + WS_SS); float* sso = (float*)(ws + WS_SSO);
    for (int m = gw; m < MT; m += NGW) {
        const float* xr = (m < NP) ? p.in[0] + (size_t)m * DM : p.in[1] + (size_t)(m - NP) * DM;
        f32x4 v[4]; float s = 0.f;
#pragma unroll
        for (int j = 0; j < 4; ++j) { v[j] = ((const f32x4*)xr)[lane + 64 * j]; s += (v[j][0] * v[j][0] + v[j][1] * v[j][1]) + (v[j][2] * v[j][2] + v[j][3] * v[j][3]); }
        s = wave_sum(s);
#pragma unroll
        for (int j = 0; j < 4; ++j) { u32x2 o; o.x = pk2(v[j][0], v[j][1]); o.y = pk2(v[j][2], v[j][3]); ((u32x2*)(XB + (size_t)m * DM))[lane + 64 * j] = o; }
        if (lane == 0) { ss[m] = s; ss[MT + m] = 0.f; ss[2 * MT + m] = 0.f; ss[3 * MT + m] = 0.f; }
        if (lane < 4) sso[m * 4 + lane] = 0.f;
    }
}

constexpr int RQ_STR = 264, RV_STR = 72;
constexpr int RL_Q = 0, RL_K = 33792, RL_VT = 67584, RL_VD = 76800, RL_P = 86016, RL_ST = 95232;
__device__ __forceinline__ void ret_prompt_unit(LAS unsigned char* lds, const bf16* QKVG, bf16* OB, float* sso, float* state_out, int bh, int es, float lg2, int tid) {
    const int lane = tid & 63, w = __builtin_amdgcn_readfirstlane(tid >> 6), li = lane & 15, lq = lane >> 4;
    const int b = bh >> 2, h = bh & 3;
    LAS bf16* Ql = (LAS bf16*)(lds + RL_Q); LAS bf16* Kl = (LAS bf16*)(lds + RL_K); LAS bf16* VT = (LAS bf16*)(lds + RL_VT);
    LAS bf16* VD = (LAS bf16*)(lds + RL_VD); LAS bf16* PP = (LAS bf16*)(lds + RL_P); LAS bf16* ST = (LAS bf16*)(lds + RL_ST);
    for (int i = tid; i < 33792 / 16; i += NTHR) ((LAS u32x4*)ST)[i] = (u32x4){0u, 0u, 0u, 0u};
    f32x4 S[2][4];
#pragma unroll
    for (int a = 0; a < 2; ++a)
#pragma unroll
        for (int e = 0; e < 4; ++e) S[a][e] = (f32x4){0.f, 0.f, 0.f, 0.f};
    const size_t rowbase = (size_t)b * SEQ;
    const bf16* qg = QKVG + rowbase * 6144 + h * 256;
    const bf16* kg = qg + 1024;
    const bf16* vg = QKVG + rowbase * 6144 + 2048 + h * 512 + es * 64;
    const int srow = tid >> 5, sch = tid & 31;
    const int vrow = tid >> 3, vch = tid & 7;
    u32x4 rq[4], rk[4], rv;
#define RET_LOAD(t0_) do { _Pragma("unroll") for (int i_ = 0; i_ < 4; ++i_) { const size_t o_ = (size_t)((t0_) + srow + 16 * i_) * 6144 + sch * 8; rq[i_] = *(const u32x4*)(qg + o_); rk[i_] = *(const u32x4*)(kg + o_); } \
        rv = *(const u32x4*)(vg + (size_t)((t0_) + vrow) * 6144 + vch * 8); } while (0)
    RET_LOAD(0);
    const int ib = w >> 1, nh = w & 1;
    const float dS = __builtin_amdgcn_exp2f(64.0f * lg2);
    for (int c = 0; c < 32; ++c) {
        const int t0 = c * 64;
#pragma unroll
        for (int i = 0; i < 4; ++i) { *(LAS u32x4*)(Ql + (srow + 16 * i) * RQ_STR + sch * 8) = rq[i]; *(LAS u32x4*)(Kl + (srow + 16 * i) * RQ_STR + sch * 8) = rk[i]; }
        { const float dec = __builtin_amdgcn_exp2f((float)(63 - vrow) * lg2);
#pragma unroll
          for (int j = 0; j < 4; ++j) { const unsigned wv = rv[j]; const int e0 = vch * 8 + 2 * j;
              VT[e0 * RV_STR + vrow] = (bf16)(wv & 0xffffu); VT[(e0 + 1) * RV_STR + vrow] = (bf16)(wv >> 16);
              VD[e0 * RV_STR + vrow] = (bf16)f2bf(bflo(wv) * dec); VD[(e0 + 1) * RV_STR + vrow] = (bf16)f2bf(bfhi(wv) * dec); } }
        __syncthreads();
        if (c + 1 < 32) RET_LOAD(t0 + 64);
        f32x4 accS[2], accO[2];
#pragma unroll
        for (int t = 0; t < 2; ++t) { accS[t] = (f32x4){0.f, 0.f, 0.f, 0.f}; accO[t] = (f32x4){0.f, 0.f, 0.f, 0.f}; }
#pragma unroll
        for (int ks = 0; ks < 8; ++ks) {
            const bf16x8 a = *(const LAS bf16x8*)(Ql + (16 * ib + li) * RQ_STR + 32 * ks + 8 * lq);
#pragma unroll
            for (int t = 0; t < 2; ++t) {
                const bf16x8 bs = *(const LAS bf16x8*)(ST + (16 * (2 * nh + t) + li) * RQ_STR + 32 * ks + 8 * lq);
                accO[t] = mfma16(a, bs, accO[t]);
                if (2 * nh + t <= ib) { const bf16x8 bk = *(const LAS bf16x8*)(Kl + (16 * (2 * nh + t) + li) * RQ_STR + 32 * ks + 8 * lq); accS[t] = mfma16(a, bk, accS[t]); }
            }
        }
#pragma unroll
        for (int t = 0; t < 2; ++t) { const int jb = 2 * nh + t, j = 16 * jb + li;
#pragma unroll
            for (int r = 0; r < 4; ++r) { const int i = 16 * ib + 4 * lq + r;
                const float val = (j <= i) ? accS[t][r] * __builtin_amdgcn_exp2f((float)(i - j) * lg2) : 0.f;
                PP[i * RV_STR + j] = (bf16)f2bf(val); } }
        __syncthreads();
        f32x4 accA[2];
#pragma unroll
        for (int t = 0; t < 2; ++t) accA[t] = (f32x4){0.f, 0.f, 0.f, 0.f};
#pragma unroll
        for (int ks = 0; ks < 2; ++ks) {
            const bf16x8 a = *(const LAS bf16x8*)(PP + (16 * ib + li) * RV_STR + 32 * ks + 8 * lq);
#pragma unroll
            for (int t = 0; t < 2; ++t) { const bf16x8 bv = *(const LAS bf16x8*)(VT + (16 * (2 * nh + t) + li) * RV_STR + 32 * ks + 8 * lq); accA[t] = mfma16(a, bv, accA[t]); }
        }
#pragma unroll
        for (int r = 0; r < 4; ++r) { const int i = 16 * ib + 4 * lq + r; const float f = __builtin_amdgcn_exp2f((float)(i + 1) * lg2);
            const size_t row = rowbase + t0 + i; float q2 = 0.f;
#pragma unroll
            for (int t = 0; t < 2; ++t) { const float o = accA[t][r] + f * accO[t][r]; q2 += o * o; OB[row * 2048 + h * 512 + es * 64 + 16 * (2 * nh + t) + li] = (bf16)f2bf(o); }
            q2 += __shfl_xor(q2, 1); q2 += __shfl_xor(q2, 2); q2 += __shfl_xor(q2, 4); q2 += __shfl_xor(q2, 8);
            if (li == 0 && sso) atomicAdd(sso + row * 4 + h, q2); }
#pragma unroll
        for (int a = 0; a < 2; ++a)
#pragma unroll
            for (int e = 0; e < 4; ++e) S[a][e] = S[a][e] * dS;
#pragma unroll
        for (int ks = 0; ks < 2; ++ks) {
            bf16x8 ka[2];
#pragma unroll
            for (int dm = 0; dm < 2; ++dm)
#pragma unroll
                for (int jj = 0; jj < 8; ++jj) ka[dm][jj] = (short)Kl[(32 * ks + 8 * lq + jj) * RQ_STR + 32 * w + 16 * dm + li];
#pragma unroll
            for (int en = 0; en < 4; ++en) { const bf16x8 bv = *(const LAS bf16x8*)(VD + (16 * en + li) * RV_STR + 32 * ks + 8 * lq);
#pragma unroll
                for (int dm = 0; dm < 2; ++dm) S[dm][en] = mfma16(ka[dm], bv, S[dm][en]); }
        }
#pragma unroll
        for (int dm = 0; dm < 2; ++dm)
#pragma unroll
            for (int en = 0; en < 4; ++en) { u32x2 o; o.x = pk2(S[dm][en][0], S[dm][en][1]); o.y = pk2(S[dm][en][2], S[dm][en][3]);
                *(LAS u32x2*)(ST + (16 * en + li) * RQ_STR + 32 * w + 16 * dm + 4 * lq) = o; }
        __syncthreads();
    }
#undef RET_LOAD
    float* so = state_out + ((size_t)bh * 256) * 512 + es * 64;
#pragma unroll
    for (int dm = 0; dm < 2; ++dm)
#pragma unroll
        for (int en = 0; en < 4; ++en)
#pragma unroll
            for (int r = 0; r < 4; ++r) so[(size_t)(32 * w + 16 * dm + 4 * lq + r) * 512 + 16 * en + li] = S[dm][en][r];
}

__device__ __forceinline__ void ret_sample_unit(LAS unsigned char* lds, const bf16* QKVG, bf16* OB, const float* state_in, float* state_out, int bh, float lg2, int tid) {
    const int lane = tid & 63, w = __builtin_amdgcn_readfirstlane(tid >> 6);
    const int b = bh >> 2, h = bh & 3;
    LAS float* qk8 = (LAS float*)lds;
    LAS float* qkd = qk8 + 2048;
    LAS float* red = qkd + 16;
    LAS float* wsm = red + 8192;
    const size_t r0 = (size_t)(NP + b * 4);
    {
        const int idx = tid * 4, which = idx >> 10, t = (idx >> 8) & 3, d = idx & 255;
        const u32x2 v = *(const u32x2*)(QKVG + (r0 + t) * 6144 + which * 1024 + h * 256 + d);
        LAS float* dst = qk8 + d * 8 + which * 4 + t;
        dst[0] = bflo(v.x); dst[8] = bfhi(v.x); dst[16] = bflo(v.y); dst[24] = bfhi(v.y);
    }
    __syncthreads();
    {
#pragma unroll
        for (int pp = 0; pp < 2; ++pp) { const int pr = 2 * w + pp, i = pr >> 2, j = pr & 3; float s = 0.f;
#pragma unroll
            for (int dd = 0; dd < 4; ++dd) { const int d = lane * 4 + dd; s += qk8[d * 8 + i] * qk8[d * 8 + 4 + j]; }
            s = wave_sum(s); if (lane == 0) qkd[pr] = s; }
    }
    const float g1 = __builtin_amdgcn_exp2f(lg2), g2 = g1 * g1, g3 = g2 * g1, g4 = g2 * g2;
    const int ec = tid & 127, dg = tid >> 7;
    f32x4 vv[4];
#pragma unroll
    for (int j = 0; j < 4; ++j) { const u32x2 v = *(const u32x2*)(QKVG + (r0 + j) * 6144 + 2048 + h * 512 + 4 * ec); vv[j] = (f32x4){bflo(v.x), bfhi(v.x), bflo(v.y), bfhi(v.y)}; }
    vv[0] = vv[0] * g3; vv[1] = vv[1] * g2; vv[2] = vv[2] * g1;
    f32x4 oa[4];
#pragma unroll
    for (int i = 0; i < 4; ++i) oa[i] = (f32x4){0.f, 0.f, 0.f, 0.f};
    const float* sin_ = state_in + ((size_t)bh * 256 + dg * 64) * 512 + 4 * ec;
    float* sout = state_out + ((size_t)bh * 256 + dg * 64) * 512 + 4 * ec;
#pragma unroll 8
    for (int dd = 0; dd < 64; ++dd) {
        const f32x4 s = *(const f32x4*)(sin_ + (size_t)dd * 512);
        const f32x4 q4 = *(const LAS f32x4*)(qk8 + (dg * 64 + dd) * 8), k4 = *(const LAS f32x4*)(qk8 + (dg * 64 + dd) * 8 + 4);
        const f32x4 sn = s * g4 + vv[0] * k4[0] + vv[1] * k4[1] + vv[2] * k4[2] + vv[3] * k4[3];
        __builtin_nontemporal_store(sn, (f32x4*)(sout + (size_t)dd * 512));
        oa[0] += s * q4[0]; oa[1] += s * q4[1]; oa[2] += s * q4[2]; oa[3] += s * q4[3];
    }
#pragma unroll
    for (int i = 0; i < 4; ++i) *(LAS f32x4*)(red + (dg * 4 + i) * 512 + 4 * ec) = oa[i];
    __syncthreads();
    {
        const int e = tid; float vj[4], o[4], q2[4];
#pragma unroll
        for (int j = 0; j < 4; ++j) vj[j] = bf2f(QKVG[(r0 + j) * 6144 + 2048 + h * 512 + e]);
        const float gp[4] = {1.0f, g1, g2, g3};
#pragma unroll
        for (int i = 0; i < 4; ++i) { float ob = (red[(0 * 4 + i) * 512 + e] + red[(1 * 4 + i) * 512 + e]) + (red[(2 * 4 + i) * 512 + e] + red[(3 * 4 + i) * 512 + e]);
            float acc = ob * gp[i] * g1;
#pragma unroll
            for (int j = 0; j < 4; ++j) if (j <= i) acc += gp[i - j] * qkd[i * 4 + j] * vj[j];
            o[i] = acc; q2[i] = wave_sum(acc * acc); }
        if (lane == 0) {
#pragma unroll
            for (int i = 0; i < 4; ++i) wsm[w * 4 + i] = q2[i]; }
        __syncthreads();
#pragma unroll
        for (int i = 0; i < 4; ++i) { float t = 0.f;
#pragma unroll
            for (int ww = 0; ww < 8; ++ww) t += wsm[ww * 4 + i];
            const float rstd = __builtin_amdgcn_rsqf(t * (1.0f / 512.0f) + EPS);
            const float sg = bf2f(QKVG[(r0 + i) * 6144 + 4096 + h * 512 + e]);
            OB[(r0 + i) * 2048 + h * 512 + e] = (bf16)f2bf(o[i] * rstd * sg); }
    }
    __syncthreads();
}

__device__ __forceinline__ void ret_norm_pass(const bf16* QKVG, bf16* OB, const float* sso, int gw, int NGW, int lane) {
    for (int m = gw; m < NP; m += NGW) {
        const f32x4 s4 = *(const f32x4*)(sso + (size_t)m * 4);
#pragma unroll
        for (int j = 0; j < 4; ++j) {
            const float rstd = __builtin_amdgcn_rsqf(s4[j] * (1.0f / 512.0f) + EPS);
            u32x4 o = *(const u32x4*)(OB + (size_t)m * 2048 + 512 * j + lane * 8); const u32x4 g = *(const u32x4*)(QKVG + (size_t)m * 6144 + 4096 + 512 * j + lane * 8);
#pragma unroll
            for (int k = 0; k < 4; ++k) o[k] = pk2(bflo(o[k]) * rstd * bflo(g[k]), bfhi(o[k]) * rstd * bfhi(g[k]));
            *(u32x4*)(OB + (size_t)m * 2048 + 512 * j + lane * 8) = o;
        }
    }
}

constexpr int AK_STR = 72, AV_STR = 264, AP_STR = 168;
constexpr int AL_K = 0, AL_VT = 36864, AL_P = 70656;
__device__ __forceinline__ void attn_item(const LAS bf16* Kl, const LAS bf16* VT, LAS bf16* Pw, const bf16* qp, int jt0, const int (&lo)[4], const int (&hi)[4], const float (&sink)[4], bf16* const (&outp)[4], int li, int lq) {
    bf16x8 qa[2];
#pragma unroll
    for (int ks = 0; ks < 2; ++ks) qa[ks] = *(const bf16x8*)(qp + 32 * ks + 8 * lq);
    f32x4 sc[10];
#pragma unroll
    for (int jt = 0; jt < 10; ++jt) { sc[jt] = (f32x4){0.f, 0.f, 0.f, 0.f};
#pragma unroll
        for (int ks = 0; ks < 2; ++ks) { const bf16x8 bk = *(const LAS bf16x8*)(Kl + (16 * (jt0 + jt) + li) * AK_STR + 32 * ks + 8 * lq); sc[jt] = mfma16(qa[ks], bk, sc[jt]); } }
    float mx[4], den[4];
#pragma unroll
    for (int r = 0; r < 4; ++r) { float m = sink[r];
#pragma unroll
        for (int jt = 0; jt < 10; ++jt) { const int j = 16 * (jt0 + jt) + li; const bool ok = (j >= lo[r]) && (j <= hi[r]); sc[jt][r] = ok ? sc[jt][r] : -INFINITY; m = fmaxf(m, sc[jt][r]); }
        m = fmaxf(m, __shfl_xor(m, 1)); m = fmaxf(m, __shfl_xor(m, 2)); m = fmaxf(m, __shfl_xor(m, 4)); m = fmaxf(m, __shfl_xor(m, 8));
        float s = 0.f;
#pragma unroll
        for (int jt = 0; jt < 10; ++jt) { const float e = __expf(sc[jt][r] - m); sc[jt][r] = e; s += e; }
        s += __shfl_xor(s, 1); s += __shfl_xor(s, 2); s += __shfl_xor(s, 4); s += __shfl_xor(s, 8);
        mx[r] = m; den[r] = __builtin_amdgcn_rcpf(s + __expf(sink[r] - m)); }
#pragma unroll
    for (int jt = 0; jt < 10; ++jt)
#pragma unroll
        for (int r = 0; r < 4; ++r) Pw[(4 * lq + r) * AP_STR + 16 * jt + li] = (bf16)f2bf(sc[jt][r] * den[r]);
    LDS_WAIT();
    f32x4 oc[4];
#pragma unroll
    for (int dn = 0; dn < 4; ++dn) oc[dn] = (f32x4){0.f, 0.f, 0.f, 0.f};
#pragma unroll
    for (int ks = 0; ks < 5; ++ks) { const bf16x8 pa = *(const LAS bf16x8*)(Pw + li * AP_STR + 32 * ks + 8 * lq);
#pragma unroll
        for (int dn = 0; dn < 4; ++dn) { const bf16x8 bv = *(const LAS bf16x8*)(VT + (16 * dn + li) * AV_STR + 16 * jt0 + 32 * ks + 8 * lq); oc[dn] = mfma16(pa, bv, oc[dn]); } }
#pragma unroll
    for (int r = 0; r < 4; ++r)
#pragma unroll
        for (int dn = 0; dn < 4; ++dn) outp[r][16 * dn + li] = (bf16)f2bf(oc[dn][r]);
    LDS_WAIT();
    (void)mx;
}
__device__ __forceinline__ void attn_prompt_unit(LAS unsigned char* lds, const bf16* QKV, bf16* AO, const float* sinks, int unit, int tid) {
    const int lane = tid & 63, w = __builtin_amdgcn_readfirstlane(tid >> 6), li = lane & 15, lq = lane >> 4;
    const int kvh = unit & 3, nb = (unit >> 2) & 15, b = unit >> 6;
    LAS bf16* Kl = (LAS bf16*)(lds + AL_K); LAS bf16* VT = (LAS bf16*)(lds + AL_VT); LAS bf16* Pw = (LAS bf16*)(lds + AL_P + w * 5376);
    const size_t rowbase = (size_t)b * SEQ; const int tb = nb * 128 - 128;
#pragma unroll
    for (int i = 0; i < 4; ++i) { const int id = tid + NTHR * i, j = id >> 3, ch = id & 7; const int t = tb + j;
        u32x4 kv = (u32x4){0u, 0u, 0u, 0u}, vv = (u32x4){0u, 0u, 0u, 0u};
        if (t >= 0) { const bf16* src = QKV + (rowbase + t) * 1536 + 1024 + kvh * 64 + ch * 8; kv = *(const u32x4*)src; vv = *(const u32x4*)(src + 256); }
        *(LAS u32x4*)(Kl + j * AK_STR + ch * 8) = kv;
#pragma unroll
        for (int k = 0; k < 4; ++k) { VT[(ch * 8 + 2 * k) * AV_STR + j] = (bf16)(vv[k] & 0xffffu); VT[(ch * 8 + 2 * k + 1) * AV_STR + j] = (bf16)(vv[k] >> 16); } }
    __syncthreads();
#pragma unroll 1
    for (int it = 0; it < 4; ++it) { const int id = w * 4 + it, g = id >> 3, qt = id & 7, hq = kvh * 4 + g;
        const size_t qrow0 = rowbase + nb * 128 + 16 * qt;
        const bf16* qp = QKV + (qrow0 + li) * 1536 + hq * 64;
        int lo[4], hi[4]; float sk[4]; bf16* op[4]; const float sv = sinks[hq];
#pragma unroll
        for (int r = 0; r < 4; ++r) { const int i = 16 * qt + 4 * lq + r; lo[r] = (nb > 0) ? i : (i > 128 ? i : 128); hi[r] = i + 128; sk[r] = sv; op[r] = AO + (qrow0 + 4 * lq + r) * 1024 + hq * 64; }
        attn_item(Kl, VT, Pw, qp, qt & ~1, lo, hi, sk, op, li, lq); }
    __syncthreads();
}
__device__ __forceinline__ void attn_sample_unit(LAS unsigned char* lds, const bf16* QKV, bf16* AO, const float* sinks, const float* ck, const float* cv, float* ok, float* ov, int unit, int tid) {
    const int lane = tid & 63, w = __builtin_amdgcn_readfirstlane(tid >> 6), li = lane & 15, lq = lane >> 4;
    const int kvh = unit & 3, b = unit >> 2;
    LAS bf16* Kl = (LAS bf16*)(lds + AL_K); LAS bf16* VT = (LAS bf16*)(lds + AL_VT); LAS bf16* Pw = (LAS bf16*)(lds + AL_P);
#pragma unroll
    for (int i = 0; i < 4; ++i) { const int id = tid + NTHR * i, j = id >> 4, ch = id & 15;
        const size_t so = ((size_t)(b * 128 + j) * 4 + kvh) * 64 + ch * 4;
        const f32x4 kf = *(const f32x4*)(ck + so), vf = *(const f32x4*)(cv + so);
        if (j >= 4) { const size_t d_ = ((size_t)(b * 128 + j - 4) * 4 + kvh) * 64 + ch * 4; *(f32x4*)(ok + d_) = kf; *(f32x4*)(ov + d_) = vf; }
        u32x2 kb; kb.x = pk2(kf[0], kf[1]); kb.y = pk2(kf[2], kf[3]); *(LAS u32x2*)(Kl + j * AK_STR + ch * 4) = kb;
#pragma unroll
        for (int k = 0; k < 4; ++k) VT[(ch * 4 + k) * AV_STR + j] = (bf16)f2bf(vf[k]); }
    if (tid < 256) { const int j = 128 + (tid >> 3), ch = tid & 7;
        u32x4 kv = (u32x4){0u, 0u, 0u, 0u}, vv = (u32x4){0u, 0u, 0u, 0u};
        if (j < 132) { const bf16* src = QKV + (size_t)(NP + b * 4 + (j - 128)) * 1536 + 1024 + kvh * 64 + ch * 8; kv = *(const u32x4*)src; vv = *(const u32x4*)(src + 256); }
        *(LAS u32x4*)(Kl + j * AK_STR + ch * 8) = kv;
#pragma unroll
        for (int k = 0; k < 4; ++k) { VT[(ch * 8 + 2 * k) * AV_STR + j] = (bf16)(vv[k] & 0xffffu); VT[(ch * 8 + 2 * k + 1) * AV_STR + j] = (bf16)(vv[k] >> 16); } }
    __syncthreads();
    if (w == 0) {
        const int gA = li >> 2, tA = li & 3;
        const bf16* qp = QKV + (size_t)(NP + b * 4 + tA) * 1536 + (kvh * 4 + gA) * 64;
        int lo[4], hi[4]; float sk[4]; bf16* op[4];
#pragma unroll
        for (int r = 0; r < 4; ++r) { const int rr = 4 * lq + r, g = rr >> 2, t = rr & 3; lo[r] = t; hi[r] = t + 128; sk[r] = sinks[kvh * 4 + g]; op[r] = AO + (size_t)(NP + b * 4 + t) * 1024 + (kvh * 4 + g) * 64; }
        attn_item(Kl, VT, Pw, qp, 0, lo, hi, sk, op, li, lq);
    }
    __syncthreads();
}

#define XB_TMO      128
#define XB_XCNT(j)  (256  + 64 * (j))
#define XB_XSUB(j)  (1280 + 64 * (j))
#define XB_XGEN(j)  (2304 + 64 * (j))
#define XB_TOP      3328
#define XB_TOPGEN   3392
#define XCD_BAR_WORDS 3456
#define XB_SPIN_CAP (1u << 18)

__device__ __forceinline__ unsigned xb_ld(unsigned* p)              { return __hip_atomic_load(p, __ATOMIC_RELAXED, __HIP_MEMORY_SCOPE_AGENT); }
__device__ __forceinline__ unsigned xb_add(unsigned* p, unsigned v) { return __hip_atomic_fetch_add(p, v, __ATOMIC_RELAXED, __HIP_MEMORY_SCOPE_AGENT); }
__device__ __forceinline__ unsigned xb_xcc_id() { return (unsigned)__builtin_amdgcn_s_getreg((3 << 11) | 20) & 0xFu; }
#define XB_SPIN(cond, bar) do { unsigned _sp = 0; while (cond) { __builtin_amdgcn_s_sleep(1); \
    if ((++_sp & 255u) == 0u) { if (xb_ld(&(bar)[XB_TMO])) break; if (_sp > XB_SPIN_CAP) { atomicAdd(&(bar)[XB_TMO], 1u); break; } } } } while (0)

struct XcdBarrier {
    unsigned* bar; unsigned x;
    volatile LAS unsigned* st;
};

__device__ __forceinline__ XcdBarrier xcd_barrier_post(unsigned* bar, volatile LAS unsigned* st) {
    XcdBarrier b; b.bar = bar; b.x = xb_xcc_id(); b.st = st;
    if (threadIdx.x == 0) (void)xb_add(&bar[XB_XCNT(b.x)], 1u);
    return b;
}
__device__ __forceinline__ void xcd_barrier_complete(unsigned* bar, unsigned x, unsigned& nloc, unsigned& nx) {
    const unsigned G = gridDim.x * gridDim.y * gridDim.z;
    unsigned sum, cnt, mine, sp = 0u;
    for (;;) {
        sum = 0u; cnt = 0u; mine = 0u;
#pragma unroll
        for (unsigned j = 0; j < 16; ++j) { const unsigned c = xb_ld(&bar[XB_XCNT(j)]); sum += c; cnt += (c > 0u) ? 1u : 0u; mine = (j == x) ? c : mine; }
        if (sum == G) break;
        __builtin_amdgcn_s_sleep(1);
        if ((++sp & 255u) == 0u) { if (xb_ld(&bar[XB_TMO])) break; if (sp > XB_SPIN_CAP) { atomicAdd(&bar[XB_TMO], 1u); break; } }
    }
    nloc = mine > 0u ? mine : 1u; nx = cnt > 0u ? cnt : 1u;
}

__device__ __forceinline__ void xcd_barrier(const XcdBarrier& b) {
    asm volatile("s_waitcnt vmcnt(0)" ::: "memory");
    __syncthreads();
    if (threadIdx.x == 0) {
        unsigned* bar = b.bar;
        __builtin_amdgcn_s_waitcnt(0);
        unsigned nloc = b.st[0], nx = b.st[1];
        if (nloc == 0u) { xcd_barrier_complete(bar, b.x, nloc, nx); b.st[0] = nloc; b.st[1] = nx; }
        const unsigned old = xb_add(&bar[XB_XSUB(b.x)], 1u);
        const unsigned gen = old / nloc;
        if (old + 1u == (gen + 1u) * nloc) {
            __builtin_amdgcn_fence(__ATOMIC_RELEASE, "agent");
            asm volatile("s_waitcnt vmcnt(0)" ::: "memory");
            const unsigned og = xb_add(&bar[XB_TOP], 1u);
            const unsigned tg = og / nx;
            if (og + 1u == (tg + 1u) * nx) xb_add(&bar[XB_TOPGEN], 1u);
            else XB_SPIN(xb_ld(&bar[XB_TOPGEN]) == tg, bar);
            __builtin_amdgcn_fence(__ATOMIC_ACQUIRE, "agent");
            xb_add(&bar[XB_XGEN(b.x)], 1u);
            asm volatile("s_waitcnt vmcnt(0)" ::: "memory");
        } else {
            XB_SPIN(xb_ld(&bar[XB_XGEN(b.x)]) == gen, bar);
            __builtin_amdgcn_fence(__ATOMIC_ACQUIRE, "agent");
            asm volatile("s_waitcnt vmcnt(0)" ::: "memory");
        }
    }
    __syncthreads();
}

#ifndef PROBE_DUP
#define PROBE_DUP 0
#endif
__global__ void __launch_bounds__(NTHR) hybrid_fwd(Params p) {
    extern __shared__ __attribute__((aligned(16))) unsigned char lds_raw[];
    LAS unsigned char* lds = (LAS unsigned char*)lds_raw;
    cg::grid_group grid = cg::this_grid();
    const int tid = threadIdx.x, lane = tid & 63, wave = __builtin_amdgcn_readfirstlane(tid >> 6);
    const int G = gridDim.x, bx = blockIdx.x, vcu = (G % 8 == 0) ? (bx % 8) * (G / 8) + bx / 8 : bx;
    unsigned char* ws = p.ws; float* out = p.out;
    bf16* XB = (bf16*)(ws + WS_XB); bf16* BIG = (bf16*)(ws + WS_BIG); bf16* OB = (bf16*)(ws + WS_OB);
    float* ss = (float*)(ws + WS_SS); float* sso = (float*)(ws + WS_SSO);
    const int lo = p.ph_lo, hi = p.ph_hi;
    volatile LAS unsigned* bst = (volatile LAS unsigned*)(lds + LDS_BYTES - 64);
    if (tid < 2) bst[tid] = 0u;
    __syncthreads();
    XcdBarrier bar = xcd_barrier_post((unsigned*)(ws + WS_CTL), bst);
#define IN(k) (lo <= (k) && (k) < hi)
#define SEAM(k) do { if (IN(k) && IN((k) + 1)) { if ((k) == 0) grid.sync(); else xcd_barrier(bar); } } while (0)
    if (IN(0)) { p0_prologue(p, lds, tid, lane, wave, vcu, G);
#if PROBE_DUP & 1
        __syncthreads(); p0_prologue(p, lds, tid, lane, wave, vcu, G);
#endif
    }
    SEAM(0);
    if (IN(1)) {
        pg8::Gemm g{XB, (const bf16*)(ws + WS_WRI), MT, 6144, 1024}; pg8::StaticOrder S; S.init(MT, 6144, G, bx);
        pg8::EpiRetIn E{BIG, ss, (const float*)(ws + WS_TRC), (const float*)(ws + WS_TRS)};
        pg8::gemm_phase<pg8::EpiRetIn, pg8::StaticOrder, true, true>(lds, g, S, E);
    }
    SEAM(1);
    if (IN(2)) {
#if PROBE_DUP & 2
        for (int u = vcu; u < 256; u += G) ret_prompt_unit(lds, BIG, OB, nullptr, out + OUT_SP, u >> 3, u & 7, p.lg2[(u >> 3) & 3], tid);
        __syncthreads();
#endif
        for (int u = vcu; u < 256; u += G) ret_prompt_unit(lds, BIG, OB, sso, out + OUT_SP, u >> 3, u & 7, p.lg2[(u >> 3) & 3], tid);
        __syncthreads();
#if PROBE_DUP & 4
        for (int u = vcu; u < 512; u += G) ret_sample_unit(lds, BIG, OB, p.in[2], out + OUT_SS, u, p.lg2[u & 3], tid);
#endif
        for (int u = vcu; u < 512; u += G) ret_sample_unit(lds, BIG, OB, p.in[2], out + OUT_SS, u, p.lg2[u & 3], tid);
    }
    SEAM(2);
    if (IN(3)) ret_norm_pass(BIG, OB, sso, vcu * NWAVES + wave, G * NWAVES, lane);
    SEAM(3);
    if (IN(4)) {
        pg8::Gemm g{OB, (const bf16*)(ws + WS_WRO), MT, 1024, 2048}; pg8::StaticOrder S; S.init(MT, 1024, G, bx);
        pg8::EpiRes E{p.in[0], p.in[1], out, XB, ss + MT};
        pg8::gemm_phase<pg8::EpiRes, pg8::StaticOrder, true, true>(lds, g, S, E);
    }
    SEAM(4);
    if (IN(5)) {
        pg8::Gemm g{XB, (const bf16*)(ws + WS_WFI0), MT, 5632, 1024}; pg8::StaticOrder S; S.init(MT, 5632, G, bx);
        pg8::EpiSwiglu E{BIG, ss + MT};
        pg8::gemm_phase<pg8::EpiSwiglu, pg8::StaticOrder, true, true>(lds, g, S, E);
#if PROBE_DUP & 64
        __syncthreads();
        pg8::gemm_phase<pg8::EpiSwiglu, pg8::StaticOrder, true, true>(lds, g, S, E);
#endif
    }
    SEAM(5);
#if PROBE_DUP & 256
    for (int k_ = 0; k_ < 10; ++k_) grid.sync();
#endif
    if (IN(6)) {
        pg8::Gemm g{BIG, (const bf16*)(ws + WS_WFO0), MT, 1024, 2816}; pg8::StaticOrder S; S.init(MT, 1024, G, bx);
#if PROBE_DUP & 128
        { pg8::EpiRes E2{out, out + (size_t)NP * DM, (float*)(ws + WS_SCR), (bf16*)(ws + WS_SCR + (size_t)MT * 4096), nullptr};
          pg8::gemm_phase<pg8::EpiRes, pg8::StaticOrder, true, true>(lds, g, S, E2); __syncthreads(); }
#endif
        pg8::EpiRes E{out, out + (size_t)NP * DM, out, XB, ss + 2 * MT};
        pg8::gemm_phase<pg8::EpiRes, pg8::StaticOrder, true, true>(lds, g, S, E);
    }
    SEAM(6);
    if (IN(7)) {
        pg8::Gemm g{XB, (const bf16*)(ws + WS_WSI), MT, 1536, 1024}; pg8::StaticOrder S; S.init(MT, 1536, G, bx);
        pg8::EpiSwaIn E{BIG, ss + 2 * MT, (const float*)(ws + WS_TSC), (const float*)(ws + WS_TSS), p.in[11], p.in[12], out + OUT_KP, out + OUT_VP, out + OUT_KS, out + OUT_VS};
        pg8::gemm_phase<pg8::EpiSwaIn, pg8::StaticOrder, true, true>(lds, g, S, E);
    }
    SEAM(7);
    if (IN(8)) {
#if PROBE_DUP & 16
        for (int u = vcu; u < 512; u += G) attn_prompt_unit(lds, BIG, OB, p.in[13], u, tid);
#endif
#if PROBE_DUP & 32
        for (int u = vcu; u < 512; u += G) attn_sample_unit(lds, BIG, OB, p.in[13], p.in[3], p.in[4], out + OUT_KS, out + OUT_VS, u, tid);
#endif
        for (int u = vcu; u < 512; u += G) attn_prompt_unit(lds, BIG, OB, p.in[13], u, tid);
        for (int u = vcu; u < 512; u += G) attn_sample_unit(lds, BIG, OB, p.in[13], p.in[3], p.in[4], out + OUT_KS, out + OUT_VS, u, tid);
    }
    SEAM(8);
    if (IN(9)) {
        pg8::Gemm g{OB, (const bf16*)(ws + WS_WSO), MT, 1024, 1024}; pg8::StaticOrder S; S.init(MT, 1024, G, bx);
        pg8::EpiRes E{out, out + (size_t)NP * DM, out, XB, ss + 3 * MT};
        pg8::gemm_phase<pg8::EpiRes, pg8::StaticOrder, true, true>(lds, g, S, E);
    }
    SEAM(9);
    if (IN(10)) {
        pg8::Gemm g{XB, (const bf16*)(ws + WS_WFI1), MT, 5632, 1024}; pg8::StaticOrder S; S.init(MT, 5632, G, bx);
        pg8::EpiSwiglu E{BIG, ss + 3 * MT};
        pg8::gemm_phase<pg8::EpiSwiglu, pg8::StaticOrder, true, true>(lds, g, S, E);
    }
    SEAM(10);
    if (IN(11)) {
        pg8::Gemm g{BIG, (const bf16*)(ws + WS_WFO1), MT, 1024, 2816}; pg8::StaticOrder S; S.init(MT, 1024, G, bx);
        pg8::EpiRes E{out, out + (size_t)NP * DM, out, nullptr, nullptr};
        pg8::gemm_phase<pg8::EpiRes, pg8::StaticOrder, true, true>(lds, g, S, E);
    }
#undef IN
#undef SEAM
}

#ifndef N_LAUNCHES
#define N_LAUNCHES 1
#endif
extern "C" void kernel_launch(void* const* d_in, const int* in_sizes, int n_in, void* d_out, int out_size, void* d_ws, size_t ws_size, hipStream_t stream) {
    static int grid = 0;
    if (grid == 0) {
        if (n_in != 16 || (size_t)out_size != OUT_END || ws_size < WS_TOTAL) { fprintf(stderr, "kernel_launch: unexpected shapes (n_in %d out %d ws %zu need %zu)\n", n_in, out_size, ws_size, (size_t)WS_TOTAL); grid = -1; return; }
        int dev = 0, cus = 0, per_cu = 0;
        (void)hipGetDevice(&dev); (void)hipDeviceGetAttribute(&cus, hipDeviceAttributeMultiprocessorCount, dev);
        if (hipFuncSetAttribute((const void*)hybrid_fwd, hipFuncAttributeMaxDynamicSharedMemorySize, LDS_BYTES) != hipSuccess) { fprintf(stderr, "kernel_launch: hipFuncSetAttribute failed\n"); grid = -1; return; }
        if (hipOccupancyMaxActiveBlocksPerMultiprocessor(&per_cu, (const void*)hybrid_fwd, NTHR, LDS_BYTES) != hipSuccess || per_cu < 1) { fprintf(stderr, "kernel_launch: occupancy query says %d\n", per_cu); per_cu = 1; }
        (void)hipGetLastError();
        grid = cus * 1;
        if (grid <= 0) grid = 256;
    }
    if (grid < 0) return;
    if (hipMemsetAsync((char*)d_ws + WS_CTL, 0, CTL_BYTES, stream) != hipSuccess) { fprintf(stderr, "kernel_launch: memset failed\n"); return; }
    Params p; memset(&p, 0, sizeof(p));
    for (int i = 0; i < 16; ++i) p.in[i] = (const float*)d_in[i];
    p.out = (float*)d_out; p.ws = (unsigned char*)d_ws;
    const double two_pi = 6.283185307179586476925286766559;
    for (int i = 0; i < 128; ++i) p.invR[i] = 1.0 / std::pow(10000.0, (double)i / 127.0) / two_pi;
    for (int i = 0; i < 32; ++i) p.invS[i] = 1.0 / std::pow(10000.0, (double)(2 * i) / 64.0) / two_pi;
    for (int h = 0; h < 4; ++h) p.lg2[h] = (float)std::log2(1.0 - std::ldexp(1.0, -5 - h));
#if N_LAUNCHES == 1
    p.ph_lo = 0; p.ph_hi = 12;
    void* args[] = {&p};
    hipError_t e = hipLaunchCooperativeKernel((const void*)hybrid_fwd, dim3(grid), dim3(NTHR), args, LDS_BYTES, stream);
    if (e != hipSuccess) fprintf(stderr, "kernel_launch: cooperative launch failed: %s (grid %d)\n", hipGetErrorString(e), grid);
#else
    for (int ph = 0; ph < 12; ++ph) { p.ph_lo = ph; p.ph_hi = ph + 1; hipLaunchKernelGGL(hybrid_fwd, dim3(grid), dim3(NTHR), LDS_BYTES, stream, p); }
#endif
}
```

```cpp
#include <hip/hip_runtime.h>
#include <hip/hip_cooperative_groups.h>
#include <cstdio>
#include <cstdint>
#include <cmath>
#include <cstring>
namespace cg = cooperative_groups;
namespace pg8 {
#define PG8_LAS __attribute__((address_space(3)))
typedef unsigned short bf16_t;
typedef short bf16x8 __attribute__((ext_vector_type(8)));
typedef float f32x4 __attribute__((ext_vector_type(4)));
typedef unsigned u32x4 __attribute__((ext_vector_type(4)));
constexpr int BM = 256, BK = 64, HALF = 128, HTB = HALF * BK * 2  , STAGE_BYTES = 8 * HTB, NXCD = 8, WGM = 8;

__host__ __device__ __forceinline__ int lds_byte(int r, int c) { const int st = (r >> 4) * 2 + (c >> 5), rr = r & 15, cc = c & 31, ob = rr * 64 + cc * 2; return st * 1024 + (ob ^ (((ob >> 9) & 1) << 5)); }
__host__ __device__ __forceinline__ void stage_rc(int b, int& R, int& C) { const int st = b / 1024, sb = b % 1024, swz = sb ^ (((sb >> 9) & 1) << 5); R = (st >> 1) * 16 + swz / 64; C = (st & 1) * 32 + (swz % 64) / 2; }
__host__ __device__ __forceinline__ int perm32(int rho) { const int n = rho >> 4, i = rho & 15; return 8 * (i >> 2) + 4 * n + (i & 3); }

struct Unit { int pm, pn; };
struct Gemm { const bf16_t* A; const bf16_t* Bt; int M, N, K; };

struct StaticOrder {
    int nM, nN, nwg, G, c;
    __host__ __device__ void init(int M, int N, int G_, int c_) { nM = M / BM; nN = N / BM; nwg = nM * nN; G = G_; c = c_; }
    __host__ __device__ bool next(int i, Unit& u) const {
        const long L = (long)i * G + c; if (L >= nwg) return false;
        int wgid = (int)L; { const int q = nwg / NXCD, r = nwg % NXCD, xcd = wgid % NXCD, off = wgid / NXCD; wgid = (xcd < r ? xcd * (q + 1) : r * (q + 1) + (xcd - r) * q) + off; }
        const int nig = WGM * nN, gid = wgid / nig, fm = gid * WGM, gsz = (nM - fm) < WGM ? (nM - fm) : WGM;
        u.pm = fm + ((wgid % nig) % gsz); u.pn = (wgid % nig) / gsz; return true;
    }
    __device__ __forceinline__ void a_ready(const Unit&) const {}
    __device__ __forceinline__ void done(const Unit&) const {}
};

__device__ __forceinline__ unsigned cvt_pk_bf16(float lo, float hi) { unsigned r; asm volatile("v_cvt_pk_bf16_f32 %0, %1, %2" : "=v"(r) : "v"(lo), "v"(hi)); return r; }
typedef float f32x2 __attribute__((ext_vector_type(2)));
constexpr int P_NP = 16384, P_D = 1024;
constexpr float P_EPS = 1e-6f;
__device__ __forceinline__ float silu_f(float x) { return x * __builtin_amdgcn_rcpf(1.0f + __expf(-x)); }
__device__ __forceinline__ int pos_index(int row) { return row < P_NP ? (row & 2047) : 2048 + (row & 3); }
__device__ __forceinline__ u32x4 pack8(const f32x4 a, const f32x4 b) { u32x4 w; w.x = cvt_pk_bf16(a[0], a[1]); w.y = cvt_pk_bf16(a[2], a[3]); w.z = cvt_pk_bf16(b[0], b[1]); w.w = cvt_pk_bf16(b[2], b[3]); return w; }

struct EpiRetIn {
    static constexpr bool PERM = true, AFTER_DRAIN = false;
    bf16_t* O; const float* ss; const float* cosT; const float* sinT;
    __device__ __forceinline__ void operator()(const f32x4 (&acc)[2][2][4][2], const Unit& u, int wr, int wc, int fr, int fq) const {
        const int pn = u.pn, ci = wc * 32 + 8 * fq;
#pragma unroll
        for (int ai = 0; ai < 2; ++ai)
#pragma unroll
            for (int m = 0; m < 4; ++m) {
                const int row = u.pm * BM + ai * HALF + wr * 64 + m * 16 + fr;
                const float rstd = __builtin_amdgcn_rsqf(ss[row] * (1.0f / 1024.0f) + P_EPS);
                bf16_t* rowp = O + (size_t)row * 6144 + pn * 256 + ci;
                if (pn < 8) {
                    const int pidx = pos_index(row);
                    const f32x4* cp = (const f32x4*)(cosT + pidx * 128 + ci); const f32x4* sp = (const f32x4*)(sinT + pidx * 128 + ci);
                    const float sc = (pn >= 4) ? rstd * 0.0625f : rstd;
                    f32x4 o1[2], o2[2];
#pragma unroll
                    for (int n = 0; n < 2; ++n) { const f32x4 c = cp[n], s = sp[n]; const f32x4 x1 = acc[ai][0][m][n] * sc, x2 = acc[ai][1][m][n] * sc; o1[n] = x1 * c - x2 * s; o2[n] = x2 * c + x1 * s; }
                    *(u32x4*)(rowp) = pack8(o1[0], o1[1]); *(u32x4*)(rowp + HALF) = pack8(o2[0], o2[1]);
                } else if (pn < 16) {
#pragma unroll
                    for (int bj = 0; bj < 2; ++bj) *(u32x4*)(rowp + bj * HALF) = pack8(acc[ai][bj][m][0] * rstd, acc[ai][bj][m][1] * rstd);
                } else {
#pragma unroll
                    for (int bj = 0; bj < 2; ++bj) { f32x4 a = acc[ai][bj][m][0] * rstd, b = acc[ai][bj][m][1] * rstd;
#pragma unroll
                        for (int j = 0; j < 4; ++j) { a[j] = silu_f(a[j]); b[j] = silu_f(b[j]); }
                        *(u32x4*)(rowp + bj * HALF) = pack8(a, b); }
                }
            }
    }
};
struct EpiRes {
    static constexpr bool PERM = true, AFTER_DRAIN = false;
    const float* resP; const float* resS; float* out; bf16_t* xb; float* ssn;
    __device__ __forceinline__ void operator()(const f32x4 (&acc)[2][2][4][2], const Unit& u, int wr, int wc, int fr, int fq) const {
        const int col0 = u.pn * BM + wc * 32 + 8 * fq;
#pragma unroll
        for (int ai = 0; ai < 2; ++ai)
#pragma unroll
            for (int m = 0; m < 4; ++m) {
                const int row = u.pm * BM + ai * HALF + wr * 64 + m * 16 + fr;
                const float* rp = (row < P_NP ? resP + (size_t)row * P_D : resS + (size_t)(row - P_NP) * P_D) + col0;
                float* op = out + (size_t)row * P_D + col0; float s = 0.f;
#pragma unroll
                for (int bj = 0; bj < 2; ++bj) {
                    const f32x4 v0 = *(const f32x4*)(rp + bj * HALF) + acc[ai][bj][m][0], v1 = *(const f32x4*)(rp + bj * HALF + 4) + acc[ai][bj][m][1];
                    *(f32x4*)(op + bj * HALF) = v0; *(f32x4*)(op + bj * HALF + 4) = v1;
                    s += (v0[0] * v0[0] + v0[1] * v0[1]) + (v0[2] * v0[2] + v0[3] * v0[3]) + (v1[0] * v1[0] + v1[1] * v1[1]) + (v1[2] * v1[2] + v1[3] * v1[3]);
                    if (xb) *(u32x4*)(xb + (size_t)row * P_D + col0 + bj * HALF) = pack8(v0, v1);
                }
                if (ssn) { s += __shfl_xor(s, 16); s += __shfl_xor(s, 32); if (fq == 0) atomicAdd(ssn + row, s); }
            }
    }
};
struct EpiSwiglu {
    static constexpr bool PERM = true, AFTER_DRAIN = false;
    bf16_t* H; const float* ss;
    __device__ __forceinline__ void operator()(const f32x4 (&acc)[2][2][4][2], const Unit& u, int wr, int wc, int fr, int fq) const {
        const int col0 = u.pn * HALF + wc * 32 + 8 * fq;
#pragma unroll
        for (int ai = 0; ai < 2; ++ai)
#pragma unroll
            for (int m = 0; m < 4; ++m) {
                const int row = u.pm * BM + ai * HALF + wr * 64 + m * 16 + fr;
                const float rstd = __builtin_amdgcn_rsqf(ss[row] * (1.0f / 1024.0f) + P_EPS);
                f32x4 h[2];
#pragma unroll
                for (int n = 0; n < 2; ++n) { const f32x4 g = acc[ai][0][m][n] * rstd, uu = acc[ai][1][m][n] * rstd;
#pragma unroll
                    for (int j = 0; j < 4; ++j) h[n][j] = silu_f(g[j]) * uu[j]; }
                *(u32x4*)(H + (size_t)row * 2816 + col0) = pack8(h[0], h[1]);
            }
    }
};
struct EpiSwaIn {
    static constexpr bool PERM = true, AFTER_DRAIN = false;
    bf16_t* O; const float* ss; const float* cosT; const float* sinT; const float* qg; const float* kg; float* kc_p; float* vc_p; float* kc_s; float* vc_s;
    __device__ __forceinline__ void operator()(const f32x4 (&acc)[2][2][4][2], const Unit& u, int wr, int wc, int fr, int fq) const {
        const int pn = u.pn;
        const float* G = (pn < 4) ? qg : kg;
        f32x4 g1[2], g2[2];
#pragma unroll
        for (int n = 0; n < 2; ++n) { g1[n] = *(const f32x4*)(G + 8 * fq + 4 * n); g2[n] = *(const f32x4*)(G + 32 + 8 * fq + 4 * n); }
        const int cbase = (pn < 4 ? (pn * 4 + wc) * 64 : (pn == 4 ? 1024 : 1280) + wc * 64) + 8 * fq;
#pragma unroll
        for (int ai = 0; ai < 2; ++ai)
#pragma unroll
            for (int m = 0; m < 4; ++m) {
                const int row = u.pm * BM + ai * HALF + wr * 64 + m * 16 + fr;
                const float rstd = __builtin_amdgcn_rsqf(ss[row] * (1.0f / 1024.0f) + P_EPS);
                bf16_t* rowp = O + (size_t)row * 1536 + cbase;
                float* cdst = nullptr;
                if (pn >= 4) {
                    float* cp_ = (pn == 4) ? kc_p : vc_p; float* cs_ = (pn == 4) ? kc_s : vc_s;
                    if (row < P_NP) { const int b = row >> 11, t = row & 2047; if (t >= 1920) cdst = cp_ + ((size_t)(b * 128 + (t - 1920)) * 4 + wc) * 64 + 8 * fq; }
                    else { const int s_ = row - P_NP, b = s_ >> 2, t = s_ & 3; cdst = cs_ + ((size_t)(b * 128 + 124 + t) * 4 + wc) * 64 + 8 * fq; }
                }
                f32x4 o1[2], o2[2];
                if (pn < 5) {
                    f32x4 x1[2], x2[2]; float q = 0.f;
#pragma unroll
                    for (int n = 0; n < 2; ++n) { x1[n] = acc[ai][0][m][n] * rstd; x2[n] = acc[ai][1][m][n] * rstd;
                        q += (x1[n][0] * x1[n][0] + x1[n][1] * x1[n][1]) + (x1[n][2] * x1[n][2] + x1[n][3] * x1[n][3]) + (x2[n][0] * x2[n][0] + x2[n][1] * x2[n][1]) + (x2[n][2] * x2[n][2] + x2[n][3] * x2[n][3]); }
                    q += __shfl_xor(q, 16); q += __shfl_xor(q, 32);
                    const float hr = __builtin_amdgcn_rsqf(q * (1.0f / 64.0f) + P_EPS);
                    const int pidx = pos_index(row);
                    const f32x4* cp = (const f32x4*)(cosT + pidx * 32 + 8 * fq); const f32x4* sp = (const f32x4*)(sinT + pidx * 32 + 8 * fq);
                    const float osc = (pn < 4) ? 0.125f : 1.0f;
#pragma unroll
                    for (int n = 0; n < 2; ++n) { const f32x4 c = cp[n], s = sp[n]; const f32x4 a = x1[n] * hr * g1[n], b = x2[n] * hr * g2[n]; o1[n] = (a * c - b * s) * osc; o2[n] = (b * c + a * s) * osc; }
                } else {
#pragma unroll
                    for (int n = 0; n < 2; ++n) { o1[n] = acc[ai][0][m][n] * rstd; o2[n] = acc[ai][1][m][n] * rstd; }
                }
                *(u32x4*)(rowp) = pack8(o1[0], o1[1]); *(u32x4*)(rowp + 32) = pack8(o2[0], o2[1]);
                if (cdst) { *(f32x4*)(cdst) = o1[0]; *(f32x4*)(cdst + 4) = o1[1]; *(f32x4*)(cdst + 32) = o2[0]; *(f32x4*)(cdst + 36) = o2[1]; }
            }
    }
};

template <class Epi, class Sched, bool ALIGN_EPI = false, bool SP2 = false>
__device__ __forceinline__ void gemm_phase(PG8_LAS unsigned char* lds, const Gemm g, const Sched& S, const Epi& E) {
    const int tid = threadIdx.x, wid = __builtin_amdgcn_readfirstlane(tid >> 6), lane = tid & 63, wr = wid >> 2, wc = wid & 3, fr = lane & 15, fq = lane >> 4;
    const int K = g.K, nt = K / BK;
    unsigned voffA[2], voffB[2];
#pragma unroll
    for (int i = 0; i < 2; ++i) { int R, C; stage_rc(tid * 16 + i * 8192, R, C); const int Rb = Epi::PERM ? ((R & ~31) + perm32(R & 31)) : R;
        voffA[i] = (unsigned)(R * K + C) * 2u; voffB[i] = (unsigned)(Rb * K + C) * 2u; }
    const size_t kstep = (size_t)(BK * 2);
    const size_t hstep = (size_t)HALF * K * 2;
    const size_t tstep = 2 * hstep;
    const unsigned ldsw = (unsigned)wid * 1024u;
    const int aoff = lds_byte(wr * 64 + fr, fq * 8), boff = lds_byte(wc * 32 + fr, fq * 8);
#define PG8_SA(b, h) (((b) * 2 + (h)) * HTB)
#define PG8_SB(b, h) ((4 + (b) * 2 + (h)) * HTB)
#define PG8_STAGE(bufoff, gbase, voff) do { _Pragma("unroll") for (int _i = 0; _i < 2; ++_i) \
        __builtin_amdgcn_global_load_lds((const unsigned*)((const char*)(gbase) + (voff)[_i]), (PG8_LAS unsigned*)(lds + (bufoff) + ldsw + _i * 8192), 16, 0, 0); } while (0)
#define PG8_LDA(dst, b, h) do { _Pragma("unroll") for (int m = 0; m < 4; ++m) _Pragma("unroll") for (int k = 0; k < 2; ++k) dst[m][k] = *(const PG8_LAS bf16x8*)(lds + PG8_SA(b, h) + aoff + m * 2048 + k * 1024); } while (0)
#define PG8_LDB(dst, b, h) do { _Pragma("unroll") for (int n = 0; n < 2; ++n) _Pragma("unroll") for (int k = 0; k < 2; ++k) dst[n][k] = *(const PG8_LAS bf16x8*)(lds + PG8_SB(b, h) + boff + n * 2048 + k * 1024); } while (0)
#define PG8_MMA(ai, bj, At, Bt) do { __builtin_amdgcn_s_setprio(1); _Pragma("unroll") for (int m = 0; m < 4; ++m) _Pragma("unroll") for (int n = 0; n < 2; ++n) _Pragma("unroll") for (int k = 0; k < 2; ++k) \
        acc[ai][bj][m][n] = __builtin_amdgcn_mfma_f32_16x16x32_bf16(Bt[n][k], At[m][k], acc[ai][bj][m][n], 0, 0, 0); __builtin_amdgcn_s_setprio(0); } while (0)
#define PG8_WAIT_V(n) asm volatile("s_waitcnt vmcnt(" #n ")" ::: "memory")
#define PG8_WAIT_L(n) asm volatile("s_waitcnt lgkmcnt(" #n ")" ::: "memory")
#define PG8_BAR __builtin_amdgcn_s_barrier()
#define PG8_SCHED __builtin_amdgcn_sched_barrier(0)
    Unit cur, nxt; int ui = 0;
    if (!S.next(0, cur)) return;
    f32x4 acc[2][2][4][2];
#pragma unroll
    for (int a = 0; a < 2; ++a)
#pragma unroll
        for (int b = 0; b < 2; ++b)
#pragma unroll
            for (int m = 0; m < 4; ++m)
#pragma unroll
                for (int n = 0; n < 2; ++n) acc[a][b][m][n] = (f32x4){0.f, 0.f, 0.f, 0.f};
    bf16x8 At[4][2], B0[2][2], B1[2][2];
    const char* cA = (const char*)g.A + (size_t)cur.pm * tstep; const char* cB = (const char*)g.Bt + (size_t)cur.pn * tstep;
    S.a_ready(cur);
    if constexpr (SP2) {
        PG8_STAGE(PG8_SB(0, 0), cB, voffB); PG8_STAGE(PG8_SB(0, 1), cB + hstep, voffB); PG8_STAGE(PG8_SA(0, 0), cA, voffA); PG8_STAGE(PG8_SA(0, 1), cA + hstep, voffA);
        if (wr == 1) PG8_BAR;
        PG8_WAIT_V(2); PG8_BAR;
        PG8_STAGE(PG8_SB(1, 0), cB + kstep, voffB); PG8_STAGE(PG8_SA(1, 0), cA + kstep, voffA); PG8_STAGE(PG8_SB(1, 1), cB + hstep + kstep, voffB);
        PG8_WAIT_V(6); PG8_BAR;
    } else {
        PG8_STAGE(PG8_SB(0, 0), cB, voffB); PG8_STAGE(PG8_SA(0, 0), cA, voffA); PG8_STAGE(PG8_SB(0, 1), cB + hstep, voffB); PG8_STAGE(PG8_SA(0, 1), cA + hstep, voffA);
        if (wr == 1) PG8_BAR;
        PG8_WAIT_V(4); PG8_BAR;
        PG8_STAGE(PG8_SB(1, 0), cB + kstep, voffB); PG8_STAGE(PG8_SA(1, 0), cA + kstep, voffA); PG8_STAGE(PG8_SB(1, 1), cB + hstep + kstep, voffB);
        PG8_WAIT_V(6); PG8_BAR;
    }
    for (;;) {
        const bool has_next = S.next(ui + 1, nxt);
        const char* nA = has_next ? (const char*)g.A + (size_t)nxt.pm * tstep : cA; const char* nB = has_next ? (const char*)g.Bt + (size_t)nxt.pn * tstep : cB;
        for (int t = 0; t < nt; t += 2) {
            const bool last = (t == nt - 2);
            const char* a1 = cA + (size_t)(t + 1) * kstep;
            const char* a2 = last ? nA : cA + (size_t)(t + 2) * kstep; const char* b2 = last ? nB : cB + (size_t)(t + 2) * kstep;
            const char* a3 = a2 + kstep; const char* b3 = b2 + kstep;
            if (last && has_next) S.a_ready(nxt);
            if constexpr (SP2) {
            PG8_LDB(B0, 0, 0); PG8_LDB(B1, 0, 1); PG8_SCHED; PG8_LDA(At, 0, 0); PG8_STAGE(PG8_SA(1, 1), a1 + hstep, voffA);
            PG8_WAIT_V(8); PG8_WAIT_L(0); PG8_BAR; PG8_MMA(0, 0, At, B0); PG8_MMA(0, 1, At, B1); PG8_BAR; PG8_SCHED;
            PG8_LDA(At, 0, 1); PG8_STAGE(PG8_SB(0, 0), b2, voffB); PG8_STAGE(PG8_SB(0, 1), b2 + hstep, voffB); PG8_STAGE(PG8_SA(0, 0), a2, voffA);
            PG8_WAIT_V(8); PG8_WAIT_L(0); PG8_BAR; PG8_MMA(1, 0, At, B0); PG8_MMA(1, 1, At, B1); PG8_BAR; PG8_SCHED;
            PG8_LDB(B0, 1, 0); PG8_LDB(B1, 1, 1); PG8_SCHED; PG8_LDA(At, 1, 0); PG8_STAGE(PG8_SA(0, 1), a2 + hstep, voffA);
            PG8_WAIT_V(8); PG8_WAIT_L(0); PG8_BAR; PG8_MMA(0, 0, At, B0); PG8_MMA(0, 1, At, B1); PG8_BAR; PG8_SCHED;
            PG8_LDA(At, 1, 1); PG8_STAGE(PG8_SB(1, 0), b3, voffB); PG8_STAGE(PG8_SB(1, 1), b3 + hstep, voffB); PG8_STAGE(PG8_SA(1, 0), a3, voffA);
            PG8_WAIT_V(8); PG8_WAIT_L(0); PG8_BAR; PG8_MMA(1, 0, At, B0); PG8_MMA(1, 1, At, B1); PG8_BAR; PG8_SCHED;
            } else {
            PG8_LDB(B0, 0, 0); PG8_SCHED; PG8_LDA(At, 0, 0); PG8_STAGE(PG8_SA(1, 1), a1 + hstep, voffA);
            PG8_WAIT_L(8); PG8_BAR; PG8_WAIT_L(0); PG8_MMA(0, 0, At, B0); PG8_BAR; PG8_SCHED;
            PG8_LDB(B1, 0, 1); PG8_STAGE(PG8_SB(0, 0), b2, voffB);
            PG8_BAR; PG8_WAIT_L(0); PG8_MMA(0, 1, At, B1); PG8_BAR;
            PG8_LDA(At, 0, 1); PG8_STAGE(PG8_SA(0, 0), a2, voffA);
            PG8_BAR; PG8_WAIT_L(0); PG8_MMA(1, 0, At, B0); PG8_BAR; PG8_SCHED;
            PG8_STAGE(PG8_SB(0, 1), b2 + hstep, voffB);
            PG8_WAIT_V(6); PG8_BAR; PG8_MMA(1, 1, At, B1); PG8_BAR;
            PG8_LDB(B0, 1, 0); PG8_SCHED; PG8_LDA(At, 1, 0); PG8_STAGE(PG8_SA(0, 1), a2 + hstep, voffA);
            PG8_WAIT_L(8); PG8_BAR; PG8_WAIT_L(0); PG8_MMA(0, 0, At, B0); PG8_BAR; PG8_SCHED;
            PG8_LDB(B1, 1, 1); PG8_STAGE(PG8_SB(1, 0), b3, voffB);
            PG8_BAR; PG8_WAIT_L(0); PG8_MMA(0, 1, At, B1); PG8_BAR;
            PG8_LDA(At, 1, 1); PG8_STAGE(PG8_SA(1, 0), a3, voffA);
            PG8_BAR; PG8_WAIT_L(0); PG8_MMA(1, 0, At, B0); PG8_BAR; PG8_SCHED;
            PG8_STAGE(PG8_SB(1, 1), b3 + hstep, voffB);
            PG8_WAIT_V(6); PG8_BAR; PG8_MMA(1, 1, At, B1); PG8_BAR;
            }
        }
        if constexpr (ALIGN_EPI) { if (wr == 0) PG8_BAR; }
        if constexpr (!Epi::AFTER_DRAIN) { E(acc, cur, wr, wc, fr, fq); S.done(cur); }
        if (!has_next) break;
#pragma unroll
        for (int a = 0; a < 2; ++a)
#pragma unroll
            for (int b = 0; b < 2; ++b)
#pragma unroll
                for (int m = 0; m < 4; ++m)
#pragma unroll
                    for (int n = 0; n < 2; ++n) acc[a][b][m][n] = (f32x4){0.f, 0.f, 0.f, 0.f};
        cur = nxt; cA = nA; cB = nB; ++ui;
        if constexpr (ALIGN_EPI) { if (wr == 1) PG8_BAR; }
    }
    PG8_WAIT_V(0);
    if constexpr (!ALIGN_EPI) { if (wr == 0) PG8_BAR; }
    PG8_BAR;
    if constexpr (Epi::AFTER_DRAIN) { E.fused(acc, cur, wr, wc, fr, fq, lds, wid, lane); S.done(cur); }
#undef PG8_SA
#undef PG8_SB
#undef PG8_STAGE
#undef PG8_LDA
#undef PG8_LDB
#undef PG8_MMA
#undef PG8_WAIT_V
#undef PG8_WAIT_L
#undef PG8_BAR
#undef PG8_SCHED
}
}
#define LAS __attribute__((address_space(3)))
typedef unsigned short bf16;
typedef unsigned u32x4 __attribute__((ext_vector_type(4)));
typedef unsigned u32x2 __attribute__((ext_vector_type(2)));
typedef float f32x4 __attribute__((ext_vector_type(4)));
typedef short bf16x8 __attribute__((ext_vector_type(8)));
#define LDS_WAIT() asm volatile("s_waitcnt lgkmcnt(0)" ::: "memory")

constexpr int NWAVES = 8, NTHR = 512;
constexpr int DM = 1024, NP = 16384, NS = 512, MT = NP + NS, SEQ = 2048, DFF = 2816;
constexpr float EPS = 1e-6f;
constexpr int LDS_BYTES = 147456;

constexpr size_t al256(size_t x) { return (x + 255) & ~(size_t)255; }
constexpr size_t WS_WRI = 0;
constexpr size_t WS_WRO = WS_WRI + al256(6144ull * 1024 * 2);
constexpr size_t WS_WFI0 = WS_WRO + al256(1024ull * 2048 * 2);
constexpr size_t WS_WFO0 = WS_WFI0 + al256(5632ull * 1024 * 2);
constexpr size_t WS_WFI1 = WS_WFO0 + al256(1024ull * 2816 * 2);
constexpr size_t WS_WFO1 = WS_WFI1 + al256(5632ull * 1024 * 2);
constexpr size_t WS_WSI = WS_WFO1 + al256(1024ull * 2816 * 2);
constexpr size_t WS_WSO = WS_WSI + al256(1536ull * 1024 * 2);
constexpr size_t WS_XB = WS_WSO + al256(1024ull * 1024 * 2);
constexpr size_t WS_BIG = WS_XB + al256((size_t)MT * 1024 * 2);
constexpr size_t WS_OB = WS_BIG + al256((size_t)MT * 6144 * 2);
constexpr size_t WS_SS = WS_OB + al256((size_t)MT * 2048 * 2);
constexpr size_t WS_SSO = WS_SS + al256(4ull * MT * 4);
constexpr size_t WS_TRC = WS_SSO + al256((size_t)MT * 4 * 4);
constexpr size_t WS_TRS = WS_TRC + al256(2052ull * 128 * 4);
constexpr size_t WS_TSC = WS_TRS + al256(2052ull * 128 * 4);
constexpr size_t WS_TSS = WS_TSC + al256(2052ull * 32 * 4);
constexpr size_t WS_END = WS_TSS + al256(2052ull * 32 * 4);
constexpr size_t WS_CTL = WS_END, CTL_BYTES = 65536;
constexpr size_t WS_SCR = WS_CTL + CTL_BYTES;
constexpr size_t WS_TOTAL = WS_SCR;
constexpr size_t OUT_Y = 0, OUT_SP = (size_t)MT * 1024, OUT_SS = OUT_SP + 8ull * 4 * 256 * 512, OUT_KP = OUT_SS + 128ull * 4 * 256 * 512,
                 OUT_VP = OUT_KP + 8ull * 128 * 256, OUT_KS = OUT_VP + 8ull * 128 * 256, OUT_VS = OUT_KS + 128ull * 128 * 256, OUT_END = OUT_VS + 128ull * 128 * 256;

struct Params {
    const float* in[16]; float* out; unsigned char* ws;
    double invR[128]; double invS[32];
    float lg2[4];
    int ph_lo, ph_hi;
};

__device__ __forceinline__ unsigned f2bf(float f) { unsigned u = __builtin_bit_cast(unsigned, f); return (u + 0x7fffu + ((u >> 16) & 1u)) >> 16; }
__device__ __forceinline__ unsigned pk2(float lo, float hi) { return pg8::cvt_pk_bf16(lo, hi); }
__device__ __forceinline__ float bf2f(unsigned short b) { return __builtin_bit_cast(float, (unsigned)b << 16); }
__device__ __forceinline__ float bflo(unsigned w) { return __builtin_bit_cast(float, w << 16); }
__device__ __forceinline__ float bfhi(unsigned w) { return __builtin_bit_cast(float, w & 0xffff0000u); }
__device__ __forceinline__ float wave_sum(float v) {
#pragma unroll
    for (int o = 1; o < 64; o <<= 1) v += __shfl_xor(v, o);
    return v;
}
__device__ __forceinline__ f32x4 mfma16(bf16x8 a, bf16x8 b, f32x4 c) { return __builtin_amdgcn_mfma_f32_16x16x32_bf16(a, b, c, 0, 0, 0); }

__device__ __forceinline__ void transpose_item(const float* W, int K, int N, const float* gain, bf16* WT, int n0, int drow0, int k0, LAS float* scr, int lane) {
#pragma unroll 8
    for (int i = 0; i < 32; ++i) { const int kk = 2 * i + (lane >> 5); const float g = gain ? gain[k0 + kk] : 1.0f; scr[kk * 33 + (lane & 31)] = W[(size_t)(k0 + kk) * N + n0 + (lane & 31)] * g; }
    LDS_WAIT();
    const int c = lane & 7;
#pragma unroll
    for (int j = 0; j < 4; ++j) { const int n = (lane >> 3) + 8 * j; const LAS float* s = scr + (8 * c) * 33 + n;
        u32x4 o; o.x = pk2(s[0 * 33], s[1 * 33]); o.y = pk2(s[2 * 33], s[3 * 33]); o.z = pk2(s[4 * 33], s[5 * 33]); o.w = pk2(s[6 * 33], s[7 * 33]);
        *(u32x4*)(WT + (size_t)(drow0 + n) * K + k0 + 8 * c) = o; }
    LDS_WAIT();
}
__device__ __forceinline__ void transpose_mat(const float* W, int K, int N, const float* gain, bf16* WT, int mode, int r, LAS float* scr, int lane) {
    const int nblk = N / 32, kb = r / nblk, nb = r % nblk, n0 = 32 * nb; int d0 = n0;
    if (mode == 1) { d0 = (n0 < DFF) ? (n0 / 128) * 256 + (n0 % 128) : ((n0 - DFF) / 128) * 256 + 128 + ((n0 - DFF) % 128); }
    else if (mode == 2) { const int pn = n0 / 256, r256 = n0 % 256, wc = r256 / 64, bj = (r256 % 64) / 32; d0 = 256 * pn + 128 * bj + 32 * wc; }
    transpose_item(W, K, N, gain, WT, n0, d0, 64 * kb, scr, lane);
}
__device__ __forceinline__ void p0_prologue(const Params& p, LAS unsigned char* lds, int tid, int lane, int wave, int vcu, int G) {
    unsigned char* ws = p.ws;
    LAS float* scr = (LAS float*)(lds + wave * 16384);
    const int gw = vcu * NWAVES + wave, NGW = G * NWAVES;
    constexpr int I_RI = 16 * 192, I_RO = 32 * 32, I_FI = 16 * 176, I_FO = 44 * 32, I_SI = 16 * 48, I_SO = 16 * 32;
    constexpr int NITEMS = I_RI + I_RO + 2 * I_FI + 2 * I_FO + I_SI + I_SO;
    const float* nmix = p.in[5]; const float* nffn = p.in[6];
    for (int it = gw; it < NITEMS; it += NGW) {
        int r = it;
        if (r < I_RI) { transpose_mat(p.in[7], 1024, 6144, nmix, (bf16*)(ws + WS_WRI), 0, r, scr, lane); continue; } r -= I_RI;
        if (r < I_RO) { transpose_mat(p.in[8], 2048, 1024, nullptr, (bf16*)(ws + WS_WRO), 0, r, scr, lane); continue; } r -= I_RO;
        if (r < I_FI) { transpose_mat(p.in[14], 1024, 5632, nffn, (bf16*)(ws + WS_WFI0), 1, r, scr, lane); continue; } r -= I_FI;
        if (r < I_FO) { transpose_mat(p.in[15], 2816, 1024, nullptr, (bf16*)(ws + WS_WFO0), 0, r, scr, lane); continue; } r -= I_FO;
        if (r < I_SI) { transpose_mat(p.in[9], 1024, 1536, nmix + 1024, (bf16*)(ws + WS_WSI), 2, r, scr, lane); continue; } r -= I_SI;
        if (r < I_SO) { transpose_mat(p.in[10], 1024, 1024, nullptr, (bf16*)(ws + WS_WSO), 0, r, scr, lane); continue; } r -= I_SO;
        if (r < I_FI) { transpose_mat(p.in[14] + (size_t)1024 * 5632, 1024, 5632, nffn + 1024, (bf16*)(ws + WS_WFI1), 1, r, scr, lane); continue; } r -= I_FI;
        transpose_mat(p.in[15] + (size_t)2816 * 1024, 2816, 1024, nullptr, (bf16*)(ws + WS_WFO1), 0, r, scr, lane);
    }
    float* cR = (float*)(ws + WS_TRC); float* sR = (float*)(ws + WS_TRS); float* cS = (float*)(ws + WS_TSC); float* sS = (float*)(ws + WS_TSS);
    for (int idx = vcu * NTHR + tid; idx < 2052 * 160; idx += G * NTHR) {
        const int pi = idx / 160, c = idx % 160; const double pos = (pi < 2048) ? (double)pi : (double)(16384 + (pi - 2048));
        double rev = pos * ((c < 128) ? p.invR[c] : p.invS[c - 128]); rev -= __builtin_rint(rev);
        const float cv = __builtin_amdgcn_cosf((float)rev), sv = __builtin_amdgcn_sinf((float)rev);
        if (c < 128) { cR[pi * 128 + c] = cv; sR[pi * 128 + c] = sv; } else { cS[pi * 32 + c - 128] = cv; sS[pi * 32 + c - 128] = sv; }
    }
    bf16* XB = (bf16*)(ws + WS_XB); float* ss = (float*)(ws + WS_SS); float* sso = (float*)(ws + WS_SSO);
    for (int m = gw; m < MT; m += NGW) {
        const float* xr = (m < NP) ? p.in[0] + (size_t)m * DM : p.in[1] + (size_t)(m - NP) * DM;
        f32x4 v[4]; float s = 0.f;
#pragma unroll
        for (int j = 0; j < 4; ++j) { v[j] = ((const f32x4*)xr)[lane + 64 * j]; s += (v[j][0] * v[j][0] + v[j][1] * v[j][1]) + (v[j][2] * v[j][2] + v[j][3] * v[j][3]); }
        s = wave_sum(s);
#pragma unroll
        for (int j = 0; j < 4; ++j) { u32x2 o; o.x = pk2(v[j][0], v[j][1]); o.y = pk2(v[j][2], v[j][3]); ((u32x2*)(XB + (size_t)m * DM))[lane + 64 * j] = o; }
        if (lane == 0) { ss[m] = s; ss[MT + m] = 0.f; ss[2 * MT + m] = 0.f; ss[3 * MT + m] = 0.f; }
        if (lane < 4) sso[m * 4 + lane] = 0.f;
    }
}

constexpr int RQ_STR = 264, RV_STR = 72;
constexpr int RL_Q = 0, RL_K = 33792, RL_VT = 67584, RL_VD = 76800, RL_P = 86016, RL_ST = 95232;
__device__ __forceinline__ void ret_prompt_unit(LAS unsigned char* lds, const bf16* QKVG, bf16* OB, float* sso, float* state_out, int bh, int es, float lg2, int tid) {
    const int lane = tid & 63, w = __builtin_amdgcn_readfirstlane(tid >> 6), li = lane & 15, lq = lane >> 4;
    const int b = bh >> 2, h = bh & 3;
    LAS bf16* Ql = (LAS bf16*)(lds + RL_Q); LAS bf16* Kl = (LAS bf16*)(lds + RL_K); LAS bf16* VT = (LAS bf16*)(lds + RL_VT);
    LAS bf16* VD = (LAS bf16*)(lds + RL_VD); LAS bf16* PP = (LAS bf16*)(lds + RL_P); LAS bf16* ST = (LAS bf16*)(lds + RL_ST);
    for (int i = tid; i < 33792 / 16; i += NTHR) ((LAS u32x4*)ST)[i] = (u32x4){0u, 0u, 0u, 0u};
    f32x4 S[2][4];
#pragma unroll
    for (int a = 0; a < 2; ++a)
#pragma unroll
        for (int e = 0; e < 4; ++e) S[a][e] = (f32x4){0.f, 0.f, 0.f, 0.f};
    const size_t rowbase = (size_t)b * SEQ;
    const bf16* qg = QKVG + rowbase * 6144 + h * 256;
    const bf16* kg = qg + 1024;
    const bf16* vg = QKVG + rowbase * 6144 + 2048 + h * 512 + es * 64;
    const int srow = tid >> 5, sch = tid & 31;
    const int vrow = tid >> 3, vch = tid & 7;
    u32x4 rq[4], rk[4], rv;
#define RET_LOAD(t0_) do { _Pragma("unroll") for (int i_ = 0; i_ < 4; ++i_) { const size_t o_ = (size_t)((t0_) + srow + 16 * i_) * 6144 + sch * 8; rq[i_] = *(const u32x4*)(qg + o_); rk[i_] = *(const u32x4*)(kg + o_); } \
        rv = *(const u32x4*)(vg + (size_t)((t0_) + vrow) * 6144 + vch * 8); } while (0)
    RET_LOAD(0);
    const int ib = w >> 1, nh = w & 1;
    const float dS = __builtin_amdgcn_exp2f(64.0f * lg2);
    for (int c = 0; c < 32; ++c) {
        const int t0 = c * 64;
#pragma unroll
        for (int i = 0; i < 4; ++i) { *(LAS u32x4*)(Ql + (srow + 16 * i) * RQ_STR + sch * 8) = rq[i]; *(LAS u32x4*)(Kl + (srow + 16 * i) * RQ_STR + sch * 8) = rk[i]; }
        { const float dec = __builtin_amdgcn_exp2f((float)(63 - vrow) * lg2);
#pragma unroll
          for (int j = 0; j < 4; ++j) { const unsigned wv = rv[j]; const int e0 = vch * 8 + 2 * j;
              VT[e0 * RV_STR + vrow] = (bf16)(wv & 0xffffu); VT[(e0 + 1) * RV_STR + vrow] = (bf16)(wv >> 16);
              VD[e0 * RV_STR + vrow] = (bf16)f2bf(bflo(wv) * dec); VD[(e0 + 1) * RV_STR + vrow] = (bf16)f2bf(bfhi(wv) * dec); } }
        __syncthreads();
        if (c + 1 < 32) RET_LOAD(t0 + 64);
        f32x4 accS[2], accO[2];
#pragma unroll
        for (int t = 0; t < 2; ++t) { accS[t] = (f32x4){0.f, 0.f, 0.f, 0.f}; accO[t] = (f32x4){0.f, 0.f, 0.f, 0.f}; }
#pragma unroll
        for (int ks = 0; ks < 8; ++ks) {
            const bf16x8 a = *(const LAS bf16x8*)(Ql + (16 * ib + li) * RQ_STR + 32 * ks + 8 * lq);
#pragma unroll
            for (int t = 0; t < 2; ++t) {
                const bf16x8 bs = *(const LAS bf16x8*)(ST + (16 * (2 * nh + t) + li) * RQ_STR + 32 * ks + 8 * lq);
                accO[t] = mfma16(a, bs, accO[t]);
                if (2 * nh + t <= ib) { const bf16x8 bk = *(const LAS bf16x8*)(Kl + (16 * (2 * nh + t) + li) * RQ_STR + 32 * ks + 8 * lq); accS[t] = mfma16(a, bk, accS[t]); }
            }
        }
#pragma unroll
        for (int t = 0; t < 2; ++t) { const int jb = 2 * nh + t, j = 16 * jb + li;
#pragma unroll
            for (int r = 0; r < 4; ++r) { const int i = 16 * ib + 4 * lq + r;
                const float val = (j <= i) ? accS[t][r] * __builtin_amdgcn_exp2f((float)(i - j) * lg2) : 0.f;
                PP[i * RV_STR + j] = (bf16)f2bf(val); } }
        __syncthreads();
        f32x4 accA[2];
#pragma unroll
        for (int t = 0; t < 2; ++t) accA[t] = (f32x4){0.f, 0.f, 0.f, 0.f};
#pragma unroll
        for (int ks = 0; ks < 2; ++ks) {
            const bf16x8 a = *(const LAS bf16x8*)(PP + (16 * ib + li) * RV_STR + 32 * ks + 8 * lq);
#pragma unroll
            for (int t = 0; t < 2; ++t) { const bf16x8 bv = *(const LAS bf16x8*)(VT + (16 * (2 * nh + t) + li) * RV_STR + 32 * ks + 8 * lq); accA[t] = mfma16(a, bv, accA[t]); }
        }
#pragma unroll
        for (int r = 0; r < 4; ++r) { const int i = 16 * ib + 4 * lq + r; const float f = __builtin_amdgcn_exp2f((float)(i + 1) * lg2);
            const size_t row = rowbase + t0 + i; float q2 = 0.f;
#pragma unroll
            for (int t = 0; t < 2; ++t) { const float o = accA[t][r] + f * accO[t][r]; q2 += o * o; OB[row * 2048 + h * 512 + es * 64 + 16 * (2 * nh + t) + li] = (bf16)f2bf(o); }
            q2 += __shfl_xor(q2, 1); q2 += __shfl_xor(q2, 2); q2 += __shfl_xor(q2, 4); q2 += __shfl_xor(q2, 8);
            if (li == 0 && sso) atomicAdd(sso + row * 4 + h, q2); }
#pragma unroll
        for (int a = 0; a < 2; ++a)
#pragma unroll
            for (int e = 0; e < 4; ++e) S[a][e] = S[a][e] * dS;
#pragma unroll
        for (int ks = 0; ks < 2; ++ks) {
            bf16x8 ka[2];
#pragma unroll
            for (int dm = 0; dm < 2; ++dm)
#pragma unroll
                for (int jj = 0; jj < 8; ++jj) ka[dm][jj] = (short)Kl[(32 * ks + 8 * lq + jj) * RQ_STR + 32 * w + 16 * dm + li];
#pragma unroll
            for (int en = 0; en < 4; ++en) { const bf16x8 bv = *(const LAS bf16x8*)(VD + (16 * en + li) * RV_STR + 32 * ks + 8 * lq);
#pragma unroll
                for (int dm = 0; dm < 2; ++dm) S[dm][en] = mfma16(ka[dm], bv, S[dm][en]); }
        }
#pragma unroll
        for (int dm = 0; dm < 2; ++dm)
#pragma unroll
            for (int en = 0; en < 4; ++en) { u32x2 o; o.x = pk2(S[dm][en][0], S[dm][en][1]); o.y = pk2(S[dm][en][2], S[dm][en][3]);
                *(LAS u32x2*)(ST + (16 * en + li) * RQ_STR + 32 * w + 16 * dm + 4 * lq) = o; }
        __syncthreads();
    }
#undef RET_LOAD
    float* so = state_out + ((size_t)bh * 256) * 512 + es * 64;
#pragma unroll
    for (int dm = 0; dm < 2; ++dm)
#pragma unroll
        for (int en = 0; en < 4; ++en)
#pragma unroll
            for (int r = 0; r < 4; ++r) so[(size_t)(32 * w + 16 * dm + 4 * lq + r) * 512 + 16 * en + li] = S[dm][en][r];
}

__device__ __forceinline__ void ret_sample_unit(LAS unsigned char* lds, const bf16* QKVG, bf16* OB, const float* state_in, float* state_out, int bh, float lg2, int tid) {
    const int lane = tid & 63, w = __builtin_amdgcn_readfirstlane(tid >> 6);
    const int b = bh >> 2, h = bh & 3;
    LAS float* qk8 = (LAS float*)lds;
    LAS float* qkd = qk8 + 2048;
    LAS float* red = qkd + 16;
    LAS float* wsm = red + 8192;
    const size_t r0 = (size_t)(NP + b * 4);
    {
        const int idx = tid * 4, which = idx >> 10, t = (idx >> 8) & 3, d = idx & 255;
        const u32x2 v = *(const u32x2*)(QKVG + (r0 + t) * 6144 + which * 1024 + h * 256 + d);
        LAS float* dst = qk8 + d * 8 + which * 4 + t;
        dst[0] = bflo(v.x); dst[8] = bfhi(v.x); dst[16] = bflo(v.y); dst[24] = bfhi(v.y);
    }
    __syncthreads();
    {
#pragma unroll
        for (int pp = 0; pp < 2; ++pp) { const int pr = 2 * w + pp, i = pr >> 2, j = pr & 3; float s = 0.f;
#pragma unroll
            for (int dd = 0; dd < 4; ++dd) { const int d = lane * 4 + dd; s += qk8[d * 8 + i] * qk8[d * 8 + 4 + j]; }
            s = wave_sum(s); if (lane == 0) qkd[pr] = s; }
    }
    const float g1 = __builtin_amdgcn_exp2f(lg2), g2 = g1 * g1, g3 = g2 * g1, g4 = g2 * g2;
    const int ec = tid & 127, dg = tid >> 7;
    f32x4 vv[4];
#pragma unroll
    for (int j = 0; j < 4; ++j) { const u32x2 v = *(const u32x2*)(QKVG + (r0 + j) * 6144 + 2048 + h * 512 + 4 * ec); vv[j] = (f32x4){bflo(v.x), bfhi(v.x), bflo(v.y), bfhi(v.y)}; }
    vv[0] = vv[0] * g3; vv[1] = vv[1] * g2; vv[2] = vv[2] * g1;
    f32x4 oa[4];
#pragma unroll
    for (int i = 0; i < 4; ++i) oa[i] = (f32x4){0.f, 0.f, 0.f, 0.f};
    const float* sin_ = state_in + ((size_t)bh * 256 + dg * 64) * 512 + 4 * ec;
    float* sout = state_out + ((size_t)bh * 256 + dg * 64) * 512 + 4 * ec;
#pragma unroll 8
    for (int dd = 0; dd < 64; ++dd) {
        const f32x4 s = *(const f32x4*)(sin_ + (size_t)dd * 512);
        const f32x4 q4 = *(const LAS f32x4*)(qk8 + (dg * 64 + dd) * 8), k4 = *(const LAS f32x4*)(qk8 + (dg * 64 + dd) * 8 + 4);
        const f32x4 sn = s * g4 + vv[0] * k4[0] + vv[1] * k4[1] + vv[2] * k4[2] + vv[3] * k4[3];
        __builtin_nontemporal_store(sn, (f32x4*)(sout + (size_t)dd * 512));
        oa[0] += s * q4[0]; oa[1] += s * q4[1]; oa[2] += s * q4[2]; oa[3] += s * q4[3];
    }
#pragma unroll
    for (int i = 0; i < 4; ++i) *(LAS f32x4*)(red + (dg * 4 + i) * 512 + 4 * ec) = oa[i];
    __syncthreads();
    {
        const int e = tid; float vj[4], o[4], q2[4];
#pragma unroll
        for (int j = 0; j < 4; ++j) vj[j] = bf2f(QKVG[(r0 + j) * 6144 + 2048 + h * 512 + e]);
        const float gp[4] = {1.0f, g1, g2, g3};
#pragma unroll
        for (int i = 0; i < 4; ++i) { float ob = (red[(0 * 4 + i) * 512 + e] + red[(1 * 4 + i) * 512 + e]) + (red[(2 * 4 + i) * 512 + e] + red[(3 * 4 + i) * 512 + e]);
            float acc = ob * gp[i] * g1;
#pragma unroll
            for (int j = 0; j < 4; ++j) if (j <= i) acc += gp[i - j] * qkd[i * 4 + j] * vj[j];
            o[i] = acc; q2[i] = wave_sum(acc * acc); }
        if (lane == 0) {
#pragma unroll
            for (int i = 0; i < 4; ++i) wsm[w * 4 + i] = q2[i]; }
        __syncthreads();
#pragma unroll
        for (int i = 0; i < 4; ++i) { float t = 0.f;
#pragma unroll
            for (int ww = 0; ww < 8; ++ww) t += wsm[ww * 4 + i];
            const float rstd = __builtin_amdgcn_rsqf(t * (1.0f / 512.0f) + EPS);
            const float sg = bf2f(QKVG[(r0 + i) * 6144 + 4096 + h * 512 + e]);
            OB[(r0 + i) * 2048 + h * 512 + e] = (bf16)f2bf(o[i] * rstd * sg); }
    }
    __syncthreads();
}

__device__ __forceinline__ void ret_norm_pass(const bf16* QKVG, bf16* OB, const float* sso, int gw, int NGW, int lane) {
    for (int m = gw; m < NP; m += NGW) {
        const f32x4 s4 = *(const f32x4*)(sso + (size_t)m * 4);
#pragma unroll
        for (int j = 0; j < 4; ++j) {
            const float rstd = __builtin_amdgcn_rsqf(s4[j] * (1.0f / 512.0f) + EPS);
            u32x4 o = *(const u32x4*)(OB + (size_t)m * 2048 + 512 * j + lane * 8); const u32x4 g = *(const u32x4*)(QKVG + (size_t)m * 6144 + 4096 + 512 * j + lane * 8);
#pragma unroll
            for (int k = 0; k < 4; ++k) o[k] = pk2(bflo(o[k]) * rstd * bflo(g[k]), bfhi(o[k]) * rstd * bfhi(g[k]));
            *(u32x4*)(OB + (size_t)m * 2048 + 512 * j + lane * 8) = o;
        }
    }
}

constexpr int AK_STR = 72, AV_STR = 264, AP_STR = 168;
constexpr int AL_K = 0, AL_VT = 36864, AL_P = 70656;
__device__ __forceinline__ void attn_item(const LAS bf16* Kl, const LAS bf16* VT, LAS bf16* Pw, const bf16* qp, int jt0, const int (&lo)[4], const int (&hi)[4], const float (&sink)[4], bf16* const (&outp)[4], int li, int lq) {
    bf16x8 qa[2];
#pragma unroll
    for (int ks = 0; ks < 2; ++ks) qa[ks] = *(const bf16x8*)(qp + 32 * ks + 8 * lq);
    f32x4 sc[10];
#pragma unroll
    for (int jt = 0; jt < 10; ++jt) { sc[jt] = (f32x4){0.f, 0.f, 0.f, 0.f};
#pragma unroll
        for (int ks = 0; ks < 2; ++ks) { const bf16x8 bk = *(const LAS bf16x8*)(Kl + (16 * (jt0 + jt) + li) * AK_STR + 32 * ks + 8 * lq); sc[jt] = mfma16(qa[ks], bk, sc[jt]); } }
    float mx[4], den[4];
#pragma unroll
    for (int r = 0; r < 4; ++r) { float m = sink[r];
#pragma unroll
        for (int jt = 0; jt < 10; ++jt) { const int j = 16 * (jt0 + jt) + li; const bool ok = (j >= lo[r]) && (j <= hi[r]); sc[jt][r] = ok ? sc[jt][r] : -INFINITY; m = fmaxf(m, sc[jt][r]); }
        m = fmaxf(m, __shfl_xor(m, 1)); m = fmaxf(m, __shfl_xor(m, 2)); m = fmaxf(m, __shfl_xor(m, 4)); m = fmaxf(m, __shfl_xor(m, 8));
        float s = 0.f;
#pragma unroll
        for (int jt = 0; jt < 10; ++jt) { const float e = __expf(sc[jt][r] - m); sc[jt][r] = e; s += e; }
        s += __shfl_xor(s, 1); s += __shfl_xor(s, 2); s += __shfl_xor(s, 4); s += __shfl_xor(s, 8);
        mx[r] = m; den[r] = __builtin_amdgcn_rcpf(s + __expf(sink[r] - m)); }
#pragma unroll
    for (int jt = 0; jt < 10; ++jt)
#pragma unroll
        for (int r = 0; r < 4; ++r) Pw[(4 * lq + r) * AP_STR + 16 * jt + li] = (bf16)f2bf(sc[jt][r] * den[r]);
    LDS_WAIT();
    f32x4 oc[4];
#pragma unroll
    for (int dn = 0; dn < 4; ++dn) oc[dn] = (f32x4){0.f, 0.f, 0.f, 0.f};
#pragma unroll
    for (int ks = 0; ks < 5; ++ks) { const bf16x8 pa = *(const LAS bf16x8*)(Pw + li * AP_STR + 32 * ks + 8 * lq);
#pragma unroll
        for (int dn = 0; dn < 4; ++dn) { const bf16x8 bv = *(const LAS bf16x8*)(VT + (16 * dn + li) * AV_STR + 16 * jt0 + 32 * ks + 8 * lq); oc[dn] = mfma16(pa, bv, oc[dn]); } }
#pragma unroll
    for (int r = 0; r < 4; ++r)
#pragma unroll
        for (int dn = 0; dn < 4; ++dn) outp[r][16 * dn + li] = (bf16)f2bf(oc[dn][r]);
    LDS_WAIT();
    (void)mx;
}
__device__ __forceinline__ void attn_prompt_unit(LAS unsigned char* lds, const bf16* QKV, bf16* AO, const float* sinks, int unit, int tid) {
    const int lane = tid & 63, w = __builtin_amdgcn_readfirstlane(tid >> 6), li = lane & 15, lq = lane >> 4;
    const int kvh = unit & 3, nb = (unit >> 2) & 15, b = unit >> 6;
    LAS bf16* Kl = (LAS bf16*)(lds + AL_K); LAS bf16* VT = (LAS bf16*)(lds + AL_VT); LAS bf16* Pw = (LAS bf16*)(lds + AL_P + w * 5376);
    const size_t rowbase = (size_t)b * SEQ; const int tb = nb * 128 - 128;
#pragma unroll
    for (int i = 0; i < 4; ++i) { const int id = tid + NTHR * i, j = id >> 3, ch = id & 7; const int t = tb + j;
        u32x4 kv = (u32x4){0u, 0u, 0u, 0u}, vv = (u32x4){0u, 0u, 0u, 0u};
        if (t >= 0) { const bf16* src = QKV + (rowbase + t) * 1536 + 1024 + kvh * 64 + ch * 8; kv = *(const u32x4*)src; vv = *(const u32x4*)(src + 256); }
        *(LAS u32x4*)(Kl + j * AK_STR + ch * 8) = kv;
#pragma unroll
        for (int k = 0; k < 4; ++k) { VT[(ch * 8 + 2 * k) * AV_STR + j] = (bf16)(vv[k] & 0xffffu); VT[(ch * 8 + 2 * k + 1) * AV_STR + j] = (bf16)(vv[k] >> 16); } }
    __syncthreads();
#pragma unroll 1
    for (int it = 0; it < 4; ++it) { const int id = w * 4 + it, g = id >> 3, qt = id & 7, hq = kvh * 4 + g;
        const size_t qrow0 = rowbase + nb * 128 + 16 * qt;
        const bf16* qp = QKV + (qrow0 + li) * 1536 + hq * 64;
        int lo[4], hi[4]; float sk[4]; bf16* op[4]; const float sv = sinks[hq];
#pragma unroll
        for (int r = 0; r < 4; ++r) { const int i = 16 * qt + 4 * lq + r; lo[r] = (nb > 0) ? i : (i > 128 ? i : 128); hi[r] = i + 128; sk[r] = sv; op[r] = AO + (qrow0 + 4 * lq + r) * 1024 + hq * 64; }
        attn_item(Kl, VT, Pw, qp, qt & ~1, lo, hi, sk, op, li, lq); }
    __syncthreads();
}
__device__ __forceinline__ void attn_sample_unit(LAS unsigned char* lds, const bf16* QKV, bf16* AO, const float* sinks, const float* ck, const float* cv, float* ok, float* ov, int unit, int tid) {
    const int lane = tid & 63, w = __builtin_amdgcn_readfirstlane(tid >> 6), li = lane & 15, lq = lane >> 4;
    const int kvh = unit & 3, b = unit >> 2;
    LAS bf16* Kl = (LAS bf16*)(lds + AL_K); LAS bf16* VT = (LAS bf16*)(lds + AL_VT); LAS bf16* Pw = (LAS bf16*)(lds + AL_P);
#pragma unroll
    for (int i = 0; i < 4; ++i) { const int id = tid + NTHR * i, j = id >> 4, ch = id & 15;
        const size_t so = ((size_t)(b * 128 + j) * 4 + kvh) * 64 + ch * 4;
        const f32x4 kf = *(const f32x4*)(ck + so), vf = *(const f32x4*)(cv + so);
        if (j >= 4) { const size_t d_ = ((size_t)(b * 128 + j - 4) * 4 + kvh) * 64 + ch * 4; *(f32x4*)(ok + d_) = kf; *(f32x4*)(ov + d_) = vf; }
        u32x2 kb; kb.x = pk2(kf[0], kf[1]); kb.y = pk2(kf[2], kf[3]); *(LAS u32x2*)(Kl + j * AK_STR + ch * 4) = kb;
#pragma unroll
        for (int k = 0; k < 4; ++k) VT[(ch * 4 + k) * AV_STR + j] = (bf16)f2bf(vf[k]); }
    if (tid < 256) { const int j = 128 + (tid >> 3), ch = tid & 7;
        u32x4 kv = (u32x4){0u, 0u, 0u, 0u}, vv = (u32x4){0u, 0u, 0u, 0u};
        if (j < 132) { const bf16* src = QKV + (size_t)(NP + b * 4 + (j - 128)) * 1536 + 1024 + kvh * 64 + ch * 8; kv = *(const u32x4*)src; vv = *(const u32x4*)(src + 256); }
        *(LAS u32x4*)(Kl + j * AK_STR + ch * 8) = kv;
#pragma unroll
        for (int k = 0; k < 4; ++k) { VT[(ch * 8 + 2 * k) * AV_STR + j] = (bf16)(vv[k] & 0xffffu); VT[(ch * 8 + 2 * k + 1) * AV_STR + j] = (bf16)(vv[k] >> 16); } }
    __syncthreads();
    if (w == 0) {
        const int gA = li >> 2, tA = li & 3;
        const bf16* qp = QKV + (size_t)(NP + b * 4 + tA) * 1536 + (kvh * 4 + gA) * 64;
        int lo[4], hi[4]; float sk[4]; bf16* op[4];
#pragma unroll
        for (int r = 0; r < 4; ++r) { const int rr = 4 * lq + r, g = rr >> 2, t = rr & 3; lo[r] = t; hi[r] = t + 128; sk[r] = sinks[kvh * 4 + g]; op[r] = AO + (size_t)(NP + b * 4 + t) * 1024 + (kvh * 4 + g) * 64; }
        attn_item(Kl, VT, Pw, qp, 0, lo, hi, sk, op, li, lq);
    }
    __syncthreads();
}

#define XB_TMO      128
#define XB_XCNT(j)  (256  + 64 * (j))
#define XB_XSUB(j)  (1280 + 64 * (j))
#define XB_XGEN(j)  (2304 + 64 * (j))
#define XB_TOP      3328
#define XB_TOPGEN   3392
#define XCD_BAR_WORDS 3456
#define XB_SPIN_CAP (1u << 18)

__device__ __forceinline__ unsigned xb_ld(unsigned* p)              { return __hip_atomic_load(p, __ATOMIC_RELAXED, __HIP_MEMORY_SCOPE_AGENT); }
__device__ __forceinline__ unsigned xb_add(unsigned* p, unsigned v) { return __hip_atomic_fetch_add(p, v, __ATOMIC_RELAXED, __HIP_MEMORY_SCOPE_AGENT); }
__device__ __forceinline__ unsigned xb_xcc_id() { return (unsigned)__builtin_amdgcn_s_getreg((3 << 11) | 20) & 0xFu; }
#define XB_SPIN(cond, bar) do { unsigned _sp = 0; while (cond) { __builtin_amdgcn_s_sleep(1); \
    if ((++_sp & 255u) == 0u) { if (xb_ld(&(bar)[XB_TMO])) break; if (_sp > XB_SPIN_CAP) { atomicAdd(&(bar)[XB_TMO], 1u); break; } } } } while (0)

struct XcdBarrier {
    unsigned* bar; unsigned x;
    volatile LAS unsigned* st;
};

__device__ __forceinline__ XcdBarrier xcd_barrier_post(unsigned* bar, volatile LAS unsigned* st) {
    XcdBarrier b; b.bar = bar; b.x = xb_xcc_id(); b.st = st;
    if (threadIdx.x == 0) (void)xb_add(&bar[XB_XCNT(b.x)], 1u);
    return b;
}
__device__ __forceinline__ void xcd_barrier_complete(unsigned* bar, unsigned x, unsigned& nloc, unsigned& nx) {
    const unsigned G = gridDim.x * gridDim.y * gridDim.z;
    unsigned sum, cnt, mine, sp = 0u;
    for (;;) {
        sum = 0u; cnt = 0u; mine = 0u;
#pragma unroll
        for (unsigned j = 0; j < 16; ++j) { const unsigned c = xb_ld(&bar[XB_XCNT(j)]); sum += c; cnt += (c > 0u) ? 1u : 0u; mine = (j == x) ? c : mine; }
        if (sum == G) break;
        __builtin_amdgcn_s_sleep(1);
        if ((++sp & 255u) == 0u) { if (xb_ld(&bar[XB_TMO])) break; if (sp > XB_SPIN_CAP) { atomicAdd(&bar[XB_TMO], 1u); break; } }
    }
    nloc = mine > 0u ? mine : 1u; nx = cnt > 0u ? cnt : 1u;
}

__device__ __forceinline__ void xcd_barrier(const XcdBarrier& b) {
    asm volatile("s_waitcnt vmcnt(0)" ::: "memory");
    __syncthreads();
    if (threadIdx.x == 0) {
        unsigned* bar = b.bar;
        __builtin_amdgcn_s_waitcnt(0);
        unsigned nloc = b.st[0], nx = b.st[1];
        if (nloc == 0u) { xcd_barrier_complete(bar, b.x, nloc, nx); b.st[0] = nloc; b.st[1] = nx; }
        const unsigned old = xb_add(&bar[XB_XSUB(b.x)], 1u);
        const unsigned gen = old / nloc;
        if (old + 1u == (gen + 1u) * nloc) {
            __builtin_amdgcn_fence(__ATOMIC_RELEASE, "agent");
            asm volatile("s_waitcnt vmcnt(0)" ::: "memory");
            const unsigned og = xb_add(&bar[XB_TOP], 1u);
            const unsigned tg = og / nx;
            if (og + 1u == (tg + 1u) * nx) xb_add(&bar[XB_TOPGEN], 1u);
            else XB_SPIN(xb_ld(&bar[XB_TOPGEN]) == tg, bar);
            __builtin_amdgcn_fence(__ATOMIC_ACQUIRE, "agent");
            xb_add(&bar[XB_XGEN(b.x)], 1u);
            asm volatile("s_waitcnt vmcnt(0)" ::: "memory");
        } else {
            XB_SPIN(xb_ld(&bar[XB_XGEN(b.x)]) == gen, bar);
            __builtin_amdgcn_fence(__ATOMIC_ACQUIRE, "agent");
            asm volatile("s_waitcnt vmcnt(0)" ::: "memory");
        }
    }
    __syncthreads();
}

#ifndef PROBE_DUP
#define PROBE_DUP 0
#endif
struct ListOrder {
    int nM, nN, nwg, pm_off, L0, dL, n, extraL;
    __device__ __forceinline__ void init(int Mrows, int N, int pm_off_) { nM = Mrows / 256; nN = N / 256; nwg = nM * nN; pm_off = pm_off_; }
    __device__ __forceinline__ bool next(int i, pg8::Unit& u) const {
        int L; if (i < n) L = L0 + i * dL; else if (i == n && extraL >= 0) L = extraL; else return false;
        if (L >= nwg) return false;
        int wgid = L; { const int q = nwg / 8, r = nwg % 8, xcd = wgid % 8, off = wgid / 8; wgid = (xcd < r ? xcd * (q + 1) : r * (q + 1) + (xcd - r) * q) + off; }
        const int nig = 8 * nN, gid = wgid / nig, fm = gid * 8, gsz = (nM - fm) < 8 ? (nM - fm) : 8;
        u.pm = fm + ((wgid % nig) % gsz) + pm_off; u.pn = (wgid % nig) / gsz; return true;
    }
    __device__ __forceinline__ void a_ready(const pg8::Unit&) const {}
    __device__ __forceinline__ void done(const pg8::Unit&) const {}
};
__device__ __forceinline__ void flag_signal(unsigned* f, int tid) {
    asm volatile("s_waitcnt vmcnt(0)" ::: "memory");
    __syncthreads();
    if (tid == 0) { __builtin_amdgcn_fence(__ATOMIC_RELEASE, "agent"); asm volatile("s_waitcnt vmcnt(0)" ::: "memory"); (void)xb_add(f, 1u); }
}
__device__ __forceinline__ void flag_wait(unsigned* f, unsigned n, int tid) {
    if (tid == 0) { unsigned sp = 0u; while (xb_ld(f) < n) { __builtin_amdgcn_s_sleep(4); if (++sp > (1u << 16)) break; }
        __builtin_amdgcn_fence(__ATOMIC_ACQUIRE, "agent"); asm volatile("s_waitcnt vmcnt(0)" ::: "memory"); }
    __syncthreads();
}
enum { K_NONE = 0, K_RETIN, K_RES, K_SWIGLU, K_SWAIN };
constexpr int NSTEPS = 21;
__global__ void __launch_bounds__(NTHR) hybrid_fwd(Params p) {
    extern __shared__ __attribute__((aligned(16))) unsigned char lds_raw[];
    LAS unsigned char* lds = (LAS unsigned char*)lds_raw;
    cg::grid_group grid = cg::this_grid();
    const int tid = threadIdx.x, lane = tid & 63, wave = __builtin_amdgcn_readfirstlane(tid >> 6);
    const int G = gridDim.x, c = blockIdx.x, vcu = (c % 8) * (G / 8) + c / 8;
    unsigned char* ws = p.ws; float* out = p.out;
    bf16* XB = (bf16*)(ws + WS_XB); bf16* BIG = (bf16*)(ws + WS_BIG); bf16* OB = (bf16*)(ws + WS_OB);
    float* ss = (float*)(ws + WS_SS); float* sso = (float*)(ws + WS_SSO);
    unsigned* ctl = (unsigned*)(ws + WS_CTL);
    unsigned* F1 = ctl + 4096; unsigned* F3 = ctl + 4096 + 64; unsigned* F4 = ctl + 4096 + 128; unsigned* F5 = ctl + 4096 + 192;
    volatile LAS unsigned* bst = (volatile LAS unsigned*)(lds + LDS_BYTES - 64);
    if (tid < 2) bst[tid] = 0u;
    __syncthreads();
    XcdBarrier bar = xcd_barrier_post(ctl, bst);
    const bool hi8 = (c >= 248), mid44 = (c >= 144 && c < 188);
    float* outS = out + (size_t)NP * DM;
#define GEMM_RES(Aptr, Wptr, Kc, E_)   do { pg8::Gemm g_{Aptr, (const bf16*)(ws + Wptr), MT, 1024, Kc}; pg8::gemm_phase<pg8::EpiRes, ListOrder, true, true>(lds, g_, S, E_); } while (0)
#define GEMM_SWIGLU(Wptr, ssp)         do { pg8::Gemm g_{XB, (const bf16*)(ws + Wptr), MT, 5632, 1024}; pg8::EpiSwiglu E_{BIG, ssp}; pg8::gemm_phase<pg8::EpiSwiglu, ListOrder, true, true>(lds, g_, S, E_); } while (0)
#define GEMM_SWAIN()                   do { pg8::Gemm g_{XB, (const bf16*)(ws + WS_WSI), MT, 1536, 1024}; \
        pg8::EpiSwaIn E_{BIG, ss + 2 * MT, (const float*)(ws + WS_TSC), (const float*)(ws + WS_TSS), p.in[11], p.in[12], out + OUT_KP, out + OUT_VP, out + OUT_KS, out + OUT_VS}; \
        pg8::gemm_phase<pg8::EpiSwaIn, ListOrder, true, true>(lds, g_, S, E_); } while (0)
    const int lo_ = p.ph_lo, hi_ = p.ph_hi;
#define IN(k) (lo_ <= (k) && (k) < hi_)
#define SEAM(k, kind) do { if (IN((k) + 1)) { if ((kind) == 2) grid.sync(); else if ((kind) == 1) xcd_barrier(bar); } } while (0)
    if (IN(0)) { ListOrder S; S.init(NP, 1024, 0); S.L0 = c; S.dL = 256; S.n = 0; S.extraL = -1;
       p0_prologue(p, lds, tid, lane, wave, vcu, G);
#if PROBE_DUP & 1
            __syncthreads(); p0_prologue(p, lds, tid, lane, wave, vcu, G);
#endif
        SEAM(0, 2); }
    if (IN(1)) { ListOrder S; S.init(NP, 1024, 0); S.L0 = c; S.dL = 256; S.n = 0; S.extraL = -1;
       { pg8::Gemm g_{XB, (const bf16*)(ws + WS_WRI), MT, 6144, 1024}; S.init(MT, 6144, 0); S.n = 7;
                  pg8::EpiRetIn E_{BIG, ss, (const float*)(ws + WS_TRC), (const float*)(ws + WS_TRS)};
                  pg8::gemm_phase<pg8::EpiRetIn, ListOrder, true, true>(lds, g_, S, E_); }
        SEAM(1, 1); }
    if (IN(2)) { ListOrder S; S.init(NP, 1024, 0); S.L0 = c; S.dL = 256; S.n = 0; S.extraL = -1;
       for (int u = vcu; u < 256; u += G) ret_prompt_unit(lds, BIG, OB, sso, out + OUT_SP, u >> 3, u & 7, p.lg2[(u >> 3) & 3], tid);
            __syncthreads();
            for (int u = vcu; u < 512; u += G) ret_sample_unit(lds, BIG, OB, p.in[2], out + OUT_SS, u, p.lg2[u & 3], tid);
        SEAM(2, 1); }
    if (IN(3)) { ListOrder S; S.init(NP, 1024, 0); S.L0 = c; S.dL = 256; S.n = 0; S.extraL = -1;
       ret_norm_pass(BIG, OB, sso, vcu * NWAVES + wave, G * NWAVES, lane);
        SEAM(3, 1); }
    if (IN(4)) { ListOrder S; S.init(NP, 1024, 0); S.L0 = c; S.dL = 256; S.n = 0; S.extraL = -1;
       { S.n = 1; pg8::EpiRes E_{p.in[0], p.in[1], out, XB, ss + MT}; GEMM_RES(OB, WS_WRO, 2048, E_); }
        SEAM(4, 1); }
    if (IN(5)) { ListOrder S; S.init(NP, 1024, 0); S.L0 = c; S.dL = 256; S.n = 0; S.extraL = -1;
       { S.init(NS, 1024, 64); S.L0 = c - 248; S.n = hi8 ? 1 : 0; pg8::EpiRes E_{p.in[0], p.in[1], out, XB, ss + MT}; GEMM_RES(OB, WS_WRO, 2048, E_); if (hi8) flag_signal(F1, tid); }
        SEAM(5, 0); }
    if (IN(6)) { ListOrder S; S.init(NP, 1024, 0); S.L0 = c; S.dL = 256; S.n = 0; S.extraL = -1;
       { S.init(NP, 5632, 0);
                  if (hi8) S.n = 3; else if (c >= 128 && c < 144) { S.n = 5; S.extraL = (3 + (c - 128) / 8) * 256 + 248 + (c - 128) % 8; } else S.n = (c < 128) ? 6 : 5;
                  GEMM_SWIGLU(WS_WFI0, ss + MT); }
        SEAM(6, 0); }
    if (IN(7)) { ListOrder S; S.init(NP, 1024, 0); S.L0 = c; S.dL = 256; S.n = 0; S.extraL = -1;
       { S.init(NS, 5632, 64); S.L0 = c - 144; S.n = mid44 ? 1 : 0; if (mid44) flag_wait(F1, 8u, tid); GEMM_SWIGLU(WS_WFI0, ss + MT); }
        SEAM(7, 1); }
    if (IN(8)) { ListOrder S; S.init(NP, 1024, 0); S.L0 = c; S.dL = 256; S.n = 0; S.extraL = -1;
       { S.n = 1; pg8::EpiRes E_{out, outS, out, XB, ss + 2 * MT}; GEMM_RES(BIG, WS_WFO0, 2816, E_); }
        SEAM(8, 1); }
    if (IN(9)) { ListOrder S; S.init(NP, 1024, 0); S.L0 = c; S.dL = 256; S.n = 0; S.extraL = -1;
       { S.init(NS, 1024, 64); S.L0 = c - 248; S.n = hi8 ? 1 : 0; pg8::EpiRes E_{out, outS, out, XB, ss + 2 * MT}; GEMM_RES(BIG, WS_WFO0, 2816, E_); }
        SEAM(9, 0); }
    if (IN(10)) { ListOrder S; S.init(NP, 1024, 0); S.L0 = c; S.dL = 256; S.n = 0; S.extraL = -1;
       { S.init(NP, 1536, 0);
                   if (hi8) S.n = 0; else if (c < 128) S.n = 2; else { S.n = 1; if (c < 136) S.extraL = 248 + (c - 128); }
                   GEMM_SWAIN(); }
        SEAM(10, 1); }
    if (IN(11)) { ListOrder S; S.init(NP, 1024, 0); S.L0 = c; S.dL = 256; S.n = 0; S.extraL = -1;
       { const bool m12 = (c >= 236 && c < 248); S.init(NS, 1536, 64); S.L0 = c - 236; S.n = m12 ? 1 : 0; GEMM_SWAIN(); if (m12) flag_signal(F3, tid); }
        SEAM(11, 0); }
    if (IN(12)) { ListOrder S; S.init(NP, 1024, 0); S.L0 = c; S.dL = 256; S.n = 0; S.extraL = -1;
       for (int u = vcu; u < 512; u += G) attn_prompt_unit(lds, BIG, OB, p.in[13], u, tid);
        SEAM(12, 0); }
    if (IN(13)) { ListOrder S; S.init(NP, 1024, 0); S.L0 = c; S.dL = 256; S.n = 0; S.extraL = -1;
       flag_wait(F3, 12u, tid);
                 for (int u = vcu; u < 512; u += G) attn_sample_unit(lds, BIG, OB, p.in[13], p.in[3], p.in[4], out + OUT_KS, out + OUT_VS, u, tid);
        SEAM(13, 1); }
    if (IN(14)) { ListOrder S; S.init(NP, 1024, 0); S.L0 = c; S.dL = 256; S.n = 0; S.extraL = -1;
       { S.n = 1; pg8::EpiRes E_{out, outS, out, XB, ss + 3 * MT}; GEMM_RES(OB, WS_WSO, 1024, E_); }
        SEAM(14, 1); }
    if (IN(15)) { ListOrder S; S.init(NP, 1024, 0); S.L0 = c; S.dL = 256; S.n = 0; S.extraL = -1;
       { S.init(NS, 1024, 64); S.L0 = c - 248; S.n = hi8 ? 1 : 0; pg8::EpiRes E_{out, outS, out, XB, ss + 3 * MT}; GEMM_RES(OB, WS_WSO, 1024, E_); if (hi8) flag_signal(F4, tid); }
        SEAM(15, 0); }
    if (IN(16)) { ListOrder S; S.init(NP, 1024, 0); S.L0 = c; S.dL = 256; S.n = 0; S.extraL = -1;
       { S.init(NP, 5632, 0);
                   if (hi8 || mid44) S.n = 1; else if (c < 128) S.n = 6; else { S.n = 5; int j = -1; if (c < 144) j = c - 128; else if (c >= 188 && c < 196) j = 16 + (c - 188); if (j >= 0) S.extraL = (2 + j / 8) * 256 + 248 + j % 8; }
                   GEMM_SWIGLU(WS_WFI1, ss + 3 * MT); }
        SEAM(16, 0); }
    if (IN(17)) { ListOrder S; S.init(NP, 1024, 0); S.L0 = c; S.dL = 256; S.n = 0; S.extraL = -1;
       { S.init(NS, 5632, 64); S.L0 = c - 144; S.n = mid44 ? 1 : 0; if (mid44) flag_wait(F4, 8u, tid); GEMM_SWIGLU(WS_WFI1, ss + 3 * MT); if (mid44) flag_signal(F5, tid); }
        SEAM(17, 0); }
    if (IN(18)) { ListOrder S; S.init(NP, 1024, 0); S.L0 = c; S.dL = 256; S.n = 0; S.extraL = -1;
       { S.init(NS, 1024, 64); S.L0 = c - 248; S.n = hi8 ? 1 : 0; if (hi8) flag_wait(F5, 44u, tid); pg8::EpiRes E_{out, outS, out, nullptr, nullptr}; GEMM_RES(BIG, WS_WFO1, 2816, E_); }
        SEAM(18, 0); }
    if (IN(19)) { ListOrder S; S.init(NP, 1024, 0); S.L0 = c; S.dL = 256; S.n = 0; S.extraL = -1;
       { S.init(NP, 5632, 0); S.L0 = 256 + c; S.n = hi8 ? 1 : (mid44 ? 4 : 0); GEMM_SWIGLU(WS_WFI1, ss + 3 * MT); }
        SEAM(19, 1); }
    if (IN(20)) { ListOrder S; S.init(NP, 1024, 0); S.L0 = c; S.dL = 256; S.n = 0; S.extraL = -1;
       { S.n = 1; pg8::EpiRes E_{out, outS, out, nullptr, nullptr}; GEMM_RES(BIG, WS_WFO1, 2816, E_); }
        SEAM(20, 0); }
#undef IN
#undef SEAM
}

#ifndef N_LAUNCHES
#define N_LAUNCHES 1
#endif
extern "C" void kernel_launch(void* const* d_in, const int* in_sizes, int n_in, void* d_out, int out_size, void* d_ws, size_t ws_size, hipStream_t stream) {
    static int grid = 0;
    if (grid == 0) {
        if (n_in != 16 || (size_t)out_size != OUT_END || ws_size < WS_TOTAL) { fprintf(stderr, "kernel_launch: unexpected shapes (n_in %d out %d ws %zu need %zu)\n", n_in, out_size, ws_size, (size_t)WS_TOTAL); grid = -1; return; }
        int dev = 0, cus = 0, per_cu = 0;
        (void)hipGetDevice(&dev); (void)hipDeviceGetAttribute(&cus, hipDeviceAttributeMultiprocessorCount, dev);
        if (hipFuncSetAttribute((const void*)hybrid_fwd, hipFuncAttributeMaxDynamicSharedMemorySize, LDS_BYTES) != hipSuccess) { fprintf(stderr, "kernel_launch: hipFuncSetAttribute failed\n"); grid = -1; return; }
        if (hipOccupancyMaxActiveBlocksPerMultiprocessor(&per_cu, (const void*)hybrid_fwd, NTHR, LDS_BYTES) != hipSuccess || per_cu < 1) { fprintf(stderr, "kernel_launch: occupancy query says %d\n", per_cu); per_cu = 1; }
        (void)hipGetLastError();
        grid = cus * 1;
        if (grid != 256) { fprintf(stderr, "kernel_launch: built for a 256-CU device (got %d)\n", cus); grid = -1; return; }
    }
    if (grid < 0) return;
    if (hipMemsetAsync((char*)d_ws + WS_CTL, 0, CTL_BYTES, stream) != hipSuccess) { fprintf(stderr, "kernel_launch: memset failed\n"); return; }
    Params p; memset(&p, 0, sizeof(p));
    for (int i = 0; i < 16; ++i) p.in[i] = (const float*)d_in[i];
    p.out = (float*)d_out; p.ws = (unsigned char*)d_ws;
    const double two_pi = 6.283185307179586476925286766559;
    for (int i = 0; i < 128; ++i) p.invR[i] = 1.0 / std::pow(10000.0, (double)i / 127.0) / two_pi;
    for (int i = 0; i < 32; ++i) p.invS[i] = 1.0 / std::pow(10000.0, (double)(2 * i) / 64.0) / two_pi;
    for (int h = 0; h < 4; ++h) p.lg2[h] = (float)std::log2(1.0 - std::ldexp(1.0, -5 - h));
#if N_LAUNCHES == 1
    p.ph_lo = 0; p.ph_hi = NSTEPS;
    void* args[] = {&p};
    hipError_t e = hipLaunchCooperativeKernel((const void*)hybrid_fwd, dim3(grid), dim3(NTHR), args, LDS_BYTES, stream);
    if (e != hipSuccess) fprintf(stderr, "kernel_launch: cooperative launch failed: %s (grid %d)\n", hipGetErrorString(e), grid);
#else
    for (int ph = 0; ph < NSTEPS; ++ph) { p.ph_lo = ph; p.ph_hi = ph + 1; hipLaunchKernelGGL(hybrid_fwd, dim3(grid), dim3(NTHR), LDS_BYTES, stream, p); }
#endif
}
```

```cpp
#include <hip/hip_runtime.h>
#include <hip/hip_cooperative_groups.h>
#include <cstdio>
#include <cstdint>
#include <cmath>
#include <cstring>
namespace cg = cooperative_groups;
namespace pg8 {
#define PG8_LAS __attribute__((address_space(3)))
typedef unsigned short bf16_t;
typedef short bf16x8 __attribute__((ext_vector_type(8)));
typedef float f32x4 __attribute__((ext_vector_type(4)));
typedef unsigned u32x4 __attribute__((ext_vector_type(4)));
constexpr int BM = 256, BK = 64, HALF = 128, HTB = HALF * BK * 2  , STAGE_BYTES = 8 * HTB, NXCD = 8, WGM = 8;

__host__ __device__ __forceinline__ int lds_byte(int r, int c) { const int st = (r >> 4) * 2 + (c >> 5), rr = r & 15, cc = c & 31, ob = rr * 64 + cc * 2; return st * 1024 + (ob ^ (((ob >> 9) & 1) << 5)); }
__host__ __device__ __forceinline__ void stage_rc(int b, int& R, int& C) { const int st = b / 1024, sb = b % 1024, swz = sb ^ (((sb >> 9) & 1) << 5); R = (st >> 1) * 16 + swz / 64; C = (st & 1) * 32 + (swz % 64) / 2; }
__host__ __device__ __forceinline__ int perm32(int rho) { const int n = rho >> 4, i = rho & 15; return 8 * (i >> 2) + 4 * n + (i & 3); }

struct Unit { int pm, pn; };
struct Gemm { const bf16_t* A; const bf16_t* Bt; int M, N, K; };

struct StaticOrder {
    int nM, nN, nwg, G, c;
    __host__ __device__ void init(int M, int N, int G_, int c_) { nM = M / BM; nN = N / BM; nwg = nM * nN; G = G_; c = c_; }
    __host__ __device__ bool next(int i, Unit& u) const {
        const long L = (long)i * G + c; if (L >= nwg) return false;
        int wgid = (int)L; { const int q = nwg / NXCD, r = nwg % NXCD, xcd = wgid % NXCD, off = wgid / NXCD; wgid = (xcd < r ? xcd * (q + 1) : r * (q + 1) + (xcd - r) * q) + off; }
        const int nig = WGM * nN, gid = wgid / nig, fm = gid * WGM, gsz = (nM - fm) < WGM ? (nM - fm) : WGM;
        u.pm = fm + ((wgid % nig) % gsz); u.pn = (wgid % nig) / gsz; return true;
    }
    __device__ __forceinline__ void a_ready(const Unit&) const {}
    __device__ __forceinline__ void done(const Unit&) const {}
};

__device__ __forceinline__ unsigned cvt_pk_bf16(float lo, float hi) { unsigned r; asm volatile("v_cvt_pk_bf16_f32 %0, %1, %2" : "=v"(r) : "v"(lo), "v"(hi)); return r; }
typedef float f32x2 __attribute__((ext_vector_type(2)));
constexpr int P_NP = 16384, P_D = 1024, P_MT = 16896;
constexpr float P_EPS = 1e-6f;
__device__ __forceinline__ float silu_f(float x) { return x * __builtin_amdgcn_rcpf(1.0f + __expf(-x)); }
__device__ __forceinline__ float row_rstd(const float* ssp, int row) {
    const f32x4* pp = (const f32x4*)(ssp + (size_t)row * 16); const f32x4 a = (pp[0] + pp[1]) + (pp[2] + pp[3]);
    return __builtin_amdgcn_rsqf(((a[0] + a[1]) + (a[2] + a[3])) * (1.0f / 1024.0f) + P_EPS);
}
__device__ __forceinline__ int pos_index(int row) { return row < P_NP ? (row & 2047) : 2048 + (row & 3); }
__device__ __forceinline__ u32x4 pack8(const f32x4 a, const f32x4 b) { u32x4 w; w.x = cvt_pk_bf16(a[0], a[1]); w.y = cvt_pk_bf16(a[2], a[3]); w.z = cvt_pk_bf16(b[0], b[1]); w.w = cvt_pk_bf16(b[2], b[3]); return w; }

struct EpiRetIn {
    static constexpr bool PERM = true, AFTER_DRAIN = false;
    bf16_t* O; const float* ss; const float* cosT; const float* sinT;
    __device__ __forceinline__ void operator()(const f32x4 (&acc)[2][2][4][2], const Unit& u, int wr, int wc, int fr, int fq) const {
        const int pn = u.pn, ci = wc * 32 + 8 * fq;
#pragma unroll
        for (int ai = 0; ai < 2; ++ai)
#pragma unroll
            for (int m = 0; m < 4; ++m) {
                const int row = u.pm * BM + ai * HALF + wr * 64 + m * 16 + fr;
                const float rstd = __builtin_amdgcn_rsqf(ss[row] * (1.0f / 1024.0f) + P_EPS);
                bf16_t* rowp;
                if (pn < 8) rowp = O + ((size_t)pn * P_MT + row) * 256 + ci;
                else { const int q_ = pn - 8; rowp = O + (size_t)8 * P_MT * 256 + ((size_t)(q_ >> 1) * P_MT + row) * 512 + (q_ & 1) * 256 + ci; }
                if (pn < 8) {
                    const int pidx = pos_index(row);
                    const f32x4* cp = (const f32x4*)(cosT + pidx * 128 + ci); const f32x4* sp = (const f32x4*)(sinT + pidx * 128 + ci);
                    const float sc = (pn >= 4) ? rstd * 0.0625f : rstd;
                    f32x4 o1[2], o2[2];
#pragma unroll
                    for (int n = 0; n < 2; ++n) { const f32x4 c = cp[n], s = sp[n]; const f32x4 x1 = acc[ai][0][m][n] * sc, x2 = acc[ai][1][m][n] * sc; o1[n] = x1 * c - x2 * s; o2[n] = x2 * c + x1 * s; }
                    *(u32x4*)(rowp) = pack8(o1[0], o1[1]); *(u32x4*)(rowp + HALF) = pack8(o2[0], o2[1]);
                } else if (pn < 16) {
#pragma unroll
                    for (int bj = 0; bj < 2; ++bj) *(u32x4*)(rowp + bj * HALF) = pack8(acc[ai][bj][m][0] * rstd, acc[ai][bj][m][1] * rstd);
                } else {
#pragma unroll
                    for (int bj = 0; bj < 2; ++bj) { f32x4 a = acc[ai][bj][m][0] * rstd, b = acc[ai][bj][m][1] * rstd;
#pragma unroll
                        for (int j = 0; j < 4; ++j) { a[j] = silu_f(a[j]); b[j] = silu_f(b[j]); }
                        *(u32x4*)(rowp + bj * HALF) = pack8(a, b); }
                }
            }
    }
};
struct EpiRes {
    static constexpr bool PERM = true, AFTER_DRAIN = false;
    bf16_t* xb; float* outF; float* ssn; const PG8_LAS float* hs;
    __device__ __forceinline__ void operator()(const f32x4 (&acc)[2][2][4][2], const Unit& u, int wr, int wc, int fr, int fq) const {
        const int col0 = u.pn * BM + wc * 32 + 8 * fq;
#pragma unroll
        for (int ai = 0; ai < 2; ++ai)
#pragma unroll
            for (int m = 0; m < 4; ++m) {
                const int row = u.pm * BM + ai * HALF + wr * 64 + m * 16 + fr;
                bf16_t* xp = xb + (size_t)row * P_D + col0; float s = 0.f;
                const float hsc = hs ? hs[(ai * HALF + wr * 64 + m * 16 + fr) * 4 + 3] : 1.0f;
#pragma unroll
                for (int bj = 0; bj < 2; ++bj) {
                    const u32x4 rw = *(const u32x4*)(xp + bj * HALF);
                    const f32x4 r0 = (f32x4){__builtin_bit_cast(float, rw.x << 16), __builtin_bit_cast(float, rw.x & 0xffff0000u), __builtin_bit_cast(float, rw.y << 16), __builtin_bit_cast(float, rw.y & 0xffff0000u)};
                    const f32x4 r1 = (f32x4){__builtin_bit_cast(float, rw.z << 16), __builtin_bit_cast(float, rw.z & 0xffff0000u), __builtin_bit_cast(float, rw.w << 16), __builtin_bit_cast(float, rw.w & 0xffff0000u)};
                    const f32x4 v0 = r0 + acc[ai][bj][m][0] * hsc, v1 = r1 + acc[ai][bj][m][1] * hsc;
                    s += (v0[0] * v0[0] + v0[1] * v0[1]) + (v0[2] * v0[2] + v0[3] * v0[3]) + (v1[0] * v1[0] + v1[1] * v1[1]) + (v1[2] * v1[2] + v1[3] * v1[3]);
                    if (outF) { float* op = outF + (size_t)row * P_D + col0 + bj * HALF; *(f32x4*)(op) = v0; *(f32x4*)(op + 4) = v1; }
                    else *(u32x4*)(xp + bj * HALF) = pack8(v0, v1);
                }
                if (ssn) { s += __shfl_xor(s, 16); s += __shfl_xor(s, 32); if (fq == 0) atomicAdd(ssn + row, s); }
            }
    }
};
struct EpiSwiglu {
    static constexpr bool PERM = true, AFTER_DRAIN = false;
    bf16_t* H; const float* ss;
    __device__ __forceinline__ void operator()(const f32x4 (&acc)[2][2][4][2], const Unit& u, int wr, int wc, int fr, int fq) const {
        const int col0 = u.pn * HALF + wc * 32 + 8 * fq;
#pragma unroll
        for (int ai = 0; ai < 2; ++ai)
#pragma unroll
            for (int m = 0; m < 4; ++m) {
                const int row = u.pm * BM + ai * HALF + wr * 64 + m * 16 + fr;
                const float rstd = __builtin_amdgcn_rsqf(ss[row] * (1.0f / 1024.0f) + P_EPS);
                f32x4 h[2];
#pragma unroll
                for (int n = 0; n < 2; ++n) { const f32x4 g = acc[ai][0][m][n] * rstd, uu = acc[ai][1][m][n] * rstd;
#pragma unroll
                    for (int j = 0; j < 4; ++j) h[n][j] = silu_f(g[j]) * uu[j]; }
                *(u32x4*)(H + (size_t)row * 2816 + col0) = pack8(h[0], h[1]);
            }
    }
};
struct EpiSwaIn {
    static constexpr bool PERM = true, AFTER_DRAIN = false;
    bf16_t* O; const float* ss; const float* cosT; const float* sinT; const float* qg; const float* kg; float* kc_p; float* vc_p; float* kc_s; float* vc_s;
    __device__ __forceinline__ void operator()(const f32x4 (&acc)[2][2][4][2], const Unit& u, int wr, int wc, int fr, int fq) const {
        const int pn = u.pn;
        const float* G = (pn < 4) ? qg : kg;
        f32x4 g1[2], g2[2];
#pragma unroll
        for (int n = 0; n < 2; ++n) { g1[n] = *(const f32x4*)(G + 8 * fq + 4 * n); g2[n] = *(const f32x4*)(G + 32 + 8 * fq + 4 * n); }
        const int cbase = (pn < 4 ? (pn * 4 + wc) * 64 : (pn == 4 ? 1024 : 1280) + wc * 64) + 8 * fq;
#pragma unroll
        for (int ai = 0; ai < 2; ++ai)
#pragma unroll
            for (int m = 0; m < 4; ++m) {
                const int row = u.pm * BM + ai * HALF + wr * 64 + m * 16 + fr;
                const float rstd = __builtin_amdgcn_rsqf(ss[row] * (1.0f / 1024.0f) + P_EPS);
                bf16_t* rowp = O + (size_t)row * 1536 + cbase;
                float* cdst = nullptr;
                if (pn >= 4) {
                    float* cp_ = (pn == 4) ? kc_p : vc_p; float* cs_ = (pn == 4) ? kc_s : vc_s;
                    if (row < P_NP) { const int b = row >> 11, t = row & 2047; if (t >= 1920) cdst = cp_ + ((size_t)(b * 128 + (t - 1920)) * 4 + wc) * 64 + 8 * fq; }
                    else { const int s_ = row - P_NP, b = s_ >> 2, t = s_ & 3; cdst = cs_ + ((size_t)(b * 128 + 124 + t) * 4 + wc) * 64 + 8 * fq; }
                }
                f32x4 o1[2], o2[2];
                if (pn < 5) {
                    f32x4 x1[2], x2[2]; float q = 0.f;
#pragma unroll
                    for (int n = 0; n < 2; ++n) { x1[n] = acc[ai][0][m][n] * rstd; x2[n] = acc[ai][1][m][n] * rstd;
                        q += (x1[n][0] * x1[n][0] + x1[n][1] * x1[n][1]) + (x1[n][2] * x1[n][2] + x1[n][3] * x1[n][3]) + (x2[n][0] * x2[n][0] + x2[n][1] * x2[n][1]) + (x2[n][2] * x2[n][2] + x2[n][3] * x2[n][3]); }
                    q += __shfl_xor(q, 16); q += __shfl_xor(q, 32);
                    const float hr = __builtin_amdgcn_rsqf(q * (1.0f / 64.0f) + P_EPS);
                    const int pidx = pos_index(row);
                    const f32x4* cp = (const f32x4*)(cosT + pidx * 32 + 8 * fq); const f32x4* sp = (const f32x4*)(sinT + pidx * 32 + 8 * fq);
                    const float osc = (pn < 4) ? 0.125f : 1.0f;
#pragma unroll
                    for (int n = 0; n < 2; ++n) { const f32x4 c = cp[n], s = sp[n]; const f32x4 a = x1[n] * hr * g1[n], b = x2[n] * hr * g2[n]; o1[n] = (a * c - b * s) * osc; o2[n] = (b * c + a * s) * osc; }
                } else {
#pragma unroll
                    for (int n = 0; n < 2; ++n) { o1[n] = acc[ai][0][m][n] * rstd; o2[n] = acc[ai][1][m][n] * rstd; }
                }
                *(u32x4*)(rowp) = pack8(o1[0], o1[1]); *(u32x4*)(rowp + 32) = pack8(o2[0], o2[1]);
                if (cdst) { *(f32x4*)(cdst) = o1[0]; *(f32x4*)(cdst + 4) = o1[1]; *(f32x4*)(cdst + 32) = o2[0]; *(f32x4*)(cdst + 36) = o2[1]; }
            }
    }
};

template <class Epi, class Sched, bool ALIGN_EPI = false, bool SP2 = false, bool HS = false>
__device__ __forceinline__ void gemm_phase(PG8_LAS unsigned char* lds, const Gemm g, const Sched& S, const Epi& E, const PG8_LAS float* hs = nullptr) {
    const int tid = threadIdx.x, wid = __builtin_amdgcn_readfirstlane(tid >> 6), lane = tid & 63, wr = wid >> 2, wc = wid & 3, fr = lane & 15, fq = lane >> 4;
    const int K = g.K, nt = K / BK;
    unsigned voffA[2], voffB[2];
#pragma unroll
    for (int i = 0; i < 2; ++i) { int R, C; stage_rc(tid * 16 + i * 8192, R, C); const int Rb = Epi::PERM ? ((R & ~31) + perm32(R & 31)) : R;
        voffA[i] = (unsigned)(R * K + C) * 2u; voffB[i] = (unsigned)(Rb * K + C) * 2u; }
    const size_t kstep = (size_t)(BK * 2);
    const size_t hstep = (size_t)HALF * K * 2;
    const size_t tstep = 2 * hstep;
    const unsigned ldsw = (unsigned)wid * 1024u;
    const int aoff = lds_byte(wr * 64 + fr, fq * 8), boff = lds_byte(wc * 32 + fr, fq * 8);
#define PG8_SA(b, h) (((b) * 2 + (h)) * HTB)
#define PG8_SB(b, h) ((4 + (b) * 2 + (h)) * HTB)
#define PG8_STAGE(bufoff, gbase, voff) do { _Pragma("unroll") for (int _i = 0; _i < 2; ++_i) \
        __builtin_amdgcn_global_load_lds((const unsigned*)((const char*)(gbase) + (voff)[_i]), (PG8_LAS unsigned*)(lds + (bufoff) + ldsw + _i * 8192), 16, 0, 0); } while (0)
#define PG8_LDA(dst, b, h) do { _Pragma("unroll") for (int m = 0; m < 4; ++m) _Pragma("unroll") for (int k = 0; k < 2; ++k) dst[m][k] = *(const PG8_LAS bf16x8*)(lds + PG8_SA(b, h) + aoff + m * 2048 + k * 1024); } while (0)
#define PG8_LDB(dst, b, h) do { _Pragma("unroll") for (int n = 0; n < 2; ++n) _Pragma("unroll") for (int k = 0; k < 2; ++k) dst[n][k] = *(const PG8_LAS bf16x8*)(lds + PG8_SB(b, h) + boff + n * 2048 + k * 1024); } while (0)
#define PG8_MMA(ai, bj, At, Bt) do { __builtin_amdgcn_s_setprio(1); _Pragma("unroll") for (int m = 0; m < 4; ++m) _Pragma("unroll") for (int n = 0; n < 2; ++n) _Pragma("unroll") for (int k = 0; k < 2; ++k) \
        acc[ai][bj][m][n] = __builtin_amdgcn_mfma_f32_16x16x32_bf16(Bt[n][k], At[m][k], acc[ai][bj][m][n], 0, 0, 0); __builtin_amdgcn_s_setprio(0); } while (0)
#define PG8_WAIT_V(n) asm volatile("s_waitcnt vmcnt(" #n ")" ::: "memory")
#define PG8_WAIT_L(n) asm volatile("s_waitcnt lgkmcnt(" #n ")" ::: "memory")
#define PG8_BAR __builtin_amdgcn_s_barrier()
#define PG8_SCHED __builtin_amdgcn_sched_barrier(0)
    Unit cur, nxt; int ui = 0;
    if (!S.next(0, cur)) return;
    f32x4 acc[2][2][4][2];
#pragma unroll
    for (int a = 0; a < 2; ++a)
#pragma unroll
        for (int b = 0; b < 2; ++b)
#pragma unroll
            for (int m = 0; m < 4; ++m)
#pragma unroll
                for (int n = 0; n < 2; ++n) acc[a][b][m][n] = (f32x4){0.f, 0.f, 0.f, 0.f};
    bf16x8 At[4][2], B0[2][2], B1[2][2];
    const char* cA = (const char*)g.A + (size_t)cur.pm * tstep; const char* cB = (const char*)g.Bt + (size_t)cur.pn * tstep;
    S.a_ready(cur);
    if constexpr (SP2) {
        PG8_STAGE(PG8_SB(0, 0), cB, voffB); PG8_STAGE(PG8_SB(0, 1), cB + hstep, voffB); PG8_STAGE(PG8_SA(0, 0), cA, voffA); PG8_STAGE(PG8_SA(0, 1), cA + hstep, voffA);
        if (wr == 1) PG8_BAR;
        PG8_WAIT_V(2); PG8_BAR;
        PG8_STAGE(PG8_SB(1, 0), cB + kstep, voffB); PG8_STAGE(PG8_SA(1, 0), cA + kstep, voffA); PG8_STAGE(PG8_SB(1, 1), cB + hstep + kstep, voffB);
        PG8_WAIT_V(6); PG8_BAR;
    } else {
        PG8_STAGE(PG8_SB(0, 0), cB, voffB); PG8_STAGE(PG8_SA(0, 0), cA, voffA); PG8_STAGE(PG8_SB(0, 1), cB + hstep, voffB); PG8_STAGE(PG8_SA(0, 1), cA + hstep, voffA);
        if (wr == 1) PG8_BAR;
        PG8_WAIT_V(4); PG8_BAR;
        PG8_STAGE(PG8_SB(1, 0), cB + kstep, voffB); PG8_STAGE(PG8_SA(1, 0), cA + kstep, voffA); PG8_STAGE(PG8_SB(1, 1), cB + hstep + kstep, voffB);
        PG8_WAIT_V(6); PG8_BAR;
    }
    for (;;) {
        const bool has_next = S.next(ui + 1, nxt);
        const char* nA = has_next ? (const char*)g.A + (size_t)nxt.pm * tstep : cA; const char* nB = has_next ? (const char*)g.Bt + (size_t)nxt.pn * tstep : cB;
        for (int t = 0; t < nt; t += 2) {
            if constexpr (HS) { if (t == 8 || t == 16 || t == 24) { const int hb_ = (t >> 3) - 1;
#pragma unroll
                for (int ai = 0; ai < 2; ++ai)
#pragma unroll
                    for (int m = 0; m < 4; ++m) { const float rt_ = hs[(ai * HALF + wr * 64 + m * 16 + fr) * 4 + hb_];
#pragma unroll
                        for (int bj = 0; bj < 2; ++bj)
#pragma unroll
                            for (int n = 0; n < 2; ++n) acc[ai][bj][m][n] = acc[ai][bj][m][n] * rt_; } } }
            const bool last = (t == nt - 2);
            const char* a1 = cA + (size_t)(t + 1) * kstep;
            const char* a2 = last ? nA : cA + (size_t)(t + 2) * kstep; const char* b2 = last ? nB : cB + (size_t)(t + 2) * kstep;
            const char* a3 = a2 + kstep; const char* b3 = b2 + kstep;
            if (last && has_next) S.a_ready(nxt);
            if constexpr (SP2) {
            PG8_LDB(B0, 0, 0); PG8_LDB(B1, 0, 1); PG8_SCHED; PG8_LDA(At, 0, 0); PG8_STAGE(PG8_SA(1, 1), a1 + hstep, voffA);
            PG8_WAIT_V(8); PG8_WAIT_L(0); PG8_BAR; PG8_MMA(0, 0, At, B0); PG8_MMA(0, 1, At, B1); PG8_BAR; PG8_SCHED;
            PG8_LDA(At, 0, 1); PG8_STAGE(PG8_SB(0, 0), b2, voffB); PG8_STAGE(PG8_SB(0, 1), b2 + hstep, voffB); PG8_STAGE(PG8_SA(0, 0), a2, voffA);
            PG8_WAIT_V(8); PG8_WAIT_L(0); PG8_BAR; PG8_MMA(1, 0, At, B0); PG8_MMA(1, 1, At, B1); PG8_BAR; PG8_SCHED;
            PG8_LDB(B0, 1, 0); PG8_LDB(B1, 1, 1); PG8_SCHED; PG8_LDA(At, 1, 0); PG8_STAGE(PG8_SA(0, 1), a2 + hstep, voffA);
            PG8_WAIT_V(8); PG8_WAIT_L(0); PG8_BAR; PG8_MMA(0, 0, At, B0); PG8_MMA(0, 1, At, B1); PG8_BAR; PG8_SCHED;
            PG8_LDA(At, 1, 1); PG8_STAGE(PG8_SB(1, 0), b3, voffB); PG8_STAGE(PG8_SB(1, 1), b3 + hstep, voffB); PG8_STAGE(PG8_SA(1, 0), a3, voffA);
            PG8_WAIT_V(8); PG8_WAIT_L(0); PG8_BAR; PG8_MMA(1, 0, At, B0); PG8_MMA(1, 1, At, B1); PG8_BAR; PG8_SCHED;
            } else {
            PG8_LDB(B0, 0, 0); PG8_SCHED; PG8_LDA(At, 0, 0); PG8_STAGE(PG8_SA(1, 1), a1 + hstep, voffA);
            PG8_WAIT_L(8); PG8_BAR; PG8_WAIT_L(0); PG8_MMA(0, 0, At, B0); PG8_BAR; PG8_SCHED;
            PG8_LDB(B1, 0, 1); PG8_STAGE(PG8_SB(0, 0), b2, voffB);
            PG8_BAR; PG8_WAIT_L(0); PG8_MMA(0, 1, At, B1); PG8_BAR;
            PG8_LDA(At, 0, 1); PG8_STAGE(PG8_SA(0, 0), a2, voffA);
            PG8_BAR; PG8_WAIT_L(0); PG8_MMA(1, 0, At, B0); PG8_BAR; PG8_SCHED;
            PG8_STAGE(PG8_SB(0, 1), b2 + hstep, voffB);
            PG8_WAIT_V(6); PG8_BAR; PG8_MMA(1, 1, At, B1); PG8_BAR;
            PG8_LDB(B0, 1, 0); PG8_SCHED; PG8_LDA(At, 1, 0); PG8_STAGE(PG8_SA(0, 1), a2 + hstep, voffA);
            PG8_WAIT_L(8); PG8_BAR; PG8_WAIT_L(0); PG8_MMA(0, 0, At, B0); PG8_BAR; PG8_SCHED;
            PG8_LDB(B1, 1, 1); PG8_STAGE(PG8_SB(1, 0), b3, voffB);
            PG8_BAR; PG8_WAIT_L(0); PG8_MMA(0, 1, At, B1); PG8_BAR;
            PG8_LDA(At, 1, 1); PG8_STAGE(PG8_SA(1, 0), a3, voffA);
            PG8_BAR; PG8_WAIT_L(0); PG8_MMA(1, 0, At, B0); PG8_BAR; PG8_SCHED;
            PG8_STAGE(PG8_SB(1, 1), b3 + hstep, voffB);
            PG8_WAIT_V(6); PG8_BAR; PG8_MMA(1, 1, At, B1); PG8_BAR;
            }
        }
        if constexpr (ALIGN_EPI) { if (wr == 0) PG8_BAR; }
        if constexpr (!Epi::AFTER_DRAIN) { E(acc, cur, wr, wc, fr, fq); S.done(cur); }
        if (!has_next) break;
#pragma unroll
        for (int a = 0; a < 2; ++a)
#pragma unroll
            for (int b = 0; b < 2; ++b)
#pragma unroll
                for (int m = 0; m < 4; ++m)
#pragma unroll
                    for (int n = 0; n < 2; ++n) acc[a][b][m][n] = (f32x4){0.f, 0.f, 0.f, 0.f};
        cur = nxt; cA = nA; cB = nB; ++ui;
        if constexpr (ALIGN_EPI) { if (wr == 1) PG8_BAR; }
    }
    PG8_WAIT_V(0);
    if constexpr (!ALIGN_EPI) { if (wr == 0) PG8_BAR; }
    PG8_BAR;
    if constexpr (Epi::AFTER_DRAIN) { E.fused(acc, cur, wr, wc, fr, fq, lds, wid, lane); S.done(cur); }
#undef PG8_SA
#undef PG8_SB
#undef PG8_STAGE
#undef PG8_LDA
#undef PG8_LDB
#undef PG8_MMA
#undef PG8_WAIT_V
#undef PG8_WAIT_L
#undef PG8_BAR
#undef PG8_SCHED
}
}
#define LAS __attribute__((address_space(3)))
typedef unsigned short bf16;
typedef unsigned u32x4 __attribute__((ext_vector_type(4)));
typedef unsigned u32x2 __attribute__((ext_vector_type(2)));
typedef float f32x4 __attribute__((ext_vector_type(4)));
typedef short bf16x8 __attribute__((ext_vector_type(8)));
#define LDS_WAIT() asm volatile("s_waitcnt lgkmcnt(0)" ::: "memory")

constexpr int NWAVES = 8, NTHR = 512;
constexpr int DM = 1024, NP = 16384, NS = 512, MT = NP + NS, SEQ = 2048, DFF = 2816;
constexpr float EPS = 1e-6f;
constexpr int LDS_BYTES = 147456;

constexpr size_t al256(size_t x) { return (x + 255) & ~(size_t)255; }
constexpr size_t WS_WRI = 0;
constexpr size_t WS_WRO = WS_WRI + al256(6144ull * 1024 * 2);
constexpr size_t WS_WFI0 = WS_WRO + al256(1024ull * 2048 * 2);
constexpr size_t WS_WFO0 = WS_WFI0 + al256(5632ull * 1024 * 2);
constexpr size_t WS_WFI1 = WS_WFO0 + al256(1024ull * 2816 * 2);
constexpr size_t WS_WFO1 = WS_WFI1 + al256(5632ull * 1024 * 2);
constexpr size_t WS_WSI = WS_WFO1 + al256(1024ull * 2816 * 2);
constexpr size_t WS_WSO = WS_WSI + al256(1536ull * 1024 * 2);
constexpr size_t WS_XB = WS_WSO + al256(1024ull * 1024 * 2);
constexpr size_t WS_BIG = WS_XB + al256((size_t)MT * 1024 * 2);
constexpr size_t WS_OB = WS_BIG + al256((size_t)MT * 6144 * 2);
constexpr size_t WS_SS = WS_OB + al256((size_t)MT * 2048 * 2);
constexpr size_t WS_SSO = WS_SS + al256(4ull * MT * 4);
constexpr size_t WS_TRC = WS_SSO + al256((size_t)MT * 4 * 4);
constexpr size_t WS_TRS = WS_TRC + al256(2052ull * 128 * 4);
constexpr size_t WS_TSC = WS_TRS + al256(2052ull * 128 * 4);
constexpr size_t WS_TSS = WS_TSC + al256(2052ull * 32 * 4);
constexpr size_t WS_END = WS_TSS + al256(2052ull * 32 * 4);
constexpr size_t WS_SSOP = WS_END;
constexpr size_t WS_CTL = WS_SSOP + al256((size_t)NP * 64 * 4), CTL_BYTES = 65536;
constexpr size_t WS_SCR = WS_CTL + CTL_BYTES;
constexpr size_t WS_TOTAL = WS_SCR;
constexpr size_t OUT_Y = 0, OUT_SP = (size_t)MT * 1024, OUT_SS = OUT_SP + 8ull * 4 * 256 * 512, OUT_KP = OUT_SS + 128ull * 4 * 256 * 512,
                 OUT_VP = OUT_KP + 8ull * 128 * 256, OUT_KS = OUT_VP + 8ull * 128 * 256, OUT_VS = OUT_KS + 128ull * 128 * 256, OUT_END = OUT_VS + 128ull * 128 * 256;

struct Params {
    const float* in[16]; float* out; unsigned char* ws;
    double invR[128]; double invS[32];
    float lg2[4];
    int ph_lo, ph_hi;
};

__device__ __forceinline__ unsigned f2bf(float f) { unsigned u = __builtin_bit_cast(unsigned, f); return (u + 0x7fffu + ((u >> 16) & 1u)) >> 16; }
__device__ __forceinline__ unsigned pk2(float lo, float hi) { return pg8::cvt_pk_bf16(lo, hi); }
__device__ __forceinline__ float bf2f(unsigned short b) { return __builtin_bit_cast(float, (unsigned)b << 16); }
__device__ __forceinline__ float bflo(unsigned w) { return __builtin_bit_cast(float, w << 16); }
__device__ __forceinline__ float bfhi(unsigned w) { return __builtin_bit_cast(float, w & 0xffff0000u); }
__device__ __forceinline__ float wave_sum(float v) {
#pragma unroll
    for (int o = 1; o < 64; o <<= 1) v += __shfl_xor(v, o);
    return v;
}
__device__ __forceinline__ f32x4 mfma16(bf16x8 a, bf16x8 b, f32x4 c) { return __builtin_amdgcn_mfma_f32_16x16x32_bf16(a, b, c, 0, 0, 0); }

__device__ __forceinline__ void transpose_item(const float* W, int K, int N, const float* gain, bf16* WT, int n0, int d0a, int d0b, int k0, LAS float* scr, int lane) {
    f32x4 wv[16];
#pragma unroll
    for (int i = 0; i < 16; ++i) { const int kk = 4 * i + (lane >> 4); wv[i] = __builtin_nontemporal_load((const f32x4*)(W + (size_t)(k0 + kk) * N + n0 + 4 * (lane & 15))); }
#pragma unroll
    for (int i = 0; i < 16; ++i) { const int kk = 4 * i + (lane >> 4); const float g = gain ? gain[k0 + kk] : 1.0f; LAS float* d = scr + kk * 65 + 4 * (lane & 15);
        d[0] = wv[i][0] * g; d[1] = wv[i][1] * g; d[2] = wv[i][2] * g; d[3] = wv[i][3] * g; }
    LDS_WAIT();
    const int c = lane & 7;
#pragma unroll
    for (int j = 0; j < 8; ++j) { const int n = (lane >> 3) + 8 * j; const LAS float* s = scr + (8 * c) * 65 + n;
        u32x4 o; o.x = pk2(s[0 * 65], s[1 * 65]); o.y = pk2(s[2 * 65], s[3 * 65]); o.z = pk2(s[4 * 65], s[5 * 65]); o.w = pk2(s[6 * 65], s[7 * 65]);
        const int drow = (n < 32) ? d0a + n : d0b + n - 32;
        *(u32x4*)(WT + (size_t)drow * K + k0 + 8 * c) = o; }
    LDS_WAIT();
}
__device__ __forceinline__ int dmap32(int mode, int n0) {
    if (mode == 1) return (n0 < DFF) ? (n0 / 128) * 256 + (n0 % 128) : ((n0 - DFF) / 128) * 256 + 128 + ((n0 - DFF) % 128);
    if (mode == 2) { const int pn = n0 / 256, r256 = n0 % 256, wc = r256 / 64, bj = (r256 % 64) / 32; return 256 * pn + 128 * bj + 32 * wc; }
    return n0;
}
__device__ __forceinline__ void transpose_mat(const float* W, int K, int N, const float* gain, bf16* WT, int mode, int r, LAS float* scr, int lane) {
    const int nblk = N / 64, kb = r / nblk, nb = r % nblk, n0 = 64 * nb;
    transpose_item(W, K, N, gain, WT, n0, dmap32(mode, n0), dmap32(mode, n0 + 32), 64 * kb, scr, lane);
}
__device__ __forceinline__ void p0_prologue(const Params& p, LAS unsigned char* lds, int tid, int lane, int wave, int vcu, int G, int part, int wid1, int nwg1) {
    unsigned char* ws = p.ws;
    LAS float* scr = (LAS float*)(lds + wave * 16896);
    const int gw = part ? wid1 * NWAVES + wave : vcu * NWAVES + wave, NGW = (part ? nwg1 : G) * NWAVES;
    constexpr int I_RI = 16 * 96, I_RO = 32 * 16, I_FI = 16 * 88, I_FO = 44 * 16, I_SI = 16 * 24, I_SO = 16 * 16;
    constexpr int NITEMS = I_RI + I_RO + 2 * I_FI + 2 * I_FO + I_SI + I_SO;
    const float* nmix = p.in[5]; const float* nffn = p.in[6];
    for (int it = (part ? I_RI + gw : gw); it < (part ? NITEMS : I_RI); it += NGW) {
        int r = it;
        if (r < I_RI) { transpose_mat(p.in[7], 1024, 6144, nmix, (bf16*)(ws + WS_WRI), 0, r, scr, lane); continue; } r -= I_RI;
        if (r < I_RO) { transpose_mat(p.in[8], 2048, 1024, nullptr, (bf16*)(ws + WS_WRO), 0, r, scr, lane); continue; } r -= I_RO;
        if (r < I_FI) { transpose_mat(p.in[14], 1024, 5632, nffn, (bf16*)(ws + WS_WFI0), 1, r, scr, lane); continue; } r -= I_FI;
        if (r < I_FO) { transpose_mat(p.in[15], 2816, 1024, nullptr, (bf16*)(ws + WS_WFO0), 0, r, scr, lane); continue; } r -= I_FO;
        if (r < I_SI) { transpose_mat(p.in[9], 1024, 1536, nmix + 1024, (bf16*)(ws + WS_WSI), 2, r, scr, lane); continue; } r -= I_SI;
        if (r < I_SO) { transpose_mat(p.in[10], 1024, 1024, nullptr, (bf16*)(ws + WS_WSO), 0, r, scr, lane); continue; } r -= I_SO;
        if (r < I_FI) { transpose_mat(p.in[14] + (size_t)1024 * 5632, 1024, 5632, nffn + 1024, (bf16*)(ws + WS_WFI1), 1, r, scr, lane); continue; } r -= I_FI;
        transpose_mat(p.in[15] + (size_t)2816 * 1024, 2816, 1024, nullptr, (bf16*)(ws + WS_WFO1), 0, r, scr, lane);
    }
    if (part) return;
    float* cR = (float*)(ws + WS_TRC); float* sR = (float*)(ws + WS_TRS); float* cS = (float*)(ws + WS_TSC); float* sS = (float*)(ws + WS_TSS);
    for (int idx = vcu * NTHR + tid; idx < 2052 * 160; idx += G * NTHR) {
        const int pi = idx / 160, c = idx % 160; const double pos = (pi < 2048) ? (double)pi : (double)(16384 + (pi - 2048));
        double rev = pos * ((c < 128) ? p.invR[c] : p.invS[c - 128]); rev -= __builtin_rint(rev);
        const float cv = __builtin_amdgcn_cosf((float)rev), sv = __builtin_amdgcn_sinf((float)rev);
        if (c < 128) { cR[pi * 128 + c] = cv; sR[pi * 128 + c] = sv; } else { cS[pi * 32 + c - 128] = cv; sS[pi * 32 + c - 128] = sv; }
    }
    bf16* XB = (bf16*)(ws + WS_XB); float* ss = (float*)(ws + WS_SS); float* sso = (float*)(ws + WS_SSO);
    for (int m = gw; m < MT; m += NGW) {
        const float* xr = (m < NP) ? p.in[0] + (size_t)m * DM : p.in[1] + (size_t)(m - NP) * DM;
        f32x4 v[4]; float s = 0.f;
#pragma unroll
        for (int j = 0; j < 4; ++j) { v[j] = ((const f32x4*)xr)[lane + 64 * j]; s += (v[j][0] * v[j][0] + v[j][1] * v[j][1]) + (v[j][2] * v[j][2] + v[j][3] * v[j][3]); }
        s = wave_sum(s);
#pragma unroll
        for (int j = 0; j < 4; ++j) { u32x2 o; o.x = pk2(v[j][0], v[j][1]); o.y = pk2(v[j][2], v[j][3]); ((u32x2*)(XB + (size_t)m * DM))[lane + 64 * j] = o; }
        if (lane == 0) { ss[m] = s; ss[MT + m] = 0.f; ss[2 * MT + m] = 0.f; ss[3 * MT + m] = 0.f; }
    }
}

constexpr int RQ_STR = 264, RV_STR = 72;
constexpr int RL_Q = 0, RL_K = 33792, RL_VT = 67584, RL_VD = 76800, RL_P = 86016, RL_ST = 95232, RL_GL = 129024;
__device__ __forceinline__ void ret_prompt_unit(LAS unsigned char* lds, const bf16* QKVG, bf16* OB, float* sso, float* state_out, int bh, int es, float lg2, int tid) {
    const int lane = tid & 63, w = __builtin_amdgcn_readfirstlane(tid >> 6), li = lane & 15, lq = lane >> 4;
    const int b = bh >> 2, h = bh & 3;
    LAS bf16* Ql = (LAS bf16*)(lds + RL_Q); LAS bf16* Kl = (LAS bf16*)(lds + RL_K); LAS bf16* VT = (LAS bf16*)(lds + RL_VT);
    LAS bf16* VD = (LAS bf16*)(lds + RL_VD); LAS bf16* PP = (LAS bf16*)(lds + RL_P); LAS bf16* ST = (LAS bf16*)(lds + RL_ST);
    for (int i = tid; i < 33792 / 16; i += NTHR) ((LAS u32x4*)ST)[i] = (u32x4){0u, 0u, 0u, 0u};
    f32x4 S[2][4];
#pragma unroll
    for (int a = 0; a < 2; ++a)
#pragma unroll
        for (int e = 0; e < 4; ++e) S[a][e] = (f32x4){0.f, 0.f, 0.f, 0.f};
    const size_t rowbase = (size_t)b * SEQ;
    const bf16* qg = QKVG + ((size_t)h * MT + rowbase) * 256;
    const bf16* kg = qg + (size_t)4 * MT * 256;
    const bf16* vg = QKVG + (size_t)8 * MT * 256 + ((size_t)h * MT + rowbase) * 512 + es * 64;
    const int srow = tid >> 5, sch = tid & 31;
    const int vrow = tid & 63, vch = tid >> 6;
    const bf16* gg = vg + (size_t)4 * MT * 512;
    LAS bf16* GL = (LAS bf16*)(lds + RL_GL);
    u32x4 rq[4], rk[4], rv, rg;
#define RET_LOAD(t0_) do { _Pragma("unroll") for (int i_ = 0; i_ < 4; ++i_) { const size_t o_ = (size_t)((t0_) + srow + 16 * i_) * 256 + sch * 8; rq[i_] = *(const u32x4*)(qg + o_); rk[i_] = *(const u32x4*)(kg + o_); } \
        rv = *(const u32x4*)(vg + (size_t)((t0_) + vrow) * 512 + vch * 8); rg = *(const u32x4*)(gg + (size_t)((t0_) + vrow) * 512 + vch * 8); } while (0)
    RET_LOAD(0);
    const int ib = w >> 1, nh = w & 1;
    const float dS = __builtin_amdgcn_exp2f(64.0f * lg2);
    for (int c = 0; c < 32; ++c) {
        const int t0 = c * 64;
        asm volatile("s_waitcnt vmcnt(0)" ::: "memory");
#pragma unroll
        for (int i = 0; i < 4; ++i) { *(LAS u32x4*)(Ql + (srow + 16 * i) * RQ_STR + sch * 8) = rq[i]; *(LAS u32x4*)(Kl + (srow + 16 * i) * RQ_STR + sch * 8) = rk[i]; }
        *(LAS u32x4*)(GL + vrow * RV_STR + vch * 8) = rg;
        { const float dec = __builtin_amdgcn_exp2f((float)(63 - vrow) * lg2);
#pragma unroll
          for (int j = 0; j < 4; ++j) { const unsigned wv = rv[j]; const int e0 = vch * 8 + 2 * j;
              VT[e0 * RV_STR + vrow] = (bf16)(wv & 0xffffu); VT[(e0 + 1) * RV_STR + vrow] = (bf16)(wv >> 16);
              VD[e0 * RV_STR + vrow] = (bf16)f2bf(bflo(wv) * dec); VD[(e0 + 1) * RV_STR + vrow] = (bf16)f2bf(bfhi(wv) * dec); } }
        __syncthreads();
        if (c + 1 < 32) RET_LOAD(t0 + 64);
        f32x4 accS[2], accO[2];
#pragma unroll
        for (int t = 0; t < 2; ++t) { accS[t] = (f32x4){0.f, 0.f, 0.f, 0.f}; accO[t] = (f32x4){0.f, 0.f, 0.f, 0.f}; }
#pragma unroll
        for (int ks = 0; ks < 8; ++ks) {
            const bf16x8 a = *(const LAS bf16x8*)(Ql + (16 * ib + li) * RQ_STR + 32 * ks + 8 * lq);
#pragma unroll
            for (int t = 0; t < 2; ++t) {
                const bf16x8 bs = *(const LAS bf16x8*)(ST + (16 * (2 * nh + t) + li) * RQ_STR + 32 * ks + 8 * lq);
                accO[t] = mfma16(a, bs, accO[t]);
                { const bf16x8 bk = *(const LAS bf16x8*)(Kl + (16 * (2 * nh + t) + li) * RQ_STR + 32 * ks + 8 * lq); accS[t] = mfma16(a, bk, accS[t]); }
            }
        }
#pragma unroll
        for (int t = 0; t < 2; ++t) { const int jb = 2 * nh + t, j = 16 * jb + li;
#pragma unroll
            for (int r = 0; r < 4; ++r) { const int i = 16 * ib + 4 * lq + r;
                const float val = (j <= i) ? accS[t][r] * __builtin_amdgcn_exp2f((float)(i - j) * lg2) : 0.f;
                PP[i * RV_STR + j] = (bf16)f2bf(val); } }
        __syncthreads();
        f32x4 accA[2];
#pragma unroll
        for (int t = 0; t < 2; ++t) accA[t] = (f32x4){0.f, 0.f, 0.f, 0.f};
#pragma unroll
        for (int ks = 0; ks < 2; ++ks) {
            const bf16x8 a = *(const LAS bf16x8*)(PP + (16 * ib + li) * RV_STR + 32 * ks + 8 * lq);
#pragma unroll
            for (int t = 0; t < 2; ++t) { const bf16x8 bv = *(const LAS bf16x8*)(VT + (16 * (2 * nh + t) + li) * RV_STR + 32 * ks + 8 * lq); accA[t] = mfma16(a, bv, accA[t]); }
        }
#pragma unroll
        for (int r = 0; r < 4; ++r) { const int i = 16 * ib + 4 * lq + r; const float f = __builtin_amdgcn_exp2f((float)(i + 1) * lg2);
            const size_t row = rowbase + t0 + i; float q2 = 0.f;
#pragma unroll
            for (int t = 0; t < 2; ++t) { const float o = accA[t][r] + f * accO[t][r]; q2 += o * o; OB[row * 2048 + h * 512 + es * 64 + 16 * (2 * nh + t) + li] = (bf16)f2bf(o * bf2f(GL[i * RV_STR + 16 * (2 * nh + t) + li])); }
            q2 += __shfl_xor(q2, 1); q2 += __shfl_xor(q2, 2); q2 += __shfl_xor(q2, 4); q2 += __shfl_xor(q2, 8);
            if (li == 0 && sso) sso[(row * 4 + h) * 16 + es * 2 + nh] = q2; }
#pragma unroll
        for (int a = 0; a < 2; ++a)
#pragma unroll
            for (int e = 0; e < 4; ++e) S[a][e] = S[a][e] * dS;
#pragma unroll
        for (int ks = 0; ks < 2; ++ks) {
            bf16x8 ka[2];
#pragma unroll
            for (int dm = 0; dm < 2; ++dm)
#pragma unroll
                for (int jj = 0; jj < 8; ++jj) ka[dm][jj] = (short)Kl[(32 * ks + 8 * lq + jj) * RQ_STR + 32 * w + 16 * dm + li];
#pragma unroll
            for (int en = 0; en < 4; ++en) { const bf16x8 bv = *(const LAS bf16x8*)(VD + (16 * en + li) * RV_STR + 32 * ks + 8 * lq);
#pragma unroll
                for (int dm = 0; dm < 2; ++dm) S[dm][en] = mfma16(ka[dm], bv, S[dm][en]); }
        }
#pragma unroll
        for (int dm = 0; dm < 2; ++dm)
#pragma unroll
            for (int en = 0; en < 4; ++en) { u32x2 o; o.x = f2bf(S[dm][en][0]) | (f2bf(S[dm][en][1]) << 16); o.y = f2bf(S[dm][en][2]) | (f2bf(S[dm][en][3]) << 16);
                *(LAS u32x2*)(ST + (16 * en + li) * RQ_STR + 32 * w + 16 * dm + 4 * lq) = o; }
        __syncthreads();
    }
#undef RET_LOAD
    float* so = state_out + ((size_t)bh * 256) * 512 + es * 64;
#pragma unroll
    for (int dm = 0; dm < 2; ++dm)
#pragma unroll
        for (int en = 0; en < 4; ++en)
#pragma unroll
            for (int r = 0; r < 4; ++r) so[(size_t)(32 * w + 16 * dm + 4 * lq + r) * 512 + 16 * en + li] = S[dm][en][r];
}

__device__ __forceinline__ void ret_sample_unit(LAS unsigned char* lds, const bf16* QKVG, bf16* OB, const float* state_in, float* state_out, int bh, float lg2, int tid) {
    const int lane = tid & 63, w = __builtin_amdgcn_readfirstlane(tid >> 6);
    const int b = bh >> 2, h = bh & 3;
    LAS float* qk8 = (LAS float*)lds;
    LAS float* qkd = qk8 + 2048;
    LAS float* red = qkd + 16;
    LAS float* wsm = red + 8192;
    const size_t r0 = (size_t)(NP + b * 4);
    {
        const int idx = tid * 4, which = idx >> 10, t = (idx >> 8) & 3, d = idx & 255;
        const u32x2 v = *(const u32x2*)(QKVG + (size_t)which * 4 * MT * 256 + ((size_t)h * MT + r0 + t) * 256 + d);
        LAS float* dst = qk8 + d * 8 + which * 4 + t;
        dst[0] = bflo(v.x); dst[8] = bfhi(v.x); dst[16] = bflo(v.y); dst[24] = bfhi(v.y);
    }
    __syncthreads();
    {
#pragma unroll
        for (int pp = 0; pp < 2; ++pp) { const int pr = 2 * w + pp, i = pr >> 2, j = pr & 3; float s = 0.f;
#pragma unroll
            for (int dd = 0; dd < 4; ++dd) { const int d = lane * 4 + dd; s += qk8[d * 8 + i] * qk8[d * 8 + 4 + j]; }
            s = wave_sum(s); if (lane == 0) qkd[pr] = s; }
    }
    const float g1 = __builtin_amdgcn_exp2f(lg2), g2 = g1 * g1, g3 = g2 * g1, g4 = g2 * g2;
    const int ec = tid & 127, dg = tid >> 7;
    f32x4 vv[4];
#pragma unroll
    for (int j = 0; j < 4; ++j) { const u32x2 v = *(const u32x2*)(QKVG + (size_t)8 * MT * 256 + ((size_t)h * MT + r0 + j) * 512 + 4 * ec); vv[j] = (f32x4){bflo(v.x), bfhi(v.x), bflo(v.y), bfhi(v.y)}; }
    vv[0] = vv[0] * g3; vv[1] = vv[1] * g2; vv[2] = vv[2] * g1;
    f32x4 oa[4];
#pragma unroll
    for (int i = 0; i < 4; ++i) oa[i] = (f32x4){0.f, 0.f, 0.f, 0.f};
    const float* sin_ = state_in + ((size_t)bh * 256 + dg * 64) * 512 + 4 * ec;
    float* sout = state_out + ((size_t)bh * 256 + dg * 64) * 512 + 4 * ec;
    f32x4 sb[2][8];
#pragma unroll
    for (int r = 0; r < 8; ++r) sb[0][r] = __builtin_nontemporal_load((const f32x4*)(sin_ + (size_t)r * 512));
#pragma unroll
    for (int bt = 0; bt < 8; ++bt) {
        if (bt + 1 < 8) {
#pragma unroll
            for (int r = 0; r < 8; ++r) sb[(bt + 1) & 1][r] = __builtin_nontemporal_load((const f32x4*)(sin_ + (size_t)((bt + 1) * 8 + r) * 512));
            asm volatile("s_waitcnt vmcnt(8)" ::: "memory");
        } else asm volatile("s_waitcnt vmcnt(0)" ::: "memory");
#pragma unroll
        for (int r = 0; r < 8; ++r) { const int dd = bt * 8 + r; const f32x4 s = sb[bt & 1][r];
            const f32x4 q4 = *(const LAS f32x4*)(qk8 + (dg * 64 + dd) * 8), k4 = *(const LAS f32x4*)(qk8 + (dg * 64 + dd) * 8 + 4);
            const f32x4 sn = s * g4 + vv[0] * k4[0] + vv[1] * k4[1] + vv[2] * k4[2] + vv[3] * k4[3];
            __builtin_nontemporal_store(sn, (f32x4*)(sout + (size_t)dd * 512));
            oa[0] += s * q4[0]; oa[1] += s * q4[1]; oa[2] += s * q4[2]; oa[3] += s * q4[3]; }
    }
#pragma unroll
    for (int i = 0; i < 4; ++i) *(LAS f32x4*)(red + (dg * 4 + i) * 512 + 4 * ec) = oa[i];
    __syncthreads();
    {
        const int e = tid; float vj[4], o[4], q2[4];
#pragma unroll
        for (int j = 0; j < 4; ++j) vj[j] = bf2f(QKVG[(size_t)8 * MT * 256 + ((size_t)h * MT + r0 + j) * 512 + e]);
        const float gp[4] = {1.0f, g1, g2, g3};
#pragma unroll
        for (int i = 0; i < 4; ++i) { float ob = (red[(0 * 4 + i) * 512 + e] + red[(1 * 4 + i) * 512 + e]) + (red[(2 * 4 + i) * 512 + e] + red[(3 * 4 + i) * 512 + e]);
            float acc = ob * gp[i] * g1;
#pragma unroll
            for (int j = 0; j < 4; ++j) if (j <= i) acc += gp[i - j] * qkd[i * 4 + j] * vj[j];
            o[i] = acc; q2[i] = wave_sum(acc * acc); }
        if (lane == 0) {
#pragma unroll
            for (int i = 0; i < 4; ++i) wsm[w * 4 + i] = q2[i]; }
        __syncthreads();
#pragma unroll
        for (int i = 0; i < 4; ++i) { float t = 0.f;
#pragma unroll
            for (int ww = 0; ww < 8; ++ww) t += wsm[ww * 4 + i];
            const float rstd = __builtin_amdgcn_rsqf(t * (1.0f / 512.0f) + EPS);
            const float sg = bf2f(QKVG[(size_t)8 * MT * 256 + (size_t)4 * MT * 512 + ((size_t)h * MT + r0 + i) * 512 + e]);
            OB[(r0 + i) * 2048 + h * 512 + e] = (bf16)f2bf(o[i] * rstd * sg); }
    }
    __syncthreads();
}

__device__ __forceinline__ void ret_norm_pass(const bf16* QKVG, bf16* OB, const float* sso, int gw, int NGW, int lane) {
    for (int m = gw; m < NP; m += NGW) {
#pragma unroll
        for (int j = 0; j < 4; ++j) {
            const f32x4* pp = (const f32x4*)(sso + ((size_t)m * 4 + j) * 16);
            const f32x4 pa = pp[0] + pp[1] + pp[2] + pp[3];
            const float rstd = __builtin_amdgcn_rsqf(((pa[0] + pa[1]) + (pa[2] + pa[3])) * (1.0f / 512.0f) + EPS);
            u32x4 o = *(const u32x4*)(OB + (size_t)m * 2048 + 512 * j + lane * 8); const u32x4 g = *(const u32x4*)(QKVG + (size_t)8 * MT * 256 + (size_t)4 * MT * 512 + ((size_t)j * MT + m) * 512 + lane * 8);
#pragma unroll
            for (int k = 0; k < 4; ++k) o[k] = pk2(bflo(o[k]) * rstd * bflo(g[k]), bfhi(o[k]) * rstd * bfhi(g[k]));
            *(u32x4*)(OB + (size_t)m * 2048 + 512 * j + lane * 8) = o;
        }
    }
}

constexpr int AK_STR = 72, AV_STR = 264, AP_STR = 168;
constexpr int AL_K = 0, AL_VT = 36864, AL_P = 70656;
template <int AVS> __device__ __forceinline__ void attn_item(const LAS bf16* Kl, const LAS bf16* VT, LAS bf16* Pw, const bf16x8 (&qa)[2], int jt0, const int (&lo)[4], const int (&hi)[4], const float (&sink)[4], bf16* const (&outp)[4], int li, int lq) {
    f32x4 sc[10];
#pragma unroll
    for (int jt = 0; jt < 10; ++jt) { sc[jt] = (f32x4){0.f, 0.f, 0.f, 0.f};
#pragma unroll
        for (int ks = 0; ks < 2; ++ks) { const bf16x8 bk = *(const LAS bf16x8*)(Kl + (16 * (jt0 + jt) + li) * AK_STR + 32 * ks + 8 * lq); sc[jt] = mfma16(qa[ks], bk, sc[jt]); } }
    float mx[4], den[4];
#pragma unroll
    for (int r = 0; r < 4; ++r) { float m = sink[r];
#pragma unroll
        for (int jt = 0; jt < 10; ++jt) { const int j = 16 * (jt0 + jt) + li; const bool ok = (j >= lo[r]) && (j <= hi[r]); sc[jt][r] = ok ? sc[jt][r] : -INFINITY; m = fmaxf(m, sc[jt][r]); }
        m = fmaxf(m, __shfl_xor(m, 1)); m = fmaxf(m, __shfl_xor(m, 2)); m = fmaxf(m, __shfl_xor(m, 4)); m = fmaxf(m, __shfl_xor(m, 8));
        float s = 0.f;
#pragma unroll
        for (int jt = 0; jt < 10; ++jt) { const float e = __expf(sc[jt][r] - m); sc[jt][r] = e; s += e; }
        s += __shfl_xor(s, 1); s += __shfl_xor(s, 2); s += __shfl_xor(s, 4); s += __shfl_xor(s, 8);
        mx[r] = m; den[r] = __builtin_amdgcn_rcpf(s + __expf(sink[r] - m)); }
#pragma unroll
    for (int jt = 0; jt < 10; ++jt)
#pragma unroll
        for (int r = 0; r < 4; ++r) Pw[(4 * lq + r) * AP_STR + 16 * jt + li] = (bf16)f2bf(sc[jt][r] * den[r]);
    LDS_WAIT();
    f32x4 oc[4];
#pragma unroll
    for (int dn = 0; dn < 4; ++dn) oc[dn] = (f32x4){0.f, 0.f, 0.f, 0.f};
#pragma unroll
    for (int ks = 0; ks < 5; ++ks) { const bf16x8 pa = *(const LAS bf16x8*)(Pw + li * AP_STR + 32 * ks + 8 * lq);
#pragma unroll
        for (int dn = 0; dn < 4; ++dn) { const bf16x8 bv = *(const LAS bf16x8*)(VT + (16 * dn + li) * AVS + 16 * jt0 + 32 * ks + 8 * lq); oc[dn] = mfma16(pa, bv, oc[dn]); } }
#pragma unroll
    for (int r = 0; r < 4; ++r)
#pragma unroll
        for (int dn = 0; dn < 4; ++dn) outp[r][16 * dn + li] = (bf16)f2bf(oc[dn][r]);
    LDS_WAIT();
    (void)mx;
}
__device__ __forceinline__ void attn_prompt_unit(LAS unsigned char* lds, const bf16* QKV, bf16* AO, const float* sinks, int unit, int tid) {
    const int lane = tid & 63, w = __builtin_amdgcn_readfirstlane(tid >> 6), li = lane & 15, lq = lane >> 4;
    const int kvh = unit & 3, nb = (unit >> 2) & 15, b = unit >> 6;
    LAS bf16* Kl = (LAS bf16*)(lds + AL_K); LAS bf16* VT = (LAS bf16*)(lds + AL_VT); LAS bf16* Pw = (LAS bf16*)(lds + AL_P + w * 5376);
    const size_t rowbase = (size_t)b * SEQ; const int tb = nb * 128 - 128;
    bf16x8 qf[4][2];
#pragma unroll
    for (int it = 0; it < 4; ++it) { const int id = w * 4 + it, g = id >> 3, qt = id & 7; const bf16* qp = QKV + (rowbase + nb * 128 + 16 * qt + li) * 1536 + (kvh * 4 + g) * 64;
#pragma unroll
        for (int ks = 0; ks < 2; ++ks) qf[it][ks] = *(const bf16x8*)(qp + 32 * ks + 8 * lq); }
#pragma unroll
    for (int i = 0; i < 4; ++i) { const int id = tid + NTHR * i, j = id >> 3, ch = id & 7; const int t = tb + j;
        u32x4 kv = (u32x4){0u, 0u, 0u, 0u}, vv = (u32x4){0u, 0u, 0u, 0u};
        if (t >= 0) { const bf16* src = QKV + (rowbase + t) * 1536 + 1024 + kvh * 64 + ch * 8; kv = *(const u32x4*)src; vv = *(const u32x4*)(src + 256); }
        *(LAS u32x4*)(Kl + j * AK_STR + ch * 8) = kv;
#pragma unroll
        for (int k = 0; k < 4; ++k) { VT[(ch * 8 + 2 * k) * AV_STR + j] = (bf16)(vv[k] & 0xffffu); VT[(ch * 8 + 2 * k + 1) * AV_STR + j] = (bf16)(vv[k] >> 16); } }
    __syncthreads();
#pragma unroll
    for (int it = 0; it < 4; ++it) { const int id = w * 4 + it, g = id >> 3, qt = id & 7, hq = kvh * 4 + g;
        const size_t qrow0 = rowbase + nb * 128 + 16 * qt;
        int lo[4], hi[4]; float sk[4]; bf16* op[4]; const float sv = sinks[hq];
#pragma unroll
        for (int r = 0; r < 4; ++r) { const int i = 16 * qt + 4 * lq + r; lo[r] = (nb > 0) ? i : (i > 128 ? i : 128); hi[r] = i + 128; sk[r] = sv; op[r] = AO + (qrow0 + 4 * lq + r) * 1024 + hq * 64; }
        attn_item<AV_STR>(Kl, VT, Pw, qf[it], qt & ~1, lo, hi, sk, op, li, lq); }
    __syncthreads();
}
constexpr int AS_VSTR = 168, AS_SLOT = 51200, AS_K = 0, AS_VT = 23040, AS_P = 44544;
__device__ __forceinline__ void attn_sample_pair(LAS unsigned char* lds, const bf16* QKV, bf16* AO, const float* sinks, const float* ck, const float* cv, float* ok, float* ov, int unit0, int unit1, int tid) {
    const int lane = tid & 63, w = __builtin_amdgcn_readfirstlane(tid >> 6), li = lane & 15, lq = lane >> 4;
#pragma unroll 1
    for (int s = 0; s < 2; ++s) {
        const int unit = s ? unit1 : unit0; const int kvh = unit & 3, b = unit >> 2;
        LAS bf16* Kl = (LAS bf16*)(lds + s * AS_SLOT + AS_K); LAS bf16* VT = (LAS bf16*)(lds + s * AS_SLOT + AS_VT);
#pragma unroll
        for (int i = 0; i < 4; ++i) { const int id = tid + NTHR * i, j = id >> 4, ch = id & 15;
            const size_t so = ((size_t)(b * 128 + j) * 4 + kvh) * 64 + ch * 4;
            const f32x4 kf = *(const f32x4*)(ck + so), vf = *(const f32x4*)(cv + so);
            if (j >= 4) { const size_t d_ = ((size_t)(b * 128 + j - 4) * 4 + kvh) * 64 + ch * 4; *(f32x4*)(ok + d_) = kf; *(f32x4*)(ov + d_) = vf; }
            u32x2 kb; kb.x = pk2(kf[0], kf[1]); kb.y = pk2(kf[2], kf[3]); *(LAS u32x2*)(Kl + j * AK_STR + ch * 4) = kb;
#pragma unroll
            for (int k = 0; k < 4; ++k) VT[(ch * 4 + k) * AS_VSTR + j] = (bf16)f2bf(vf[k]); }
        if (tid < 256) { const int j = 128 + (tid >> 3), ch = tid & 7;
            u32x4 kv = (u32x4){0u, 0u, 0u, 0u}, vv = (u32x4){0u, 0u, 0u, 0u};
            if (j < 132) { const bf16* src = QKV + (size_t)(NP + b * 4 + (j - 128)) * 1536 + 1024 + kvh * 64 + ch * 8; kv = *(const u32x4*)src; vv = *(const u32x4*)(src + 256); }
            *(LAS u32x4*)(Kl + j * AK_STR + ch * 8) = kv;
#pragma unroll
            for (int k = 0; k < 4; ++k) { VT[(ch * 8 + 2 * k) * AS_VSTR + j] = (bf16)(vv[k] & 0xffffu); VT[(ch * 8 + 2 * k + 1) * AS_VSTR + j] = (bf16)(vv[k] >> 16); } }
    }
    __syncthreads();
    if (w < 2) {
        const int unit = w ? unit1 : unit0; const int kvh = unit & 3, b = unit >> 2;
        const LAS bf16* Kl = (const LAS bf16*)(lds + w * AS_SLOT + AS_K); const LAS bf16* VT = (const LAS bf16*)(lds + w * AS_SLOT + AS_VT); LAS bf16* Pw = (LAS bf16*)(lds + w * AS_SLOT + AS_P);
        const int gA = li >> 2, tA = li & 3;
        const bf16* qp = QKV + (size_t)(NP + b * 4 + tA) * 1536 + (kvh * 4 + gA) * 64;
        bf16x8 qa[2];
#pragma unroll
        for (int ks = 0; ks < 2; ++ks) qa[ks] = *(const bf16x8*)(qp + 32 * ks + 8 * lq);
        int lo[4], hi[4]; float sk[4]; bf16* op[4];
#pragma unroll
        for (int r = 0; r < 4; ++r) { const int rr = 4 * lq + r, g = rr >> 2, t = rr & 3; lo[r] = t; hi[r] = t + 128; sk[r] = sinks[kvh * 4 + g]; op[r] = AO + (size_t)(NP + b * 4 + t) * 1024 + (kvh * 4 + g) * 64; }
        attn_item<AS_VSTR>(Kl, VT, Pw, qa, 0, lo, hi, sk, op, li, lq);
    }
    __syncthreads();
}

#define XB_TMO      128
#define XB_XCNT(j)  (256  + 64 * (j))
#define XB_XSUB(j)  (1280 + 64 * (j))
#define XB_XGEN(j)  (2304 + 64 * (j))
#define XB_TOP      3328
#define XB_TOPGEN   3392
#define XCD_BAR_WORDS 3456
#define XB_SPIN_CAP (1u << 18)

__device__ __forceinline__ unsigned xb_ld(unsigned* p)              { return __hip_atomic_load(p, __ATOMIC_RELAXED, __HIP_MEMORY_SCOPE_AGENT); }
__device__ __forceinline__ unsigned xb_add(unsigned* p, unsigned v) { return __hip_atomic_fetch_add(p, v, __ATOMIC_RELAXED, __HIP_MEMORY_SCOPE_AGENT); }
__device__ __forceinline__ unsigned xb_xcc_id() { return (unsigned)__builtin_amdgcn_s_getreg((3 << 11) | 20) & 0xFu; }
#define XB_SPIN(cond, bar) do { unsigned _sp = 0; while (cond) { __builtin_amdgcn_s_sleep(1); \
    if ((++_sp & 255u) == 0u) { if (xb_ld(&(bar)[XB_TMO])) break; if (_sp > XB_SPIN_CAP) { atomicAdd(&(bar)[XB_TMO], 1u); break; } } } } while (0)

struct XcdBarrier {
    unsigned* bar; unsigned x;
    volatile LAS unsigned* st;
};

__device__ __forceinline__ XcdBarrier xcd_barrier_post(unsigned* bar, volatile LAS unsigned* st) {
    XcdBarrier b; b.bar = bar; b.x = xb_xcc_id(); b.st = st;
    if (threadIdx.x == 0) (void)xb_add(&bar[XB_XCNT(b.x)], 1u);
    return b;
}
__device__ __forceinline__ void xcd_barrier_complete(unsigned* bar, unsigned x, unsigned& nloc, unsigned& nx) {
    const unsigned G = gridDim.x * gridDim.y * gridDim.z;
    unsigned sum, cnt, mine, sp = 0u;
    for (;;) {
        sum = 0u; cnt = 0u; mine = 0u;
#pragma unroll
        for (unsigned j = 0; j < 16; ++j) { const unsigned c = xb_ld(&bar[XB_XCNT(j)]); sum += c; cnt += (c > 0u) ? 1u : 0u; mine = (j == x) ? c : mine; }
        if (sum == G) break;
        __builtin_amdgcn_s_sleep(1);
        if ((++sp & 255u) == 0u) { if (xb_ld(&bar[XB_TMO])) break; if (sp > XB_SPIN_CAP) { atomicAdd(&bar[XB_TMO], 1u); break; } }
    }
    nloc = mine > 0u ? mine : 1u; nx = cnt > 0u ? cnt : 1u;
}

__device__ __forceinline__ void xcd_barrier(const XcdBarrier& b) {
    asm volatile("s_waitcnt vmcnt(0)" ::: "memory");
    __syncthreads();
    if (threadIdx.x == 0) {
        unsigned* bar = b.bar;
        __builtin_amdgcn_s_waitcnt(0);
        unsigned nloc = b.st[0], nx = b.st[1];
        if (nloc == 0u) { xcd_barrier_complete(bar, b.x, nloc, nx); b.st[0] = nloc; b.st[1] = nx; }
        const unsigned old = xb_add(&bar[XB_XSUB(b.x)], 1u);
        const unsigned gen = old / nloc;
        if (old + 1u == (gen + 1u) * nloc) {
            __builtin_amdgcn_fence(__ATOMIC_RELEASE, "agent");
            asm volatile("s_waitcnt vmcnt(0)" ::: "memory");
            const unsigned og = xb_add(&bar[XB_TOP], 1u);
            const unsigned tg = og / nx;
            if (og + 1u == (tg + 1u) * nx) xb_add(&bar[XB_TOPGEN], 1u);
            else XB_SPIN(xb_ld(&bar[XB_TOPGEN]) == tg, bar);
            __builtin_amdgcn_fence(__ATOMIC_ACQUIRE, "agent");
            xb_add(&bar[XB_XGEN(b.x)], 1u);
            asm volatile("s_waitcnt vmcnt(0)" ::: "memory");
        } else {
            XB_SPIN(xb_ld(&bar[XB_XGEN(b.x)]) == gen, bar);
            __builtin_amdgcn_fence(__ATOMIC_ACQUIRE, "agent");
            asm volatile("s_waitcnt vmcnt(0)" ::: "memory");
        }
    }
    __syncthreads();
}

#ifndef PROBE_DUP
#define PROBE_DUP 0
#endif
struct ListOrder {
    int nM, nN, nwg, pm_off, L0, dL, n, extraL;
    __device__ __forceinline__ void init(int Mrows, int N, int pm_off_) { nM = Mrows / 256; nN = N / 256; nwg = nM * nN; pm_off = pm_off_; }
    __device__ __forceinline__ bool next(int i, pg8::Unit& u) const {
        int L; if (i < n) L = L0 + i * dL; else if (i == n && extraL >= 0) L = extraL; else return false;
        if (L >= nwg) return false;
        int wgid = L; { const int q = nwg / 8, r = nwg % 8, xcd = wgid % 8, off = wgid / 8; wgid = (xcd < r ? xcd * (q + 1) : r * (q + 1) + (xcd - r) * q) + off; }
        const int nig = 8 * nN, gid = wgid / nig, fm = gid * 8, gsz = (nM - fm) < 8 ? (nM - fm) : 8;
        u.pm = fm + ((wgid % nig) % gsz) + pm_off; u.pn = (wgid % nig) / gsz; return true;
    }
    __device__ __forceinline__ void a_ready(const pg8::Unit&) const {}
    __device__ __forceinline__ void done(const pg8::Unit&) const {}
};
__device__ __forceinline__ void flag_signal(unsigned* f, int tid) {
    asm volatile("s_waitcnt vmcnt(0)" ::: "memory");
    __syncthreads();
    if (tid == 0) { __builtin_amdgcn_fence(__ATOMIC_RELEASE, "agent"); asm volatile("s_waitcnt vmcnt(0)" ::: "memory"); (void)xb_add(f, 1u); }
}
__device__ __forceinline__ void flag_wait(unsigned* f, unsigned n, int tid) {
    if (tid == 0) { unsigned sp = 0u; while (xb_ld(f) < n) { __builtin_amdgcn_s_sleep(4); if (++sp > (1u << 16)) break; }
        __builtin_amdgcn_fence(__ATOMIC_ACQUIRE, "agent"); asm volatile("s_waitcnt vmcnt(0)" ::: "memory"); }
    __syncthreads();
}
enum { K_NONE = 0, K_RETIN, K_RES, K_SWIGLU, K_SWAIN };
constexpr int NSTEPS = 21;
__global__ void __launch_bounds__(NTHR) hybrid_fwd(Params p) {
    extern __shared__ __attribute__((aligned(16))) unsigned char lds_raw[];
    LAS unsigned char* lds = (LAS unsigned char*)lds_raw;
    cg::grid_group grid = cg::this_grid();
    const int tid = threadIdx.x, lane = tid & 63, wave = __builtin_amdgcn_readfirstlane(tid >> 6);
    const int G = gridDim.x, c = blockIdx.x, vcu = (c % 8) * (G / 8) + c / 8;
    unsigned char* ws = p.ws; float* out = p.out;
    bf16* XB = (bf16*)(ws + WS_XB); bf16* BIG = (bf16*)(ws + WS_BIG); bf16* OB = (bf16*)(ws + WS_OB);
    float* ss = (float*)(ws + WS_SS); float* sso = (float*)(ws + WS_SSO);
    unsigned* ctl = (unsigned*)(ws + WS_CTL);
    unsigned* F1 = ctl + 4096; unsigned* F3 = ctl + 4096 + 64; unsigned* F4 = ctl + 4096 + 128; unsigned* F5 = ctl + 4096 + 192;
    volatile LAS unsigned* bst = (volatile LAS unsigned*)(lds + LDS_BYTES - 64);
    if (tid < 2) bst[tid] = 0u;
    __syncthreads();
    XcdBarrier bar = xcd_barrier_post(ctl, bst);
    const bool hi8 = (c >= 248), mid44 = (c >= 144 && c < 188);
    float* outS = out + (size_t)NP * DM;
#define GEMM_RES(Aptr, Wptr, Kc, E_)   do { pg8::Gemm g_{Aptr, (const bf16*)(ws + Wptr), MT, 1024, Kc}; pg8::gemm_phase<pg8::EpiRes, ListOrder, true, true>(lds, g_, S, E_); } while (0)
#define GEMM_SWIGLU(Wptr, ssp)         do { pg8::Gemm g_{XB, (const bf16*)(ws + Wptr), MT, 5632, 1024}; pg8::EpiSwiglu E_{BIG, ssp}; pg8::gemm_phase<pg8::EpiSwiglu, ListOrder, true, true>(lds, g_, S, E_); } while (0)
#define GEMM_SWAIN()                   do { pg8::Gemm g_{XB, (const bf16*)(ws + WS_WSI), MT, 1536, 1024}; \
        pg8::EpiSwaIn E_{BIG, ss + 2 * MT, (const float*)(ws + WS_TSC), (const float*)(ws + WS_TSS), p.in[11], p.in[12], out + OUT_KP, out + OUT_VP, out + OUT_KS, out + OUT_VS}; \
        pg8::gemm_phase<pg8::EpiSwaIn, ListOrder, true, true>(lds, g_, S, E_); } while (0)
    const int lo_ = p.ph_lo, hi_ = p.ph_hi;
#if defined(PROBE_T)
    unsigned long long pt0 = 0, pt1 = 0;
#endif
#define IN(k) (lo_ <= (k) && (k) < hi_)
#define SEAM(k, kind) do { if (IN((k) + 1)) { if ((kind) == 2 && G != 256) grid.sync(); else if ((kind) >= 1) xcd_barrier(bar); } } while (0)
#if defined(PROBE_T)
    if (PROBE_T == 0 && c == 0 && tid == 0) pt0 = __builtin_amdgcn_s_memrealtime();
#endif
    if (IN(0)) { ListOrder S; S.init(NP, 1024, 0); S.L0 = c; S.dL = 256; S.n = 0; S.extraL = -1;
       p0_prologue(p, lds, tid, lane, wave, vcu, G, 0, 0, 0);
#if PROBE_DUP & 1
            __syncthreads(); p0_prologue(p, lds, tid, lane, wave, vcu, G, 0, 0, 0);
#endif
        SEAM(0, 2); }
#if defined(PROBE_T)
    if (PROBE_T == 0 && c == 0 && tid == 0) pt1 = __builtin_amdgcn_s_memrealtime();
#endif
#if defined(PROBE_T)
    if (PROBE_T == 1 && c == 0 && tid == 0) pt0 = __builtin_amdgcn_s_memrealtime();
#endif
    if (IN(1)) { ListOrder S; S.init(NP, 1024, 0); S.L0 = c; S.dL = 256; S.n = 0; S.extraL = -1;
       { pg8::Gemm g_{XB, (const bf16*)(ws + WS_WRI), MT, 6144, 1024};
                  pg8::EpiRetIn E_{BIG, ss, (const float*)(ws + WS_TRC), (const float*)(ws + WS_TRS)};
                  if (c >= 208) { S.init(NS, 6144, 64); S.L0 = c - 208; S.n = 1; pg8::gemm_phase<pg8::EpiRetIn, ListOrder, true, true>(lds, g_, S, E_); }
                  else { p0_prologue(p, lds, tid, lane, wave, vcu, G, 1, c, 208); __syncthreads(); }
                  S.init(NP, 6144, 0); S.L0 = c; S.n = 6;
                  pg8::gemm_phase<pg8::EpiRetIn, ListOrder, true, true>(lds, g_, S, E_); }
        SEAM(1, 1); }
#if defined(PROBE_T)
    if (PROBE_T == 1 && c == 0 && tid == 0) pt1 = __builtin_amdgcn_s_memrealtime();
#endif
#if defined(PROBE_T)
    if (PROBE_T == 2 && c == 0 && tid == 0) pt0 = __builtin_amdgcn_s_memrealtime();
#endif
    if (IN(2)) { ListOrder S; S.init(NP, 1024, 0); S.L0 = c; S.dL = 256; S.n = 0; S.extraL = -1;

#if defined(PROBE_T)
            if (PROBE_T == 102 && c == 0 && tid == 0) pt0 = __builtin_amdgcn_s_memrealtime();
#endif
            for (int u = vcu; u < 256; u += G) ret_prompt_unit(lds, BIG, OB, (float*)(ws + WS_SSOP), out + OUT_SP, u >> 3, u & 7, p.lg2[(u >> 3) & 3], tid);
            __syncthreads();
#if defined(PROBE_T)
            if (PROBE_T == 102 && c == 0 && tid == 0) pt1 = __builtin_amdgcn_s_memrealtime();
            if (PROBE_T == 103 && c == 0 && tid == 0) pt0 = __builtin_amdgcn_s_memrealtime();
#endif
            for (int u = vcu; u < 512; u += G) ret_sample_unit(lds, BIG, OB, p.in[2], out + OUT_SS, u, p.lg2[u & 3], tid);
#if defined(PROBE_T)
            if (PROBE_T == 103 && c == 0 && tid == 0) pt1 = __builtin_amdgcn_s_memrealtime();
#endif


        SEAM(2, 1); }
#if defined(PROBE_T)
    if (PROBE_T == 2 && c == 0 && tid == 0) pt1 = __builtin_amdgcn_s_memrealtime();
#endif
#if defined(PROBE_T)
    if (PROBE_T == 3 && c == 0 && tid == 0) pt0 = __builtin_amdgcn_s_memrealtime();
#endif
    if (IN(3)) { ListOrder S; S.init(NP, 1024, 0); S.L0 = c; S.dL = 256; S.n = 0; S.extraL = -1;
        SEAM(3, 0); }
#if defined(PROBE_T)
    if (PROBE_T == 3 && c == 0 && tid == 0) pt1 = __builtin_amdgcn_s_memrealtime();
#endif
#if defined(PROBE_T)
    if (PROBE_T == 4 && c == 0 && tid == 0) pt0 = __builtin_amdgcn_s_memrealtime();
#endif
    if (IN(4)) { ListOrder S; S.init(NP, 1024, 0); S.L0 = c; S.dL = 256; S.n = 0; S.extraL = -1;
       { S.n = 1; LAS float* HT = (LAS float*)(lds + 131072); LAS float* HS4 = HT + 1024;
         { pg8::Unit u0; S.next(0, u0); const float* pp = (const float*)(ws + WS_SSOP) + ((size_t)(u0.pm * 256 + (tid >> 1)) * 4 + (tid & 1) * 2) * 16;
#pragma unroll
           for (int hh = 0; hh < 2; ++hh) { const f32x4* q4 = (const f32x4*)(pp + hh * 16); const f32x4 a = (q4[0] + q4[1]) + (q4[2] + q4[3]);
               HS4[(tid >> 1) * 4 + (tid & 1) * 2 + hh] = __builtin_amdgcn_rsqf(((a[0] + a[1]) + (a[2] + a[3])) * (1.0f / 512.0f) + EPS); }
           __syncthreads();
           if (tid < 256) { const f32x4 s4 = *(const LAS f32x4*)(HS4 + tid * 4); *(LAS f32x4*)(HT + tid * 4) = (f32x4){s4[0] / s4[1], s4[1] / s4[2], s4[2] / s4[3], s4[3]}; }
           __syncthreads(); }
         pg8::EpiRes E_{XB, nullptr, ss + MT, HT}; pg8::Gemm g_{OB, (const bf16*)(ws + WS_WRO), MT, 1024, 2048};
         pg8::gemm_phase<pg8::EpiRes, ListOrder, true, true, true>(lds, g_, S, E_, HT); }
        SEAM(4, 1); }
#if defined(PROBE_T)
    if (PROBE_T == 4 && c == 0 && tid == 0) pt1 = __builtin_amdgcn_s_memrealtime();
#endif
#if defined(PROBE_T)
    if (PROBE_T == 5 && c == 0 && tid == 0) pt0 = __builtin_amdgcn_s_memrealtime();
#endif
    if (IN(5)) { ListOrder S; S.init(NP, 1024, 0); S.L0 = c; S.dL = 256; S.n = 0; S.extraL = -1;
       { S.init(NS, 1024, 64); S.L0 = c - 248; S.n = hi8 ? 1 : 0; pg8::EpiRes E_{XB, nullptr, ss + MT, nullptr}; GEMM_RES(OB, WS_WRO, 2048, E_); if (hi8) flag_signal(F1, tid); }
        SEAM(5, 0); }
#if defined(PROBE_T)
    if (PROBE_T == 5 && c == 0 && tid == 0) pt1 = __builtin_amdgcn_s_memrealtime();
#endif
#if defined(PROBE_T)
    if (PROBE_T == 6 && c == 0 && tid == 0) pt0 = __builtin_amdgcn_s_memrealtime();
#endif
    if (IN(6)) { ListOrder S; S.init(NP, 1024, 0); S.L0 = c; S.dL = 256; S.n = 0; S.extraL = -1;
       { S.init(NP, 5632, 0);
                  if (hi8) S.n = 3; else if (c >= 128 && c < 144) { S.n = 5; S.extraL = (3 + (c - 128) / 8) * 256 + 248 + (c - 128) % 8; } else S.n = (c < 128) ? 6 : 5;
                  GEMM_SWIGLU(WS_WFI0, ss + MT); }
        SEAM(6, 0); }
#if defined(PROBE_T)
    if (PROBE_T == 6 && c == 0 && tid == 0) pt1 = __builtin_amdgcn_s_memrealtime();
#endif
#if defined(PROBE_T)
    if (PROBE_T == 7 && c == 0 && tid == 0) pt0 = __builtin_amdgcn_s_memrealtime();
#endif
    if (IN(7)) { ListOrder S; S.init(NP, 1024, 0); S.L0 = c; S.dL = 256; S.n = 0; S.extraL = -1;
       { S.init(NS, 5632, 64); S.L0 = c - 144; S.n = mid44 ? 1 : 0; if (mid44) flag_wait(F1, 8u, tid); GEMM_SWIGLU(WS_WFI0, ss + MT); }
        SEAM(7, 1); }
#if defined(PROBE_T)
    if (PROBE_T == 7 && c == 0 && tid == 0) pt1 = __builtin_amdgcn_s_memrealtime();
#endif
#if defined(PROBE_T)
    if (PROBE_T == 8 && c == 0 && tid == 0) pt0 = __builtin_amdgcn_s_memrealtime();
#endif
    if (IN(8)) { ListOrder S; S.init(NP, 1024, 0); S.L0 = c; S.dL = 256; S.n = 0; S.extraL = -1;
       { S.n = 1; pg8::EpiRes E_{XB, nullptr, ss + 2 * MT, nullptr}; GEMM_RES(BIG, WS_WFO0, 2816, E_); }
        SEAM(8, 1); }
#if defined(PROBE_T)
    if (PROBE_T == 8 && c == 0 && tid == 0) pt1 = __builtin_amdgcn_s_memrealtime();
#endif
#if defined(PROBE_T)
    if (PROBE_T == 9 && c == 0 && tid == 0) pt0 = __builtin_amdgcn_s_memrealtime();
#endif
    if (IN(9)) { ListOrder S; S.init(NP, 1024, 0); S.L0 = c; S.dL = 256; S.n = 0; S.extraL = -1;
       { S.init(NS, 1024, 64); S.L0 = c - 248; S.n = hi8 ? 1 : 0; pg8::EpiRes E_{XB, nullptr, ss + 2 * MT, nullptr}; GEMM_RES(BIG, WS_WFO0, 2816, E_); }
        SEAM(9, 0); }
#if defined(PROBE_T)
    if (PROBE_T == 9 && c == 0 && tid == 0) pt1 = __builtin_amdgcn_s_memrealtime();
#endif
#if defined(PROBE_T)
    if (PROBE_T == 10 && c == 0 && tid == 0) pt0 = __builtin_amdgcn_s_memrealtime();
#endif
    if (IN(10)) { ListOrder S; S.init(NP, 1024, 0); S.L0 = c; S.dL = 256; S.n = 0; S.extraL = -1;
       { S.init(NP, 1536, 0);
                   if (hi8) S.n = 0; else if (c < 128) S.n = 2; else { S.n = 1; if (c < 136) S.extraL = 248 + (c - 128); }
                   GEMM_SWAIN(); }
        SEAM(10, 1); }
#if defined(PROBE_T)
    if (PROBE_T == 10 && c == 0 && tid == 0) pt1 = __builtin_amdgcn_s_memrealtime();
#endif
#if defined(PROBE_T)
    if (PROBE_T == 11 && c == 0 && tid == 0) pt0 = __builtin_amdgcn_s_memrealtime();
#endif
    if (IN(11)) { ListOrder S; S.init(NP, 1024, 0); S.L0 = c; S.dL = 256; S.n = 0; S.extraL = -1;
       { const bool m12 = (c >= 236 && c < 248); S.init(NS, 1536, 64); S.L0 = c - 236; S.n = m12 ? 1 : 0; GEMM_SWAIN(); if (m12) flag_signal(F3, tid); }
        SEAM(11, 0); }
#if defined(PROBE_T)
    if (PROBE_T == 11 && c == 0 && tid == 0) pt1 = __builtin_amdgcn_s_memrealtime();
#endif
#if defined(PROBE_T)
    if (PROBE_T == 12 && c == 0 && tid == 0) pt0 = __builtin_amdgcn_s_memrealtime();
#endif
    if (IN(12)) { ListOrder S; S.init(NP, 1024, 0); S.L0 = c; S.dL = 256; S.n = 0; S.extraL = -1;
       for (int u = vcu; u < 512; u += G) attn_prompt_unit(lds, BIG, OB, p.in[13], u, tid);
        SEAM(12, 0); }
#if defined(PROBE_T)
    if (PROBE_T == 12 && c == 0 && tid == 0) pt1 = __builtin_amdgcn_s_memrealtime();
#endif
#if defined(PROBE_T)
    if (PROBE_T == 13 && c == 0 && tid == 0) pt0 = __builtin_amdgcn_s_memrealtime();
#endif
    if (IN(13)) { ListOrder S; S.init(NP, 1024, 0); S.L0 = c; S.dL = 256; S.n = 0; S.extraL = -1;
       flag_wait(F3, 12u, tid);
                 if (!(c >= 236 && c < 248)) {
                     attn_sample_pair(lds, BIG, OB, p.in[13], p.in[3], p.in[4], out + OUT_KS, out + OUT_VS, vcu, vcu + 256, tid);
                     if (c < 12) { const int c2 = 236 + c, v2 = (c2 % 8) * (G / 8) + c2 / 8; attn_sample_pair(lds, BIG, OB, p.in[13], p.in[3], p.in[4], out + OUT_KS, out + OUT_VS, v2, v2 + 256, tid); } }
        SEAM(13, 1); }
#if defined(PROBE_T)
    if (PROBE_T == 13 && c == 0 && tid == 0) pt1 = __builtin_amdgcn_s_memrealtime();
#endif
#if defined(PROBE_T)
    if (PROBE_T == 14 && c == 0 && tid == 0) pt0 = __builtin_amdgcn_s_memrealtime();
#endif
    if (IN(14)) { ListOrder S; S.init(NP, 1024, 0); S.L0 = c; S.dL = 256; S.n = 0; S.extraL = -1;
       { S.n = 1; pg8::EpiRes E_{XB, nullptr, ss + 3 * MT, nullptr}; GEMM_RES(OB, WS_WSO, 1024, E_); }
        SEAM(14, 1); }
#if defined(PROBE_T)
    if (PROBE_T == 14 && c == 0 && tid == 0) pt1 = __builtin_amdgcn_s_memrealtime();
#endif
#if defined(PROBE_T)
    if (PROBE_T == 15 && c == 0 && tid == 0) pt0 = __builtin_amdgcn_s_memrealtime();
#endif
    if (IN(15)) { ListOrder S; S.init(NP, 1024, 0); S.L0 = c; S.dL = 256; S.n = 0; S.extraL = -1;
       { S.init(NS, 1024, 64); S.L0 = c - 248; S.n = hi8 ? 1 : 0; pg8::EpiRes E_{XB, nullptr, ss + 3 * MT, nullptr}; GEMM_RES(OB, WS_WSO, 1024, E_); if (hi8) flag_signal(F4, tid); }
        SEAM(15, 0); }
#if defined(PROBE_T)
    if (PROBE_T == 15 && c == 0 && tid == 0) pt1 = __builtin_amdgcn_s_memrealtime();
#endif
#if defined(PROBE_T)
    if (PROBE_T == 16 && c == 0 && tid == 0) pt0 = __builtin_amdgcn_s_memrealtime();
#endif
    if (IN(16)) { ListOrder S; S.init(NP, 1024, 0); S.L0 = c; S.dL = 256; S.n = 0; S.extraL = -1;
       { S.init(NP, 5632, 0);
                   if (hi8 || mid44) S.n = 1; else if (c < 128) S.n = 6; else { S.n = 5; int j = -1; if (c < 144) j = c - 128; else if (c >= 188 && c < 204) j = 16 + (c - 188); if (j >= 0) S.extraL = (1 + j / 8) * 256 + 248 + j % 8; }
                   GEMM_SWIGLU(WS_WFI1, ss + 3 * MT); }
        SEAM(16, 0); }
#if defined(PROBE_T)
    if (PROBE_T == 16 && c == 0 && tid == 0) pt1 = __builtin_amdgcn_s_memrealtime();
#endif
#if defined(PROBE_T)
    if (PROBE_T == 17 && c == 0 && tid == 0) pt0 = __builtin_amdgcn_s_memrealtime();
#endif
    if (IN(17)) { ListOrder S; S.init(NP, 1024, 0); S.L0 = c; S.dL = 256; S.n = 0; S.extraL = -1;
       { S.init(NS, 5632, 64); S.L0 = c - 144; S.n = mid44 ? 1 : 0; if (mid44) flag_wait(F4, 8u, tid); GEMM_SWIGLU(WS_WFI1, ss + 3 * MT); if (mid44) flag_signal(F5, tid); }
        SEAM(17, 0); }
#if defined(PROBE_T)
    if (PROBE_T == 17 && c == 0 && tid == 0) pt1 = __builtin_amdgcn_s_memrealtime();
#endif
#if defined(PROBE_T)
    if (PROBE_T == 18 && c == 0 && tid == 0) pt0 = __builtin_amdgcn_s_memrealtime();
#endif
    if (IN(18)) { ListOrder S; S.init(NP, 1024, 0); S.L0 = c; S.dL = 256; S.n = 0; S.extraL = -1;
       { S.init(NS, 1024, 64); S.L0 = c - 248; S.n = hi8 ? 1 : 0; if (hi8) flag_wait(F5, 44u, tid); pg8::EpiRes E_{XB, out, nullptr, nullptr}; GEMM_RES(BIG, WS_WFO1, 2816, E_); }
        SEAM(18, 0); }
#if defined(PROBE_T)
    if (PROBE_T == 18 && c == 0 && tid == 0) pt1 = __builtin_amdgcn_s_memrealtime();
#endif
#if defined(PROBE_T)
    if (PROBE_T == 19 && c == 0 && tid == 0) pt0 = __builtin_amdgcn_s_memrealtime();
#endif
    if (IN(19)) { ListOrder S; S.init(NP, 1024, 0); S.L0 = c; S.dL = 256; S.n = 0; S.extraL = -1;
       { S.init(NP, 5632, 0); S.L0 = 256 + c; S.n = mid44 ? 4 : 0; GEMM_SWIGLU(WS_WFI1, ss + 3 * MT); }
        SEAM(19, 1); }
#if defined(PROBE_T)
    if (PROBE_T == 19 && c == 0 && tid == 0) pt1 = __builtin_amdgcn_s_memrealtime();
#endif
#if defined(PROBE_T)
    if (PROBE_T == 20 && c == 0 && tid == 0) pt0 = __builtin_amdgcn_s_memrealtime();
#endif
    if (IN(20)) { ListOrder S; S.init(NP, 1024, 0); S.L0 = c; S.dL = 256; S.n = 0; S.extraL = -1;
       { S.n = 1; pg8::EpiRes E_{XB, out, nullptr, nullptr}; GEMM_RES(BIG, WS_WFO1, 2816, E_); }
        SEAM(20, 0); }
#if defined(PROBE_T)
    if (PROBE_T == 20 && c == 0 && tid == 0) pt1 = __builtin_amdgcn_s_memrealtime();
#endif
#undef IN
#undef SEAM
#if defined(PROBE_T)
    if (c == 0 && tid == 0) { const unsigned long long te = __builtin_amdgcn_s_memrealtime(), d = (pt1 - pt0) * 4ull; while (__builtin_amdgcn_s_memrealtime() - te < d) __builtin_amdgcn_s_sleep(8); }
#endif
}

#ifndef N_LAUNCHES
#define N_LAUNCHES 1
#endif
extern "C" void kernel_launch(void* const* d_in, const int* in_sizes, int n_in, void* d_out, int out_size, void* d_ws, size_t ws_size, hipStream_t stream) {
    static int grid = 0;
    if (grid == 0) {
        if (n_in != 16 || (size_t)out_size != OUT_END || ws_size < WS_TOTAL) { fprintf(stderr, "kernel_launch: unexpected shapes (n_in %d out %d ws %zu need %zu)\n", n_in, out_size, ws_size, (size_t)WS_TOTAL); grid = -1; return; }
        int dev = 0, cus = 0, per_cu = 0;
        (void)hipGetDevice(&dev); (void)hipDeviceGetAttribute(&cus, hipDeviceAttributeMultiprocessorCount, dev);
        if (hipFuncSetAttribute((const void*)hybrid_fwd, hipFuncAttributeMaxDynamicSharedMemorySize, LDS_BYTES) != hipSuccess) { fprintf(stderr, "kernel_launch: hipFuncSetAttribute failed\n"); grid = -1; return; }
        if (hipOccupancyMaxActiveBlocksPerMultiprocessor(&per_cu, (const void*)hybrid_fwd, NTHR, LDS_BYTES) != hipSuccess || per_cu < 1) { fprintf(stderr, "kernel_launch: occupancy query says %d\n", per_cu); per_cu = 1; }
        (void)hipGetLastError();
        grid = cus * 1;
        if (grid != 256) { fprintf(stderr, "kernel_launch: built for a 256-CU device (got %d)\n", cus); grid = -1; return; }
    }
    if (grid < 0) return;
    if (hipMemsetAsync((char*)d_ws + WS_CTL, 0, CTL_BYTES, stream) != hipSuccess) { fprintf(stderr, "kernel_launch: memset failed\n"); return; }
    Params p; memset(&p, 0, sizeof(p));
    for (int i = 0; i < 16; ++i) p.in[i] = (const float*)d_in[i];
    p.out = (float*)d_out; p.ws = (unsigned char*)d_ws;
    const double two_pi = 6.283185307179586476925286766559;
    for (int i = 0; i < 128; ++i) p.invR[i] = 1.0 / std::pow(10000.0, (double)i / 127.0) / two_pi;
    for (int i = 0; i < 32; ++i) p.invS[i] = 1.0 / std::pow(10000.0, (double)(2 * i) / 64.0) / two_pi;
    for (int h = 0; h < 4; ++h) p.lg2[h] = (float)std::log2(1.0 - std::ldexp(1.0, -5 - h));
#if N_LAUNCHES == 1
    p.ph_lo = 0; p.ph_hi = NSTEPS;
    void* args[] = {&p};
    hipError_t e = hipLaunchCooperativeKernel((const void*)hybrid_fwd, dim3(grid), dim3(NTHR), args, LDS_BYTES, stream);
    if (e != hipSuccess) fprintf(stderr, "kernel_launch: cooperative launch failed: %s (grid %d)\n", hipGetErrorString(e), grid);
#else
    for (int ph = 0; ph < NSTEPS; ++ph) { p.ph_lo = ph; p.ph_hi = ph + 1; hipLaunchKernelGGL(hybrid_fwd, dim3(grid), dim3(NTHR), LDS_BYTES, stream, p); }
#endif
}
```

```cpp
#include <hip/hip_runtime.h>
#include <hip/hip_cooperative_groups.h>
#include <cstdio>
#include <cstdint>
#include <cmath>
#include <cstring>
namespace cg = cooperative_groups;
namespace pg8 {
#define PG8_LAS __attribute__((address_space(3)))
typedef unsigned short bf16_t;
typedef short bf16x8 __attribute__((ext_vector_type(8)));
typedef float f32x4 __attribute__((ext_vector_type(4)));
typedef unsigned u32x4 __attribute__((ext_vector_type(4)));
constexpr int BM = 256, BK = 64, HALF = 128, HTB = HALF * BK * 2  , STAGE_BYTES = 8 * HTB, NXCD = 8, WGM = 8;

__host__ __device__ __forceinline__ int lds_byte(int r, int c) { const int st = (r >> 4) * 2 + (c >> 5), rr = r & 15, cc = c & 31, ob = rr * 64 + cc * 2; return st * 1024 + (ob ^ (((ob >> 9) & 1) << 5)); }
__host__ __device__ __forceinline__ void stage_rc(int b, int& R, int& C) { const int st = b / 1024, sb = b % 1024, swz = sb ^ (((sb >> 9) & 1) << 5); R = (st >> 1) * 16 + swz / 64; C = (st & 1) * 32 + (swz % 64) / 2; }
__host__ __device__ __forceinline__ int perm32(int rho) { const int n = rho >> 4, i = rho & 15; return 8 * (i >> 2) + 4 * n + (i & 3); }

struct Unit { int pm, pn; };
struct Gemm { const bf16_t* A; const bf16_t* Bt; int M, N, K; };

struct StaticOrder {
    int nM, nN, nwg, G, c;
    __host__ __device__ void init(int M, int N, int G_, int c_) { nM = M / BM; nN = N / BM; nwg = nM * nN; G = G_; c = c_; }
    __host__ __device__ bool next(int i, Unit& u) const {
        const long L = (long)i * G + c; if (L >= nwg) return false;
        int wgid = (int)L; { const int q = nwg / NXCD, r = nwg % NXCD, xcd = wgid % NXCD, off = wgid / NXCD; wgid = (xcd < r ? xcd * (q + 1) : r * (q + 1) + (xcd - r) * q) + off; }
        const int nig = WGM * nN, gid = wgid / nig, fm = gid * WGM, gsz = (nM - fm) < WGM ? (nM - fm) : WGM;
        u.pm = fm + ((wgid % nig) % gsz); u.pn = (wgid % nig) / gsz; return true;
    }
    __device__ __forceinline__ void a_ready(const Unit&) const {}
    __device__ __forceinline__ void done(const Unit&) const {}
};

__device__ __forceinline__ unsigned cvt_pk_bf16(float lo, float hi) { unsigned r; asm volatile("v_cvt_pk_bf16_f32 %0, %1, %2" : "=v"(r) : "v"(lo), "v"(hi)); return r; }
typedef float f32x2 __attribute__((ext_vector_type(2)));
constexpr int P_NP = 16384, P_D = 1024, P_MT = 16896;
constexpr float P_EPS = 1e-6f;
__device__ __forceinline__ float silu_f(float x) { return x * __builtin_amdgcn_rcpf(1.0f + __expf(-x)); }
__device__ __forceinline__ float row_rstd(const float* ssp, int row) {
    const f32x4* pp = (const f32x4*)(ssp + (size_t)row * 16); const f32x4 a = (pp[0] + pp[1]) + (pp[2] + pp[3]);
    return __builtin_amdgcn_rsqf(((a[0] + a[1]) + (a[2] + a[3])) * (1.0f / 1024.0f) + P_EPS);
}
__device__ __forceinline__ int pos_index(int row) { return row < P_NP ? (row & 2047) : 2048 + (row & 3); }
__device__ __forceinline__ u32x4 pack8(const f32x4 a, const f32x4 b) { u32x4 w; w.x = cvt_pk_bf16(a[0], a[1]); w.y = cvt_pk_bf16(a[2], a[3]); w.z = cvt_pk_bf16(b[0], b[1]); w.w = cvt_pk_bf16(b[2], b[3]); return w; }

struct EpiRetIn {
    static constexpr bool PERM = true, AFTER_DRAIN = false;
    bf16_t* O; const float* ss; const float* cosT; const float* sinT;
    __device__ __forceinline__ void operator()(const f32x4 (&acc)[2][2][4][2], const Unit& u, int wr, int wc, int fr, int fq) const {
        const int pn = u.pn, ci = wc * 32 + 8 * fq;
#pragma unroll
        for (int ai = 0; ai < 2; ++ai)
#pragma unroll
            for (int m = 0; m < 4; ++m) {
                const int row = u.pm * BM + ai * HALF + wr * 64 + m * 16 + fr;
                const float rstd = __builtin_amdgcn_rsqf(ss[row] * (1.0f / 1024.0f) + P_EPS);
                bf16_t* rowp;
                if (pn < 8) rowp = O + ((size_t)pn * P_MT + row) * 256 + ci;
                else { const int q_ = pn - 8; rowp = O + (size_t)8 * P_MT * 256 + ((size_t)(q_ >> 1) * P_MT + row) * 512 + (q_ & 1) * 256 + ci; }
                if (pn < 8) {
                    const int pidx = pos_index(row);
                    const f32x4* cp = (const f32x4*)(cosT + pidx * 128 + ci); const f32x4* sp = (const f32x4*)(sinT + pidx * 128 + ci);
                    const float sc = (pn >= 4) ? rstd * 0.0625f : rstd;
                    f32x4 o1[2], o2[2];
#pragma unroll
                    for (int n = 0; n < 2; ++n) { const f32x4 c = cp[n], s = sp[n]; const f32x4 x1 = acc[ai][0][m][n] * sc, x2 = acc[ai][1][m][n] * sc; o1[n] = x1 * c - x2 * s; o2[n] = x2 * c + x1 * s; }
                    *(u32x4*)(rowp) = pack8(o1[0], o1[1]); *(u32x4*)(rowp + HALF) = pack8(o2[0], o2[1]);
                } else if (pn < 16) {
#pragma unroll
                    for (int bj = 0; bj < 2; ++bj) *(u32x4*)(rowp + bj * HALF) = pack8(acc[ai][bj][m][0] * rstd, acc[ai][bj][m][1] * rstd);
                } else {
#pragma unroll
                    for (int bj = 0; bj < 2; ++bj) { f32x4 a = acc[ai][bj][m][0] * rstd, b = acc[ai][bj][m][1] * rstd;
#pragma unroll
                        for (int j = 0; j < 4; ++j) { a[j] = silu_f(a[j]); b[j] = silu_f(b[j]); }
                        *(u32x4*)(rowp + bj * HALF) = pack8(a, b); }
                }
            }
    }
};
struct EpiRes {
    static constexpr bool PERM = true, AFTER_DRAIN = false;
    bf16_t* xb; float* outF; float* ssn; const PG8_LAS float* hs;
    __device__ __forceinline__ void operator()(const f32x4 (&acc)[2][2][4][2], const Unit& u, int wr, int wc, int fr, int fq) const {
        const int col0 = u.pn * BM + wc * 32 + 8 * fq;
#pragma unroll
        for (int ai = 0; ai < 2; ++ai)
#pragma unroll
            for (int m = 0; m < 4; ++m) {
                const int row = u.pm * BM + ai * HALF + wr * 64 + m * 16 + fr;
                bf16_t* xp = xb + (size_t)row * P_D + col0; float s = 0.f;
                const float hsc = hs ? hs[(ai * HALF + wr * 64 + m * 16 + fr) * 4 + 3] : 1.0f;
#pragma unroll
                for (int bj = 0; bj < 2; ++bj) {
                    const u32x4 rw = *(const u32x4*)(xp + bj * HALF);
                    const f32x4 r0 = (f32x4){__builtin_bit_cast(float, rw.x << 16), __builtin_bit_cast(float, rw.x & 0xffff0000u), __builtin_bit_cast(float, rw.y << 16), __builtin_bit_cast(float, rw.y & 0xffff0000u)};
                    const f32x4 r1 = (f32x4){__builtin_bit_cast(float, rw.z << 16), __builtin_bit_cast(float, rw.z & 0xffff0000u), __builtin_bit_cast(float, rw.w << 16), __builtin_bit_cast(float, rw.w & 0xffff0000u)};
                    const f32x4 v0 = r0 + acc[ai][bj][m][0] * hsc, v1 = r1 + acc[ai][bj][m][1] * hsc;
                    s += (v0[0] * v0[0] + v0[1] * v0[1]) + (v0[2] * v0[2] + v0[3] * v0[3]) + (v1[0] * v1[0] + v1[1] * v1[1]) + (v1[2] * v1[2] + v1[3] * v1[3]);
                    if (outF) { float* op = outF + (size_t)row * P_D + col0 + bj * HALF; *(f32x4*)(op) = v0; *(f32x4*)(op + 4) = v1; }
                    else *(u32x4*)(xp + bj * HALF) = pack8(v0, v1);
                }
                if (ssn) { s += __shfl_xor(s, 16); s += __shfl_xor(s, 32); if (fq == 0) atomicAdd(ssn + row, s); }
            }
    }
};
struct EpiSwiglu {
    static constexpr bool PERM = true, AFTER_DRAIN = false;
    bf16_t* H; const float* ss;
    __device__ __forceinline__ void operator()(const f32x4 (&acc)[2][2][4][2], const Unit& u, int wr, int wc, int fr, int fq) const {
        const int col0 = u.pn * HALF + wc * 32 + 8 * fq;
#pragma unroll
        for (int ai = 0; ai < 2; ++ai)
#pragma unroll
            for (int m = 0; m < 4; ++m) {
                const int row = u.pm * BM + ai * HALF + wr * 64 + m * 16 + fr;
                const float rstd = __builtin_amdgcn_rsqf(ss[row] * (1.0f / 1024.0f) + P_EPS);
                f32x4 h[2];
#pragma unroll
                for (int n = 0; n < 2; ++n) { const f32x4 g = acc[ai][0][m][n] * rstd, uu = acc[ai][1][m][n] * rstd;
#pragma unroll
                    for (int j = 0; j < 4; ++j) h[n][j] = silu_f(g[j]) * uu[j]; }
                *(u32x4*)(H + (size_t)row * 2816 + col0) = pack8(h[0], h[1]);
            }
    }
};
struct EpiSwaIn {
    static constexpr bool PERM = true, AFTER_DRAIN = false;
    bf16_t* O; const float* ss; const float* cosT; const float* sinT; const float* qg; const float* kg; float* kc_p; float* vc_p; float* kc_s; float* vc_s;
    __device__ __forceinline__ void operator()(const f32x4 (&acc)[2][2][4][2], const Unit& u, int wr, int wc, int fr, int fq) const {
        const int pn = u.pn;
        const float* G = (pn < 4) ? qg : kg;
        f32x4 g1[2], g2[2];
#pragma unroll
        for (int n = 0; n < 2; ++n) { g1[n] = *(const f32x4*)(G + 8 * fq + 4 * n); g2[n] = *(const f32x4*)(G + 32 + 8 * fq + 4 * n); }
        const int cbase = (pn < 4 ? (pn * 4 + wc) * 64 : (pn == 4 ? 1024 : 1280) + wc * 64) + 8 * fq;
#pragma unroll
        for (int ai = 0; ai < 2; ++ai)
#pragma unroll
            for (int m = 0; m < 4; ++m) {
                const int row = u.pm * BM + ai * HALF + wr * 64 + m * 16 + fr;
                const float rstd = __builtin_amdgcn_rsqf(ss[row] * (1.0f / 1024.0f) + P_EPS);
                bf16_t* rowp = O + (size_t)row * 1536 + cbase;
                float* cdst = nullptr;
                if (pn >= 4) {
                    float* cp_ = (pn == 4) ? kc_p : vc_p; float* cs_ = (pn == 4) ? kc_s : vc_s;
                    if (row < P_NP) { const int b = row >> 11, t = row & 2047; if (t >= 1920) cdst = cp_ + ((size_t)(b * 128 + (t - 1920)) * 4 + wc) * 64 + 8 * fq; }
                    else { const int s_ = row - P_NP, b = s_ >> 2, t = s_ & 3; cdst = cs_ + ((size_t)(b * 128 + 124 + t) * 4 + wc) * 64 + 8 * fq; }
                }
                f32x4 o1[2], o2[2];
                if (pn < 5) {
                    f32x4 x1[2], x2[2]; float q = 0.f;
#pragma unroll
                    for (int n = 0; n < 2; ++n) { x1[n] = acc[ai][0][m][n] * rstd; x2[n] = acc[ai][1][m][n] * rstd;
                        q += (x1[n][0] * x1[n][0] + x1[n][1] * x1[n][1]) + (x1[n][2] * x1[n][2] + x1[n][3] * x1[n][3]) + (x2[n][0] * x2[n][0] + x2[n][1] * x2[n][1]) + (x2[n][2] * x2[n][2] + x2[n][3] * x2[n][3]); }
                    q += __shfl_xor(q, 16); q += __shfl_xor(q, 32);
                    const float hr = __builtin_amdgcn_rsqf(q * (1.0f / 64.0f) + P_EPS);
                    const int pidx = pos_index(row);
                    const f32x4* cp = (const f32x4*)(cosT + pidx * 32 + 8 * fq); const f32x4* sp = (const f32x4*)(sinT + pidx * 32 + 8 * fq);
                    const float osc = (pn < 4) ? 0.125f : 1.0f;
#pragma unroll
                    for (int n = 0; n < 2; ++n) { const f32x4 c = cp[n], s = sp[n]; const f32x4 a = x1[n] * hr * g1[n], b = x2[n] * hr * g2[n]; o1[n] = (a * c - b * s) * osc; o2[n] = (b * c + a * s) * osc; }
                } else {
#pragma unroll
                    for (int n = 0; n < 2; ++n) { o1[n] = acc[ai][0][m][n] * rstd; o2[n] = acc[ai][1][m][n] * rstd; }
                }
                *(u32x4*)(rowp) = pack8(o1[0], o1[1]); *(u32x4*)(rowp + 32) = pack8(o2[0], o2[1]);
                if (cdst) { *(f32x4*)(cdst) = o1[0]; *(f32x4*)(cdst + 4) = o1[1]; *(f32x4*)(cdst + 32) = o2[0]; *(f32x4*)(cdst + 36) = o2[1]; }
            }
    }
};

template <class Epi, class Sched, bool ALIGN_EPI = false, bool SP2 = false, bool HS = false>
__device__ __forceinline__ void gemm_phase(PG8_LAS unsigned char* lds, const Gemm g, const Sched& S, const Epi& E, const PG8_LAS float* hs = nullptr) {
    const int tid = threadIdx.x, wid = __builtin_amdgcn_readfirstlane(tid >> 6), lane = tid & 63, wr = wid >> 2, wc = wid & 3, fr = lane & 15, fq = lane >> 4;
    const int K = g.K, nt = K / BK;
    unsigned voffA[2], voffB[2];
#pragma unroll
    for (int i = 0; i < 2; ++i) { int R, C; stage_rc(tid * 16 + i * 8192, R, C); const int Rb = Epi::PERM ? ((R & ~31) + perm32(R & 31)) : R;
        voffA[i] = (unsigned)(R * K + C) * 2u; voffB[i] = (unsigned)(Rb * K + C) * 2u; }
    const size_t kstep = (size_t)(BK * 2);
    const size_t hstep = (size_t)HALF * K * 2;
    const size_t tstep = 2 * hstep;
    const unsigned ldsw = (unsigned)wid * 1024u;
    const int aoff = lds_byte(wr * 64 + fr, fq * 8), boff = lds_byte(wc * 32 + fr, fq * 8);
#define PG8_SA(b, h) (((b) * 2 + (h)) * HTB)
#define PG8_SB(b, h) ((4 + (b) * 2 + (h)) * HTB)
#define PG8_STAGE(bufoff, gbase, voff) do { _Pragma("unroll") for (int _i = 0; _i < 2; ++_i) \
        __builtin_amdgcn_global_load_lds((const unsigned*)((const char*)(gbase) + (voff)[_i]), (PG8_LAS unsigned*)(lds + (bufoff) + ldsw + _i * 8192), 16, 0, 0); } while (0)
#define PG8_LDA(dst, b, h) do { _Pragma("unroll") for (int m = 0; m < 4; ++m) _Pragma("unroll") for (int k = 0; k < 2; ++k) dst[m][k] = *(const PG8_LAS bf16x8*)(lds + PG8_SA(b, h) + aoff + m * 2048 + k * 1024); } while (0)
#define PG8_LDB(dst, b, h) do { _Pragma("unroll") for (int n = 0; n < 2; ++n) _Pragma("unroll") for (int k = 0; k < 2; ++k) dst[n][k] = *(const PG8_LAS bf16x8*)(lds + PG8_SB(b, h) + boff + n * 2048 + k * 1024); } while (0)
#define PG8_MMA(ai, bj, At, Bt) do { __builtin_amdgcn_s_setprio(1); _Pragma("unroll") for (int m = 0; m < 4; ++m) _Pragma("unroll") for (int n = 0; n < 2; ++n) _Pragma("unroll") for (int k = 0; k < 2; ++k) \
        acc[ai][bj][m][n] = __builtin_amdgcn_mfma_f32_16x16x32_bf16(Bt[n][k], At[m][k], acc[ai][bj][m][n], 0, 0, 0); __builtin_amdgcn_s_setprio(0); } while (0)
#define PG8_WAIT_V(n) asm volatile("s_waitcnt vmcnt(" #n ")" ::: "memory")
#define PG8_WAIT_L(n) asm volatile("s_waitcnt lgkmcnt(" #n ")" ::: "memory")
#define PG8_BAR __builtin_amdgcn_s_barrier()
#define PG8_SCHED __builtin_amdgcn_sched_barrier(0)
    Unit cur, nxt; int ui = 0;
    if (!S.next(0, cur)) return;
    f32x4 acc[2][2][4][2];
#pragma unroll
    for (int a = 0; a < 2; ++a)
#pragma unroll
        for (int b = 0; b < 2; ++b)
#pragma unroll
            for (int m = 0; m < 4; ++m)
#pragma unroll
                for (int n = 0; n < 2; ++n) acc[a][b][m][n] = (f32x4){0.f, 0.f, 0.f, 0.f};
    bf16x8 At[4][2], B0[2][2], B1[2][2];
    const char* cA = (const char*)g.A + (size_t)cur.pm * tstep; const char* cB = (const char*)g.Bt + (size_t)cur.pn * tstep;
    S.a_ready(cur);
    if constexpr (SP2) {
        PG8_STAGE(PG8_SB(0, 0), cB, voffB); PG8_STAGE(PG8_SB(0, 1), cB + hstep, voffB); PG8_STAGE(PG8_SA(0, 0), cA, voffA); PG8_STAGE(PG8_SA(0, 1), cA + hstep, voffA);
        if (wr == 1) PG8_BAR;
        PG8_WAIT_V(2); PG8_BAR;
        PG8_STAGE(PG8_SB(1, 0), cB + kstep, voffB); PG8_STAGE(PG8_SA(1, 0), cA + kstep, voffA); PG8_STAGE(PG8_SB(1, 1), cB + hstep + kstep, voffB);
        PG8_WAIT_V(6); PG8_BAR;
    } else {
        PG8_STAGE(PG8_SB(0, 0), cB, voffB); PG8_STAGE(PG8_SA(0, 0), cA, voffA); PG8_STAGE(PG8_SB(0, 1), cB + hstep, voffB); PG8_STAGE(PG8_SA(0, 1), cA + hstep, voffA);
        if (wr == 1) PG8_BAR;
        PG8_WAIT_V(4); PG8_BAR;
        PG8_STAGE(PG8_SB(1, 0), cB + kstep, voffB); PG8_STAGE(PG8_SA(1, 0), cA + kstep, voffA); PG8_STAGE(PG8_SB(1, 1), cB + hstep + kstep, voffB);
        PG8_WAIT_V(6); PG8_BAR;
    }
    for (;;) {
        const bool has_next = S.next(ui + 1, nxt);
        const char* nA = has_next ? (const char*)g.A + (size_t)nxt.pm * tstep : cA; const char* nB = has_next ? (const char*)g.Bt + (size_t)nxt.pn * tstep : cB;
        for (int t = 0; t < nt; t += 2) {
            if constexpr (HS) { if (t == 8 || t == 16 || t == 24) { const int hb_ = (t >> 3) - 1;
#pragma unroll
                for (int ai = 0; ai < 2; ++ai)
#pragma unroll
                    for (int m = 0; m < 4; ++m) { const float rt_ = hs[(ai * HALF + wr * 64 + m * 16 + fr) * 4 + hb_];
#pragma unroll
                        for (int bj = 0; bj < 2; ++bj)
#pragma unroll
                            for (int n = 0; n < 2; ++n) acc[ai][bj][m][n] = acc[ai][bj][m][n] * rt_; } } }
            const bool last = (t == nt - 2);
            const char* a1 = cA + (size_t)(t + 1) * kstep;
            const char* a2 = last ? nA : cA + (size_t)(t + 2) * kstep; const char* b2 = last ? nB : cB + (size_t)(t + 2) * kstep;
            const char* a3 = a2 + kstep; const char* b3 = b2 + kstep;
            if (last && has_next) S.a_ready(nxt);
            if constexpr (SP2) {
            PG8_LDB(B0, 0, 0); PG8_LDB(B1, 0, 1); PG8_SCHED; PG8_LDA(At, 0, 0); PG8_STAGE(PG8_SA(1, 1), a1 + hstep, voffA);
            PG8_WAIT_V(8); PG8_WAIT_L(0); PG8_BAR; PG8_MMA(0, 0, At, B0); PG8_MMA(0, 1, At, B1); PG8_BAR; PG8_SCHED;
            PG8_LDA(At, 0, 1); PG8_STAGE(PG8_SB(0, 0), b2, voffB); PG8_STAGE(PG8_SB(0, 1), b2 + hstep, voffB); PG8_STAGE(PG8_SA(0, 0), a2, voffA);
            PG8_WAIT_V(8); PG8_WAIT_L(0); PG8_BAR; PG8_MMA(1, 0, At, B0); PG8_MMA(1, 1, At, B1); PG8_BAR; PG8_SCHED;
            PG8_LDB(B0, 1, 0); PG8_LDB(B1, 1, 1); PG8_SCHED; PG8_LDA(At, 1, 0); PG8_STAGE(PG8_SA(0, 1), a2 + hstep, voffA);
            PG8_WAIT_V(8); PG8_WAIT_L(0); PG8_BAR; PG8_MMA(0, 0, At, B0); PG8_MMA(0, 1, At, B1); PG8_BAR; PG8_SCHED;
            PG8_LDA(At, 1, 1); PG8_STAGE(PG8_SB(1, 0), b3, voffB); PG8_STAGE(PG8_SB(1, 1), b3 + hstep, voffB); PG8_STAGE(PG8_SA(1, 0), a3, voffA);
            PG8_WAIT_V(8); PG8_WAIT_L(0); PG8_BAR; PG8_MMA(1, 0, At, B0); PG8_MMA(1, 1, At, B1); PG8_BAR; PG8_SCHED;
            } else {
            PG8_LDB(B0, 0, 0); PG8_SCHED; PG8_LDA(At, 0, 0); PG8_STAGE(PG8_SA(1, 1), a1 + hstep, voffA);
            PG8_WAIT_L(8); PG8_BAR; PG8_WAIT_L(0); PG8_MMA(0, 0, At, B0); PG8_BAR; PG8_SCHED;
            PG8_LDB(B1, 0, 1); PG8_STAGE(PG8_SB(0, 0), b2, voffB);
            PG8_BAR; PG8_WAIT_L(0); PG8_MMA(0, 1, At, B1); PG8_BAR;
            PG8_LDA(At, 0, 1); PG8_STAGE(PG8_SA(0, 0), a2, voffA);
            PG8_BAR; PG8_WAIT_L(0); PG8_MMA(1, 0, At, B0); PG8_BAR; PG8_SCHED;
            PG8_STAGE(PG8_SB(0, 1), b2 + hstep, voffB);
            PG8_WAIT_V(6); PG8_BAR; PG8_MMA(1, 1, At, B1); PG8_BAR;
            PG8_LDB(B0, 1, 0); PG8_SCHED; PG8_LDA(At, 1, 0); PG8_STAGE(PG8_SA(0, 1), a2 + hstep, voffA);
            PG8_WAIT_L(8); PG8_BAR; PG8_WAIT_L(0); PG8_MMA(0, 0, At, B0); PG8_BAR; PG8_SCHED;
            PG8_LDB(B1, 1, 1); PG8_STAGE(PG8_SB(1, 0), b3, voffB);
            PG8_BAR; PG8_WAIT_L(0); PG8_MMA(0, 1, At, B1); PG8_BAR;
            PG8_LDA(At, 1, 1); PG8_STAGE(PG8_SA(1, 0), a3, voffA);
            PG8_BAR; PG8_WAIT_L(0); PG8_MMA(1, 0, At, B0); PG8_BAR; PG8_SCHED;
            PG8_STAGE(PG8_SB(1, 1), b3 + hstep, voffB);
            PG8_WAIT_V(6); PG8_BAR; PG8_MMA(1, 1, At, B1); PG8_BAR;
            }
        }
        if constexpr (ALIGN_EPI) { if (wr == 0) PG8_BAR; }
        if constexpr (!Epi::AFTER_DRAIN) { E(acc, cur, wr, wc, fr, fq); S.done(cur); }
        if (!has_next) break;
#pragma unroll
        for (int a = 0; a < 2; ++a)
#pragma unroll
            for (int b = 0; b < 2; ++b)
#pragma unroll
                for (int m = 0; m < 4; ++m)
#pragma unroll
                    for (int n = 0; n < 2; ++n) acc[a][b][m][n] = (f32x4){0.f, 0.f, 0.f, 0.f};
        cur = nxt; cA = nA; cB = nB; ++ui;
        if constexpr (ALIGN_EPI) { if (wr == 1) PG8_BAR; }
    }
    PG8_WAIT_V(0);
    if constexpr (!ALIGN_EPI) { if (wr == 0) PG8_BAR; }
    PG8_BAR;
    if constexpr (Epi::AFTER_DRAIN) { E.fused(acc, cur, wr, wc, fr, fq, lds, wid, lane); S.done(cur); }
#undef PG8_SA
#undef PG8_SB
#undef PG8_STAGE
#undef PG8_LDA
#undef PG8_LDB
#undef PG8_MMA
#undef PG8_WAIT_V
#undef PG8_WAIT_L
#undef PG8_BAR
#undef PG8_SCHED
}
}
#define LAS __attribute__((address_space(3)))
typedef unsigned short bf16;
typedef unsigned u32x4 __attribute__((ext_vector_type(4)));
typedef unsigned u32x2 __attribute__((ext_vector_type(2)));
typedef float f32x4 __attribute__((ext_vector_type(4)));
typedef short bf16x8 __attribute__((ext_vector_type(8)));
#define LDS_WAIT() asm volatile("s_waitcnt lgkmcnt(0)" ::: "memory")

constexpr int NWAVES = 8, NTHR = 512;
constexpr int DM = 1024, NP = 16384, NS = 512, MT = NP + NS, SEQ = 2048, DFF = 2816;
constexpr float EPS = 1e-6f;
constexpr int LDS_BYTES = 147456;

constexpr size_t al256(size_t x) { return (x + 255) & ~(size_t)255; }
constexpr size_t WS_WRI = 0;
constexpr size_t WS_WRO = WS_WRI + al256(6144ull * 1024 * 2);
constexpr size_t WS_WFI0 = WS_WRO + al256(1024ull * 2048 * 2);
constexpr size_t WS_WFO0 = WS_WFI0 + al256(5632ull * 1024 * 2);
constexpr size_t WS_WFI1 = WS_WFO0 + al256(1024ull * 2816 * 2);
constexpr size_t WS_WFO1 = WS_WFI1 + al256(5632ull * 1024 * 2);
constexpr size_t WS_WSI = WS_WFO1 + al256(1024ull * 2816 * 2);
constexpr size_t WS_WSO = WS_WSI + al256(1536ull * 1024 * 2);
constexpr size_t WS_XB = WS_WSO + al256(1024ull * 1024 * 2);
constexpr size_t WS_BIG = WS_XB + al256((size_t)MT * 1024 * 2);
constexpr size_t WS_OB = WS_BIG + al256((size_t)MT * 6144 * 2);
constexpr size_t WS_SS = WS_OB + al256((size_t)MT * 2048 * 2);
constexpr size_t WS_SSO = WS_SS + al256(4ull * MT * 4);
constexpr size_t WS_TRC = WS_SSO + al256((size_t)MT * 4 * 4);
constexpr size_t WS_TRS = WS_TRC + al256(2052ull * 128 * 4);
constexpr size_t WS_TSC = WS_TRS + al256(2052ull * 128 * 4);
constexpr size_t WS_TSS = WS_TSC + al256(2052ull * 32 * 4);
constexpr size_t WS_END = WS_TSS + al256(2052ull * 32 * 4);
constexpr size_t WS_SSOP = WS_END;
constexpr size_t WS_CTL = WS_SSOP + al256((size_t)NP * 64 * 4), CTL_BYTES = 65536;
constexpr size_t WS_SCR = WS_CTL + CTL_BYTES;
constexpr size_t WS_TOTAL = WS_SCR;
constexpr size_t OUT_Y = 0, OUT_SP = (size_t)MT * 1024, OUT_SS = OUT_SP + 8ull * 4 * 256 * 512, OUT_KP = OUT_SS + 128ull * 4 * 256 * 512,
                 OUT_VP = OUT_KP + 8ull * 128 * 256, OUT_KS = OUT_VP + 8ull * 128 * 256, OUT_VS = OUT_KS + 128ull * 128 * 256, OUT_END = OUT_VS + 128ull * 128 * 256;

struct Params {
    const float* in[16]; float* out; unsigned char* ws;
    double invR[128]; double invS[32];
    float lg2[4];
    int ph_lo, ph_hi;
};

__device__ __forceinline__ unsigned f2bf(float f) { unsigned u = __builtin_bit_cast(unsigned, f); return (u + 0x7fffu + ((u >> 16) & 1u)) >> 16; }
__device__ __forceinline__ unsigned pk2(float lo, float hi) { return pg8::cvt_pk_bf16(lo, hi); }
__device__ __forceinline__ float bf2f(unsigned short b) { return __builtin_bit_cast(float, (unsigned)b << 16); }
__device__ __forceinline__ float bflo(unsigned w) { return __builtin_bit_cast(float, w << 16); }
__device__ __forceinline__ float bfhi(unsigned w) { return __builtin_bit_cast(float, w & 0xffff0000u); }
__device__ __forceinline__ float wave_sum(float v) {
#pragma unroll
    for (int o = 1; o < 64; o <<= 1) v += __shfl_xor(v, o);
    return v;
}
__device__ __forceinline__ f32x4 mfma16(bf16x8 a, bf16x8 b, f32x4 c) { return __builtin_amdgcn_mfma_f32_16x16x32_bf16(a, b, c, 0, 0, 0); }

__device__ __forceinline__ void transpose_item(const float* W, int K, int N, const float* gain, bf16* WT, int n0, int d0a, int d0b, int k0, LAS float* scr, int lane) {
    f32x4 wv[16];
#pragma unroll
    for (int i = 0; i < 16; ++i) { const int kk = 4 * i + (lane >> 4); wv[i] = __builtin_nontemporal_load((const f32x4*)(W + (size_t)(k0 + kk) * N + n0 + 4 * (lane & 15))); }
#pragma unroll
    for (int i = 0; i < 16; ++i) { const int kk = 4 * i + (lane >> 4); const float g = gain ? gain[k0 + kk] : 1.0f; LAS float* d = scr + kk * 65 + 4 * (lane & 15);
        d[0] = wv[i][0] * g; d[1] = wv[i][1] * g; d[2] = wv[i][2] * g; d[3] = wv[i][3] * g; }
    LDS_WAIT();
    const int c = lane & 7;
#pragma unroll
    for (int j = 0; j < 8; ++j) { const int n = (lane >> 3) + 8 * j; const LAS float* s = scr + (8 * c) * 65 + n;
        u32x4 o; o.x = pk2(s[0 * 65], s[1 * 65]); o.y = pk2(s[2 * 65], s[3 * 65]); o.z = pk2(s[4 * 65], s[5 * 65]); o.w = pk2(s[6 * 65], s[7 * 65]);
        const int drow = (n < 32) ? d0a + n : d0b + n - 32;
        *(u32x4*)(WT + (size_t)drow * K + k0 + 8 * c) = o; }
    LDS_WAIT();
}
__device__ __forceinline__ int dmap32(int mode, int n0) {
    if (mode == 1) return (n0 < DFF) ? (n0 / 128) * 256 + (n0 % 128) : ((n0 - DFF) / 128) * 256 + 128 + ((n0 - DFF) % 128);
    if (mode == 2) { const int pn = n0 / 256, r256 = n0 % 256, wc = r256 / 64, bj = (r256 % 64) / 32; return 256 * pn + 128 * bj + 32 * wc; }
    return n0;
}
__device__ __forceinline__ void transpose_mat(const float* W, int K, int N, const float* gain, bf16* WT, int mode, int r, LAS float* scr, int lane) {
    const int nblk = N / 64, kb = r / nblk, nb = r % nblk, n0 = 64 * nb;
    transpose_item(W, K, N, gain, WT, n0, dmap32(mode, n0), dmap32(mode, n0 + 32), 64 * kb, scr, lane);
}
__device__ __forceinline__ void p0_prologue(const Params& p, LAS unsigned char* lds, int tid, int lane, int wave, int vcu, int G, int part, int wid1, int nwg1) {
    unsigned char* ws = p.ws;
    LAS float* scr = (LAS float*)(lds + wave * 16896);
    const int gw = part ? wid1 * NWAVES + wave : vcu * NWAVES + wave, NGW = (part ? nwg1 : G) * NWAVES;
    constexpr int I_RI = 16 * 96, I_RO = 32 * 16, I_FI = 16 * 88, I_FO = 44 * 16, I_SI = 16 * 24, I_SO = 16 * 16;
    constexpr int NITEMS = I_RI + I_RO + 2 * I_FI + 2 * I_FO + I_SI + I_SO;
    const float* nmix = p.in[5]; const float* nffn = p.in[6];
    for (int it = (part ? I_RI + gw : gw); it < (part ? NITEMS : I_RI); it += NGW) {
        int r = it;
        if (r < I_RI) { transpose_mat(p.in[7], 1024, 6144, nmix, (bf16*)(ws + WS_WRI), 0, r, scr, lane); continue; } r -= I_RI;
        if (r < I_RO) { transpose_mat(p.in[8], 2048, 1024, nullptr, (bf16*)(ws + WS_WRO), 0, r, scr, lane); continue; } r -= I_RO;
        if (r < I_FI) { transpose_mat(p.in[14], 1024, 5632, nffn, (bf16*)(ws + WS_WFI0), 1, r, scr, lane); continue; } r -= I_FI;
        if (r < I_FO) { transpose_mat(p.in[15], 2816, 1024, nullptr, (bf16*)(ws + WS_WFO0), 0, r, scr, lane); continue; } r -= I_FO;
        if (r < I_SI) { transpose_mat(p.in[9], 1024, 1536, nmix + 1024, (bf16*)(ws + WS_WSI), 2, r, scr, lane); continue; } r -= I_SI;
        if (r < I_SO) { transpose_mat(p.in[10], 1024, 1024, nullptr, (bf16*)(ws + WS_WSO), 0, r, scr, lane); continue; } r -= I_SO;
        if (r < I_FI) { transpose_mat(p.in[14] + (size_t)1024 * 5632, 1024, 5632, nffn + 1024, (bf16*)(ws + WS_WFI1), 1, r, scr, lane); continue; } r -= I_FI;
        transpose_mat(p.in[15] + (size_t)2816 * 1024, 2816, 1024, nullptr, (bf16*)(ws + WS_WFO1), 0, r, scr, lane);
    }
    if (part) return;
    float* cR = (float*)(ws + WS_TRC); float* sR = (float*)(ws + WS_TRS); float* cS = (float*)(ws + WS_TSC); float* sS = (float*)(ws + WS_TSS);
    for (int idx = vcu * NTHR + tid; idx < 2052 * 160; idx += G * NTHR) {
        const int pi = idx / 160, c = idx % 160; const double pos = (pi < 2048) ? (double)pi : (double)(16384 + (pi - 2048));
        double rev = pos * ((c < 128) ? p.invR[c] : p.invS[c - 128]); rev -= __builtin_rint(rev);
        const float cv = __builtin_amdgcn_cosf((float)rev), sv = __builtin_amdgcn_sinf((float)rev);
        if (c < 128) { cR[pi * 128 + c] = cv; sR[pi * 128 + c] = sv; } else { cS[pi * 32 + c - 128] = cv; sS[pi * 32 + c - 128] = sv; }
    }
    bf16* XB = (bf16*)(ws + WS_XB); float* ss = (float*)(ws + WS_SS); float* sso = (float*)(ws + WS_SSO);
    for (int m = gw; m < MT; m += NGW) {
        const float* xr = (m < NP) ? p.in[0] + (size_t)m * DM : p.in[1] + (size_t)(m - NP) * DM;
        f32x4 v[4]; float s = 0.f;
#pragma unroll
        for (int j = 0; j < 4; ++j) { v[j] = ((const f32x4*)xr)[lane + 64 * j]; s += (v[j][0] * v[j][0] + v[j][1] * v[j][1]) + (v[j][2] * v[j][2] + v[j][3] * v[j][3]); }
        s = wave_sum(s);
#pragma unroll
        for (int j = 0; j < 4; ++j) { u32x2 o; o.x = pk2(v[j][0], v[j][1]); o.y = pk2(v[j][2], v[j][3]); ((u32x2*)(XB + (size_t)m * DM))[lane + 64 * j] = o; }
        if (lane == 0) { ss[m] = s; ss[MT + m] = 0.f; ss[2 * MT + m] = 0.f; ss[3 * MT + m] = 0.f; }
    }
}

constexpr int RQ_STR = 264, RV_STR = 72;
constexpr int RL_Q = 0, RL_K = 33792, RL_VT = 67584, RL_VD = 76800, RL_P = 86016, RL_ST = 95232, RL_GL = 129024;
__device__ __forceinline__ void ret_prompt_unit(LAS unsigned char* lds, const bf16* QKVG, bf16* OB, float* sso, float* state_out, int bh, int es, float lg2, int tid) {
    const int lane = tid & 63, w = __builtin_amdgcn_readfirstlane(tid >> 6), li = lane & 15, lq = lane >> 4;
    const int b = bh >> 2, h = bh & 3;
    LAS bf16* Ql = (LAS bf16*)(lds + RL_Q); LAS bf16* Kl = (LAS bf16*)(lds + RL_K); LAS bf16* VT = (LAS bf16*)(lds + RL_VT);
    LAS bf16* VD = (LAS bf16*)(lds + RL_VD); LAS bf16* PP = (LAS bf16*)(lds + RL_P); LAS bf16* ST = (LAS bf16*)(lds + RL_ST);
    for (int i = tid; i < 33792 / 16; i += NTHR) ((LAS u32x4*)ST)[i] = (u32x4){0u, 0u, 0u, 0u};
    f32x4 S[2][4];
#pragma unroll
    for (int a = 0; a < 2; ++a)
#pragma unroll
        for (int e = 0; e < 4; ++e) S[a][e] = (f32x4){0.f, 0.f, 0.f, 0.f};
    const size_t rowbase = (size_t)b * SEQ;
    const bf16* qg = QKVG + ((size_t)h * MT + rowbase) * 256;
    const bf16* kg = qg + (size_t)4 * MT * 256;
    const bf16* vg = QKVG + (size_t)8 * MT * 256 + ((size_t)h * MT + rowbase) * 512 + es * 64;
    const int srow = tid >> 5, sch = tid & 31;
    const int vrow = tid & 63, vch = tid >> 6;
    const bf16* gg = vg + (size_t)4 * MT * 512;
    LAS bf16* GL = (LAS bf16*)(lds + RL_GL);
    u32x4 rq[4], rk[4], rv, rg;
#define RET_LOAD(t0_) do { _Pragma("unroll") for (int i_ = 0; i_ < 4; ++i_) { const size_t o_ = (size_t)((t0_) + srow + 16 * i_) * 256 + sch * 8; rq[i_] = *(const u32x4*)(qg + o_); rk[i_] = *(const u32x4*)(kg + o_); } \
        rv = *(const u32x4*)(vg + (size_t)((t0_) + vrow) * 512 + vch * 8); rg = *(const u32x4*)(gg + (size_t)((t0_) + vrow) * 512 + vch * 8); } while (0)
    RET_LOAD(0);
    const int ib = w >> 1, nh = w & 1;
    const float dS = __builtin_amdgcn_exp2f(64.0f * lg2);
    for (int c = 0; c < 32; ++c) {
        const int t0 = c * 64;
        asm volatile("s_waitcnt vmcnt(0)" ::: "memory");
#pragma unroll
        for (int i = 0; i < 4; ++i) { *(LAS u32x4*)(Ql + (srow + 16 * i) * RQ_STR + sch * 8) = rq[i]; *(LAS u32x4*)(Kl + (srow + 16 * i) * RQ_STR + sch * 8) = rk[i]; }
        *(LAS u32x4*)(GL + vrow * RV_STR + vch * 8) = rg;
        { const float dec = __builtin_amdgcn_exp2f((float)(63 - vrow) * lg2);
#pragma unroll
          for (int j = 0; j < 4; ++j) { const unsigned wv = rv[j]; const int e0 = vch * 8 + 2 * j;
              VT[e0 * RV_STR + vrow] = (bf16)(wv & 0xffffu); VT[(e0 + 1) * RV_STR + vrow] = (bf16)(wv >> 16);
              VD[e0 * RV_STR + vrow] = (bf16)f2bf(bflo(wv) * dec); VD[(e0 + 1) * RV_STR + vrow] = (bf16)f2bf(bfhi(wv) * dec); } }
        __syncthreads();
        if (c + 1 < 32) RET_LOAD(t0 + 64);
        f32x4 accS[2], accO[2];
#pragma unroll
        for (int t = 0; t < 2; ++t) { accS[t] = (f32x4){0.f, 0.f, 0.f, 0.f}; accO[t] = (f32x4){0.f, 0.f, 0.f, 0.f}; }
#pragma unroll
        for (int kh = 0; kh < 4; ++kh) {
            bf16x8 fa[2], fs[2][2], fk[2][2];
#pragma unroll
            for (int kk = 0; kk < 2; ++kk) { const int ks = 2 * kh + kk;
                fa[kk] = *(const LAS bf16x8*)(Ql + (16 * ib + li) * RQ_STR + 32 * ks + 8 * lq);
#pragma unroll
                for (int t = 0; t < 2; ++t) { fs[kk][t] = *(const LAS bf16x8*)(ST + (16 * (2 * nh + t) + li) * RQ_STR + 32 * ks + 8 * lq);
                    fk[kk][t] = *(const LAS bf16x8*)(Kl + (16 * (2 * nh + t) + li) * RQ_STR + 32 * ks + 8 * lq); } }
            __builtin_amdgcn_sched_barrier(0);
#pragma unroll
            for (int kk = 0; kk < 2; ++kk)
#pragma unroll
                for (int t = 0; t < 2; ++t) { accO[t] = mfma16(fa[kk], fs[kk][t], accO[t]); accS[t] = mfma16(fa[kk], fk[kk][t], accS[t]); }
            __builtin_amdgcn_sched_barrier(0);
        }
#pragma unroll
        for (int t = 0; t < 2; ++t) { const int jb = 2 * nh + t, j = 16 * jb + li;
#pragma unroll
            for (int r = 0; r < 4; ++r) { const int i = 16 * ib + 4 * lq + r;
                const float val = (j <= i) ? accS[t][r] * __builtin_amdgcn_exp2f((float)(i - j) * lg2) : 0.f;
                PP[i * RV_STR + j] = (bf16)f2bf(val); } }
        __syncthreads();
        f32x4 accA[2];
#pragma unroll
        for (int t = 0; t < 2; ++t) accA[t] = (f32x4){0.f, 0.f, 0.f, 0.f};
#pragma unroll
        for (int ks = 0; ks < 2; ++ks) {
            const bf16x8 a = *(const LAS bf16x8*)(PP + (16 * ib + li) * RV_STR + 32 * ks + 8 * lq);
#pragma unroll
            for (int t = 0; t < 2; ++t) { const bf16x8 bv = *(const LAS bf16x8*)(VT + (16 * (2 * nh + t) + li) * RV_STR + 32 * ks + 8 * lq); accA[t] = mfma16(a, bv, accA[t]); }
        }
#pragma unroll
        for (int r = 0; r < 4; ++r) { const int i = 16 * ib + 4 * lq + r; const float f = __builtin_amdgcn_exp2f((float)(i + 1) * lg2);
            const size_t row = rowbase + t0 + i; float q2 = 0.f;
#pragma unroll
            for (int t = 0; t < 2; ++t) { const float o = accA[t][r] + f * accO[t][r]; q2 += o * o; OB[row * 2048 + h * 512 + es * 64 + 16 * (2 * nh + t) + li] = (bf16)f2bf(o * bf2f(GL[i * RV_STR + 16 * (2 * nh + t) + li])); }
            q2 += __shfl_xor(q2, 1); q2 += __shfl_xor(q2, 2); q2 += __shfl_xor(q2, 4); q2 += __shfl_xor(q2, 8);
            if (li == 0 && sso) sso[(row * 4 + h) * 16 + es * 2 + nh] = q2; }
#pragma unroll
        for (int a = 0; a < 2; ++a)
#pragma unroll
            for (int e = 0; e < 4; ++e) S[a][e] = S[a][e] * dS;
#pragma unroll
        for (int ks = 0; ks < 2; ++ks) {
            bf16x8 ka[2];
#pragma unroll
            for (int dm = 0; dm < 2; ++dm)
#pragma unroll
                for (int jj = 0; jj < 8; ++jj) ka[dm][jj] = (short)Kl[(32 * ks + 8 * lq + jj) * RQ_STR + 32 * w + 16 * dm + li];
#pragma unroll
            for (int en = 0; en < 4; ++en) { const bf16x8 bv = *(const LAS bf16x8*)(VD + (16 * en + li) * RV_STR + 32 * ks + 8 * lq);
#pragma unroll
                for (int dm = 0; dm < 2; ++dm) S[dm][en] = mfma16(ka[dm], bv, S[dm][en]); }
        }
#pragma unroll
        for (int dm = 0; dm < 2; ++dm)
#pragma unroll
            for (int en = 0; en < 4; ++en) { u32x2 o; o.x = f2bf(S[dm][en][0]) | (f2bf(S[dm][en][1]) << 16); o.y = f2bf(S[dm][en][2]) | (f2bf(S[dm][en][3]) << 16);
                *(LAS u32x2*)(ST + (16 * en + li) * RQ_STR + 32 * w + 16 * dm + 4 * lq) = o; }
        __syncthreads();
    }
#undef RET_LOAD
    float* so = state_out + ((size_t)bh * 256) * 512 + es * 64;
#pragma unroll
    for (int dm = 0; dm < 2; ++dm)
#pragma unroll
        for (int en = 0; en < 4; ++en)
#pragma unroll
            for (int r = 0; r < 4; ++r) so[(size_t)(32 * w + 16 * dm + 4 * lq + r) * 512 + 16 * en + li] = S[dm][en][r];
}

__device__ __forceinline__ void ret_sample_unit(LAS unsigned char* lds, const bf16* QKVG, bf16* OB, const float* state_in, float* state_out, int bh, float lg2, int tid) {
    const int lane = tid & 63, w = __builtin_amdgcn_readfirstlane(tid >> 6);
    const int b = bh >> 2, h = bh & 3;
    LAS float* qk8 = (LAS float*)lds;
    LAS float* qkd = qk8 + 2048;
    LAS float* red = qkd + 16;
    LAS float* wsm = red + 8192;
    const size_t r0 = (size_t)(NP + b * 4);
    {
        const int idx = tid * 4, which = idx >> 10, t = (idx >> 8) & 3, d = idx & 255;
        const u32x2 v = *(const u32x2*)(QKVG + (size_t)which * 4 * MT * 256 + ((size_t)h * MT + r0 + t) * 256 + d);
        LAS float* dst = qk8 + d * 8 + which * 4 + t;
        dst[0] = bflo(v.x); dst[8] = bfhi(v.x); dst[16] = bflo(v.y); dst[24] = bfhi(v.y);
    }
    __syncthreads();
    {
#pragma unroll
        for (int pp = 0; pp < 2; ++pp) { const int pr = 2 * w + pp, i = pr >> 2, j = pr & 3; float s = 0.f;
#pragma unroll
            for (int dd = 0; dd < 4; ++dd) { const int d = lane * 4 + dd; s += qk8[d * 8 + i] * qk8[d * 8 + 4 + j]; }
            s = wave_sum(s); if (lane == 0) qkd[pr] = s; }
    }
    const float g1 = __builtin_amdgcn_exp2f(lg2), g2 = g1 * g1, g3 = g2 * g1, g4 = g2 * g2;
    const int ec = tid & 127, dg = tid >> 7;
    f32x4 vv[4];
#pragma unroll
    for (int j = 0; j < 4; ++j) { const u32x2 v = *(const u32x2*)(QKVG + (size_t)8 * MT * 256 + ((size_t)h * MT + r0 + j) * 512 + 4 * ec); vv[j] = (f32x4){bflo(v.x), bfhi(v.x), bflo(v.y), bfhi(v.y)}; }
    vv[0] = vv[0] * g3; vv[1] = vv[1] * g2; vv[2] = vv[2] * g1;
    f32x4 oa[4];
#pragma unroll
    for (int i = 0; i < 4; ++i) oa[i] = (f32x4){0.f, 0.f, 0.f, 0.f};
    const float* sin_ = state_in + ((size_t)bh * 256 + dg * 64) * 512 + 4 * ec;
    float* sout = state_out + ((size_t)bh * 256 + dg * 64) * 512 + 4 * ec;
    f32x4 sb[2][8];
#pragma unroll
    for (int r = 0; r < 8; ++r) sb[0][r] = __builtin_nontemporal_load((const f32x4*)(sin_ + (size_t)r * 512));
#pragma unroll
    for (int bt = 0; bt < 8; ++bt) {
        if (bt + 1 < 8) {
#pragma unroll
            for (int r = 0; r < 8; ++r) sb[(bt + 1) & 1][r] = __builtin_nontemporal_load((const f32x4*)(sin_ + (size_t)((bt + 1) * 8 + r) * 512));
            asm volatile("s_waitcnt vmcnt(8)" ::: "memory");
        } else asm volatile("s_waitcnt vmcnt(0)" ::: "memory");
#pragma unroll
        for (int r = 0; r < 8; ++r) { const int dd = bt * 8 + r; const f32x4 s = sb[bt & 1][r];
            const f32x4 q4 = *(const LAS f32x4*)(qk8 + (dg * 64 + dd) * 8), k4 = *(const LAS f32x4*)(qk8 + (dg * 64 + dd) * 8 + 4);
            const f32x4 sn = s * g4 + vv[0] * k4[0] + vv[1] * k4[1] + vv[2] * k4[2] + vv[3] * k4[3];
            __builtin_nontemporal_store(sn, (f32x4*)(sout + (size_t)dd * 512));
            oa[0] += s * q4[0]; oa[1] += s * q4[1]; oa[2] += s * q4[2]; oa[3] += s * q4[3]; }
    }
#pragma unroll
    for (int i = 0; i < 4; ++i) *(LAS f32x4*)(red + (dg * 4 + i) * 512 + 4 * ec) = oa[i];
    __syncthreads();
    {
        const int e = tid; float vj[4], o[4], q2[4];
#pragma unroll
        for (int j = 0; j < 4; ++j) vj[j] = bf2f(QKVG[(size_t)8 * MT * 256 + ((size_t)h * MT + r0 + j) * 512 + e]);
        const float gp[4] = {1.0f, g1, g2, g3};
#pragma unroll
        for (int i = 0; i < 4; ++i) { float ob = (red[(0 * 4 + i) * 512 + e] + red[(1 * 4 + i) * 512 + e]) + (red[(2 * 4 + i) * 512 + e] + red[(3 * 4 + i) * 512 + e]);
            float acc = ob * gp[i] * g1;
#pragma unroll
            for (int j = 0; j < 4; ++j) if (j <= i) acc += gp[i - j] * qkd[i * 4 + j] * vj[j];
            o[i] = acc; q2[i] = wave_sum(acc * acc); }
        if (lane == 0) {
#pragma unroll
            for (int i = 0; i < 4; ++i) wsm[w * 4 + i] = q2[i]; }
        __syncthreads();
#pragma unroll
        for (int i = 0; i < 4; ++i) { float t = 0.f;
#pragma unroll
            for (int ww = 0; ww < 8; ++ww) t += wsm[ww * 4 + i];
            const float rstd = __builtin_amdgcn_rsqf(t * (1.0f / 512.0f) + EPS);
            const float sg = bf2f(QKVG[(size_t)8 * MT * 256 + (size_t)4 * MT * 512 + ((size_t)h * MT + r0 + i) * 512 + e]);
            OB[(r0 + i) * 2048 + h * 512 + e] = (bf16)f2bf(o[i] * rstd * sg); }
    }
    __syncthreads();
}

__device__ __forceinline__ void ret_norm_pass(const bf16* QKVG, bf16* OB, const float* sso, int gw, int NGW, int lane) {
    for (int m = gw; m < NP; m += NGW) {
#pragma unroll
        for (int j = 0; j < 4; ++j) {
            const f32x4* pp = (const f32x4*)(sso + ((size_t)m * 4 + j) * 16);
            const f32x4 pa = pp[0] + pp[1] + pp[2] + pp[3];
            const float rstd = __builtin_amdgcn_rsqf(((pa[0] + pa[1]) + (pa[2] + pa[3])) * (1.0f / 512.0f) + EPS);
            u32x4 o = *(const u32x4*)(OB + (size_t)m * 2048 + 512 * j + lane * 8); const u32x4 g = *(const u32x4*)(QKVG + (size_t)8 * MT * 256 + (size_t)4 * MT * 512 + ((size_t)j * MT + m) * 512 + lane * 8);
#pragma unroll
            for (int k = 0; k < 4; ++k) o[k] = pk2(bflo(o[k]) * rstd * bflo(g[k]), bfhi(o[k]) * rstd * bfhi(g[k]));
            *(u32x4*)(OB + (size_t)m * 2048 + 512 * j + lane * 8) = o;
        }
    }
}

constexpr int AK_STR = 72, AV_STR = 264, AP_STR = 168;
constexpr int AL_K = 0, AL_VT = 36864, AL_P = 70656;
template <int AVS> __device__ __forceinline__ void attn_item(const LAS bf16* Kl, const LAS bf16* VT, LAS bf16* Pw, const bf16x8 (&qa)[2], int jt0, const int (&lo)[4], const int (&hi)[4], const float (&sink)[4], bf16* const (&outp)[4], int li, int lq) {
    f32x4 sc[10];
#pragma unroll
    for (int jt = 0; jt < 10; ++jt) { sc[jt] = (f32x4){0.f, 0.f, 0.f, 0.f};
#pragma unroll
        for (int ks = 0; ks < 2; ++ks) { const bf16x8 bk = *(const LAS bf16x8*)(Kl + (16 * (jt0 + jt) + li) * AK_STR + 32 * ks + 8 * lq); sc[jt] = mfma16(qa[ks], bk, sc[jt]); } }
    float mx[4], den[4];
#pragma unroll
    for (int r = 0; r < 4; ++r) { float m = sink[r];
#pragma unroll
        for (int jt = 0; jt < 10; ++jt) { const int j = 16 * (jt0 + jt) + li; const bool ok = (j >= lo[r]) && (j <= hi[r]); sc[jt][r] = ok ? sc[jt][r] : -INFINITY; m = fmaxf(m, sc[jt][r]); }
        m = fmaxf(m, __shfl_xor(m, 1)); m = fmaxf(m, __shfl_xor(m, 2)); m = fmaxf(m, __shfl_xor(m, 4)); m = fmaxf(m, __shfl_xor(m, 8));
        float s = 0.f;
#pragma unroll
        for (int jt = 0; jt < 10; ++jt) { const float e = __expf(sc[jt][r] - m); sc[jt][r] = e; s += e; }
        s += __shfl_xor(s, 1); s += __shfl_xor(s, 2); s += __shfl_xor(s, 4); s += __shfl_xor(s, 8);
        mx[r] = m; den[r] = __builtin_amdgcn_rcpf(s + __expf(sink[r] - m)); }
#pragma unroll
    for (int jt = 0; jt < 10; ++jt)
#pragma unroll
        for (int r = 0; r < 4; ++r) Pw[(4 * lq + r) * AP_STR + 16 * jt + li] = (bf16)f2bf(sc[jt][r] * den[r]);
    LDS_WAIT();
    f32x4 oc[4];
#pragma unroll
    for (int dn = 0; dn < 4; ++dn) oc[dn] = (f32x4){0.f, 0.f, 0.f, 0.f};
#pragma unroll
    for (int ks = 0; ks < 5; ++ks) { const bf16x8 pa = *(const LAS bf16x8*)(Pw + li * AP_STR + 32 * ks + 8 * lq);
#pragma unroll
        for (int dn = 0; dn < 4; ++dn) { const bf16x8 bv = *(const LAS bf16x8*)(VT + (16 * dn + li) * AVS + 16 * jt0 + 32 * ks + 8 * lq); oc[dn] = mfma16(pa, bv, oc[dn]); } }
#pragma unroll
    for (int r = 0; r < 4; ++r)
#pragma unroll
        for (int dn = 0; dn < 4; ++dn) outp[r][16 * dn + li] = (bf16)f2bf(oc[dn][r]);
    LDS_WAIT();
    (void)mx;
}
__device__ __forceinline__ void attn_prompt_unit(LAS unsigned char* lds, const bf16* QKV, bf16* AO, const float* sinks, int unit, int tid) {
    const int lane = tid & 63, w = __builtin_amdgcn_readfirstlane(tid >> 6), li = lane & 15, lq = lane >> 4;
    const int kvh = unit & 3, nb = (unit >> 2) & 15, b = unit >> 6;
    LAS bf16* Kl = (LAS bf16*)(lds + AL_K); LAS bf16* VT = (LAS bf16*)(lds + AL_VT); LAS bf16* Pw = (LAS bf16*)(lds + AL_P + w * 5376);
    const size_t rowbase = (size_t)b * SEQ; const int tb = nb * 128 - 128;
    bf16x8 qf[4][2];
#pragma unroll
    for (int it = 0; it < 4; ++it) { const int id = w * 4 + it, g = id >> 3, qt = id & 7; const bf16* qp = QKV + (rowbase + nb * 128 + 16 * qt + li) * 1536 + (kvh * 4 + g) * 64;
#pragma unroll
        for (int ks = 0; ks < 2; ++ks) qf[it][ks] = *(const bf16x8*)(qp + 32 * ks + 8 * lq); }
#pragma unroll
    for (int i = 0; i < 4; ++i) { const int id = tid + NTHR * i, j = id >> 3, ch = id & 7; const int t = tb + j;
        u32x4 kv = (u32x4){0u, 0u, 0u, 0u}, vv = (u32x4){0u, 0u, 0u, 0u};
        if (t >= 0) { const bf16* src = QKV + (rowbase + t) * 1536 + 1024 + kvh * 64 + ch * 8; kv = *(const u32x4*)src; vv = *(const u32x4*)(src + 256); }
        *(LAS u32x4*)(Kl + j * AK_STR + ch * 8) = kv;
#pragma unroll
        for (int k = 0; k < 4; ++k) { VT[(ch * 8 + 2 * k) * AV_STR + j] = (bf16)(vv[k] & 0xffffu); VT[(ch * 8 + 2 * k + 1) * AV_STR + j] = (bf16)(vv[k] >> 16); } }
    __syncthreads();
#pragma unroll
    for (int it = 0; it < 4; ++it) { const int id = w * 4 + it, g = id >> 3, qt = id & 7, hq = kvh * 4 + g;
        const size_t qrow0 = rowbase + nb * 128 + 16 * qt;
        int lo[4], hi[4]; float sk[4]; bf16* op[4]; const float sv = sinks[hq];
#pragma unroll
        for (int r = 0; r < 4; ++r) { const int i = 16 * qt + 4 * lq + r; lo[r] = (nb > 0) ? i : (i > 128 ? i : 128); hi[r] = i + 128; sk[r] = sv; op[r] = AO + (qrow0 + 4 * lq + r) * 1024 + hq * 64; }
        attn_item<AV_STR>(Kl, VT, Pw, qf[it], qt & ~1, lo, hi, sk, op, li, lq); }
    __syncthreads();
}
constexpr int AS_VSTR = 168, AS_SLOT = 51200, AS_K = 0, AS_VT = 23040, AS_P = 44544;
__device__ __forceinline__ void attn_sample_pair(LAS unsigned char* lds, const bf16* QKV, bf16* AO, const float* sinks, const float* ck, const float* cv, float* ok, float* ov, int unit0, int unit1, int tid) {
    const int lane = tid & 63, w = __builtin_amdgcn_readfirstlane(tid >> 6), li = lane & 15, lq = lane >> 4;
#pragma unroll 1
    for (int s = 0; s < 2; ++s) {
        const int unit = s ? unit1 : unit0; const int kvh = unit & 3, b = unit >> 2;
        LAS bf16* Kl = (LAS bf16*)(lds + s * AS_SLOT + AS_K); LAS bf16* VT = (LAS bf16*)(lds + s * AS_SLOT + AS_VT);
#pragma unroll
        for (int i = 0; i < 4; ++i) { const int id = tid + NTHR * i, j = id >> 4, ch = id & 15;
            const size_t so = ((size_t)(b * 128 + j) * 4 + kvh) * 64 + ch * 4;
            const f32x4 kf = *(const f32x4*)(ck + so), vf = *(const f32x4*)(cv + so);
            if (j >= 4) { const size_t d_ = ((size_t)(b * 128 + j - 4) * 4 + kvh) * 64 + ch * 4; *(f32x4*)(ok + d_) = kf; *(f32x4*)(ov + d_) = vf; }
            u32x2 kb; kb.x = pk2(kf[0], kf[1]); kb.y = pk2(kf[2], kf[3]); *(LAS u32x2*)(Kl + j * AK_STR + ch * 4) = kb;
#pragma unroll
            for (int k = 0; k < 4; ++k) VT[(ch * 4 + k) * AS_VSTR + j] = (bf16)f2bf(vf[k]); }
        if (tid < 256) { const int j = 128 + (tid >> 3), ch = tid & 7;
            u32x4 kv = (u32x4){0u, 0u, 0u, 0u}, vv = (u32x4){0u, 0u, 0u, 0u};
            if (j < 132) { const bf16* src = QKV + (size_t)(NP + b * 4 + (j - 128)) * 1536 + 1024 + kvh * 64 + ch * 8; kv = *(const u32x4*)src; vv = *(const u32x4*)(src + 256); }
            *(LAS u32x4*)(Kl + j * AK_STR + ch * 8) = kv;
#pragma unroll
            for (int k = 0; k < 4; ++k) { VT[(ch * 8 + 2 * k) * AS_VSTR + j] = (bf16)(vv[k] & 0xffffu); VT[(ch * 8 + 2 * k + 1) * AS_VSTR + j] = (bf16)(vv[k] >> 16); } }
    }
    __syncthreads();
    if (w < 2) {
        const int unit = w ? unit1 : unit0; const int kvh = unit & 3, b = unit >> 2;
        const LAS bf16* Kl = (const LAS bf16*)(lds + w * AS_SLOT + AS_K); const LAS bf16* VT = (const LAS bf16*)(lds + w * AS_SLOT + AS_VT); LAS bf16* Pw = (LAS bf16*)(lds + w * AS_SLOT + AS_P);
        const int gA = li >> 2, tA = li & 3;
        const bf16* qp = QKV + (size_t)(NP + b * 4 + tA) * 1536 + (kvh * 4 + gA) * 64;
        bf16x8 qa[2];
#pragma unroll
        for (int ks = 0; ks < 2; ++ks) qa[ks] = *(const bf16x8*)(qp + 32 * ks + 8 * lq);
        int lo[4], hi[4]; float sk[4]; bf16* op[4];
#pragma unroll
        for (int r = 0; r < 4; ++r) { const int rr = 4 * lq + r, g = rr >> 2, t = rr & 3; lo[r] = t; hi[r] = t + 128; sk[r] = sinks[kvh * 4 + g]; op[r] = AO + (size_t)(NP + b * 4 + t) * 1024 + (kvh * 4 + g) * 64; }
        attn_item<AS_VSTR>(Kl, VT, Pw, qa, 0, lo, hi, sk, op, li, lq);
    }
    __syncthreads();
}

#define XB_TMO      128
#define XB_XCNT(j)  (256  + 64 * (j))
#define XB_XSUB(j)  (1280 + 64 * (j))
#define XB_XGEN(j)  (2304 + 64 * (j))
#define XB_TOP      3328
#define XB_TOPGEN   3392
#define XCD_BAR_WORDS 3456
#define XB_SPIN_CAP (1u << 18)

__device__ __forceinline__ unsigned xb_ld(unsigned* p)              { return __hip_atomic_load(p, __ATOMIC_RELAXED, __HIP_MEMORY_SCOPE_AGENT); }
__device__ __forceinline__ unsigned xb_add(unsigned* p, unsigned v) { return __hip_atomic_fetch_add(p, v, __ATOMIC_RELAXED, __HIP_MEMORY_SCOPE_AGENT); }
__device__ __forceinline__ unsigned xb_xcc_id() { return (unsigned)__builtin_amdgcn_s_getreg((3 << 11) | 20) & 0xFu; }
#define XB_SPIN(cond, bar) do { unsigned _sp = 0; while (cond) { __builtin_amdgcn_s_sleep(1); \
    if ((++_sp & 255u) == 0u) { if (xb_ld(&(bar)[XB_TMO])) break; if (_sp > XB_SPIN_CAP) { atomicAdd(&(bar)[XB_TMO], 1u); break; } } } } while (0)

struct XcdBarrier {
    unsigned* bar; unsigned x;
    volatile LAS unsigned* st;
};

__device__ __forceinline__ XcdBarrier xcd_barrier_post(unsigned* bar, volatile LAS unsigned* st) {
    XcdBarrier b; b.bar = bar; b.x = xb_xcc_id(); b.st = st;
    if (threadIdx.x == 0) (void)xb_add(&bar[XB_XCNT(b.x)], 1u);
    return b;
}
__device__ __forceinline__ void xcd_barrier_complete(unsigned* bar, unsigned x, unsigned& nloc, unsigned& nx) {
    const unsigned G = gridDim.x * gridDim.y * gridDim.z;
    unsigned sum, cnt, mine, sp = 0u;
    for (;;) {
        sum = 0u; cnt = 0u; mine = 0u;
#pragma unroll
        for (unsigned j = 0; j < 16; ++j) { const unsigned c = xb_ld(&bar[XB_XCNT(j)]); sum += c; cnt += (c > 0u) ? 1u : 0u; mine = (j == x) ? c : mine; }
        if (sum == G) break;
        __builtin_amdgcn_s_sleep(1);
        if ((++sp & 255u) == 0u) { if (xb_ld(&bar[XB_TMO])) break; if (sp > XB_SPIN_CAP) { atomicAdd(&bar[XB_TMO], 1u); break; } }
    }
    nloc = mine > 0u ? mine : 1u; nx = cnt > 0u ? cnt : 1u;
}

__device__ __forceinline__ void xcd_barrier(const XcdBarrier& b) {
    asm volatile("s_waitcnt vmcnt(0)" ::: "memory");
    __syncthreads();
    if (threadIdx.x == 0) {
        unsigned* bar = b.bar;
        __builtin_amdgcn_s_waitcnt(0);
        unsigned nloc = b.st[0], nx = b.st[1];
        if (nloc == 0u) { xcd_barrier_complete(bar, b.x, nloc, nx); b.st[0] = nloc; b.st[1] = nx; }
        const unsigned old = xb_add(&bar[XB_XSUB(b.x)], 1u);
        const unsigned gen = old / nloc;
        if (old + 1u == (gen + 1u) * nloc) {
            __builtin_amdgcn_fence(__ATOMIC_RELEASE, "agent");
            asm volatile("s_waitcnt vmcnt(0)" ::: "memory");
            const unsigned og = xb_add(&bar[XB_TOP], 1u);
            const unsigned tg = og / nx;
            if (og + 1u == (tg + 1u) * nx) xb_add(&bar[XB_TOPGEN], 1u);
            else XB_SPIN(xb_ld(&bar[XB_TOPGEN]) == tg, bar);
            __builtin_amdgcn_fence(__ATOMIC_ACQUIRE, "agent");
            xb_add(&bar[XB_XGEN(b.x)], 1u);
            asm volatile("s_waitcnt vmcnt(0)" ::: "memory");
        } else {
            XB_SPIN(xb_ld(&bar[XB_XGEN(b.x)]) == gen, bar);
            __builtin_amdgcn_fence(__ATOMIC_ACQUIRE, "agent");
            asm volatile("s_waitcnt vmcnt(0)" ::: "memory");
        }
    }
    __syncthreads();
}

#ifndef PROBE_DUP
#define PROBE_DUP 0
#endif
struct ListOrder {
    int nM, nN, nwg, pm_off, L0, dL, n, extraL;
    __device__ __forceinline__ void init(int Mrows, int N, int pm_off_) { nM = Mrows / 256; nN = N / 256; nwg = nM * nN; pm_off = pm_off_; }
    __device__ __forceinline__ bool next(int i, pg8::Unit& u) const {
        int L; if (i < n) L = L0 + i * dL; else if (i == n && extraL >= 0) L = extraL; else return false;
        if (L >= nwg) return false;
        int wgid = L; { const int q = nwg / 8, r = nwg % 8, xcd = wgid % 8, off = wgid / 8; wgid = (xcd < r ? xcd * (q + 1) : r * (q + 1) + (xcd - r) * q) + off; }
        const int nig = 8 * nN, gid = wgid / nig, fm = gid * 8, gsz = (nM - fm) < 8 ? (nM - fm) : 8;
        u.pm = fm + ((wgid % nig) % gsz) + pm_off; u.pn = (wgid % nig) / gsz; return true;
    }
    __device__ __forceinline__ void a_ready(const pg8::Unit&) const {}
    __device__ __forceinline__ void done(const pg8::Unit&) const {}
};
__device__ __forceinline__ void flag_signal(unsigned* f, int tid) {
    asm volatile("s_waitcnt vmcnt(0)" ::: "memory");
    __syncthreads();
    if (tid == 0) { __builtin_amdgcn_fence(__ATOMIC_RELEASE, "agent"); asm volatile("s_waitcnt vmcnt(0)" ::: "memory"); (void)xb_add(f, 1u); }
}
__device__ __forceinline__ void flag_wait(unsigned* f, unsigned n, int tid) {
    if (tid == 0) { unsigned sp = 0u; while (xb_ld(f) < n) { __builtin_amdgcn_s_sleep(4); if (++sp > (1u << 16)) break; }
        __builtin_amdgcn_fence(__ATOMIC_ACQUIRE, "agent"); asm volatile("s_waitcnt vmcnt(0)" ::: "memory"); }
    __syncthreads();
}
enum { K_NONE = 0, K_RETIN, K_RES, K_SWIGLU, K_SWAIN };
constexpr int NSTEPS = 21;
__global__ void __launch_bounds__(NTHR) hybrid_fwd(Params p) {
    extern __shared__ __attribute__((aligned(16))) unsigned char lds_raw[];
    LAS unsigned char* lds = (LAS unsigned char*)lds_raw;
    cg::grid_group grid = cg::this_grid();
    const int tid = threadIdx.x, lane = tid & 63, wave = __builtin_amdgcn_readfirstlane(tid >> 6);
    const int G = gridDim.x, c = blockIdx.x, vcu = (c % 8) * (G / 8) + c / 8;
    unsigned char* ws = p.ws; float* out = p.out;
    bf16* XB = (bf16*)(ws + WS_XB); bf16* BIG = (bf16*)(ws + WS_BIG); bf16* OB = (bf16*)(ws + WS_OB);
    float* ss = (float*)(ws + WS_SS); float* sso = (float*)(ws + WS_SSO);
    unsigned* ctl = (unsigned*)(ws + WS_CTL);
    unsigned* F1 = ctl + 4096; unsigned* F3 = ctl + 4096 + 64; unsigned* F4 = ctl + 4096 + 128; unsigned* F5 = ctl + 4096 + 192;
    volatile LAS unsigned* bst = (volatile LAS unsigned*)(lds + LDS_BYTES - 64);
    if (tid < 2) bst[tid] = 0u;
    __syncthreads();
    XcdBarrier bar = xcd_barrier_post(ctl, bst);
    const bool hi8 = (c >= 248), mid44 = (c >= 144 && c < 188);
    float* outS = out + (size_t)NP * DM;
#define GEMM_RES(Aptr, Wptr, Kc, E_)   do { pg8::Gemm g_{Aptr, (const bf16*)(ws + Wptr), MT, 1024, Kc}; pg8::gemm_phase<pg8::EpiRes, ListOrder, true, true>(lds, g_, S, E_); } while (0)
#define GEMM_SWIGLU(Wptr, ssp)         do { pg8::Gemm g_{XB, (const bf16*)(ws + Wptr), MT, 5632, 1024}; pg8::EpiSwiglu E_{BIG, ssp}; pg8::gemm_phase<pg8::EpiSwiglu, ListOrder, true, true>(lds, g_, S, E_); } while (0)
#define GEMM_SWAIN()                   do { pg8::Gemm g_{XB, (const bf16*)(ws + WS_WSI), MT, 1536, 1024}; \
        pg8::EpiSwaIn E_{BIG, ss + 2 * MT, (const float*)(ws + WS_TSC), (const float*)(ws + WS_TSS), p.in[11], p.in[12], out + OUT_KP, out + OUT_VP, out + OUT_KS, out + OUT_VS}; \
        pg8::gemm_phase<pg8::EpiSwaIn, ListOrder, true, true>(lds, g_, S, E_); } while (0)
    const int lo_ = p.ph_lo, hi_ = p.ph_hi;
#if defined(PROBE_T)
    unsigned long long pt0 = 0, pt1 = 0;
#endif
#define IN(k) (lo_ <= (k) && (k) < hi_)
#define SEAM(k, kind) do { if (IN((k) + 1)) { if ((kind) == 2 && G != 256) grid.sync(); else if ((kind) >= 1) xcd_barrier(bar); } } while (0)
#if defined(PROBE_T)
    if (PROBE_T == 0 && c == 0 && tid == 0) pt0 = __builtin_amdgcn_s_memrealtime();
#endif
    if (IN(0)) { ListOrder S; S.init(NP, 1024, 0); S.L0 = c; S.dL = 256; S.n = 0; S.extraL = -1;
       p0_prologue(p, lds, tid, lane, wave, vcu, G, 0, 0, 0);
#if PROBE_DUP & 1
            __syncthreads(); p0_prologue(p, lds, tid, lane, wave, vcu, G, 0, 0, 0);
#endif
        SEAM(0, 2); }
#if defined(PROBE_T)
    if (PROBE_T == 0 && c == 0 && tid == 0) pt1 = __builtin_amdgcn_s_memrealtime();
#endif
#if defined(PROBE_T)
    if (PROBE_T == 1 && c == 0 && tid == 0) pt0 = __builtin_amdgcn_s_memrealtime();
#endif
    if (IN(1)) { ListOrder S; S.init(NP, 1024, 0); S.L0 = c; S.dL = 256; S.n = 0; S.extraL = -1;
       { pg8::Gemm g_{XB, (const bf16*)(ws + WS_WRI), MT, 6144, 1024};
                  pg8::EpiRetIn E_{BIG, ss, (const float*)(ws + WS_TRC), (const float*)(ws + WS_TRS)};
                  if (c >= 208) { S.init(NS, 6144, 64); S.L0 = c - 208; S.n = 1; pg8::gemm_phase<pg8::EpiRetIn, ListOrder, true, true>(lds, g_, S, E_); }
                  else { p0_prologue(p, lds, tid, lane, wave, vcu, G, 1, c, 208); __syncthreads(); }
                  S.init(NP, 6144, 0); S.L0 = c; S.n = 6;
                  pg8::gemm_phase<pg8::EpiRetIn, ListOrder, true, true>(lds, g_, S, E_); }
        SEAM(1, 1); }
#if defined(PROBE_T)
    if (PROBE_T == 1 && c == 0 && tid == 0) pt1 = __builtin_amdgcn_s_memrealtime();
#endif
#if defined(PROBE_T)
    if (PROBE_T == 2 && c == 0 && tid == 0) pt0 = __builtin_amdgcn_s_memrealtime();
#endif
    if (IN(2)) { ListOrder S; S.init(NP, 1024, 0); S.L0 = c; S.dL = 256; S.n = 0; S.extraL = -1;

#if defined(PROBE_T)
            if (PROBE_T == 102 && c == 0 && tid == 0) pt0 = __builtin_amdgcn_s_memrealtime();
#endif
            for (int u = vcu; u < 256; u += G) ret_prompt_unit(lds, BIG, OB, (float*)(ws + WS_SSOP), out + OUT_SP, u >> 3, u & 7, p.lg2[(u >> 3) & 3], tid);
            __syncthreads();
#if defined(PROBE_T)
            if (PROBE_T == 102 && c == 0 && tid == 0) pt1 = __builtin_amdgcn_s_memrealtime();
            if (PROBE_T == 103 && c == 0 && tid == 0) pt0 = __builtin_amdgcn_s_memrealtime();
#endif
            for (int u = vcu; u < 512; u += G) ret_sample_unit(lds, BIG, OB, p.in[2], out + OUT_SS, u, p.lg2[u & 3], tid);
#if defined(PROBE_T)
            if (PROBE_T == 103 && c == 0 && tid == 0) pt1 = __builtin_amdgcn_s_memrealtime();
#endif


        SEAM(2, 1); }
#if defined(PROBE_T)
    if (PROBE_T == 2 && c == 0 && tid == 0) pt1 = __builtin_amdgcn_s_memrealtime();
#endif
#if defined(PROBE_T)
    if (PROBE_T == 3 && c == 0 && tid == 0) pt0 = __builtin_amdgcn_s_memrealtime();
#endif
    if (IN(3)) { ListOrder S; S.init(NP, 1024, 0); S.L0 = c; S.dL = 256; S.n = 0; S.extraL = -1;
        SEAM(3, 0); }
#if defined(PROBE_T)
    if (PROBE_T == 3 && c == 0 && tid == 0) pt1 = __builtin_amdgcn_s_memrealtime();
#endif
#if defined(PROBE_T)
    if (PROBE_T == 4 && c == 0 && tid == 0) pt0 = __builtin_amdgcn_s_memrealtime();
#endif
    if (IN(4)) { ListOrder S; S.init(NP, 1024, 0); S.L0 = c; S.dL = 256; S.n = 0; S.extraL = -1;
       { S.n = 1; LAS float* HT = (LAS float*)(lds + 131072); LAS float* HS4 = HT + 1024;
         { pg8::Unit u0; S.next(0, u0); const float* pp = (const float*)(ws + WS_SSOP) + ((size_t)(u0.pm * 256 + (tid >> 1)) * 4 + (tid & 1) * 2) * 16;
#pragma unroll
           for (int hh = 0; hh < 2; ++hh) { const f32x4* q4 = (const f32x4*)(pp + hh * 16); const f32x4 a = (q4[0] + q4[1]) + (q4[2] + q4[3]);
               HS4[(tid >> 1) * 4 + (tid & 1) * 2 + hh] = __builtin_amdgcn_rsqf(((a[0] + a[1]) + (a[2] + a[3])) * (1.0f / 512.0f) + EPS); }
           __syncthreads();
           if (tid < 256) { const f32x4 s4 = *(const LAS f32x4*)(HS4 + tid * 4); *(LAS f32x4*)(HT + tid * 4) = (f32x4){s4[0] / s4[1], s4[1] / s4[2], s4[2] / s4[3], s4[3]}; }
           __syncthreads(); }
         pg8::EpiRes E_{XB, nullptr, ss + MT, HT}; pg8::Gemm g_{OB, (const bf16*)(ws + WS_WRO), MT, 1024, 2048};
         pg8::gemm_phase<pg8::EpiRes, ListOrder, true, true, true>(lds, g_, S, E_, HT); }
        SEAM(4, 1); }
#if defined(PROBE_T)
    if (PROBE_T == 4 && c == 0 && tid == 0) pt1 = __builtin_amdgcn_s_memrealtime();
#endif
#if defined(PROBE_T)
    if (PROBE_T == 5 && c == 0 && tid == 0) pt0 = __builtin_amdgcn_s_memrealtime();
#endif
    if (IN(5)) { ListOrder S; S.init(NP, 1024, 0); S.L0 = c; S.dL = 256; S.n = 0; S.extraL = -1;
       { S.init(NS, 1024, 64); S.L0 = c - 248; S.n = hi8 ? 1 : 0; pg8::EpiRes E_{XB, nullptr, ss + MT, nullptr}; GEMM_RES(OB, WS_WRO, 2048, E_); if (hi8) flag_signal(F1, tid); }
        SEAM(5, 0); }
#if defined(PROBE_T)
    if (PROBE_T == 5 && c == 0 && tid == 0) pt1 = __builtin_amdgcn_s_memrealtime();
#endif
#if defined(PROBE_T)
    if (PROBE_T == 6 && c == 0 && tid == 0) pt0 = __builtin_amdgcn_s_memrealtime();
#endif
    if (IN(6)) { ListOrder S; S.init(NP, 1024, 0); S.L0 = c; S.dL = 256; S.n = 0; S.extraL = -1;
       { S.init(NP, 5632, 0);
                  if (hi8) S.n = 3; else if (c >= 128 && c < 144) { S.n = 5; S.extraL = (3 + (c - 128) / 8) * 256 + 248 + (c - 128) % 8; } else S.n = (c < 128) ? 6 : 5;
                  GEMM_SWIGLU(WS_WFI0, ss + MT); }
        SEAM(6, 0); }
#if defined(PROBE_T)
    if (PROBE_T == 6 && c == 0 && tid == 0) pt1 = __builtin_amdgcn_s_memrealtime();
#endif
#if defined(PROBE_T)
    if (PROBE_T == 7 && c == 0 && tid == 0) pt0 = __builtin_amdgcn_s_memrealtime();
#endif
    if (IN(7)) { ListOrder S; S.init(NP, 1024, 0); S.L0 = c; S.dL = 256; S.n = 0; S.extraL = -1;
       { S.init(NS, 5632, 64); S.L0 = c - 144; S.n = mid44 ? 1 : 0; if (mid44) flag_wait(F1, 8u, tid); GEMM_SWIGLU(WS_WFI0, ss + MT); }
        SEAM(7, 1); }
#if defined(PROBE_T)
    if (PROBE_T == 7 && c == 0 && tid == 0) pt1 = __builtin_amdgcn_s_memrealtime();
#endif
#if defined(PROBE_T)
    if (PROBE_T == 8 && c == 0 && tid == 0) pt0 = __builtin_amdgcn_s_memrealtime();
#endif
    if (IN(8)) { ListOrder S; S.init(NP, 1024, 0); S.L0 = c; S.dL = 256; S.n = 0; S.extraL = -1;
       { S.n = 1; pg8::EpiRes E_{XB, nullptr, ss + 2 * MT, nullptr}; GEMM_RES(BIG, WS_WFO0, 2816, E_); }
        SEAM(8, 1); }
#if defined(PROBE_T)
    if (PROBE_T == 8 && c == 0 && tid == 0) pt1 = __builtin_amdgcn_s_memrealtime();
#endif
#if defined(PROBE_T)
    if (PROBE_T == 9 && c == 0 && tid == 0) pt0 = __builtin_amdgcn_s_memrealtime();
#endif
    if (IN(9)) { ListOrder S; S.init(NP, 1024, 0); S.L0 = c; S.dL = 256; S.n = 0; S.extraL = -1;
       { S.init(NS, 1024, 64); S.L0 = c - 248; S.n = hi8 ? 1 : 0; pg8::EpiRes E_{XB, nullptr, ss + 2 * MT, nullptr}; GEMM_RES(BIG, WS_WFO0, 2816, E_); }
        SEAM(9, 0); }
#if defined(PROBE_T)
    if (PROBE_T == 9 && c == 0 && tid == 0) pt1 = __builtin_amdgcn_s_memrealtime();
#endif
#if defined(PROBE_T)
    if (PROBE_T == 10 && c == 0 && tid == 0) pt0 = __builtin_amdgcn_s_memrealtime();
#endif
    if (IN(10)) { ListOrder S; S.init(NP, 1024, 0); S.L0 = c; S.dL = 256; S.n = 0; S.extraL = -1;
       { S.init(NP, 1536, 0);
                   if (hi8) S.n = 0; else if (c < 128) S.n = 2; else { S.n = 1; if (c < 136) S.extraL = 248 + (c - 128); }
                   GEMM_SWAIN(); }
        SEAM(10, 1); }
#if defined(PROBE_T)
    if (PROBE_T == 10 && c == 0 && tid == 0) pt1 = __builtin_amdgcn_s_memrealtime();
#endif
#if defined(PROBE_T)
    if (PROBE_T == 11 && c == 0 && tid == 0) pt0 = __builtin_amdgcn_s_memrealtime();
#endif
    if (IN(11)) { ListOrder S; S.init(NP, 1024, 0); S.L0 = c; S.dL = 256; S.n = 0; S.extraL = -1;
       { const bool m12 = (c >= 236 && c < 248); S.init(NS, 1536, 64); S.L0 = c - 236; S.n = m12 ? 1 : 0; GEMM_SWAIN(); if (m12) flag_signal(F3, tid); }
        SEAM(11, 0); }
#if defined(PROBE_T)
    if (PROBE_T == 11 && c == 0 && tid == 0) pt1 = __builtin_amdgcn_s_memrealtime();
#endif
#if defined(PROBE_T)
    if (PROBE_T == 12 && c == 0 && tid == 0) pt0 = __builtin_amdgcn_s_memrealtime();
#endif
    if (IN(12)) { ListOrder S; S.init(NP, 1024, 0); S.L0 = c; S.dL = 256; S.n = 0; S.extraL = -1;
       for (int u = vcu; u < 512; u += G) attn_prompt_unit(lds, BIG, OB, p.in[13], u, tid);
        SEAM(12, 0); }
#if defined(PROBE_T)
    if (PROBE_T == 12 && c == 0 && tid == 0) pt1 = __builtin_amdgcn_s_memrealtime();
#endif
#if defined(PROBE_T)
    if (PROBE_T == 13 && c == 0 && tid == 0) pt0 = __builtin_amdgcn_s_memrealtime();
#endif
    if (IN(13)) { ListOrder S; S.init(NP, 1024, 0); S.L0 = c; S.dL = 256; S.n = 0; S.extraL = -1;
       flag_wait(F3, 12u, tid);
                 if (!(c >= 236 && c < 248)) {
                     attn_sample_pair(lds, BIG, OB, p.in[13], p.in[3], p.in[4], out + OUT_KS, out + OUT_VS, vcu, vcu + 256, tid);
                     if (c < 12) { const int c2 = 236 + c, v2 = (c2 % 8) * (G / 8) + c2 / 8; attn_sample_pair(lds, BIG, OB, p.in[13], p.in[3], p.in[4], out + OUT_KS, out + OUT_VS, v2, v2 + 256, tid); } }
        SEAM(13, 1); }
#if defined(PROBE_T)
    if (PROBE_T == 13 && c == 0 && tid == 0) pt1 = __builtin_amdgcn_s_memrealtime();
#endif
#if defined(PROBE_T)
    if (PROBE_T == 14 && c == 0 && tid == 0) pt0 = __builtin_amdgcn_s_memrealtime();
#endif
    if (IN(14)) { ListOrder S; S.init(NP, 1024, 0); S.L0 = c; S.dL = 256; S.n = 0; S.extraL = -1;
       { S.n = 1; pg8::EpiRes E_{XB, nullptr, ss + 3 * MT, nullptr}; GEMM_RES(OB, WS_WSO, 1024, E_); }
        SEAM(14, 1); }
#if defined(PROBE_T)
    if (PROBE_T == 14 && c == 0 && tid == 0) pt1 = __builtin_amdgcn_s_memrealtime();
#endif
#if defined(PROBE_T)
    if (PROBE_T == 15 && c == 0 && tid == 0) pt0 = __builtin_amdgcn_s_memrealtime();
#endif
    if (IN(15)) { ListOrder S; S.init(NP, 1024, 0); S.L0 = c; S.dL = 256; S.n = 0; S.extraL = -1;
       { S.init(NS, 1024, 64); S.L0 = c - 248; S.n = hi8 ? 1 : 0; pg8::EpiRes E_{XB, nullptr, ss + 3 * MT, nullptr}; GEMM_RES(OB, WS_WSO, 1024, E_); if (hi8) flag_signal(F4, tid); }
        SEAM(15, 0); }
#if defined(PROBE_T)
    if (PROBE_T == 15 && c == 0 && tid == 0) pt1 = __builtin_amdgcn_s_memrealtime();
#endif
#if defined(PROBE_T)
    if (PROBE_T == 16 && c == 0 && tid == 0) pt0 = __builtin_amdgcn_s_memrealtime();
#endif
    if (IN(16)) { ListOrder S; S.init(NP, 1024, 0); S.L0 = c; S.dL = 256; S.n = 0; S.extraL = -1;
       { S.init(NP, 5632, 0);
                   if (hi8 || mid44) S.n = 1; else if (c < 128) S.n = 6; else { S.n = 5; int j = -1; if (c < 144) j = c - 128; else if (c >= 188 && c < 204) j = 16 + (c - 188); if (j >= 0) S.extraL = (1 + j / 8) * 256 + 248 + j % 8; }
                   GEMM_SWIGLU(WS_WFI1, ss + 3 * MT); }
        SEAM(16, 0); }
#if defined(PROBE_T)
    if (PROBE_T == 16 && c == 0 && tid == 0) pt1 = __builtin_amdgcn_s_memrealtime();
#endif
#if defined(PROBE_T)
    if (PROBE_T == 17 && c == 0 && tid == 0) pt0 = __builtin_amdgcn_s_memrealtime();
#endif
    if (IN(17)) { ListOrder S; S.init(NP, 1024, 0); S.L0 = c; S.dL = 256; S.n = 0; S.extraL = -1;
       { S.init(NS, 5632, 64); S.L0 = c - 144; S.n = mid44 ? 1 : 0; if (mid44) flag_wait(F4, 8u, tid); GEMM_SWIGLU(WS_WFI1, ss + 3 * MT); if (mid44) flag_signal(F5, tid); }
        SEAM(17, 0); }
#if defined(PROBE_T)
    if (PROBE_T == 17 && c == 0 && tid == 0) pt1 = __builtin_amdgcn_s_memrealtime();
#endif
#if defined(PROBE_T)
    if (PROBE_T == 18 && c == 0 && tid == 0) pt0 = __builtin_amdgcn_s_memrealtime();
#endif
    if (IN(18)) { ListOrder S; S.init(NP, 1024, 0); S.L0 = c; S.dL = 256; S.n = 0; S.extraL = -1;
       { S.init(NS, 1024, 64); S.L0 = c - 248; S.n = hi8 ? 1 : 0; if (hi8) flag_wait(F5, 44u, tid); pg8::EpiRes E_{XB, out, nullptr, nullptr}; GEMM_RES(BIG, WS_WFO1, 2816, E_); }
        SEAM(18, 0); }
#if defined(PROBE_T)
    if (PROBE_T == 18 && c == 0 && tid == 0) pt1 = __builtin_amdgcn_s_memrealtime();
#endif
#if defined(PROBE_T)
    if (PROBE_T == 19 && c == 0 && tid == 0) pt0 = __builtin_amdgcn_s_memrealtime();
#endif
    if (IN(19)) { ListOrder S; S.init(NP, 1024, 0); S.L0 = c; S.dL = 256; S.n = 0; S.extraL = -1;
       { S.init(NP, 5632, 0); S.L0 = 256 + c; S.n = mid44 ? 4 : 0; GEMM_SWIGLU(WS_WFI1, ss + 3 * MT); }
        SEAM(19, 1); }
#if defined(PROBE_T)
    if (PROBE_T == 19 && c == 0 && tid == 0) pt1 = __builtin_amdgcn_s_memrealtime();
#endif
#if defined(PROBE_T)
    if (PROBE_T == 20 && c == 0 && tid == 0) pt0 = __builtin_amdgcn_s_memrealtime();
#endif
    if (IN(20)) { ListOrder S; S.init(NP, 1024, 0); S.L0 = c; S.dL = 256; S.n = 0; S.extraL = -1;
       { S.n = 1; pg8::EpiRes E_{XB, out, nullptr, nullptr}; GEMM_RES(BIG, WS_WFO1, 2816, E_); }
        SEAM(20, 0); }
#if defined(PROBE_T)
    if (PROBE_T == 20 && c == 0 && tid == 0) pt1 = __builtin_amdgcn_s_memrealtime();
#endif
#undef IN
#undef SEAM
#if defined(PROBE_T)
    if (c == 0 && tid == 0) { const unsigned long long te = __builtin_amdgcn_s_memrealtime(), d = (pt1 - pt0) * 4ull; while (__builtin_amdgcn_s_memrealtime() - te < d) __builtin_amdgcn_s_sleep(8); }
#endif
}

#ifndef N_LAUNCHES
#define N_LAUNCHES 1
#endif
extern "C" void kernel_launch(void* const* d_in, const int* in_sizes, int n_in, void* d_out, int out_size, void* d_ws, size_t ws_size, hipStream_t stream) {
    static int grid = 0;
    if (grid == 0) {
        if (n_in != 16 || (size_t)out_size != OUT_END || ws_size < WS_TOTAL) { fprintf(stderr, "kernel_launch: unexpected shapes (n_in %d out %d ws %zu need %zu)\n", n_in, out_size, ws_size, (size_t)WS_TOTAL); grid = -1; return; }
        int dev = 0, cus = 0, per_cu = 0;
        (void)hipGetDevice(&dev); (void)hipDeviceGetAttribute(&cus, hipDeviceAttributeMultiprocessorCount, dev);
        if (hipFuncSetAttribute((const void*)hybrid_fwd, hipFuncAttributeMaxDynamicSharedMemorySize, LDS_BYTES) != hipSuccess) { fprintf(stderr, "kernel_launch: hipFuncSetAttribute failed\n"); grid = -1; return; }
        if (hipOccupancyMaxActiveBlocksPerMultiprocessor(&per_cu, (const void*)hybrid_fwd, NTHR, LDS_BYTES) != hipSuccess || per_cu < 1) { fprintf(stderr, "kernel_launch: occupancy query says %d\n", per_cu); per_cu = 1; }
        (void)hipGetLastError();
        grid = cus * 1;
        if (grid != 256) { fprintf(stderr, "kernel_launch: built for a 256-CU device (got %d)\n", cus); grid = -1; return; }
    }
    if (grid < 0) return;
    if (hipMemsetAsync((char*)d_ws + WS_CTL, 0, CTL_BYTES, stream) != hipSuccess) { fprintf(stderr, "kernel_launch: memset failed\n"); return; }
    Params p; memset(&p, 0, sizeof(p));
    for (int i = 0; i < 16; ++i) p.in[i] = (const float*)d_in[i];
    p.out = (float*)d_out; p.ws = (unsigned char*)d_ws;
    const double two_pi = 6.283185307179586476925286766559;
    for (int i = 0; i < 128; ++i) p.invR[i] = 1.0 / std::pow(10000.0, (double)i / 127.0) / two_pi;
    for (int i = 0; i < 32; ++i) p.invS[i] = 1.0 / std::pow(10000.0, (double)(2 * i) / 64.0) / two_pi;
    for (int h = 0; h < 4; ++h) p.lg2[h] = (float)std::log2(1.0 - std::ldexp(1.0, -5 - h));
#if N_LAUNCHES == 1
    p.ph_lo = 0; p.ph_hi = NSTEPS;
    void* args[] = {&p};
    hipError_t e = hipLaunchCooperativeKernel((const void*)hybrid_fwd, dim3(grid), dim3(NTHR), args, LDS_BYTES, stream);
    if (e != hipSuccess) fprintf(stderr, "kernel_launch: cooperative launch failed: %s (grid %d)\n", hipGetErrorString(e), grid);
#else
    for (int ph = 0; ph < NSTEPS; ++ph) { p.ph_lo = ph; p.ph_hi = ph + 1; hipLaunchKernelGGL(hybrid_fwd, dim3(grid), dim3(NTHR), LDS_BYTES, stream, p); }
#endif
}
```

```cpp
#include <hip/hip_runtime.h>
#include <hip/hip_cooperative_groups.h>
#include <cstdio>
#include <cstdint>
#include <cmath>
#include <cstring>
namespace cg = cooperative_groups;
namespace pg8 {
#define PG8_LAS __attribute__((address_space(3)))
typedef unsigned short bf16_t;
typedef short bf16x8 __attribute__((ext_vector_type(8)));
typedef float f32x4 __attribute__((ext_vector_type(4)));
typedef unsigned u32x4 __attribute__((ext_vector_type(4)));
constexpr int BM = 256, BK = 64, HALF = 128, HTB = HALF * BK * 2  , STAGE_BYTES = 8 * HTB, NXCD = 8, WGM = 8;

__host__ __device__ __forceinline__ int lds_byte(int r, int c) { const int st = (r >> 4) * 2 + (c >> 5), rr = r & 15, cc = c & 31, ob = rr * 64 + cc * 2; return st * 1024 + (ob ^ (((ob >> 9) & 1) << 5)); }
__host__ __device__ __forceinline__ void stage_rc(int b, int& R, int& C) { const int st = b / 1024, sb = b % 1024, swz = sb ^ (((sb >> 9) & 1) << 5); R = (st >> 1) * 16 + swz / 64; C = (st & 1) * 32 + (swz % 64) / 2; }
__host__ __device__ __forceinline__ int perm32(int rho) { const int n = rho >> 4, i = rho & 15; return 8 * (i >> 2) + 4 * n + (i & 3); }

struct Unit { int pm, pn; };
struct Gemm { const bf16_t* A; const bf16_t* Bt; int M, N, K; };

struct StaticOrder {
    int nM, nN, nwg, G, c;
    __host__ __device__ void init(int M, int N, int G_, int c_) { nM = M / BM; nN = N / BM; nwg = nM * nN; G = G_; c = c_; }
    __host__ __device__ bool next(int i, Unit& u) const {
        const long L = (long)i * G + c; if (L >= nwg) return false;
        int wgid = (int)L; { const int q = nwg / NXCD, r = nwg % NXCD, xcd = wgid % NXCD, off = wgid / NXCD; wgid = (xcd < r ? xcd * (q + 1) : r * (q + 1) + (xcd - r) * q) + off; }
        const int nig = WGM * nN, gid = wgid / nig, fm = gid * WGM, gsz = (nM - fm) < WGM ? (nM - fm) : WGM;
        u.pm = fm + ((wgid % nig) % gsz); u.pn = (wgid % nig) / gsz; return true;
    }
    __device__ __forceinline__ void a_ready(const Unit&) const {}
    __device__ __forceinline__ void done(const Unit&) const {}
};

__device__ __forceinline__ unsigned cvt_pk_bf16(float lo, float hi) { unsigned r; asm volatile("v_cvt_pk_bf16_f32 %0, %1, %2" : "=v"(r) : "v"(lo), "v"(hi)); return r; }
typedef float f32x2 __attribute__((ext_vector_type(2)));
constexpr int P_NP = 16384, P_D = 1024, P_MT = 16896;
constexpr float P_EPS = 1e-6f;
__device__ __forceinline__ float silu_f(float x) { return x * __builtin_amdgcn_rcpf(1.0f + __expf(-x)); }
__device__ __forceinline__ float row_rstd(const float* ssp, int row) {
    const f32x4* pp = (const f32x4*)(ssp + (size_t)row * 16); const f32x4 a = (pp[0] + pp[1]) + (pp[2] + pp[3]);
    return __builtin_amdgcn_rsqf(((a[0] + a[1]) + (a[2] + a[3])) * (1.0f / 1024.0f) + P_EPS);
}
__device__ __forceinline__ int pos_index(int row) { return row < P_NP ? (row & 2047) : 2048 + (row & 3); }
__device__ __forceinline__ u32x4 pack8(const f32x4 a, const f32x4 b) { u32x4 w; w.x = cvt_pk_bf16(a[0], a[1]); w.y = cvt_pk_bf16(a[2], a[3]); w.z = cvt_pk_bf16(b[0], b[1]); w.w = cvt_pk_bf16(b[2], b[3]); return w; }

struct EpiRetIn {
    static constexpr bool PERM = true, AFTER_DRAIN = false;
    bf16_t* O; const float* ss; const float* cosT; const float* sinT;
    __device__ __forceinline__ void operator()(const f32x4 (&acc)[2][2][4][2], const Unit& u, int wr, int wc, int fr, int fq) const {
        const int pn = u.pn, ci = wc * 32 + 8 * fq;
#pragma unroll
        for (int ai = 0; ai < 2; ++ai)
#pragma unroll
            for (int m = 0; m < 4; ++m) {
                const int row = u.pm * BM + ai * HALF + wr * 64 + m * 16 + fr;
                const float rstd = __builtin_amdgcn_rsqf(ss[row] * (1.0f / 1024.0f) + P_EPS);
                bf16_t* rowp;
                if (pn < 8) rowp = O + ((size_t)pn * P_MT + row) * 256 + ci;
                else { const int q_ = pn - 8; rowp = O + (size_t)8 * P_MT * 256 + ((size_t)(q_ >> 1) * P_MT + row) * 512 + (q_ & 1) * 256 + ci; }
                if (pn < 8) {
                    const int pidx = pos_index(row);
                    const f32x4* cp = (const f32x4*)(cosT + pidx * 128 + ci); const f32x4* sp = (const f32x4*)(sinT + pidx * 128 + ci);
                    const float sc = (pn >= 4) ? rstd * 0.0625f : rstd;
                    f32x4 o1[2], o2[2];
#pragma unroll
                    for (int n = 0; n < 2; ++n) { const f32x4 c = cp[n], s = sp[n]; const f32x4 x1 = acc[ai][0][m][n] * sc, x2 = acc[ai][1][m][n] * sc; o1[n] = x1 * c - x2 * s; o2[n] = x2 * c + x1 * s; }
                    *(u32x4*)(rowp) = pack8(o1[0], o1[1]); *(u32x4*)(rowp + HALF) = pack8(o2[0], o2[1]);
                } else if (pn < 16) {
#pragma unroll
                    for (int bj = 0; bj < 2; ++bj) *(u32x4*)(rowp + bj * HALF) = pack8(acc[ai][bj][m][0] * rstd, acc[ai][bj][m][1] * rstd);
                } else {
#pragma unroll
                    for (int bj = 0; bj < 2; ++bj) { f32x4 a = acc[ai][bj][m][0] * rstd, b = acc[ai][bj][m][1] * rstd;
#pragma unroll
                        for (int j = 0; j < 4; ++j) { a[j] = silu_f(a[j]); b[j] = silu_f(b[j]); }
                        *(u32x4*)(rowp + bj * HALF) = pack8(a, b); }
                }
            }
    }
};
struct EpiRes {
    static constexpr bool PERM = true, AFTER_DRAIN = false;
    bf16_t* xb; float* outF; float* ssn; const PG8_LAS float* hs;
    __device__ __forceinline__ void operator()(const f32x4 (&acc)[2][2][4][2], const Unit& u, int wr, int wc, int fr, int fq) const {
        const int col0 = u.pn * BM + wc * 32 + 8 * fq;
#pragma unroll
        for (int ai = 0; ai < 2; ++ai)
#pragma unroll
            for (int m = 0; m < 4; ++m) {
                const int row = u.pm * BM + ai * HALF + wr * 64 + m * 16 + fr;
                bf16_t* xp = xb + (size_t)row * P_D + col0; float s = 0.f;
                const float hsc = hs ? hs[(ai * HALF + wr * 64 + m * 16 + fr) * 4 + 3] : 1.0f;
#pragma unroll
                for (int bj = 0; bj < 2; ++bj) {
                    const u32x4 rw = *(const u32x4*)(xp + bj * HALF);
                    const f32x4 r0 = (f32x4){__builtin_bit_cast(float, rw.x << 16), __builtin_bit_cast(float, rw.x & 0xffff0000u), __builtin_bit_cast(float, rw.y << 16), __builtin_bit_cast(float, rw.y & 0xffff0000u)};
                    const f32x4 r1 = (f32x4){__builtin_bit_cast(float, rw.z << 16), __builtin_bit_cast(float, rw.z & 0xffff0000u), __builtin_bit_cast(float, rw.w << 16), __builtin_bit_cast(float, rw.w & 0xffff0000u)};
                    const f32x4 v0 = r0 + acc[ai][bj][m][0] * hsc, v1 = r1 + acc[ai][bj][m][1] * hsc;
                    s += (v0[0] * v0[0] + v0[1] * v0[1]) + (v0[2] * v0[2] + v0[3] * v0[3]) + (v1[0] * v1[0] + v1[1] * v1[1]) + (v1[2] * v1[2] + v1[3] * v1[3]);
                    if (outF) { float* op = outF + (size_t)row * P_D + col0 + bj * HALF; *(f32x4*)(op) = v0; *(f32x4*)(op + 4) = v1; }
                    else *(u32x4*)(xp + bj * HALF) = pack8(v0, v1);
                }
                if (ssn) { s += __shfl_xor(s, 16); s += __shfl_xor(s, 32); if (fq == 0) atomicAdd(ssn + row, s); }
            }
    }
};
struct EpiSwiglu {
    static constexpr bool PERM = true, AFTER_DRAIN = false;
    bf16_t* H; const float* ss;
    __device__ __forceinline__ void operator()(const f32x4 (&acc)[2][2][4][2], const Unit& u, int wr, int wc, int fr, int fq) const {
        const int col0 = u.pn * HALF + wc * 32 + 8 * fq;
#pragma unroll
        for (int ai = 0; ai < 2; ++ai)
#pragma unroll
            for (int m = 0; m < 4; ++m) {
                const int row = u.pm * BM + ai * HALF + wr * 64 + m * 16 + fr;
                const float rstd = __builtin_amdgcn_rsqf(ss[row] * (1.0f / 1024.0f) + P_EPS);
                f32x4 h[2];
#pragma unroll
                for (int n = 0; n < 2; ++n) { const f32x4 g = acc[ai][0][m][n] * rstd, uu = acc[ai][1][m][n] * rstd;
#pragma unroll
                    for (int j = 0; j < 4; ++j) h[n][j] = silu_f(g[j]) * uu[j]; }
                *(u32x4*)(H + (size_t)row * 2816 + col0) = pack8(h[0], h[1]);
            }
    }
};
struct EpiSwaIn {
    static constexpr bool PERM = true, AFTER_DRAIN = false;
    bf16_t* O; const float* ss; const float* cosT; const float* sinT; const float* qg; const float* kg; float* kc_p; float* vc_p; float* kc_s; float* vc_s;
    __device__ __forceinline__ void operator()(const f32x4 (&acc)[2][2][4][2], const Unit& u, int wr, int wc, int fr, int fq) const {
        const int pn = u.pn;
        const float* G = (pn < 4) ? qg : kg;
        f32x4 g1[2], g2[2];
#pragma unroll
        for (int n = 0; n < 2; ++n) { g1[n] = *(const f32x4*)(G + 8 * fq + 4 * n); g2[n] = *(const f32x4*)(G + 32 + 8 * fq + 4 * n); }
        const int cbase = (pn < 4 ? (pn * 4 + wc) * 64 : (pn == 4 ? 1024 : 1280) + wc * 64) + 8 * fq;
#pragma unroll
        for (int ai = 0; ai < 2; ++ai)
#pragma unroll
            for (int m = 0; m < 4; ++m) {
                const int row = u.pm * BM + ai * HALF + wr * 64 + m * 16 + fr;
                const float rstd = __builtin_amdgcn_rsqf(ss[row] * (1.0f / 1024.0f) + P_EPS);
                bf16_t* rowp = O + (size_t)row * 1536 + cbase;
                float* cdst = nullptr;
                if (pn >= 4) {
                    float* cp_ = (pn == 4) ? kc_p : vc_p; float* cs_ = (pn == 4) ? kc_s : vc_s;
                    if (row < P_NP) { const int b = row >> 11, t = row & 2047; if (t >= 1920) cdst = cp_ + ((size_t)(b * 128 + (t - 1920)) * 4 + wc) * 64 + 8 * fq; }
                    else { const int s_ = row - P_NP, b = s_ >> 2, t = s_ & 3; cdst = cs_ + ((size_t)(b * 128 + 124 + t) * 4 + wc) * 64 + 8 * fq; }
                }
                f32x4 o1[2], o2[2];
                if (pn < 5) {
                    f32x4 x1[2], x2[2]; float q = 0.f;
#pragma unroll
                    for (int n = 0; n < 2; ++n) { x1[n] = acc[ai][0][m][n] * rstd; x2[n] = acc[ai][1][m][n] * rstd;
                        q += (x1[n][0] * x1[n][0] + x1[n][1] * x1[n][1]) + (x1[n][2] * x1[n][2] + x1[n][3] * x1[n][3]) + (x2[n][0] * x2[n][0] + x2[n][1] * x2[n][1]) + (x2[n][2] * x2[n][2] + x2[n][3] * x2[n][3]); }
                    q += __shfl_xor(q, 16); q += __shfl_xor(q, 32);
                    const float hr = __builtin_amdgcn_rsqf(q * (1.0f / 64.0f) + P_EPS);
                    const int pidx = pos_index(row);
                    const f32x4* cp = (const f32x4*)(cosT + pidx * 32 + 8 * fq); const f32x4* sp = (const f32x4*)(sinT + pidx * 32 + 8 * fq);
                    const float osc = (pn < 4) ? 0.125f : 1.0f;
#pragma unroll
                    for (int n = 0; n < 2; ++n) { const f32x4 c = cp[n], s = sp[n]; const f32x4 a = x1[n] * hr * g1[n], b = x2[n] * hr * g2[n]; o1[n] = (a * c - b * s) * osc; o2[n] = (b * c + a * s) * osc; }
                } else {
#pragma unroll
                    for (int n = 0; n < 2; ++n) { o1[n] = acc[ai][0][m][n] * rstd; o2[n] = acc[ai][1][m][n] * rstd; }
                }
                *(u32x4*)(rowp) = pack8(o1[0], o1[1]); *(u32x4*)(rowp + 32) = pack8(o2[0], o2[1]);
                if (cdst) { *(f32x4*)(cdst) = o1[0]; *(f32x4*)(cdst + 4) = o1[1]; *(f32x4*)(cdst + 32) = o2[0]; *(f32x4*)(cdst + 36) = o2[1]; }
            }
    }
};

template <class Epi, class Sched, bool ALIGN_EPI = false, bool SP2 = false, bool HS = false>
__device__ __forceinline__ void gemm_phase(PG8_LAS unsigned char* lds, const Gemm g, const Sched& S, const Epi& E, const PG8_LAS float* hs = nullptr) {
    const int tid = threadIdx.x, wid = __builtin_amdgcn_readfirstlane(tid >> 6), lane = tid & 63, wr = wid >> 2, wc = wid & 3, fr = lane & 15, fq = lane >> 4;
    const int K = g.K, nt = K / BK;
    unsigned voffA[2], voffB[2];
#pragma unroll
    for (int i = 0; i < 2; ++i) { int R, C; stage_rc(tid * 16 + i * 8192, R, C); const int Rb = Epi::PERM ? ((R & ~31) + perm32(R & 31)) : R;
        voffA[i] = (unsigned)(R * K + C) * 2u; voffB[i] = (unsigned)(Rb * K + C) * 2u; }
    const size_t kstep = (size_t)(BK * 2);
    const size_t hstep = (size_t)HALF * K * 2;
    const size_t tstep = 2 * hstep;
    const unsigned ldsw = (unsigned)wid * 1024u;
    const int aoff = lds_byte(wr * 64 + fr, fq * 8), boff = lds_byte(wc * 32 + fr, fq * 8);
#define PG8_SA(b, h) (((b) * 2 + (h)) * HTB)
#define PG8_SB(b, h) ((4 + (b) * 2 + (h)) * HTB)
#define PG8_STAGE(bufoff, gbase, voff) do { _Pragma("unroll") for (int _i = 0; _i < 2; ++_i) \
        __builtin_amdgcn_global_load_lds((const unsigned*)((const char*)(gbase) + (voff)[_i]), (PG8_LAS unsigned*)(lds + (bufoff) + ldsw + _i * 8192), 16, 0, 0); } while (0)
#define PG8_LDA(dst, b, h) do { _Pragma("unroll") for (int m = 0; m < 4; ++m) _Pragma("unroll") for (int k = 0; k < 2; ++k) dst[m][k] = *(const PG8_LAS bf16x8*)(lds + PG8_SA(b, h) + aoff + m * 2048 + k * 1024); } while (0)
#define PG8_LDB(dst, b, h) do { _Pragma("unroll") for (int n = 0; n < 2; ++n) _Pragma("unroll") for (int k = 0; k < 2; ++k) dst[n][k] = *(const PG8_LAS bf16x8*)(lds + PG8_SB(b, h) + boff + n * 2048 + k * 1024); } while (0)
#define PG8_MMA(ai, bj, At, Bt) do { __builtin_amdgcn_s_setprio(1); _Pragma("unroll") for (int m = 0; m < 4; ++m) _Pragma("unroll") for (int n = 0; n < 2; ++n) _Pragma("unroll") for (int k = 0; k < 2; ++k) \
        acc[ai][bj][m][n] = __builtin_amdgcn_mfma_f32_16x16x32_bf16(Bt[n][k], At[m][k], acc[ai][bj][m][n], 0, 0, 0); __builtin_amdgcn_s_setprio(0); } while (0)
#define PG8_WAIT_V(n) asm volatile("s_waitcnt vmcnt(" #n ")" ::: "memory")
#define PG8_WAIT_L(n) asm volatile("s_waitcnt lgkmcnt(" #n ")" ::: "memory")
#define PG8_BAR __builtin_amdgcn_s_barrier()
#define PG8_SCHED __builtin_amdgcn_sched_barrier(0)
    Unit cur, nxt; int ui = 0;
    if (!S.next(0, cur)) return;
    f32x4 acc[2][2][4][2];
#pragma unroll
    for (int a = 0; a < 2; ++a)
#pragma unroll
        for (int b = 0; b < 2; ++b)
#pragma unroll
            for (int m = 0; m < 4; ++m)
#pragma unroll
                for (int n = 0; n < 2; ++n) acc[a][b][m][n] = (f32x4){0.f, 0.f, 0.f, 0.f};
    bf16x8 At[4][2], B0[2][2], B1[2][2];
    const char* cA = (const char*)g.A + (size_t)cur.pm * tstep; const char* cB = (const char*)g.Bt + (size_t)cur.pn * tstep;
    S.a_ready(cur);
    if constexpr (SP2) {
        PG8_STAGE(PG8_SB(0, 0), cB, voffB); PG8_STAGE(PG8_SB(0, 1), cB + hstep, voffB); PG8_STAGE(PG8_SA(0, 0), cA, voffA); PG8_STAGE(PG8_SA(0, 1), cA + hstep, voffA);
        if (wr == 1) PG8_BAR;
        PG8_WAIT_V(2); PG8_BAR;
        PG8_STAGE(PG8_SB(1, 0), cB + kstep, voffB); PG8_STAGE(PG8_SA(1, 0), cA + kstep, voffA); PG8_STAGE(PG8_SB(1, 1), cB + hstep + kstep, voffB);
        PG8_WAIT_V(6); PG8_BAR;
    } else {
        PG8_STAGE(PG8_SB(0, 0), cB, voffB); PG8_STAGE(PG8_SA(0, 0), cA, voffA); PG8_STAGE(PG8_SB(0, 1), cB + hstep, voffB); PG8_STAGE(PG8_SA(0, 1), cA + hstep, voffA);
        if (wr == 1) PG8_BAR;
        PG8_WAIT_V(4); PG8_BAR;
        PG8_STAGE(PG8_SB(1, 0), cB + kstep, voffB); PG8_STAGE(PG8_SA(1, 0), cA + kstep, voffA); PG8_STAGE(PG8_SB(1, 1), cB + hstep + kstep, voffB);
        PG8_WAIT_V(6); PG8_BAR;
    }
    for (;;) {
        const bool has_next = S.next(ui + 1, nxt);
        const char* nA = has_next ? (const char*)g.A + (size_t)nxt.pm * tstep : cA; const char* nB = has_next ? (const char*)g.Bt + (size_t)nxt.pn * tstep : cB;
        for (int t = 0; t < nt; t += 2) {
            if constexpr (HS) { if (t == 8 || t == 16 || t == 24) { const int hb_ = (t >> 3) - 1;
#pragma unroll
                for (int ai = 0; ai < 2; ++ai)
#pragma unroll
                    for (int m = 0; m < 4; ++m) { const float rt_ = hs[(ai * HALF + wr * 64 + m * 16 + fr) * 4 + hb_];
#pragma unroll
                        for (int bj = 0; bj < 2; ++bj)
#pragma unroll
                            for (int n = 0; n < 2; ++n) acc[ai][bj][m][n] = acc[ai][bj][m][n] * rt_; } } }
            const bool last = (t == nt - 2);
            const char* a1 = cA + (size_t)(t + 1) * kstep;
            const char* a2 = last ? nA : cA + (size_t)(t + 2) * kstep; const char* b2 = last ? nB : cB + (size_t)(t + 2) * kstep;
            const char* a3 = a2 + kstep; const char* b3 = b2 + kstep;
            if (last && has_next) S.a_ready(nxt);
            if constexpr (SP2) {
            PG8_LDB(B0, 0, 0); PG8_LDB(B1, 0, 1); PG8_SCHED; PG8_LDA(At, 0, 0); PG8_STAGE(PG8_SA(1, 1), a1 + hstep, voffA);
            PG8_WAIT_V(8); PG8_WAIT_L(0); PG8_BAR; PG8_MMA(0, 0, At, B0); PG8_MMA(0, 1, At, B1); PG8_BAR; PG8_SCHED;
            PG8_LDA(At, 0, 1); PG8_STAGE(PG8_SB(0, 0), b2, voffB); PG8_STAGE(PG8_SB(0, 1), b2 + hstep, voffB); PG8_STAGE(PG8_SA(0, 0), a2, voffA);
            PG8_WAIT_V(8); PG8_WAIT_L(0); PG8_BAR; PG8_MMA(1, 0, At, B0); PG8_MMA(1, 1, At, B1); PG8_BAR; PG8_SCHED;
            PG8_LDB(B0, 1, 0); PG8_LDB(B1, 1, 1); PG8_SCHED; PG8_LDA(At, 1, 0); PG8_STAGE(PG8_SA(0, 1), a2 + hstep, voffA);
            PG8_WAIT_V(8); PG8_WAIT_L(0); PG8_BAR; PG8_MMA(0, 0, At, B0); PG8_MMA(0, 1, At, B1); PG8_BAR; PG8_SCHED;
            PG8_LDA(At, 1, 1); PG8_STAGE(PG8_SB(1, 0), b3, voffB); PG8_STAGE(PG8_SB(1, 1), b3 + hstep, voffB); PG8_STAGE(PG8_SA(1, 0), a3, voffA);
            PG8_WAIT_V(8); PG8_WAIT_L(0); PG8_BAR; PG8_MMA(1, 0, At, B0); PG8_MMA(1, 1, At, B1); PG8_BAR; PG8_SCHED;
            } else {
            PG8_LDB(B0, 0, 0); PG8_SCHED; PG8_LDA(At, 0, 0); PG8_STAGE(PG8_SA(1, 1), a1 + hstep, voffA);
            PG8_WAIT_L(8); PG8_BAR; PG8_WAIT_L(0); PG8_MMA(0, 0, At, B0); PG8_BAR; PG8_SCHED;
            PG8_LDB(B1, 0, 1); PG8_STAGE(PG8_SB(0, 0), b2, voffB);
            PG8_BAR; PG8_WAIT_L(0); PG8_MMA(0, 1, At, B1); PG8_BAR;
            PG8_LDA(At, 0, 1); PG8_STAGE(PG8_SA(0, 0), a2, voffA);
            PG8_BAR; PG8_WAIT_L(0); PG8_MMA(1, 0, At, B0); PG8_BAR; PG8_SCHED;
            PG8_STAGE(PG8_SB(0, 1), b2 + hstep, voffB);
            PG8_WAIT_V(6); PG8_BAR; PG8_MMA(1, 1, At, B1); PG8_BAR;
            PG8_LDB(B0, 1, 0); PG8_SCHED; PG8_LDA(At, 1, 0); PG8_STAGE(PG8_SA(0, 1), a2 + hstep, voffA);
            PG8_WAIT_L(8); PG8_BAR; PG8_WAIT_L(0); PG8_MMA(0, 0, At, B0); PG8_BAR; PG8_SCHED;
            PG8_LDB(B1, 1, 1); PG8_STAGE(PG8_SB(1, 0), b3, voffB);
            PG8_BAR; PG8_WAIT_L(0); PG8_MMA(0, 1, At, B1); PG8_BAR;
            PG8_LDA(At, 1, 1); PG8_STAGE(PG8_SA(1, 0), a3, voffA);
            PG8_BAR; PG8_WAIT_L(0); PG8_MMA(1, 0, At, B0); PG8_BAR; PG8_SCHED;
            PG8_STAGE(PG8_SB(1, 1), b3 + hstep, voffB);
            PG8_WAIT_V(6); PG8_BAR; PG8_MMA(1, 1, At, B1); PG8_BAR;
            }
        }
        if constexpr (ALIGN_EPI) { if (wr == 0) PG8_BAR; }
        if constexpr (!Epi::AFTER_DRAIN) { E(acc, cur, wr, wc, fr, fq); S.done(cur); }
        if (!has_next) break;
#pragma unroll
        for (int a = 0; a < 2; ++a)
#pragma unroll
            for (int b = 0; b < 2; ++b)
#pragma unroll
                for (int m = 0; m < 4; ++m)
#pragma unroll
                    for (int n = 0; n < 2; ++n) acc[a][b][m][n] = (f32x4){0.f, 0.f, 0.f, 0.f};
        cur = nxt; cA = nA; cB = nB; ++ui;
        if constexpr (ALIGN_EPI) { if (wr == 1) PG8_BAR; }
    }
    PG8_WAIT_V(0);
    if constexpr (!ALIGN_EPI) { if (wr == 0) PG8_BAR; }
    PG8_BAR;
    if constexpr (Epi::AFTER_DRAIN) { E.fused(acc, cur, wr, wc, fr, fq, lds, wid, lane); S.done(cur); }
#undef PG8_SA
#undef PG8_SB
#undef PG8_STAGE
#undef PG8_LDA
#undef PG8_LDB
#undef PG8_MMA
#undef PG8_WAIT_V
#undef PG8_WAIT_L
#undef PG8_BAR
#undef PG8_SCHED
}
}
#define LAS __attribute__((address_space(3)))
typedef unsigned short bf16;
typedef unsigned u32x4 __attribute__((ext_vector_type(4)));
typedef unsigned u32x2 __attribute__((ext_vector_type(2)));
typedef float f32x4 __attribute__((ext_vector_type(4)));
typedef short bf16x8 __attribute__((ext_vector_type(8)));
#define LDS_WAIT() asm volatile("s_waitcnt lgkmcnt(0)" ::: "memory")

constexpr int NWAVES = 8, NTHR = 512;
constexpr int DM = 1024, NP = 16384, NS = 512, MT = NP + NS, SEQ = 2048, DFF = 2816;
constexpr float EPS = 1e-6f;
constexpr int LDS_BYTES = 147456;

constexpr size_t al256(size_t x) { return (x + 255) & ~(size_t)255; }
constexpr size_t WS_WRI = 0;
constexpr size_t WS_WRO = WS_WRI + al256(6144ull * 1024 * 2);
constexpr size_t WS_WFI0 = WS_WRO + al256(1024ull * 2048 * 2);
constexpr size_t WS_WFO0 = WS_WFI0 + al256(5632ull * 1024 * 2);
constexpr size_t WS_WFI1 = WS_WFO0 + al256(1024ull * 2816 * 2);
constexpr size_t WS_WFO1 = WS_WFI1 + al256(5632ull * 1024 * 2);
constexpr size_t WS_WSI = WS_WFO1 + al256(1024ull * 2816 * 2);
constexpr size_t WS_WSO = WS_WSI + al256(1536ull * 1024 * 2);
constexpr size_t WS_XB = WS_WSO + al256(1024ull * 1024 * 2);
constexpr size_t WS_BIG = WS_XB + al256((size_t)MT * 1024 * 2);
constexpr size_t WS_OB = WS_BIG + al256((size_t)MT * 6144 * 2);
constexpr size_t WS_SS = WS_OB + al256((size_t)MT * 2048 * 2);
constexpr size_t WS_SSO = WS_SS + al256(4ull * MT * 4);
constexpr size_t WS_TRC = WS_SSO + al256((size_t)MT * 4 * 4);
constexpr size_t WS_TRS = WS_TRC + al256(2052ull * 128 * 4);
constexpr size_t WS_TSC = WS_TRS + al256(2052ull * 128 * 4);
constexpr size_t WS_TSS = WS_TSC + al256(2052ull * 32 * 4);
constexpr size_t WS_END = WS_TSS + al256(2052ull * 32 * 4);
constexpr size_t WS_SSOP = WS_END;
constexpr size_t WS_CTL = WS_SSOP + al256((size_t)NP * 64 * 4), CTL_BYTES = 65536;
constexpr size_t WS_SCR = WS_CTL + CTL_BYTES;
constexpr size_t WS_TOTAL = WS_SCR;
constexpr size_t OUT_Y = 0, OUT_SP = (size_t)MT * 1024, OUT_SS = OUT_SP + 8ull * 4 * 256 * 512, OUT_KP = OUT_SS + 128ull * 4 * 256 * 512,
                 OUT_VP = OUT_KP + 8ull * 128 * 256, OUT_KS = OUT_VP + 8ull * 128 * 256, OUT_VS = OUT_KS + 128ull * 128 * 256, OUT_END = OUT_VS + 128ull * 128 * 256;

struct Params {
    const float* in[16]; float* out; unsigned char* ws;
    double invR[128]; double invS[32];
    float lg2[4];
    int ph_lo, ph_hi;
};

__device__ __forceinline__ unsigned f2bf(float f) { unsigned u = __builtin_bit_cast(unsigned, f); return (u + 0x7fffu + ((u >> 16) & 1u)) >> 16; }
__device__ __forceinline__ unsigned pk2(float lo, float hi) { return pg8::cvt_pk_bf16(lo, hi); }
__device__ __forceinline__ float bf2f(unsigned short b) { return __builtin_bit_cast(float, (unsigned)b << 16); }
__device__ __forceinline__ float bflo(unsigned w) { return __builtin_bit_cast(float, w << 16); }
__device__ __forceinline__ float bfhi(unsigned w) { return __builtin_bit_cast(float, w & 0xffff0000u); }
__device__ __forceinline__ float wave_sum(float v) {
#pragma unroll
    for (int o = 1; o < 64; o <<= 1) v += __shfl_xor(v, o);
    return v;
}
__device__ __forceinline__ f32x4 mfma16(bf16x8 a, bf16x8 b, f32x4 c) { return __builtin_amdgcn_mfma_f32_16x16x32_bf16(a, b, c, 0, 0, 0); }

__device__ __forceinline__ void transpose_item(const float* W, int K, int N, const float* gain, bf16* WT, int n0, int d0a, int d0b, int k0, LAS float* scr, int lane) {
    f32x4 wv[16];
#pragma unroll
    for (int i = 0; i < 16; ++i) { const int kk = 4 * i + (lane >> 4); wv[i] = __builtin_nontemporal_load((const f32x4*)(W + (size_t)(k0 + kk) * N + n0 + 4 * (lane & 15))); }
#pragma unroll
    for (int i = 0; i < 16; ++i) { const int kk = 4 * i + (lane >> 4); const float g = gain ? gain[k0 + kk] : 1.0f; LAS float* d = scr + kk * 65 + 4 * (lane & 15);
        d[0] = wv[i][0] * g; d[1] = wv[i][1] * g; d[2] = wv[i][2] * g; d[3] = wv[i][3] * g; }
    LDS_WAIT();
    const int c = lane & 7;
#pragma unroll
    for (int j = 0; j < 8; ++j) { const int n = (lane >> 3) + 8 * j; const LAS float* s = scr + (8 * c) * 65 + n;
        u32x4 o; o.x = pk2(s[0 * 65], s[1 * 65]); o.y = pk2(s[2 * 65], s[3 * 65]); o.z = pk2(s[4 * 65], s[5 * 65]); o.w = pk2(s[6 * 65], s[7 * 65]);
        const int drow = (n < 32) ? d0a + n : d0b + n - 32;
        *(u32x4*)(WT + (size_t)drow * K + k0 + 8 * c) = o; }
    LDS_WAIT();
}
__device__ __forceinline__ int dmap32(int mode, int n0) {
    if (mode == 1) return (n0 < DFF) ? (n0 / 128) * 256 + (n0 % 128) : ((n0 - DFF) / 128) * 256 + 128 + ((n0 - DFF) % 128);
    if (mode == 2) { const int pn = n0 / 256, r256 = n0 % 256, wc = r256 / 64, bj = (r256 % 64) / 32; return 256 * pn + 128 * bj + 32 * wc; }
    return n0;
}
__device__ __forceinline__ void transpose_mat(const float* W, int K, int N, const float* gain, bf16* WT, int mode, int r, LAS float* scr, int lane) {
    const int nblk = N / 64, kb = r / nblk, nb = r % nblk, n0 = 64 * nb;
    transpose_item(W, K, N, gain, WT, n0, dmap32(mode, n0), dmap32(mode, n0 + 32), 64 * kb, scr, lane);
}
__device__ __forceinline__ void p0_prologue(const Params& p, LAS unsigned char* lds, int tid, int lane, int wave, int vcu, int G, int part, int wid1, int nwg1) {
    unsigned char* ws = p.ws;
    LAS float* scr = (LAS float*)(lds + wave * 16896);
    const int gw = part ? wid1 * NWAVES + wave : vcu * NWAVES + wave, NGW = (part ? nwg1 : G) * NWAVES;
    constexpr int I_RI = 16 * 96, I_RO = 32 * 16, I_FI = 16 * 88, I_FO = 44 * 16, I_SI = 16 * 24, I_SO = 16 * 16;
    constexpr int NITEMS = I_RI + I_RO + 2 * I_FI + 2 * I_FO + I_SI + I_SO;
    const float* nmix = p.in[5]; const float* nffn = p.in[6];
    for (int it = (part ? I_RI + gw : gw); it < (part ? NITEMS : I_RI); it += NGW) {
        int r = it;
        if (r < I_RI) { transpose_mat(p.in[7], 1024, 6144, nmix, (bf16*)(ws + WS_WRI), 0, r, scr, lane); continue; } r -= I_RI;
        if (r < I_RO) { transpose_mat(p.in[8], 2048, 1024, nullptr, (bf16*)(ws + WS_WRO), 0, r, scr, lane); continue; } r -= I_RO;
        if (r < I_FI) { transpose_mat(p.in[14], 1024, 5632, nffn, (bf16*)(ws + WS_WFI0), 1, r, scr, lane); continue; } r -= I_FI;
        if (r < I_FO) { transpose_mat(p.in[15], 2816, 1024, nullptr, (bf16*)(ws + WS_WFO0), 0, r, scr, lane); continue; } r -= I_FO;
        if (r < I_SI) { transpose_mat(p.in[9], 1024, 1536, nmix + 1024, (bf16*)(ws + WS_WSI), 2, r, scr, lane); continue; } r -= I_SI;
        if (r < I_SO) { transpose_mat(p.in[10], 1024, 1024, nullptr, (bf16*)(ws + WS_WSO), 0, r, scr, lane); continue; } r -= I_SO;
        if (r < I_FI) { transpose_mat(p.in[14] + (size_t)1024 * 5632, 1024, 5632, nffn + 1024, (bf16*)(ws + WS_WFI1), 1, r, scr, lane); continue; } r -= I_FI;
        transpose_mat(p.in[15] + (size_t)2816 * 1024, 2816, 1024, nullptr, (bf16*)(ws + WS_WFO1), 0, r, scr, lane);
    }
    if (part) return;
    float* cR = (float*)(ws + WS_TRC); float* sR = (float*)(ws + WS_TRS); float* cS = (float*)(ws + WS_TSC); float* sS = (float*)(ws + WS_TSS);
    for (int idx = vcu * NTHR + tid; idx < 2052 * 160; idx += G * NTHR) {
        const int pi = idx / 160, c = idx % 160; const double pos = (pi < 2048) ? (double)pi : (double)(16384 + (pi - 2048));
        double rev = pos * ((c < 128) ? p.invR[c] : p.invS[c - 128]); rev -= __builtin_rint(rev);
        const float cv = __builtin_amdgcn_cosf((float)rev), sv = __builtin_amdgcn_sinf((float)rev);
        if (c < 128) { cR[pi * 128 + c] = cv; sR[pi * 128 + c] = sv; } else { cS[pi * 32 + c - 128] = cv; sS[pi * 32 + c - 128] = sv; }
    }
    bf16* XB = (bf16*)(ws + WS_XB); float* ss = (float*)(ws + WS_SS); float* sso = (float*)(ws + WS_SSO);
    for (int m = gw; m < MT; m += NGW) {
        const float* xr = (m < NP) ? p.in[0] + (size_t)m * DM : p.in[1] + (size_t)(m - NP) * DM;
        f32x4 v[4]; float s = 0.f;
#pragma unroll
        for (int j = 0; j < 4; ++j) { v[j] = ((const f32x4*)xr)[lane + 64 * j]; s += (v[j][0] * v[j][0] + v[j][1] * v[j][1]) + (v[j][2] * v[j][2] + v[j][3] * v[j][3]); }
        s = wave_sum(s);
#pragma unroll
        for (int j = 0; j < 4; ++j) { u32x2 o; o.x = pk2(v[j][0], v[j][1]); o.y = pk2(v[j][2], v[j][3]); ((u32x2*)(XB + (size_t)m * DM))[lane + 64 * j] = o; }
        if (lane == 0) { ss[m] = s; ss[MT + m] = 0.f; ss[2 * MT + m] = 0.f; ss[3 * MT + m] = 0.f; }
    }
}

constexpr int RQ_STR = 264, RV_STR = 72;
constexpr int RL_Q = 0, RL_K = 33792, RL_VT = 67584, RL_VD = 76800, RL_P = 86016, RL_ST = 95232, RL_GL = 129024;
__device__ __forceinline__ void ret_prompt_unit(LAS unsigned char* lds, const bf16* QKVG, bf16* OB, float* sso, float* state_out, int bh, int es, float lg2, int tid) {
    const int lane = tid & 63, w = __builtin_amdgcn_readfirstlane(tid >> 6), li = lane & 15, lq = lane >> 4;
    const int b = bh >> 2, h = bh & 3;
    LAS bf16* Ql = (LAS bf16*)(lds + RL_Q); LAS bf16* Kl = (LAS bf16*)(lds + RL_K); LAS bf16* VT = (LAS bf16*)(lds + RL_VT);
    LAS bf16* VD = (LAS bf16*)(lds + RL_VD); LAS bf16* PP = (LAS bf16*)(lds + RL_P); LAS bf16* ST = (LAS bf16*)(lds + RL_ST);
    for (int i = tid; i < 33792 / 16; i += NTHR) ((LAS u32x4*)ST)[i] = (u32x4){0u, 0u, 0u, 0u};
    f32x4 S[2][4];
#pragma unroll
    for (int a = 0; a < 2; ++a)
#pragma unroll
        for (int e = 0; e < 4; ++e) S[a][e] = (f32x4){0.f, 0.f, 0.f, 0.f};
    const size_t rowbase = (size_t)b * SEQ;
    const bf16* qg = QKVG + ((size_t)h * MT + rowbase) * 256;
    const bf16* kg = qg + (size_t)4 * MT * 256;
    const bf16* vg = QKVG + (size_t)8 * MT * 256 + ((size_t)h * MT + rowbase) * 512 + es * 64;
    const int srow = tid >> 5, sch = tid & 31;
    const int vrow = tid & 63, vch = tid >> 6;
    const bf16* gg = vg + (size_t)4 * MT * 512;
    LAS bf16* OL = (LAS bf16*)(lds + RL_GL + 9216);
    const int orow = tid >> 3, och = tid & 7;
    LAS bf16* GL = (LAS bf16*)(lds + RL_GL);
    u32x4 rq[4], rk[4], rv, rg;
#define RET_LOAD(t0_) do { _Pragma("unroll") for (int i_ = 0; i_ < 4; ++i_) { const size_t o_ = (size_t)((t0_) + srow + 16 * i_) * 256 + sch * 8; rq[i_] = *(const u32x4*)(qg + o_); rk[i_] = *(const u32x4*)(kg + o_); } \
        rv = *(const u32x4*)(vg + (size_t)((t0_) + vrow) * 512 + vch * 8); rg = *(const u32x4*)(gg + (size_t)((t0_) + vrow) * 512 + vch * 8); } while (0)
    RET_LOAD(0);
    const int ib = w >> 1, nh = w & 1;
    const float dS = __builtin_amdgcn_exp2f(64.0f * lg2);
    for (int c = 0; c < 32; ++c) {
        const int t0 = c * 64;
        asm volatile("s_waitcnt vmcnt(0)" ::: "memory");
#pragma unroll
        for (int i = 0; i < 4; ++i) { *(LAS u32x4*)(Ql + (srow + 16 * i) * RQ_STR + sch * 8) = rq[i]; *(LAS u32x4*)(Kl + (srow + 16 * i) * RQ_STR + sch * 8) = rk[i]; }
        *(LAS u32x4*)(GL + vrow * RV_STR + vch * 8) = rg;
        { const float dec = __builtin_amdgcn_exp2f((float)(63 - vrow) * lg2);
#pragma unroll
          for (int j = 0; j < 4; ++j) { const unsigned wv = rv[j]; const int e0 = vch * 8 + 2 * j;
              VT[e0 * RV_STR + vrow] = (bf16)(wv & 0xffffu); VT[(e0 + 1) * RV_STR + vrow] = (bf16)(wv >> 16);
              VD[e0 * RV_STR + vrow] = (bf16)f2bf(bflo(wv) * dec); VD[(e0 + 1) * RV_STR + vrow] = (bf16)f2bf(bfhi(wv) * dec); } }
        __syncthreads();
        if (c > 0) { const u32x4 ov = *(const LAS u32x4*)(OL + orow * 64 + och * 8); *(u32x4*)(OB + (rowbase + t0 - 64 + orow) * 2048 + h * 512 + es * 64 + och * 8) = ov; }
        if (c + 1 < 32) RET_LOAD(t0 + 64);
        f32x4 accS[2], accO[2];
#pragma unroll
        for (int t = 0; t < 2; ++t) { accS[t] = (f32x4){0.f, 0.f, 0.f, 0.f}; accO[t] = (f32x4){0.f, 0.f, 0.f, 0.f}; }
#pragma unroll
        for (int kh = 0; kh < 4; ++kh) {
            bf16x8 fa[2], fs[2][2], fk[2][2];
#pragma unroll
            for (int kk = 0; kk < 2; ++kk) { const int ks = 2 * kh + kk;
                fa[kk] = *(const LAS bf16x8*)(Ql + (16 * ib + li) * RQ_STR + 32 * ks + 8 * lq);
#pragma unroll
                for (int t = 0; t < 2; ++t) { fs[kk][t] = *(const LAS bf16x8*)(ST + (16 * (2 * nh + t) + li) * RQ_STR + 32 * ks + 8 * lq);
                    fk[kk][t] = *(const LAS bf16x8*)(Kl + (16 * (2 * nh + t) + li) * RQ_STR + 32 * ks + 8 * lq); } }
            __builtin_amdgcn_sched_barrier(0);
#pragma unroll
            for (int kk = 0; kk < 2; ++kk)
#pragma unroll
                for (int t = 0; t < 2; ++t) { accO[t] = mfma16(fa[kk], fs[kk][t], accO[t]); accS[t] = mfma16(fa[kk], fk[kk][t], accS[t]); }
            __builtin_amdgcn_sched_barrier(0);
        }
#pragma unroll
        for (int t = 0; t < 2; ++t) { const int jb = 2 * nh + t, j = 16 * jb + li;
#pragma unroll
            for (int r = 0; r < 4; ++r) { const int i = 16 * ib + 4 * lq + r;
                const float val = (j <= i) ? accS[t][r] * __builtin_amdgcn_exp2f((float)(i - j) * lg2) : 0.f;
                PP[i * RV_STR + j] = (bf16)f2bf(val); } }
        __syncthreads();
        f32x4 accA[2];
#pragma unroll
        for (int t = 0; t < 2; ++t) accA[t] = (f32x4){0.f, 0.f, 0.f, 0.f};
#pragma unroll
        for (int ks = 0; ks < 2; ++ks) {
            const bf16x8 a = *(const LAS bf16x8*)(PP + (16 * ib + li) * RV_STR + 32 * ks + 8 * lq);
#pragma unroll
            for (int t = 0; t < 2; ++t) { const bf16x8 bv = *(const LAS bf16x8*)(VT + (16 * (2 * nh + t) + li) * RV_STR + 32 * ks + 8 * lq); accA[t] = mfma16(a, bv, accA[t]); }
        }
#pragma unroll
        for (int r = 0; r < 4; ++r) { const int i = 16 * ib + 4 * lq + r; const float f = __builtin_amdgcn_exp2f((float)(i + 1) * lg2);
            const size_t row = rowbase + t0 + i; float q2 = 0.f;
#pragma unroll
            for (int t = 0; t < 2; ++t) { const float o = accA[t][r] + f * accO[t][r]; q2 += o * o; OL[i * 64 + 16 * (2 * nh + t) + li] = (bf16)f2bf(o * bf2f(GL[i * RV_STR + 16 * (2 * nh + t) + li])); }
            q2 += __shfl_xor(q2, 1); q2 += __shfl_xor(q2, 2); q2 += __shfl_xor(q2, 4); q2 += __shfl_xor(q2, 8);
            if (li == 0 && sso) sso[(row * 4 + h) * 16 + es * 2 + nh] = q2; }
#pragma unroll
        for (int a = 0; a < 2; ++a)
#pragma unroll
            for (int e = 0; e < 4; ++e) S[a][e] = S[a][e] * dS;
#pragma unroll
        for (int ks = 0; ks < 2; ++ks) {
            bf16x8 ka[2];
#pragma unroll
            for (int dm = 0; dm < 2; ++dm)
#pragma unroll
                for (int jj = 0; jj < 8; ++jj) ka[dm][jj] = (short)Kl[(32 * ks + 8 * lq + jj) * RQ_STR + 32 * w + 16 * dm + li];
#pragma unroll
            for (int en = 0; en < 4; ++en) { const bf16x8 bv = *(const LAS bf16x8*)(VD + (16 * en + li) * RV_STR + 32 * ks + 8 * lq);
#pragma unroll
                for (int dm = 0; dm < 2; ++dm) S[dm][en] = mfma16(ka[dm], bv, S[dm][en]); }
        }
#pragma unroll
        for (int dm = 0; dm < 2; ++dm)
#pragma unroll
            for (int en = 0; en < 4; ++en) { u32x2 o; o.x = f2bf(S[dm][en][0]) | (f2bf(S[dm][en][1]) << 16); o.y = f2bf(S[dm][en][2]) | (f2bf(S[dm][en][3]) << 16);
                *(LAS u32x2*)(ST + (16 * en + li) * RQ_STR + 32 * w + 16 * dm + 4 * lq) = o; }
        __syncthreads();
    }
#undef RET_LOAD
    { const u32x4 ov = *(const LAS u32x4*)(OL + orow * 64 + och * 8); *(u32x4*)(OB + (rowbase + 31 * 64 + orow) * 2048 + h * 512 + es * 64 + och * 8) = ov; }
    float* so = state_out + ((size_t)bh * 256) * 512 + es * 64;
#pragma unroll
    for (int dm = 0; dm < 2; ++dm)
#pragma unroll
        for (int en = 0; en < 4; ++en)
#pragma unroll
            for (int r = 0; r < 4; ++r) so[(size_t)(32 * w + 16 * dm + 4 * lq + r) * 512 + 16 * en + li] = S[dm][en][r];
}

__device__ __forceinline__ void ret_sample_unit(LAS unsigned char* lds, const bf16* QKVG, bf16* OB, const float* state_in, float* state_out, int bh, float lg2, int tid) {
    const int lane = tid & 63, w = __builtin_amdgcn_readfirstlane(tid >> 6);
    const int b = bh >> 2, h = bh & 3;
    LAS float* qk8 = (LAS float*)lds;
    LAS float* qkd = qk8 + 2048;
    LAS float* red = qkd + 16;
    LAS float* wsm = red + 8192;
    const size_t r0 = (size_t)(NP + b * 4);
    {
        const int idx = tid * 4, which = idx >> 10, t = (idx >> 8) & 3, d = idx & 255;
        const u32x2 v = *(const u32x2*)(QKVG + (size_t)which * 4 * MT * 256 + ((size_t)h * MT + r0 + t) * 256 + d);
        LAS float* dst = qk8 + d * 8 + which * 4 + t;
        dst[0] = bflo(v.x); dst[8] = bfhi(v.x); dst[16] = bflo(v.y); dst[24] = bfhi(v.y);
    }
    __syncthreads();
    {
#pragma unroll
        for (int pp = 0; pp < 2; ++pp) { const int pr = 2 * w + pp, i = pr >> 2, j = pr & 3; float s = 0.f;
#pragma unroll
            for (int dd = 0; dd < 4; ++dd) { const int d = lane * 4 + dd; s += qk8[d * 8 + i] * qk8[d * 8 + 4 + j]; }
            s = wave_sum(s); if (lane == 0) qkd[pr] = s; }
    }
    const float g1 = __builtin_amdgcn_exp2f(lg2), g2 = g1 * g1, g3 = g2 * g1, g4 = g2 * g2;
    const int ec = tid & 127, dg = tid >> 7;
    f32x4 vv[4];
#pragma unroll
    for (int j = 0; j < 4; ++j) { const u32x2 v = *(const u32x2*)(QKVG + (size_t)8 * MT * 256 + ((size_t)h * MT + r0 + j) * 512 + 4 * ec); vv[j] = (f32x4){bflo(v.x), bfhi(v.x), bflo(v.y), bfhi(v.y)}; }
    vv[0] = vv[0] * g3; vv[1] = vv[1] * g2; vv[2] = vv[2] * g1;
    f32x4 oa[4];
#pragma unroll
    for (int i = 0; i < 4; ++i) oa[i] = (f32x4){0.f, 0.f, 0.f, 0.f};
    const float* sin_ = state_in + ((size_t)bh * 256 + dg * 64) * 512 + 4 * ec;
    float* sout = state_out + ((size_t)bh * 256 + dg * 64) * 512 + 4 * ec;
    f32x4 sb[2][8];
#pragma unroll
    for (int r = 0; r < 8; ++r) sb[0][r] = __builtin_nontemporal_load((const f32x4*)(sin_ + (size_t)r * 512));
#pragma unroll
    for (int bt = 0; bt < 8; ++bt) {
        if (bt + 1 < 8) {
#pragma unroll
            for (int r = 0; r < 8; ++r) sb[(bt + 1) & 1][r] = __builtin_nontemporal_load((const f32x4*)(sin_ + (size_t)((bt + 1) * 8 + r) * 512));
            asm volatile("s_waitcnt vmcnt(8)" ::: "memory");
        } else asm volatile("s_waitcnt vmcnt(0)" ::: "memory");
#pragma unroll
        for (int r = 0; r < 8; ++r) { const int dd = bt * 8 + r; const f32x4 s = sb[bt & 1][r];
            const f32x4 q4 = *(const LAS f32x4*)(qk8 + (dg * 64 + dd) * 8), k4 = *(const LAS f32x4*)(qk8 + (dg * 64 + dd) * 8 + 4);
            const f32x4 sn = s * g4 + vv[0] * k4[0] + vv[1] * k4[1] + vv[2] * k4[2] + vv[3] * k4[3];
            __builtin_nontemporal_store(sn, (f32x4*)(sout + (size_t)dd * 512));
            oa[0] += s * q4[0]; oa[1] += s * q4[1]; oa[2] += s * q4[2]; oa[3] += s * q4[3]; }
    }
#pragma unroll
    for (int i = 0; i < 4; ++i) *(LAS f32x4*)(red + (dg * 4 + i) * 512 + 4 * ec) = oa[i];
    __syncthreads();
    {
        const int e = tid; float vj[4], o[4], q2[4];
#pragma unroll
        for (int j = 0; j < 4; ++j) vj[j] = bf2f(QKVG[(size_t)8 * MT * 256 + ((size_t)h * MT + r0 + j) * 512 + e]);
        const float gp[4] = {1.0f, g1, g2, g3};
#pragma unroll
        for (int i = 0; i < 4; ++i) { float ob = (red[(0 * 4 + i) * 512 + e] + red[(1 * 4 + i) * 512 + e]) + (red[(2 * 4 + i) * 512 + e] + red[(3 * 4 + i) * 512 + e]);
            float acc = ob * gp[i] * g1;
#pragma unroll
            for (int j = 0; j < 4; ++j) if (j <= i) acc += gp[i - j] * qkd[i * 4 + j] * vj[j];
            o[i] = acc; q2[i] = wave_sum(acc * acc); }
        if (lane == 0) {
#pragma unroll
            for (int i = 0; i < 4; ++i) wsm[w * 4 + i] = q2[i]; }
        __syncthreads();
#pragma unroll
        for (int i = 0; i < 4; ++i) { float t = 0.f;
#pragma unroll
            for (int ww = 0; ww < 8; ++ww) t += wsm[ww * 4 + i];
            const float rstd = __builtin_amdgcn_rsqf(t * (1.0f / 512.0f) + EPS);
            const float sg = bf2f(QKVG[(size_t)8 * MT * 256 + (size_t)4 * MT * 512 + ((size_t)h * MT + r0 + i) * 512 + e]);
            OB[(r0 + i) * 2048 + h * 512 + e] = (bf16)f2bf(o[i] * rstd * sg); }
    }
    __syncthreads();
}

__device__ __forceinline__ void ret_norm_pass(const bf16* QKVG, bf16* OB, const float* sso, int gw, int NGW, int lane) {
    for (int m = gw; m < NP; m += NGW) {
#pragma unroll
        for (int j = 0; j < 4; ++j) {
            const f32x4* pp = (const f32x4*)(sso + ((size_t)m * 4 + j) * 16);
            const f32x4 pa = pp[0] + pp[1] + pp[2] + pp[3];
            const float rstd = __builtin_amdgcn_rsqf(((pa[0] + pa[1]) + (pa[2] + pa[3])) * (1.0f / 512.0f) + EPS);
            u32x4 o = *(const u32x4*)(OB + (size_t)m * 2048 + 512 * j + lane * 8); const u32x4 g = *(const u32x4*)(QKVG + (size_t)8 * MT * 256 + (size_t)4 * MT * 512 + ((size_t)j * MT + m) * 512 + lane * 8);
#pragma unroll
            for (int k = 0; k < 4; ++k) o[k] = pk2(bflo(o[k]) * rstd * bflo(g[k]), bfhi(o[k]) * rstd * bfhi(g[k]));
            *(u32x4*)(OB + (size_t)m * 2048 + 512 * j + lane * 8) = o;
        }
    }
}

constexpr int AK_STR = 72, AV_STR = 264, AP_STR = 168;
constexpr int AL_K = 0, AL_VT = 36864, AL_P = 70656;
template <int AVS> __device__ __forceinline__ void attn_item(const LAS bf16* Kl, const LAS bf16* VT, LAS bf16* Pw, const bf16x8 (&qa)[2], int jt0, const int (&lo)[4], const int (&hi)[4], const float (&sink)[4], bf16* const (&outp)[4], int li, int lq) {
    f32x4 sc[10];
#pragma unroll
    for (int jt = 0; jt < 10; ++jt) { sc[jt] = (f32x4){0.f, 0.f, 0.f, 0.f};
#pragma unroll
        for (int ks = 0; ks < 2; ++ks) { const bf16x8 bk = *(const LAS bf16x8*)(Kl + (16 * (jt0 + jt) + li) * AK_STR + 32 * ks + 8 * lq); sc[jt] = mfma16(qa[ks], bk, sc[jt]); } }
    float mx[4], den[4];
#pragma unroll
    for (int r = 0; r < 4; ++r) { float m = sink[r];
#pragma unroll
        for (int jt = 0; jt < 10; ++jt) { const int j = 16 * (jt0 + jt) + li; const bool ok = (j >= lo[r]) && (j <= hi[r]); sc[jt][r] = ok ? sc[jt][r] : -INFINITY; m = fmaxf(m, sc[jt][r]); }
        m = fmaxf(m, __shfl_xor(m, 1)); m = fmaxf(m, __shfl_xor(m, 2)); m = fmaxf(m, __shfl_xor(m, 4)); m = fmaxf(m, __shfl_xor(m, 8));
        float s = 0.f;
#pragma unroll
        for (int jt = 0; jt < 10; ++jt) { const float e = __expf(sc[jt][r] - m); sc[jt][r] = e; s += e; }
        s += __shfl_xor(s, 1); s += __shfl_xor(s, 2); s += __shfl_xor(s, 4); s += __shfl_xor(s, 8);
        mx[r] = m; den[r] = __builtin_amdgcn_rcpf(s + __expf(sink[r] - m)); }
#pragma unroll
    for (int jt = 0; jt < 10; ++jt)
#pragma unroll
        for (int r = 0; r < 4; ++r) Pw[(4 * lq + r) * AP_STR + 16 * jt + li] = (bf16)f2bf(sc[jt][r] * den[r]);
    LDS_WAIT();
    f32x4 oc[4];
#pragma unroll
    for (int dn = 0; dn < 4; ++dn) oc[dn] = (f32x4){0.f, 0.f, 0.f, 0.f};
#pragma unroll
    for (int ks = 0; ks < 5; ++ks) { const bf16x8 pa = *(const LAS bf16x8*)(Pw + li * AP_STR + 32 * ks + 8 * lq);
#pragma unroll
        for (int dn = 0; dn < 4; ++dn) { const bf16x8 bv = *(const LAS bf16x8*)(VT + (16 * dn + li) * AVS + 16 * jt0 + 32 * ks + 8 * lq); oc[dn] = mfma16(pa, bv, oc[dn]); } }
#pragma unroll
    for (int r = 0; r < 4; ++r)
#pragma unroll
        for (int dn = 0; dn < 4; ++dn) outp[r][16 * dn + li] = (bf16)f2bf(oc[dn][r]);
    LDS_WAIT();
    (void)mx;
}
__device__ __forceinline__ void attn_prompt_unit(LAS unsigned char* lds, const bf16* QKV, bf16* AO, const float* sinks, int unit, int tid) {
    const int lane = tid & 63, w = __builtin_amdgcn_readfirstlane(tid >> 6), li = lane & 15, lq = lane >> 4;
    const int kvh = unit & 3, nb = (unit >> 2) & 15, b = unit >> 6;
    LAS bf16* Kl = (LAS bf16*)(lds + AL_K); LAS bf16* VT = (LAS bf16*)(lds + AL_VT); LAS bf16* Pw = (LAS bf16*)(lds + AL_P + w * 5376);
    const size_t rowbase = (size_t)b * SEQ; const int tb = nb * 128 - 128;
    bf16x8 qf[4][2];
#pragma unroll
    for (int it = 0; it < 4; ++it) { const int id = w * 4 + it, g = id >> 3, qt = id & 7; const bf16* qp = QKV + (rowbase + nb * 128 + 16 * qt + li) * 1536 + (kvh * 4 + g) * 64;
#pragma unroll
        for (int ks = 0; ks < 2; ++ks) qf[it][ks] = *(const bf16x8*)(qp + 32 * ks + 8 * lq); }
#pragma unroll
    for (int i = 0; i < 4; ++i) { const int id = tid + NTHR * i, j = id >> 3, ch = id & 7; const int t = tb + j;
        u32x4 kv = (u32x4){0u, 0u, 0u, 0u}, vv = (u32x4){0u, 0u, 0u, 0u};
        if (t >= 0) { const bf16* src = QKV + (rowbase + t) * 1536 + 1024 + kvh * 64 + ch * 8; kv = *(const u32x4*)src; vv = *(const u32x4*)(src + 256); }
        *(LAS u32x4*)(Kl + j * AK_STR + ch * 8) = kv;
#pragma unroll
        for (int k = 0; k < 4; ++k) { VT[(ch * 8 + 2 * k) * AV_STR + j] = (bf16)(vv[k] & 0xffffu); VT[(ch * 8 + 2 * k + 1) * AV_STR + j] = (bf16)(vv[k] >> 16); } }
    __syncthreads();
#pragma unroll
    for (int it = 0; it < 4; ++it) { const int id = w * 4 + it, g = id >> 3, qt = id & 7, hq = kvh * 4 + g;
        const size_t qrow0 = rowbase + nb * 128 + 16 * qt;
        int lo[4], hi[4]; float sk[4]; bf16* op[4]; const float sv = sinks[hq];
#pragma unroll
        for (int r = 0; r < 4; ++r) { const int i = 16 * qt + 4 * lq + r; lo[r] = (nb > 0) ? i : (i > 128 ? i : 128); hi[r] = i + 128; sk[r] = sv; op[r] = AO + (qrow0 + 4 * lq + r) * 1024 + hq * 64; }
        attn_item<AV_STR>(Kl, VT, Pw, qf[it], qt & ~1, lo, hi, sk, op, li, lq); }
    __syncthreads();
}
constexpr int AS_VSTR = 168, AS_SLOT = 51200, AS_K = 0, AS_VT = 23040, AS_P = 44544;
__device__ __forceinline__ void attn_sample_pair(LAS unsigned char* lds, const bf16* QKV, bf16* AO, const float* sinks, const float* ck, const float* cv, float* ok, float* ov, int unit0, int unit1, int tid) {
    const int lane = tid & 63, w = __builtin_amdgcn_readfirstlane(tid >> 6), li = lane & 15, lq = lane >> 4;
#pragma unroll 1
    for (int s = 0; s < 2; ++s) {
        const int unit = s ? unit1 : unit0; const int kvh = unit & 3, b = unit >> 2;
        LAS bf16* Kl = (LAS bf16*)(lds + s * AS_SLOT + AS_K); LAS bf16* VT = (LAS bf16*)(lds + s * AS_SLOT + AS_VT);
#pragma unroll
        for (int i = 0; i < 4; ++i) { const int id = tid + NTHR * i, j = id >> 4, ch = id & 15;
            const size_t so = ((size_t)(b * 128 + j) * 4 + kvh) * 64 + ch * 4;
            const f32x4 kf = *(const f32x4*)(ck + so), vf = *(const f32x4*)(cv + so);
            if (j >= 4) { const size_t d_ = ((size_t)(b * 128 + j - 4) * 4 + kvh) * 64 + ch * 4; *(f32x4*)(ok + d_) = kf; *(f32x4*)(ov + d_) = vf; }
            u32x2 kb; kb.x = pk2(kf[0], kf[1]); kb.y = pk2(kf[2], kf[3]); *(LAS u32x2*)(Kl + j * AK_STR + ch * 4) = kb;
#pragma unroll
            for (int k = 0; k < 4; ++k) VT[(ch * 4 + k) * AS_VSTR + j] = (bf16)f2bf(vf[k]); }
        if (tid < 256) { const int j = 128 + (tid >> 3), ch = tid & 7;
            u32x4 kv = (u32x4){0u, 0u, 0u, 0u}, vv = (u32x4){0u, 0u, 0u, 0u};
            if (j < 132) { const bf16* src = QKV + (size_t)(NP + b * 4 + (j - 128)) * 1536 + 1024 + kvh * 64 + ch * 8; kv = *(const u32x4*)src; vv = *(const u32x4*)(src + 256); }
            *(LAS u32x4*)(Kl + j * AK_STR + ch * 8) = kv;
#pragma unroll
            for (int k = 0; k < 4; ++k) { VT[(ch * 8 + 2 * k) * AS_VSTR + j] = (bf16)(vv[k] & 0xffffu); VT[(ch * 8 + 2 * k + 1) * AS_VSTR + j] = (bf16)(vv[k] >> 16); } }
    }
    __syncthreads();
    if (w < 2) {
        const int unit = w ? unit1 : unit0; const int kvh = unit & 3, b = unit >> 2;
        const LAS bf16* Kl = (const LAS bf16*)(lds + w * AS_SLOT + AS_K); const LAS bf16* VT = (const LAS bf16*)(lds + w * AS_SLOT + AS_VT); LAS bf16* Pw = (LAS bf16*)(lds + w * AS_SLOT + AS_P);
        const int gA = li >> 2, tA = li & 3;
        const bf16* qp = QKV + (size_t)(NP + b * 4 + tA) * 1536 + (kvh * 4 + gA) * 64;
        bf16x8 qa[2];
#pragma unroll
        for (int ks = 0; ks < 2; ++ks) qa[ks] = *(const bf16x8*)(qp + 32 * ks + 8 * lq);
        int lo[4], hi[4]; float sk[4]; bf16* op[4];
#pragma unroll
        for (int r = 0; r < 4; ++r) { const int rr = 4 * lq + r, g = rr >> 2, t = rr & 3; lo[r] = t; hi[r] = t + 128; sk[r] = sinks[kvh * 4 + g]; op[r] = AO + (size_t)(NP + b * 4 + t) * 1024 + (kvh * 4 + g) * 64; }
        attn_item<AS_VSTR>(Kl, VT, Pw, qa, 0, lo, hi, sk, op, li, lq);
    }
    __syncthreads();
}

#define XB_TMO      128
#define XB_XCNT(j)  (256  + 64 * (j))
#define XB_XSUB(j)  (1280 + 64 * (j))
#define XB_XGEN(j)  (2304 + 64 * (j))
#define XB_TOP      3328
#define XB_TOPGEN   3392
#define XCD_BAR_WORDS 3456
#define XB_SPIN_CAP (1u << 18)

__device__ __forceinline__ unsigned xb_ld(unsigned* p)              { return __hip_atomic_load(p, __ATOMIC_RELAXED, __HIP_MEMORY_SCOPE_AGENT); }
__device__ __forceinline__ unsigned xb_add(unsigned* p, unsigned v) { return __hip_atomic_fetch_add(p, v, __ATOMIC_RELAXED, __HIP_MEMORY_SCOPE_AGENT); }
__device__ __forceinline__ unsigned xb_xcc_id() { return (unsigned)__builtin_amdgcn_s_getreg((3 << 11) | 20) & 0xFu; }
#define XB_SPIN(cond, bar) do { unsigned _sp = 0; while (cond) { __builtin_amdgcn_s_sleep(1); \
    if ((++_sp & 255u) == 0u) { if (xb_ld(&(bar)[XB_TMO])) break; if (_sp > XB_SPIN_CAP) { atomicAdd(&(bar)[XB_TMO], 1u); break; } } } } while (0)

struct XcdBarrier {
    unsigned* bar; unsigned x;
    volatile LAS unsigned* st;
};

__device__ __forceinline__ XcdBarrier xcd_barrier_post(unsigned* bar, volatile LAS unsigned* st) {
    XcdBarrier b; b.bar = bar; b.x = xb_xcc_id(); b.st = st;
    if (threadIdx.x == 0) (void)xb_add(&bar[XB_XCNT(b.x)], 1u);
    return b;
}
__device__ __forceinline__ void xcd_barrier_complete(unsigned* bar, unsigned x, unsigned& nloc, unsigned& nx) {
    const unsigned G = gridDim.x * gridDim.y * gridDim.z;
    unsigned sum, cnt, mine, sp = 0u;
    for (;;) {
        sum = 0u; cnt = 0u; mine = 0u;
#pragma unroll
        for (unsigned j = 0; j < 16; ++j) { const unsigned c = xb_ld(&bar[XB_XCNT(j)]); sum += c; cnt += (c > 0u) ? 1u : 0u; mine = (j == x) ? c : mine; }
        if (sum == G) break;
        __builtin_amdgcn_s_sleep(1);
        if ((++sp & 255u) == 0u) { if (xb_ld(&bar[XB_TMO])) break; if (sp > XB_SPIN_CAP) { atomicAdd(&bar[XB_TMO], 1u); break; } }
    }
    nloc = mine > 0u ? mine : 1u; nx = cnt > 0u ? cnt : 1u;
}

__device__ __forceinline__ void xcd_barrier(const XcdBarrier& b) {
    asm volatile("s_waitcnt vmcnt(0)" ::: "memory");
    __syncthreads();
    if (threadIdx.x == 0) {
        unsigned* bar = b.bar;
        __builtin_amdgcn_s_waitcnt(0);
        unsigned nloc = b.st[0], nx = b.st[1];
        if (nloc == 0u) { xcd_barrier_complete(bar, b.x, nloc, nx); b.st[0] = nloc; b.st[1] = nx; }
        const unsigned old = xb_add(&bar[XB_XSUB(b.x)], 1u);
        const unsigned gen = old / nloc;
        if (old + 1u == (gen + 1u) * nloc) {
            __builtin_amdgcn_fence(__ATOMIC_RELEASE, "agent");
            asm volatile("s_waitcnt vmcnt(0)" ::: "memory");
            const unsigned og = xb_add(&bar[XB_TOP], 1u);
            const unsigned tg = og / nx;
            if (og + 1u == (tg + 1u) * nx) xb_add(&bar[XB_TOPGEN], 1u);
            else XB_SPIN(xb_ld(&bar[XB_TOPGEN]) == tg, bar);
            __builtin_amdgcn_fence(__ATOMIC_ACQUIRE, "agent");
            xb_add(&bar[XB_XGEN(b.x)], 1u);
            asm volatile("s_waitcnt vmcnt(0)" ::: "memory");
        } else {
            XB_SPIN(xb_ld(&bar[XB_XGEN(b.x)]) == gen, bar);
            __builtin_amdgcn_fence(__ATOMIC_ACQUIRE, "agent");
            asm volatile("s_waitcnt vmcnt(0)" ::: "memory");
        }
    }
    __syncthreads();
}

#ifndef PROBE_DUP
#define PROBE_DUP 0
#endif
struct ListOrder {
    int nM, nN, nwg, pm_off, L0, dL, n, extraL;
    __device__ __forceinline__ void init(int Mrows, int N, int pm_off_) { nM = Mrows / 256; nN = N / 256; nwg = nM * nN; pm_off = pm_off_; }
    __device__ __forceinline__ bool next(int i, pg8::Unit& u) const {
        int L; if (i < n) L = L0 + i * dL; else if (i == n && extraL >= 0) L = extraL; else return false;
        if (L >= nwg) return false;
        int wgid = L; { const int q = nwg / 8, r = nwg % 8, xcd = wgid % 8, off = wgid / 8; wgid = (xcd < r ? xcd * (q + 1) : r * (q + 1) + (xcd - r) * q) + off; }
        const int nig = 8 * nN, gid = wgid / nig, fm = gid * 8, gsz = (nM - fm) < 8 ? (nM - fm) : 8;
        u.pm = fm + ((wgid % nig) % gsz) + pm_off; u.pn = (wgid % nig) / gsz; return true;
    }
    __device__ __forceinline__ void a_ready(const pg8::Unit&) const {}
    __device__ __forceinline__ void done(const pg8::Unit&) const {}
};
__device__ __forceinline__ void flag_signal(unsigned* f, int tid) {
    asm volatile("s_waitcnt vmcnt(0)" ::: "memory");
    __syncthreads();
    if (tid == 0) { __builtin_amdgcn_fence(__ATOMIC_RELEASE, "agent"); asm volatile("s_waitcnt vmcnt(0)" ::: "memory"); (void)xb_add(f, 1u); }
}
__device__ __forceinline__ void flag_wait(unsigned* f, unsigned n, int tid) {
    if (tid == 0) { unsigned sp = 0u; while (xb_ld(f) < n) { __builtin_amdgcn_s_sleep(4); if (++sp > (1u << 16)) break; }
        __builtin_amdgcn_fence(__ATOMIC_ACQUIRE, "agent"); asm volatile("s_waitcnt vmcnt(0)" ::: "memory"); }
    __syncthreads();
}
enum { K_NONE = 0, K_RETIN, K_RES, K_SWIGLU, K_SWAIN };
constexpr int NSTEPS = 21;
__global__ void __launch_bounds__(NTHR) hybrid_fwd(Params p) {
    extern __shared__ __attribute__((aligned(16))) unsigned char lds_raw[];
    LAS unsigned char* lds = (LAS unsigned char*)lds_raw;
    cg::grid_group grid = cg::this_grid();
    const int tid = threadIdx.x, lane = tid & 63, wave = __builtin_amdgcn_readfirstlane(tid >> 6);
    const int G = gridDim.x, c = blockIdx.x, vcu = (c % 8) * (G / 8) + c / 8;
    unsigned char* ws = p.ws; float* out = p.out;
    bf16* XB = (bf16*)(ws + WS_XB); bf16* BIG = (bf16*)(ws + WS_BIG); bf16* OB = (bf16*)(ws + WS_OB);
    float* ss = (float*)(ws + WS_SS); float* sso = (float*)(ws + WS_SSO);
    unsigned* ctl = (unsigned*)(ws + WS_CTL);
    unsigned* F1 = ctl + 4096; unsigned* F3 = ctl + 4096 + 64; unsigned* F4 = ctl + 4096 + 128; unsigned* F5 = ctl + 4096 + 192;
    volatile LAS unsigned* bst = (volatile LAS unsigned*)(lds + LDS_BYTES - 64);
    if (tid < 2) bst[tid] = 0u;
    __syncthreads();
    XcdBarrier bar = xcd_barrier_post(ctl, bst);
    const bool hi8 = (c >= 248), mid44 = (c >= 144 && c < 188);
    float* outS = out + (size_t)NP * DM;
#define GEMM_RES(Aptr, Wptr, Kc, E_)   do { pg8::Gemm g_{Aptr, (const bf16*)(ws + Wptr), MT, 1024, Kc}; pg8::gemm_phase<pg8::EpiRes, ListOrder, true, true>(lds, g_, S, E_); } while (0)
#define GEMM_SWIGLU(Wptr, ssp)         do { pg8::Gemm g_{XB, (const bf16*)(ws + Wptr), MT, 5632, 1024}; pg8::EpiSwiglu E_{BIG, ssp}; pg8::gemm_phase<pg8::EpiSwiglu, ListOrder, true, true>(lds, g_, S, E_); } while (0)
#define GEMM_SWAIN()                   do { pg8::Gemm g_{XB, (const bf16*)(ws + WS_WSI), MT, 1536, 1024}; \
        pg8::EpiSwaIn E_{BIG, ss + 2 * MT, (const float*)(ws + WS_TSC), (const float*)(ws + WS_TSS), p.in[11], p.in[12], out + OUT_KP, out + OUT_VP, out + OUT_KS, out + OUT_VS}; \
        pg8::gemm_phase<pg8::EpiSwaIn, ListOrder, true, true>(lds, g_, S, E_); } while (0)
    const int lo_ = p.ph_lo, hi_ = p.ph_hi;
#if defined(PROBE_T)
    unsigned long long pt0 = 0, pt1 = 0;
#endif
#define IN(k) (lo_ <= (k) && (k) < hi_)
#define SEAM(k, kind) do { if (IN((k) + 1)) { if ((kind) == 2 && G != 256) grid.sync(); else if ((kind) >= 1) xcd_barrier(bar); } } while (0)
#if defined(PROBE_T)
    if (PROBE_T == 0 && c == 0 && tid == 0) pt0 = __builtin_amdgcn_s_memrealtime();
#endif
    if (IN(0)) { ListOrder S; S.init(NP, 1024, 0); S.L0 = c; S.dL = 256; S.n = 0; S.extraL = -1;
       p0_prologue(p, lds, tid, lane, wave, vcu, G, 0, 0, 0);
#if PROBE_DUP & 1
            __syncthreads(); p0_prologue(p, lds, tid, lane, wave, vcu, G, 0, 0, 0);
#endif
        SEAM(0, 2); }
#if defined(PROBE_T)
    if (PROBE_T == 0 && c == 0 && tid == 0) pt1 = __builtin_amdgcn_s_memrealtime();
#endif
#if defined(PROBE_T)
    if (PROBE_T == 1 && c == 0 && tid == 0) pt0 = __builtin_amdgcn_s_memrealtime();
#endif
    if (IN(1)) { ListOrder S; S.init(NP, 1024, 0); S.L0 = c; S.dL = 256; S.n = 0; S.extraL = -1;
       { pg8::Gemm g_{XB, (const bf16*)(ws + WS_WRI), MT, 6144, 1024};
                  pg8::EpiRetIn E_{BIG, ss, (const float*)(ws + WS_TRC), (const float*)(ws + WS_TRS)};
                  if (c >= 208) { S.init(NS, 6144, 64); S.L0 = c - 208; S.n = 1; pg8::gemm_phase<pg8::EpiRetIn, ListOrder, true, true>(lds, g_, S, E_); }
                  else { p0_prologue(p, lds, tid, lane, wave, vcu, G, 1, c, 208); __syncthreads(); }
                  S.init(NP, 6144, 0); S.L0 = c; S.n = 6;
                  pg8::gemm_phase<pg8::EpiRetIn, ListOrder, true, true>(lds, g_, S, E_); }
        SEAM(1, 1); }
#if defined(PROBE_T)
    if (PROBE_T == 1 && c == 0 && tid == 0) pt1 = __builtin_amdgcn_s_memrealtime();
#endif
#if defined(PROBE_T)
    if (PROBE_T == 2 && c == 0 && tid == 0) pt0 = __builtin_amdgcn_s_memrealtime();
#endif
    if (IN(2)) { ListOrder S; S.init(NP, 1024, 0); S.L0 = c; S.dL = 256; S.n = 0; S.extraL = -1;

#if defined(PROBE_T)
            if (PROBE_T == 102 && c == 0 && tid == 0) pt0 = __builtin_amdgcn_s_memrealtime();
#endif
            for (int u = vcu; u < 256; u += G) ret_prompt_unit(lds, BIG, OB, (float*)(ws + WS_SSOP), out + OUT_SP, u >> 3, u & 7, p.lg2[(u >> 3) & 3], tid);
            __syncthreads();
#if defined(PROBE_T)
            if (PROBE_T == 102 && c == 0 && tid == 0) pt1 = __builtin_amdgcn_s_memrealtime();
            if (PROBE_T == 103 && c == 0 && tid == 0) pt0 = __builtin_amdgcn_s_memrealtime();
#endif
            for (int u = vcu; u < 512; u += G) ret_sample_unit(lds, BIG, OB, p.in[2], out + OUT_SS, u, p.lg2[u & 3], tid);
#if defined(PROBE_T)
            if (PROBE_T == 103 && c == 0 && tid == 0) pt1 = __builtin_amdgcn_s_memrealtime();
#endif


        SEAM(2, 1); }
#if defined(PROBE_T)
    if (PROBE_T == 2 && c == 0 && tid == 0) pt1 = __builtin_amdgcn_s_memrealtime();
#endif
#if defined(PROBE_T)
    if (PROBE_T == 3 && c == 0 && tid == 0) pt0 = __builtin_amdgcn_s_memrealtime();
#endif
    if (IN(3)) { ListOrder S; S.init(NP, 1024, 0); S.L0 = c; S.dL = 256; S.n = 0; S.extraL = -1;
        SEAM(3, 0); }
#if defined(PROBE_T)
    if (PROBE_T == 3 && c == 0 && tid == 0) pt1 = __builtin_amdgcn_s_memrealtime();
#endif
#if defined(PROBE_T)
    if (PROBE_T == 4 && c == 0 && tid == 0) pt0 = __builtin_amdgcn_s_memrealtime();
#endif
    if (IN(4)) { ListOrder S; S.init(NP, 1024, 0); S.L0 = c; S.dL = 256; S.n = 0; S.extraL = -1;
       { S.n = 1; LAS float* HT = (LAS float*)(lds + 131072); LAS float* HS4 = HT + 1024;
         { pg8::Unit u0; S.next(0, u0); const float* pp = (const float*)(ws + WS_SSOP) + ((size_t)(u0.pm * 256 + (tid >> 1)) * 4 + (tid & 1) * 2) * 16;
#pragma unroll
           for (int hh = 0; hh < 2; ++hh) { const f32x4* q4 = (const f32x4*)(pp + hh * 16); const f32x4 a = (q4[0] + q4[1]) + (q4[2] + q4[3]);
               HS4[(tid >> 1) * 4 + (tid & 1) * 2 + hh] = __builtin_amdgcn_rsqf(((a[0] + a[1]) + (a[2] + a[3])) * (1.0f / 512.0f) + EPS); }
           __syncthreads();
           if (tid < 256) { const f32x4 s4 = *(const LAS f32x4*)(HS4 + tid * 4); *(LAS f32x4*)(HT + tid * 4) = (f32x4){s4[0] / s4[1], s4[1] / s4[2], s4[2] / s4[3], s4[3]}; }
           __syncthreads(); }
         pg8::EpiRes E_{XB, nullptr, ss + MT, HT}; pg8::Gemm g_{OB, (const bf16*)(ws + WS_WRO), MT, 1024, 2048};
         pg8::gemm_phase<pg8::EpiRes, ListOrder, true, true, true>(lds, g_, S, E_, HT); }
        SEAM(4, 1); }
#if defined(PROBE_T)
    if (PROBE_T == 4 && c == 0 && tid == 0) pt1 = __builtin_amdgcn_s_memrealtime();
#endif
#if defined(PROBE_T)
    if (PROBE_T == 5 && c == 0 && tid == 0) pt0 = __builtin_amdgcn_s_memrealtime();
#endif
    if (IN(5)) { ListOrder S; S.init(NP, 1024, 0); S.L0 = c; S.dL = 256; S.n = 0; S.extraL = -1;
       { S.init(NS, 1024, 64); S.L0 = c - 248; S.n = hi8 ? 1 : 0; pg8::EpiRes E_{XB, nullptr, ss + MT, nullptr}; GEMM_RES(OB, WS_WRO, 2048, E_); if (hi8) flag_signal(F1, tid); }
        SEAM(5, 0); }
#if defined(PROBE_T)
    if (PROBE_T == 5 && c == 0 && tid == 0) pt1 = __builtin_amdgcn_s_memrealtime();
#endif
#if defined(PROBE_T)
    if (PROBE_T == 6 && c == 0 && tid == 0) pt0 = __builtin_amdgcn_s_memrealtime();
#endif
    if (IN(6)) { ListOrder S; S.init(NP, 1024, 0); S.L0 = c; S.dL = 256; S.n = 0; S.extraL = -1;
       { S.init(NP, 5632, 0);
                  if (hi8) S.n = 3; else if (c >= 128 && c < 144) { S.n = 5; S.extraL = (3 + (c - 128) / 8) * 256 + 248 + (c - 128) % 8; } else S.n = (c < 128) ? 6 : 5;
                  GEMM_SWIGLU(WS_WFI0, ss + MT); }
        SEAM(6, 0); }
#if defined(PROBE_T)
    if (PROBE_T == 6 && c == 0 && tid == 0) pt1 = __builtin_amdgcn_s_memrealtime();
#endif
#if defined(PROBE_T)
    if (PROBE_T == 7 && c == 0 && tid == 0) pt0 = __builtin_amdgcn_s_memrealtime();
#endif
    if (IN(7)) { ListOrder S; S.init(NP, 1024, 0); S.L0 = c; S.dL = 256; S.n = 0; S.extraL = -1;
       { S.init(NS, 5632, 64); S.L0 = c - 144; S.n = mid44 ? 1 : 0; if (mid44) flag_wait(F1, 8u, tid); GEMM_SWIGLU(WS_WFI0, ss + MT); }
        SEAM(7, 1); }
#if defined(PROBE_T)
    if (PROBE_T == 7 && c == 0 && tid == 0) pt1 = __builtin_amdgcn_s_memrealtime();
#endif
#if defined(PROBE_T)
    if (PROBE_T == 8 && c == 0 && tid == 0) pt0 = __builtin_amdgcn_s_memrealtime();
#endif
    if (IN(8)) { ListOrder S; S.init(NP, 1024, 0); S.L0 = c; S.dL = 256; S.n = 0; S.extraL = -1;
       { S.n = 1; pg8::EpiRes E_{XB, nullptr, ss + 2 * MT, nullptr}; GEMM_RES(BIG, WS_WFO0, 2816, E_); }
        SEAM(8, 1); }
#if defined(PROBE_T)
    if (PROBE_T == 8 && c == 0 && tid == 0) pt1 = __builtin_amdgcn_s_memrealtime();
#endif
#if defined(PROBE_T)
    if (PROBE_T == 9 && c == 0 && tid == 0) pt0 = __builtin_amdgcn_s_memrealtime();
#endif
    if (IN(9)) { ListOrder S; S.init(NP, 1024, 0); S.L0 = c; S.dL = 256; S.n = 0; S.extraL = -1;
       { S.init(NS, 1024, 64); S.L0 = c - 248; S.n = hi8 ? 1 : 0; pg8::EpiRes E_{XB, nullptr, ss + 2 * MT, nullptr}; GEMM_RES(BIG, WS_WFO0, 2816, E_); }
        SEAM(9, 0); }
#if defined(PROBE_T)
    if (PROBE_T == 9 && c == 0 && tid == 0) pt1 = __builtin_amdgcn_s_memrealtime();
#endif
#if defined(PROBE_T)
    if (PROBE_T == 10 && c == 0 && tid == 0) pt0 = __builtin_amdgcn_s_memrealtime();
#endif
    if (IN(10)) { ListOrder S; S.init(NP, 1024, 0); S.L0 = c; S.dL = 256; S.n = 0; S.extraL = -1;
       { S.init(NP, 1536, 0);
                   if (hi8) S.n = 0; else if (c < 128) S.n = 2; else { S.n = 1; if (c < 136) S.extraL = 248 + (c - 128); }
                   GEMM_SWAIN(); }
        SEAM(10, 1); }
#if defined(PROBE_T)
    if (PROBE_T == 10 && c == 0 && tid == 0) pt1 = __builtin_amdgcn_s_memrealtime();
#endif
#if defined(PROBE_T)
    if (PROBE_T == 11 && c == 0 && tid == 0) pt0 = __builtin_amdgcn_s_memrealtime();
#endif
    if (IN(11)) { ListOrder S; S.init(NP, 1024, 0); S.L0 = c; S.dL = 256; S.n = 0; S.extraL = -1;
       { const bool m12 = (c >= 236 && c < 248); S.init(NS, 1536, 64); S.L0 = c - 236; S.n = m12 ? 1 : 0; GEMM_SWAIN(); if (m12) flag_signal(F3, tid); }
        SEAM(11, 0); }
#if defined(PROBE_T)
    if (PROBE_T == 11 && c == 0 && tid == 0) pt1 = __builtin_amdgcn_s_memrealtime();
#endif
#if defined(PROBE_T)
    if (PROBE_T == 12 && c == 0 && tid == 0) pt0 = __builtin_amdgcn_s_memrealtime();
#endif
    if (IN(12)) { ListOrder S; S.init(NP, 1024, 0); S.L0 = c; S.dL = 256; S.n = 0; S.extraL = -1;
       for (int u = vcu; u < 512; u += G) attn_prompt_unit(lds, BIG, OB, p.in[13], u, tid);
        SEAM(12, 0); }
#if defined(PROBE_T)
    if (PROBE_T == 12 && c == 0 && tid == 0) pt1 = __builtin_amdgcn_s_memrealtime();
#endif
#if defined(PROBE_T)
    if (PROBE_T == 13 && c == 0 && tid == 0) pt0 = __builtin_amdgcn_s_memrealtime();
#endif
    if (IN(13)) { ListOrder S; S.init(NP, 1024, 0); S.L0 = c; S.dL = 256; S.n = 0; S.extraL = -1;
       flag_wait(F3, 12u, tid);
                 if (!(c >= 236 && c < 248)) {
                     attn_sample_pair(lds, BIG, OB, p.in[13], p.in[3], p.in[4], out + OUT_KS, out + OUT_VS, vcu, vcu + 256, tid);
                     if (c < 12) { const int c2 = 236 + c, v2 = (c2 % 8) * (G / 8) + c2 / 8; attn_sample_pair(lds, BIG, OB, p.in[13], p.in[3], p.in[4], out + OUT_KS, out + OUT_VS, v2, v2 + 256, tid); } }
        SEAM(13, 1); }
#if defined(PROBE_T)
    if (PROBE_T == 13 && c == 0 && tid == 0) pt1 = __builtin_amdgcn_s_memrealtime();
#endif
#if defined(PROBE_T)
    if (PROBE_T == 14 && c == 0 && tid == 0) pt0 = __builtin_amdgcn_s_memrealtime();
#endif
    if (IN(14)) { ListOrder S; S.init(NP, 1024, 0); S.L0 = c; S.dL = 256; S.n = 0; S.extraL = -1;
       { S.n = 1; pg8::EpiRes E_{XB, nullptr, ss + 3 * MT, nullptr}; GEMM_RES(OB, WS_WSO, 1024, E_); }
        SEAM(14, 1); }
#if defined(PROBE_T)
    if (PROBE_T == 14 && c == 0 && tid == 0) pt1 = __builtin_amdgcn_s_memrealtime();
#endif
#if defined(PROBE_T)
    if (PROBE_T == 15 && c == 0 && tid == 0) pt0 = __builtin_amdgcn_s_memrealtime();
#endif
    if (IN(15)) { ListOrder S; S.init(NP, 1024, 0); S.L0 = c; S.dL = 256; S.n = 0; S.extraL = -1;
       { S.init(NS, 1024, 64); S.L0 = c - 248; S.n = hi8 ? 1 : 0; pg8::EpiRes E_{XB, nullptr, ss + 3 * MT, nullptr}; GEMM_RES(OB, WS_WSO, 1024, E_); if (hi8) flag_signal(F4, tid); }
        SEAM(15, 0); }
#if defined(PROBE_T)
    if (PROBE_T == 15 && c == 0 && tid == 0) pt1 = __builtin_amdgcn_s_memrealtime();
#endif
#if defined(PROBE_T)
    if (PROBE_T == 16 && c == 0 && tid == 0) pt0 = __builtin_amdgcn_s_memrealtime();
#endif
    if (IN(16)) { ListOrder S; S.init(NP, 1024, 0); S.L0 = c; S.dL = 256; S.n = 0; S.extraL = -1;
       { S.init(NP, 5632, 0);
                   if (hi8 || mid44) S.n = 1; else if (c < 128) S.n = 6; else { S.n = 5; int j = -1; if (c < 144) j = c - 128; else if (c >= 188 && c < 204) j = 16 + (c - 188); if (j >= 0) S.extraL = (1 + j / 8) * 256 + 248 + j % 8; }
                   GEMM_SWIGLU(WS_WFI1, ss + 3 * MT); }
        SEAM(16, 0); }
#if defined(PROBE_T)
    if (PROBE_T == 16 && c == 0 && tid == 0) pt1 = __builtin_amdgcn_s_memrealtime();
#endif
#if defined(PROBE_T)
    if (PROBE_T == 17 && c == 0 && tid == 0) pt0 = __builtin_amdgcn_s_memrealtime();
#endif
    if (IN(17)) { ListOrder S; S.init(NP, 1024, 0); S.L0 = c; S.dL = 256; S.n = 0; S.extraL = -1;
       { S.init(NS, 5632, 64); S.L0 = c - 144; S.n = mid44 ? 1 : 0; if (mid44) flag_wait(F4, 8u, tid); GEMM_SWIGLU(WS_WFI1, ss + 3 * MT); if (mid44) flag_signal(F5, tid); }
        SEAM(17, 0); }
#if defined(PROBE_T)
    if (PROBE_T == 17 && c == 0 && tid == 0) pt1 = __builtin_amdgcn_s_memrealtime();
#endif
#if defined(PROBE_T)
    if (PROBE_T == 18 && c == 0 && tid == 0) pt0 = __builtin_amdgcn_s_memrealtime();
#endif
    if (IN(18)) { ListOrder S; S.init(NP, 1024, 0); S.L0 = c; S.dL = 256; S.n = 0; S.extraL = -1;
       { S.init(NS, 1024, 64); S.L0 = c - 248; S.n = hi8 ? 1 : 0; if (hi8) flag_wait(F5, 44u, tid); pg8::EpiRes E_{XB, out, nullptr, nullptr}; GEMM_RES(BIG, WS_WFO1, 2816, E_); }
        SEAM(18, 0); }
#if defined(PROBE_T)
    if (PROBE_T == 18 && c == 0 && tid == 0) pt1 = __builtin_amdgcn_s_memrealtime();
#endif
#if defined(PROBE_T)
    if (PROBE_T == 19 && c == 0 && tid == 0) pt0 = __builtin_amdgcn_s_memrealtime();
#endif
    if (IN(19)) { ListOrder S; S.init(NP, 1024, 0); S.L0 = c; S.dL = 256; S.n = 0; S.extraL = -1;
       { S.init(NP, 5632, 0); S.L0 = 256 + c; S.n = mid44 ? 4 : 0; GEMM_SWIGLU(WS_WFI1, ss + 3 * MT); }
        SEAM(19, 1); }
#if defined(PROBE_T)
    if (PROBE_T == 19 && c == 0 && tid == 0) pt1 = __builtin_amdgcn_s_memrealtime();
#endif
#if defined(PROBE_T)
    if (PROBE_T == 20 && c == 0 && tid == 0) pt0 = __builtin_amdgcn_s_memrealtime();
#endif
    if (IN(20)) { ListOrder S; S.init(NP, 1024, 0); S.L0 = c; S.dL = 256; S.n = 0; S.extraL = -1;
       { S.n = 1; pg8::EpiRes E_{XB, out, nullptr, nullptr}; GEMM_RES(BIG, WS_WFO1, 2816, E_); }
        SEAM(20, 0); }
#if defined(PROBE_T)
    if (PROBE_T == 20 && c == 0 && tid == 0) pt1 = __builtin_amdgcn_s_memrealtime();
#endif
#undef IN
#undef SEAM
#if defined(PROBE_T)
    if (c == 0 && tid == 0) { const unsigned long long te = __builtin_amdgcn_s_memrealtime(), d = (pt1 - pt0) * 4ull; while (__builtin_amdgcn_s_memrealtime() - te < d) __builtin_amdgcn_s_sleep(8); }
#endif
}

#ifndef N_LAUNCHES
#define N_LAUNCHES 1
#endif
extern "C" void kernel_launch(void* const* d_in, const int* in_sizes, int n_in, void* d_out, int out_size, void* d_ws, size_t ws_size, hipStream_t stream) {
    static int grid = 0;
    if (grid == 0) {
        if (n_in != 16 || (size_t)out_size != OUT_END || ws_size < WS_TOTAL) { fprintf(stderr, "kernel_launch: unexpected shapes (n_in %d out %d ws %zu need %zu)\n", n_in, out_size, ws_size, (size_t)WS_TOTAL); grid = -1; return; }
        int dev = 0, cus = 0, per_cu = 0;
        (void)hipGetDevice(&dev); (void)hipDeviceGetAttribute(&cus, hipDeviceAttributeMultiprocessorCount, dev);
        if (hipFuncSetAttribute((const void*)hybrid_fwd, hipFuncAttributeMaxDynamicSharedMemorySize, LDS_BYTES) != hipSuccess) { fprintf(stderr, "kernel_launch: hipFuncSetAttribute failed\n"); grid = -1; return; }
        if (hipOccupancyMaxActiveBlocksPerMultiprocessor(&per_cu, (const void*)hybrid_fwd, NTHR, LDS_BYTES) != hipSuccess || per_cu < 1) { fprintf(stderr, "kernel_launch: occupancy query says %d\n", per_cu); per_cu = 1; }
        (void)hipGetLastError();
        grid = cus * 1;
        if (grid != 256) { fprintf(stderr, "kernel_launch: built for a 256-CU device (got %d)\n", cus); grid = -1; return; }
    }
    if (grid < 0) return;
    if (hipMemsetAsync((char*)d_ws + WS_CTL, 0, CTL_BYTES, stream) != hipSuccess) { fprintf(stderr, "kernel_launch: memset failed\n"); return; }
    Params p; memset(&p, 0, sizeof(p));
    for (int i = 0; i < 16; ++i) p.in[i] = (const float*)d_in[i];
    p.out = (float*)d_out; p.ws = (unsigned char*)d_ws;
    const double two_pi = 6.283185307179586476925286766559;
    for (int i = 0; i < 128; ++i) p.invR[i] = 1.0 / std::pow(10000.0, (double)i / 127.0) / two_pi;
    for (int i = 0; i < 32; ++i) p.invS[i] = 1.0 / std::pow(10000.0, (double)(2 * i) / 64.0) / two_pi;
    for (int h = 0; h < 4; ++h) p.lg2[h] = (float)std::log2(1.0 - std::ldexp(1.0, -5 - h));
#if N_LAUNCHES == 1
    p.ph_lo = 0; p.ph_hi = NSTEPS;
    void* args[] = {&p};
    hipError_t e = hipLaunchCooperativeKernel((const void*)hybrid_fwd, dim3(grid), dim3(NTHR), args, LDS_BYTES, stream);
    if (e != hipSuccess) fprintf(stderr, "kernel_launch: cooperative launch failed: %s (grid %d)\n", hipGetErrorString(e), grid);
#else
    for (int ph = 0; ph < NSTEPS; ++ph) { p.ph_lo = ph; p.ph_hi = ph + 1; hipLaunchKernelGGL(hybrid_fwd, dim3(grid), dim3(NTHR), LDS_BYTES, stream, p); }
#endif
}
```

```cpp
#include <hip/hip_runtime.h>
#include <hip/hip_cooperative_groups.h>
#include <cstdio>
#include <cstdint>
#include <cmath>
#include <cstring>
namespace cg = cooperative_groups;
namespace pg8 {
#define PG8_LAS __attribute__((address_space(3)))
typedef unsigned short bf16_t;
typedef short bf16x8 __attribute__((ext_vector_type(8)));
typedef float f32x4 __attribute__((ext_vector_type(4)));
typedef unsigned u32x4 __attribute__((ext_vector_type(4)));
constexpr int BM = 256, BK = 64, HALF = 128, HTB = HALF * BK * 2  , STAGE_BYTES = 8 * HTB, NXCD = 8, WGM = 8;

__host__ __device__ __forceinline__ int lds_byte(int r, int c) { const int st = (r >> 4) * 2 + (c >> 5), rr = r & 15, cc = c & 31, ob = rr * 64 + cc * 2; return st * 1024 + (ob ^ (((ob >> 9) & 1) << 5)); }
__host__ __device__ __forceinline__ void stage_rc(int b, int& R, int& C) { const int st = b / 1024, sb = b % 1024, swz = sb ^ (((sb >> 9) & 1) << 5); R = (st >> 1) * 16 + swz / 64; C = (st & 1) * 32 + (swz % 64) / 2; }
__host__ __device__ __forceinline__ int perm32(int rho) { const int n = rho >> 4, i = rho & 15; return 8 * (i >> 2) + 4 * n + (i & 3); }

struct Unit { int pm, pn; };
struct Gemm { const bf16_t* A; const bf16_t* Bt; int M, N, K; };

struct StaticOrder {
    int nM, nN, nwg, G, c;
    __host__ __device__ void init(int M, int N, int G_, int c_) { nM = M / BM; nN = N / BM; nwg = nM * nN; G = G_; c = c_; }
    __host__ __device__ bool next(int i, Unit& u) const {
        const long L = (long)i * G + c; if (L >= nwg) return false;
        int wgid = (int)L; { const int q = nwg / NXCD, r = nwg % NXCD, xcd = wgid % NXCD, off = wgid / NXCD; wgid = (xcd < r ? xcd * (q + 1) : r * (q + 1) + (xcd - r) * q) + off; }
        const int nig = WGM * nN, gid = wgid / nig, fm = gid * WGM, gsz = (nM - fm) < WGM ? (nM - fm) : WGM;
        u.pm = fm + ((wgid % nig) % gsz); u.pn = (wgid % nig) / gsz; return true;
    }
    __device__ __forceinline__ void a_ready(const Unit&) const {}
    __device__ __forceinline__ void done(const Unit&) const {}
};

__device__ __forceinline__ unsigned cvt_pk_bf16(float lo, float hi) { unsigned r; asm volatile("v_cvt_pk_bf16_f32 %0, %1, %2" : "=v"(r) : "v"(lo), "v"(hi)); return r; }
typedef float f32x2 __attribute__((ext_vector_type(2)));
constexpr int P_NP = 16384, P_D = 1024, P_MT = 16896;
constexpr float P_EPS = 1e-6f;
__device__ __forceinline__ float silu_f(float x) { return x * __builtin_amdgcn_rcpf(1.0f + __expf(-x)); }
__device__ __forceinline__ float row_rstd(const float* ssp, int row) {
    const f32x4* pp = (const f32x4*)(ssp + (size_t)row * 16); const f32x4 a = (pp[0] + pp[1]) + (pp[2] + pp[3]);
    return __builtin_amdgcn_rsqf(((a[0] + a[1]) + (a[2] + a[3])) * (1.0f / 1024.0f) + P_EPS);
}
__device__ __forceinline__ int pos_index(int row) { return row < P_NP ? (row & 2047) : 2048 + (row & 3); }
__device__ __forceinline__ u32x4 pack8(const f32x4 a, const f32x4 b) { u32x4 w; w.x = cvt_pk_bf16(a[0], a[1]); w.y = cvt_pk_bf16(a[2], a[3]); w.z = cvt_pk_bf16(b[0], b[1]); w.w = cvt_pk_bf16(b[2], b[3]); return w; }

struct EpiRetIn {
    static constexpr bool PERM = true, AFTER_DRAIN = false;
    bf16_t* O; const float* ss; const float* cosT; const float* sinT;
    __device__ __forceinline__ void operator()(const f32x4 (&acc)[2][2][4][2], const Unit& u, int wr, int wc, int fr, int fq) const {
        const int pn = u.pn, ci = wc * 32 + 8 * fq;
#pragma unroll
        for (int ai = 0; ai < 2; ++ai)
#pragma unroll
            for (int m = 0; m < 4; ++m) {
                const int row = u.pm * BM + ai * HALF + wr * 64 + m * 16 + fr;
                const float rstd = __builtin_amdgcn_rsqf(ss[row] * (1.0f / 1024.0f) + P_EPS);
                bf16_t* rowp;
                if (pn < 8) rowp = O + ((size_t)pn * P_MT + row) * 256 + ci;
                else { const int q_ = pn - 8; rowp = O + (size_t)8 * P_MT * 256 + ((size_t)(q_ >> 1) * P_MT + row) * 512 + (q_ & 1) * 256 + ci; }
                if (pn < 8) {
                    const int pidx = pos_index(row);
                    const f32x4* cp = (const f32x4*)(cosT + pidx * 128 + ci); const f32x4* sp = (const f32x4*)(sinT + pidx * 128 + ci);
                    const float sc = (pn >= 4) ? rstd * 0.0625f : rstd;
                    f32x4 o1[2], o2[2];
#pragma unroll
                    for (int n = 0; n < 2; ++n) { const f32x4 c = cp[n], s = sp[n]; const f32x4 x1 = acc[ai][0][m][n] * sc, x2 = acc[ai][1][m][n] * sc; o1[n] = x1 * c - x2 * s; o2[n] = x2 * c + x1 * s; }
                    *(u32x4*)(rowp) = pack8(o1[0], o1[1]); *(u32x4*)(rowp + HALF) = pack8(o2[0], o2[1]);
                } else if (pn < 16) {
#pragma unroll
                    for (int bj = 0; bj < 2; ++bj) *(u32x4*)(rowp + bj * HALF) = pack8(acc[ai][bj][m][0] * rstd, acc[ai][bj][m][1] * rstd);
                } else {
#pragma unroll
                    for (int bj = 0; bj < 2; ++bj) { f32x4 a = acc[ai][bj][m][0] * rstd, b = acc[ai][bj][m][1] * rstd;
#pragma unroll
                        for (int j = 0; j < 4; ++j) { a[j] = silu_f(a[j]); b[j] = silu_f(b[j]); }
                        *(u32x4*)(rowp + bj * HALF) = pack8(a, b); }
                }
            }
    }
};
struct EpiRes {
    static constexpr bool PERM = true, AFTER_DRAIN = false;
    bf16_t* xb; float* outF; float* ssn; const PG8_LAS float* hs;
    __device__ __forceinline__ void operator()(const f32x4 (&acc)[2][2][4][2], const Unit& u, int wr, int wc, int fr, int fq) const {
        const int col0 = u.pn * BM + wc * 32 + 8 * fq;
#pragma unroll
        for (int ai = 0; ai < 2; ++ai)
#pragma unroll
            for (int m = 0; m < 4; ++m) {
                const int row = u.pm * BM + ai * HALF + wr * 64 + m * 16 + fr;
                bf16_t* xp = xb + (size_t)row * P_D + col0; float s = 0.f;
                const float hsc = hs ? hs[(ai * HALF + wr * 64 + m * 16 + fr) * 4 + 3] : 1.0f;
#pragma unroll
                for (int bj = 0; bj < 2; ++bj) {
                    const u32x4 rw = *(const u32x4*)(xp + bj * HALF);
                    const f32x4 r0 = (f32x4){__builtin_bit_cast(float, rw.x << 16), __builtin_bit_cast(float, rw.x & 0xffff0000u), __builtin_bit_cast(float, rw.y << 16), __builtin_bit_cast(float, rw.y & 0xffff0000u)};
                    const f32x4 r1 = (f32x4){__builtin_bit_cast(float, rw.z << 16), __builtin_bit_cast(float, rw.z & 0xffff0000u), __builtin_bit_cast(float, rw.w << 16), __builtin_bit_cast(float, rw.w & 0xffff0000u)};
                    const f32x4 v0 = r0 + acc[ai][bj][m][0] * hsc, v1 = r1 + acc[ai][bj][m][1] * hsc;
                    s += (v0[0] * v0[0] + v0[1] * v0[1]) + (v0[2] * v0[2] + v0[3] * v0[3]) + (v1[0] * v1[0] + v1[1] * v1[1]) + (v1[2] * v1[2] + v1[3] * v1[3]);
                    if (outF) { float* op = outF + (size_t)row * P_D + col0 + bj * HALF; *(f32x4*)(op) = v0; *(f32x4*)(op + 4) = v1; }
                    else *(u32x4*)(xp + bj * HALF) = pack8(v0, v1);
                }
                if (ssn) { s += __shfl_xor(s, 16); s += __shfl_xor(s, 32); if (fq == 0) atomicAdd(ssn + row, s); }
            }
    }
};
struct EpiSwiglu {
    static constexpr bool PERM = true, AFTER_DRAIN = false;
    bf16_t* H; const float* ss;
    __device__ __forceinline__ void operator()(const f32x4 (&acc)[2][2][4][2], const Unit& u, int wr, int wc, int fr, int fq) const {
        const int col0 = u.pn * HALF + wc * 32 + 8 * fq;
#pragma unroll
        for (int ai = 0; ai < 2; ++ai)
#pragma unroll
            for (int m = 0; m < 4; ++m) {
                const int row = u.pm * BM + ai * HALF + wr * 64 + m * 16 + fr;
                const float rstd = __builtin_amdgcn_rsqf(ss[row] * (1.0f / 1024.0f) + P_EPS);
                f32x4 h[2];
#pragma unroll
                for (int n = 0; n < 2; ++n) { const f32x4 g = acc[ai][0][m][n] * rstd, uu = acc[ai][1][m][n] * rstd;
#pragma unroll
                    for (int j = 0; j < 4; ++j) h[n][j] = silu_f(g[j]) * uu[j]; }
                *(u32x4*)(H + (size_t)row * 2816 + col0) = pack8(h[0], h[1]);
            }
    }
};
struct EpiSwaIn {
    static constexpr bool PERM = true, AFTER_DRAIN = false;
    bf16_t* O; const float* ss; const float* cosT; const float* sinT; const float* qg; const float* kg; float* kc_p; float* vc_p; float* kc_s; float* vc_s;
    __device__ __forceinline__ void operator()(const f32x4 (&acc)[2][2][4][2], const Unit& u, int wr, int wc, int fr, int fq) const {
        const int pn = u.pn;
        const float* G = (pn < 4) ? qg : kg;
        f32x4 g1[2], g2[2];
#pragma unroll
        for (int n = 0; n < 2; ++n) { g1[n] = *(const f32x4*)(G + 8 * fq + 4 * n); g2[n] = *(const f32x4*)(G + 32 + 8 * fq + 4 * n); }
        const int cbase = (pn < 4 ? (pn * 4 + wc) * 64 : (pn == 4 ? 1024 : 1280) + wc * 64) + 8 * fq;
#pragma unroll
        for (int ai = 0; ai < 2; ++ai)
#pragma unroll
            for (int m = 0; m < 4; ++m) {
                const int row = u.pm * BM + ai * HALF + wr * 64 + m * 16 + fr;
                const float rstd = __builtin_amdgcn_rsqf(ss[row] * (1.0f / 1024.0f) + P_EPS);
                bf16_t* rowp = O + (size_t)row * 1536 + cbase;
                float* cdst = nullptr;
                if (pn >= 4) {
                    float* cp_ = (pn == 4) ? kc_p : vc_p; float* cs_ = (pn == 4) ? kc_s : vc_s;
                    if (row < P_NP) { const int b = row >> 11, t = row & 2047; if (t >= 1920) cdst = cp_ + ((size_t)(b * 128 + (t - 1920)) * 4 + wc) * 64 + 8 * fq; }
                    else { const int s_ = row - P_NP, b = s_ >> 2, t = s_ & 3; cdst = cs_ + ((size_t)(b * 128 + 124 + t) * 4 + wc) * 64 + 8 * fq; }
                }
                f32x4 o1[2], o2[2];
                if (pn < 5) {
                    f32x4 x1[2], x2[2]; float q = 0.f;
#pragma unroll
                    for (int n = 0; n < 2; ++n) { x1[n] = acc[ai][0][m][n] * rstd; x2[n] = acc[ai][1][m][n] * rstd;
                        q += (x1[n][0] * x1[n][0] + x1[n][1] * x1[n][1]) + (x1[n][2] * x1[n][2] + x1[n][3] * x1[n][3]) + (x2[n][0] * x2[n][0] + x2[n][1] * x2[n][1]) + (x2[n][2] * x2[n][2] + x2[n][3] * x2[n][3]); }
                    q += __shfl_xor(q, 16); q += __shfl_xor(q, 32);
                    const float hr = __builtin_amdgcn_rsqf(q * (1.0f / 64.0f) + P_EPS);
                    const int pidx = pos_index(row);
                    const f32x4* cp = (const f32x4*)(cosT + pidx * 32 + 8 * fq); const f32x4* sp = (const f32x4*)(sinT + pidx * 32 + 8 * fq);
                    const float osc = (pn < 4) ? 0.125f : 1.0f;
#pragma unroll
                    for (int n = 0; n < 2; ++n) { const f32x4 c = cp[n], s = sp[n]; const f32x4 a = x1[n] * hr * g1[n], b = x2[n] * hr * g2[n]; o1[n] = (a * c - b * s) * osc; o2[n] = (b * c + a * s) * osc; }
                } else {
#pragma unroll
                    for (int n = 0; n < 2; ++n) { o1[n] = acc[ai][0][m][n] * rstd; o2[n] = acc[ai][1][m][n] * rstd; }
                }
                *(u32x4*)(rowp) = pack8(o1[0], o1[1]); *(u32x4*)(rowp + 32) = pack8(o2[0], o2[1]);
                if (cdst) { *(f32x4*)(cdst) = o1[0]; *(f32x4*)(cdst + 4) = o1[1]; *(f32x4*)(cdst + 32) = o2[0]; *(f32x4*)(cdst + 36) = o2[1]; }
            }
    }
};

template <class Epi, class Sched, bool ALIGN_EPI = false, bool SP2 = false, bool HS = false>
__device__ __forceinline__ void gemm_phase(PG8_LAS unsigned char* lds, const Gemm g, const Sched& S, const Epi& E, const PG8_LAS float* hs = nullptr) {
    const int tid = threadIdx.x, wid = __builtin_amdgcn_readfirstlane(tid >> 6), lane = tid & 63, wr = wid >> 2, wc = wid & 3, fr = lane & 15, fq = lane >> 4;
    const int K = g.K, nt = K / BK;
    unsigned voffA[2], voffB[2];
#pragma unroll
    for (int i = 0; i < 2; ++i) { int R, C; stage_rc(tid * 16 + i * 8192, R, C); const int Rb = Epi::PERM ? ((R & ~31) + perm32(R & 31)) : R;
        voffA[i] = (unsigned)(R * K + C) * 2u; voffB[i] = (unsigned)(Rb * K + C) * 2u; }
    const size_t kstep = (size_t)(BK * 2);
    const size_t hstep = (size_t)HALF * K * 2;
    const size_t tstep = 2 * hstep;
    const unsigned ldsw = (unsigned)wid * 1024u;
    const int aoff = lds_byte(wr * 64 + fr, fq * 8), boff = lds_byte(wc * 32 + fr, fq * 8);
#define PG8_SA(b, h) (((b) * 2 + (h)) * HTB)
#define PG8_SB(b, h) ((4 + (b) * 2 + (h)) * HTB)
#define PG8_STAGE(bufoff, gbase, voff) do { _Pragma("unroll") for (int _i = 0; _i < 2; ++_i) \
        __builtin_amdgcn_global_load_lds((const unsigned*)((const char*)(gbase) + (voff)[_i]), (PG8_LAS unsigned*)(lds + (bufoff) + ldsw + _i * 8192), 16, 0, 0); } while (0)
#define PG8_LDA(dst, b, h) do { _Pragma("unroll") for (int m = 0; m < 4; ++m) _Pragma("unroll") for (int k = 0; k < 2; ++k) dst[m][k] = *(const PG8_LAS bf16x8*)(lds + PG8_SA(b, h) + aoff + m * 2048 + k * 1024); } while (0)
#define PG8_LDB(dst, b, h) do { _Pragma("unroll") for (int n = 0; n < 2; ++n) _Pragma("unroll") for (int k = 0; k < 2; ++k) dst[n][k] = *(const PG8_LAS bf16x8*)(lds + PG8_SB(b, h) + boff + n * 2048 + k * 1024); } while (0)
#define PG8_MMA(ai, bj, At, Bt) do { __builtin_amdgcn_s_setprio(1); _Pragma("unroll") for (int m = 0; m < 4; ++m) _Pragma("unroll") for (int n = 0; n < 2; ++n) _Pragma("unroll") for (int k = 0; k < 2; ++k) \
        acc[ai][bj][m][n] = __builtin_amdgcn_mfma_f32_16x16x32_bf16(Bt[n][k], At[m][k], acc[ai][bj][m][n], 0, 0, 0); __builtin_amdgcn_s_setprio(0); } while (0)
#define PG8_WAIT_V(n) asm volatile("s_waitcnt vmcnt(" #n ")" ::: "memory")
#define PG8_WAIT_L(n) asm volatile("s_waitcnt lgkmcnt(" #n ")" ::: "memory")
#define PG8_BAR __builtin_amdgcn_s_barrier()
#define PG8_SCHED __builtin_amdgcn_sched_barrier(0)
    Unit cur, nxt; int ui = 0;
    if (!S.next(0, cur)) return;
    f32x4 acc[2][2][4][2];
#pragma unroll
    for (int a = 0; a < 2; ++a)
#pragma unroll
        for (int b = 0; b < 2; ++b)
#pragma unroll
            for (int m = 0; m < 4; ++m)
#pragma unroll
                for (int n = 0; n < 2; ++n) acc[a][b][m][n] = (f32x4){0.f, 0.f, 0.f, 0.f};
    bf16x8 At[4][2], B0[2][2], B1[2][2];
    const char* cA = (const char*)g.A + (size_t)cur.pm * tstep; const char* cB = (const char*)g.Bt + (size_t)cur.pn * tstep;
    S.a_ready(cur);
    if constexpr (SP2) {
        PG8_STAGE(PG8_SB(0, 0), cB, voffB); PG8_STAGE(PG8_SB(0, 1), cB + hstep, voffB); PG8_STAGE(PG8_SA(0, 0), cA, voffA); PG8_STAGE(PG8_SA(0, 1), cA + hstep, voffA);
        if (wr == 1) PG8_BAR;
        PG8_WAIT_V(2); PG8_BAR;
        PG8_STAGE(PG8_SB(1, 0), cB + kstep, voffB); PG8_STAGE(PG8_SA(1, 0), cA + kstep, voffA); PG8_STAGE(PG8_SB(1, 1), cB + hstep + kstep, voffB);
        PG8_WAIT_V(6); PG8_BAR;
    } else {
        PG8_STAGE(PG8_SB(0, 0), cB, voffB); PG8_STAGE(PG8_SA(0, 0), cA, voffA); PG8_STAGE(PG8_SB(0, 1), cB + hstep, voffB); PG8_STAGE(PG8_SA(0, 1), cA + hstep, voffA);
        if (wr == 1) PG8_BAR;
        PG8_WAIT_V(4); PG8_BAR;
        PG8_STAGE(PG8_SB(1, 0), cB + kstep, voffB); PG8_STAGE(PG8_SA(1, 0), cA + kstep, voffA); PG8_STAGE(PG8_SB(1, 1), cB + hstep + kstep, voffB);
        PG8_WAIT_V(6); PG8_BAR;
    }
    for (;;) {
        const bool has_next = S.next(ui + 1, nxt);
        const char* nA = has_next ? (const char*)g.A + (size_t)nxt.pm * tstep : cA; const char* nB = has_next ? (const char*)g.Bt + (size_t)nxt.pn * tstep : cB;
        for (int t = 0; t < nt; t += 2) {
            if constexpr (HS) { if (t == 8 || t == 16 || t == 24) { const int hb_ = (t >> 3) - 1;
#pragma unroll
                for (int ai = 0; ai < 2; ++ai)
#pragma unroll
                    for (int m = 0; m < 4; ++m) { const float rt_ = hs[(ai * HALF + wr * 64 + m * 16 + fr) * 4 + hb_];
#pragma unroll
                        for (int bj = 0; bj < 2; ++bj)
#pragma unroll
                            for (int n = 0; n < 2; ++n) acc[ai][bj][m][n] = acc[ai][bj][m][n] * rt_; } } }
            const bool last = (t == nt - 2);
            const char* a1 = cA + (size_t)(t + 1) * kstep;
            const char* a2 = last ? nA : cA + (size_t)(t + 2) * kstep; const char* b2 = last ? nB : cB + (size_t)(t + 2) * kstep;
            const char* a3 = a2 + kstep; const char* b3 = b2 + kstep;
            if (last && has_next) S.a_ready(nxt);
            if constexpr (SP2) {
            PG8_LDB(B0, 0, 0); PG8_LDB(B1, 0, 1); PG8_SCHED; PG8_LDA(At, 0, 0); PG8_STAGE(PG8_SA(1, 1), a1 + hstep, voffA);
            PG8_WAIT_V(8); PG8_WAIT_L(0); PG8_BAR; PG8_MMA(0, 0, At, B0); PG8_MMA(0, 1, At, B1); PG8_BAR; PG8_SCHED;
            PG8_LDA(At, 0, 1); PG8_STAGE(PG8_SB(0, 0), b2, voffB); PG8_STAGE(PG8_SB(0, 1), b2 + hstep, voffB); PG8_STAGE(PG8_SA(0, 0), a2, voffA);
            PG8_WAIT_V(8); PG8_WAIT_L(0); PG8_BAR; PG8_MMA(1, 0, At, B0); PG8_MMA(1, 1, At, B1); PG8_BAR; PG8_SCHED;
            PG8_LDB(B0, 1, 0); PG8_LDB(B1, 1, 1); PG8_SCHED; PG8_LDA(At, 1, 0); PG8_STAGE(PG8_SA(0, 1), a2 + hstep, voffA);
            PG8_WAIT_V(8); PG8_WAIT_L(0); PG8_BAR; PG8_MMA(0, 0, At, B0); PG8_MMA(0, 1, At, B1); PG8_BAR; PG8_SCHED;
            PG8_LDA(At, 1, 1); PG8_STAGE(PG8_SB(1, 0), b3, voffB); PG8_STAGE(PG8_SB(1, 1), b3 + hstep, voffB); PG8_STAGE(PG8_SA(1, 0), a3, voffA);
            PG8_WAIT_V(8); PG8_WAIT_L(0); PG8_BAR; PG8_MMA(1, 0, At, B0); PG8_MMA(1, 1, At, B1); PG8_BAR; PG8_SCHED;
            } else {
            PG8_LDB(B0, 0, 0); PG8_SCHED; PG8_LDA(At, 0, 0); PG8_STAGE(PG8_SA(1, 1), a1 + hstep, voffA);
            PG8_WAIT_L(8); PG8_BAR; PG8_WAIT_L(0); PG8_MMA(0, 0, At, B0); PG8_BAR; PG8_SCHED;
            PG8_LDB(B1, 0, 1); PG8_STAGE(PG8_SB(0, 0), b2, voffB);
            PG8_BAR; PG8_WAIT_L(0); PG8_MMA(0, 1, At, B1); PG8_BAR;
            PG8_LDA(At, 0, 1); PG8_STAGE(PG8_SA(0, 0), a2, voffA);
            PG8_BAR; PG8_WAIT_L(0); PG8_MMA(1, 0, At, B0); PG8_BAR; PG8_SCHED;
            PG8_STAGE(PG8_SB(0, 1), b2 + hstep, voffB);
            PG8_WAIT_V(6); PG8_BAR; PG8_MMA(1, 1, At, B1); PG8_BAR;
            PG8_LDB(B0, 1, 0); PG8_SCHED; PG8_LDA(At, 1, 0); PG8_STAGE(PG8_SA(0, 1), a2 + hstep, voffA);
            PG8_WAIT_L(8); PG8_BAR; PG8_WAIT_L(0); PG8_MMA(0, 0, At, B0); PG8_BAR; PG8_SCHED;
            PG8_LDB(B1, 1, 1); PG8_STAGE(PG8_SB(1, 0), b3, voffB);
            PG8_BAR; PG8_WAIT_L(0); PG8_MMA(0, 1, At, B1); PG8_BAR;
            PG8_LDA(At, 1, 1); PG8_STAGE(PG8_SA(1, 0), a3, voffA);
            PG8_BAR; PG8_WAIT_L(0); PG8_MMA(1, 0, At, B0); PG8_BAR; PG8_SCHED;
            PG8_STAGE(PG8_SB(1, 1), b3 + hstep, voffB);
            PG8_WAIT_V(6); PG8_BAR; PG8_MMA(1, 1, At, B1); PG8_BAR;
            }
        }
        if constexpr (ALIGN_EPI) { if (wr == 0) PG8_BAR; }
        if constexpr (!Epi::AFTER_DRAIN) { E(acc, cur, wr, wc, fr, fq); S.done(cur); }
        if (!has_next) break;
#pragma unroll
        for (int a = 0; a < 2; ++a)
#pragma unroll
            for (int b = 0; b < 2; ++b)
#pragma unroll
                for (int m = 0; m < 4; ++m)
#pragma unroll
                    for (int n = 0; n < 2; ++n) acc[a][b][m][n] = (f32x4){0.f, 0.f, 0.f, 0.f};
        cur = nxt; cA = nA; cB = nB; ++ui;
        if constexpr (ALIGN_EPI) { if (wr == 1) PG8_BAR; }
    }
    PG8_WAIT_V(0);
    if constexpr (!ALIGN_EPI) { if (wr == 0) PG8_BAR; }
    PG8_BAR;
    if constexpr (Epi::AFTER_DRAIN) { E.fused(acc, cur, wr, wc, fr, fq, lds, wid, lane); S.done(cur); }
#undef PG8_SA
#undef PG8_SB
#undef PG8_STAGE
#undef PG8_LDA
#undef PG8_LDB
#undef PG8_MMA
#undef PG8_WAIT_V
#undef PG8_WAIT_L
#undef PG8_BAR
#undef PG8_SCHED
}
}
#define LAS __attribute__((address_space(3)))
typedef unsigned short bf16;
typedef unsigned u32x4 __attribute__((ext_vector_type(4)));
typedef unsigned u32x2 __attribute__((ext_vector_type(2)));
typedef float f32x4 __attribute__((ext_vector_type(4)));
typedef short bf16x8 __attribute__((ext_vector_type(8)));
#define LDS_WAIT() asm volatile("s_waitcnt lgkmcnt(0)" ::: "memory")

constexpr int NWAVES = 8, NTHR = 512;
constexpr int DM = 1024, NP = 16384, NS = 512, MT = NP + NS, SEQ = 2048, DFF = 2816;
constexpr float EPS = 1e-6f;
constexpr int LDS_BYTES = 147456;

constexpr size_t al256(size_t x) { return (x + 255) & ~(size_t)255; }
constexpr size_t WS_WRI = 0;
constexpr size_t WS_WRO = WS_WRI + al256(6144ull * 1024 * 2);
constexpr size_t WS_WFI0 = WS_WRO + al256(1024ull * 2048 * 2);
constexpr size_t WS_WFO0 = WS_WFI0 + al256(5632ull * 1024 * 2);
constexpr size_t WS_WFI1 = WS_WFO0 + al256(1024ull * 2816 * 2);
constexpr size_t WS_WFO1 = WS_WFI1 + al256(5632ull * 1024 * 2);
constexpr size_t WS_WSI = WS_WFO1 + al256(1024ull * 2816 * 2);
constexpr size_t WS_WSO = WS_WSI + al256(1536ull * 1024 * 2);
constexpr size_t WS_XB = WS_WSO + al256(1024ull * 1024 * 2);
constexpr size_t WS_BIG = WS_XB + al256((size_t)MT * 1024 * 2);
constexpr size_t WS_OB = WS_BIG + al256((size_t)MT * 6144 * 2);
constexpr size_t WS_SS = WS_OB + al256((size_t)MT * 2048 * 2);
constexpr size_t WS_SSO = WS_SS + al256(4ull * MT * 4);
constexpr size_t WS_TRC = WS_SSO + al256((size_t)MT * 4 * 4);
constexpr size_t WS_TRS = WS_TRC + al256(2052ull * 128 * 4);
constexpr size_t WS_TSC = WS_TRS + al256(2052ull * 128 * 4);
constexpr size_t WS_TSS = WS_TSC + al256(2052ull * 32 * 4);
constexpr size_t WS_END = WS_TSS + al256(2052ull * 32 * 4);
constexpr size_t WS_SSOP = WS_END;
constexpr size_t WS_CTL = WS_SSOP + al256((size_t)NP * 64 * 4), CTL_BYTES = 65536;
constexpr size_t WS_SCR = WS_CTL + CTL_BYTES;
constexpr size_t WS_TOTAL = WS_SCR;
constexpr size_t OUT_Y = 0, OUT_SP = (size_t)MT * 1024, OUT_SS = OUT_SP + 8ull * 4 * 256 * 512, OUT_KP = OUT_SS + 128ull * 4 * 256 * 512,
                 OUT_VP = OUT_KP + 8ull * 128 * 256, OUT_KS = OUT_VP + 8ull * 128 * 256, OUT_VS = OUT_KS + 128ull * 128 * 256, OUT_END = OUT_VS + 128ull * 128 * 256;

struct Params {
    const float* in[16]; float* out; unsigned char* ws;
    double invR[128]; double invS[32];
    float lg2[4];
    int ph_lo, ph_hi;
};

__device__ __forceinline__ unsigned f2bf(float f) { unsigned u = __builtin_bit_cast(unsigned, f); return (u + 0x7fffu + ((u >> 16) & 1u)) >> 16; }
__device__ __forceinline__ unsigned pk2(float lo, float hi) { return pg8::cvt_pk_bf16(lo, hi); }
__device__ __forceinline__ float bf2f(unsigned short b) { return __builtin_bit_cast(float, (unsigned)b << 16); }
__device__ __forceinline__ float bflo(unsigned w) { return __builtin_bit_cast(float, w << 16); }
__device__ __forceinline__ float bfhi(unsigned w) { return __builtin_bit_cast(float, w & 0xffff0000u); }
__device__ __forceinline__ float wave_sum(float v) {
#pragma unroll
    for (int o = 1; o < 64; o <<= 1) v += __shfl_xor(v, o);
    return v;
}
__device__ __forceinline__ f32x4 mfma16(bf16x8 a, bf16x8 b, f32x4 c) { return __builtin_amdgcn_mfma_f32_16x16x32_bf16(a, b, c, 0, 0, 0); }

__device__ __forceinline__ void transpose_item(const float* W, int K, int N, const float* gain, bf16* WT, int n0, int d0a, int d0b, int k0, LAS float* scr, int lane) {
    f32x4 wv[16];
#pragma unroll
    for (int i = 0; i < 16; ++i) { const int kk = 4 * i + (lane >> 4); wv[i] = __builtin_nontemporal_load((const f32x4*)(W + (size_t)(k0 + kk) * N + n0 + 4 * (lane & 15))); }
#pragma unroll
    for (int i = 0; i < 16; ++i) { const int kk = 4 * i + (lane >> 4); const float g = gain ? gain[k0 + kk] : 1.0f; LAS float* d = scr + kk * 65 + 4 * (lane & 15);
        d[0] = wv[i][0] * g; d[1] = wv[i][1] * g; d[2] = wv[i][2] * g; d[3] = wv[i][3] * g; }
    LDS_WAIT();
    const int c = lane & 7;
#pragma unroll
    for (int j = 0; j < 8; ++j) { const int n = (lane >> 3) + 8 * j; const LAS float* s = scr + (8 * c) * 65 + n;
        u32x4 o; o.x = pk2(s[0 * 65], s[1 * 65]); o.y = pk2(s[2 * 65], s[3 * 65]); o.z = pk2(s[4 * 65], s[5 * 65]); o.w = pk2(s[6 * 65], s[7 * 65]);
        const int drow = (n < 32) ? d0a + n : d0b + n - 32;
        *(u32x4*)(WT + (size_t)drow * K + k0 + 8 * c) = o; }
    LDS_WAIT();
}
__device__ __forceinline__ int dmap32(int mode, int n0) {
    if (mode == 1) return (n0 < DFF) ? (n0 / 128) * 256 + (n0 % 128) : ((n0 - DFF) / 128) * 256 + 128 + ((n0 - DFF) % 128);
    if (mode == 2) { const int pn = n0 / 256, r256 = n0 % 256, wc = r256 / 64, bj = (r256 % 64) / 32; return 256 * pn + 128 * bj + 32 * wc; }
    return n0;
}
__device__ __forceinline__ void transpose_mat(const float* W, int K, int N, const float* gain, bf16* WT, int mode, int r, LAS float* scr, int lane) {
    const int nblk = N / 64, kb = r / nblk, nb = r % nblk, n0 = 64 * nb;
    transpose_item(W, K, N, gain, WT, n0, dmap32(mode, n0), dmap32(mode, n0 + 32), 64 * kb, scr, lane);
}
__device__ __forceinline__ void p0_prologue(const Params& p, LAS unsigned char* lds, int tid, int lane, int wave, int vcu, int G, int part, int wid1, int nwg1) {
    unsigned char* ws = p.ws;
    LAS float* scr = (LAS float*)(lds + wave * 16896);
    const int gw = part ? wid1 * NWAVES + wave : vcu * NWAVES + wave, NGW = (part ? nwg1 : G) * NWAVES;
    constexpr int I_RI = 16 * 96, I_RO = 32 * 16, I_FI = 16 * 88, I_FO = 44 * 16, I_SI = 16 * 24, I_SO = 16 * 16;
    constexpr int NITEMS = I_RI + I_RO + 2 * I_FI + 2 * I_FO + I_SI + I_SO;
    const float* nmix = p.in[5]; const float* nffn = p.in[6];
    for (int it = (part ? I_RI + gw : gw); it < (part ? NITEMS : I_RI); it += NGW) {
        int r = it;
        if (r < I_RI) { transpose_mat(p.in[7], 1024, 6144, nmix, (bf16*)(ws + WS_WRI), 0, r, scr, lane); continue; } r -= I_RI;
        if (r < I_RO) { transpose_mat(p.in[8], 2048, 1024, nullptr, (bf16*)(ws + WS_WRO), 0, r, scr, lane); continue; } r -= I_RO;
        if (r < I_FI) { transpose_mat(p.in[14], 1024, 5632, nffn, (bf16*)(ws + WS_WFI0), 1, r, scr, lane); continue; } r -= I_FI;
        if (r < I_FO) { transpose_mat(p.in[15], 2816, 1024, nullptr, (bf16*)(ws + WS_WFO0), 0, r, scr, lane); continue; } r -= I_FO;
        if (r < I_SI) { transpose_mat(p.in[9], 1024, 1536, nmix + 1024, (bf16*)(ws + WS_WSI), 2, r, scr, lane); continue; } r -= I_SI;
        if (r < I_SO) { transpose_mat(p.in[10], 1024, 1024, nullptr, (bf16*)(ws + WS_WSO), 0, r, scr, lane); continue; } r -= I_SO;
        if (r < I_FI) { transpose_mat(p.in[14] + (size_t)1024 * 5632, 1024, 5632, nffn + 1024, (bf16*)(ws + WS_WFI1), 1, r, scr, lane); continue; } r -= I_FI;
        transpose_mat(p.in[15] + (size_t)2816 * 1024, 2816, 1024, nullptr, (bf16*)(ws + WS_WFO1), 0, r, scr, lane);
    }
    if (part) return;
    float* cR = (float*)(ws + WS_TRC); float* sR = (float*)(ws + WS_TRS); float* cS = (float*)(ws + WS_TSC); float* sS = (float*)(ws + WS_TSS);
    for (int idx = vcu * NTHR + tid; idx < 2052 * 160; idx += G * NTHR) {
        const int pi = idx / 160, c = idx % 160; const double pos = (pi < 2048) ? (double)pi : (double)(16384 + (pi - 2048));
        double rev = pos * ((c < 128) ? p.invR[c] : p.invS[c - 128]); rev -= __builtin_rint(rev);
        const float cv = __builtin_amdgcn_cosf((float)rev), sv = __builtin_amdgcn_sinf((float)rev);
        if (c < 128) { cR[pi * 128 + c] = cv; sR[pi * 128 + c] = sv; } else { cS[pi * 32 + c - 128] = cv; sS[pi * 32 + c - 128] = sv; }
    }
    bf16* XB = (bf16*)(ws + WS_XB); float* ss = (float*)(ws + WS_SS); float* sso = (float*)(ws + WS_SSO);
    for (int m = gw; m < MT; m += NGW) {
        const float* xr = (m < NP) ? p.in[0] + (size_t)m * DM : p.in[1] + (size_t)(m - NP) * DM;
        f32x4 v[4]; float s = 0.f;
#pragma unroll
        for (int j = 0; j < 4; ++j) { v[j] = ((const f32x4*)xr)[lane + 64 * j]; s += (v[j][0] * v[j][0] + v[j][1] * v[j][1]) + (v[j][2] * v[j][2] + v[j][3] * v[j][3]); }
        s = wave_sum(s);
#pragma unroll
        for (int j = 0; j < 4; ++j) { u32x2 o; o.x = pk2(v[j][0], v[j][1]); o.y = pk2(v[j][2], v[j][3]); ((u32x2*)(XB + (size_t)m * DM))[lane + 64 * j] = o; }
        if (lane == 0) { ss[m] = s; ss[MT + m] = 0.f; ss[2 * MT + m] = 0.f; ss[3 * MT + m] = 0.f; }
    }
}

constexpr int RQ_STR = 264, RV_STR = 72;
constexpr int RL_Q = 0, RL_K = 33792, RL_VT = 67584, RL_VD = 76800, RL_P = 86016, RL_ST = 95232, RL_GL = 129024;
__device__ __forceinline__ void ret_prompt_unit(LAS unsigned char* lds, const bf16* QKVG, bf16* OB, float* sso, float* state_out, int bh, int es, float lg2, int tid) {
    const int lane = tid & 63, w = __builtin_amdgcn_readfirstlane(tid >> 6), li = lane & 15, lq = lane >> 4;
    const int b = bh >> 2, h = bh & 3;
    LAS bf16* Ql = (LAS bf16*)(lds + RL_Q); LAS bf16* Kl = (LAS bf16*)(lds + RL_K); LAS bf16* VT = (LAS bf16*)(lds + RL_VT);
    LAS bf16* VD = (LAS bf16*)(lds + RL_VD); LAS bf16* PP = (LAS bf16*)(lds + RL_P); LAS bf16* ST = (LAS bf16*)(lds + RL_ST);
    for (int i = tid; i < 33792 / 16; i += NTHR) ((LAS u32x4*)ST)[i] = (u32x4){0u, 0u, 0u, 0u};
    f32x4 S[2][4];
#pragma unroll
    for (int a = 0; a < 2; ++a)
#pragma unroll
        for (int e = 0; e < 4; ++e) S[a][e] = (f32x4){0.f, 0.f, 0.f, 0.f};
    const size_t rowbase = (size_t)b * SEQ;
    const bf16* qg = QKVG + ((size_t)h * MT + rowbase) * 256;
    const bf16* kg = qg + (size_t)4 * MT * 256;
    const bf16* vg = QKVG + (size_t)8 * MT * 256 + ((size_t)h * MT + rowbase) * 512 + es * 64;
    const int srow = tid >> 5, sch = tid & 31;
    const int vrow = tid & 63, vch = tid >> 6;
    const bf16* gg = vg + (size_t)4 * MT * 512;
    LAS bf16* OL = (LAS bf16*)(lds + RL_GL + 9216);
    const int orow = tid >> 3, och = tid & 7;
    LAS bf16* GL = (LAS bf16*)(lds + RL_GL);
    u32x4 rq[4], rk[4], rv, rg;
#define RET_LOAD(t0_) do { _Pragma("unroll") for (int i_ = 0; i_ < 4; ++i_) { const size_t o_ = (size_t)((t0_) + srow + 16 * i_) * 256 + sch * 8; rq[i_] = *(const u32x4*)(qg + o_); rk[i_] = *(const u32x4*)(kg + o_); } \
        rv = *(const u32x4*)(vg + (size_t)((t0_) + vrow) * 512 + vch * 8); rg = *(const u32x4*)(gg + (size_t)((t0_) + vrow) * 512 + vch * 8); } while (0)
    RET_LOAD(0);
    const int ib = w >> 1, nh = w & 1;
    const float dS = __builtin_amdgcn_exp2f(64.0f * lg2);
    for (int c = 0; c < 32; ++c) {
        const int t0 = c * 64;
        asm volatile("s_waitcnt vmcnt(0)" ::: "memory");
#pragma unroll
        for (int i = 0; i < 4; ++i) { *(LAS u32x4*)(Ql + (srow + 16 * i) * RQ_STR + sch * 8) = rq[i]; *(LAS u32x4*)(Kl + (srow + 16 * i) * RQ_STR + sch * 8) = rk[i]; }
        *(LAS u32x4*)(GL + vrow * RV_STR + vch * 8) = rg;
        { const float dec = __builtin_amdgcn_exp2f((float)(63 - vrow) * lg2);
#pragma unroll
          for (int j = 0; j < 4; ++j) { const unsigned wv = rv[j]; const int e0 = vch * 8 + 2 * j;
              VT[e0 * RV_STR + vrow] = (bf16)(wv & 0xffffu); VT[(e0 + 1) * RV_STR + vrow] = (bf16)(wv >> 16);
              VD[e0 * RV_STR + vrow] = (bf16)f2bf(bflo(wv) * dec); VD[(e0 + 1) * RV_STR + vrow] = (bf16)f2bf(bfhi(wv) * dec); } }
        __syncthreads();
        if (c > 0) { const u32x4 ov = *(const LAS u32x4*)(OL + orow * 64 + och * 8); *(u32x4*)(OB + (rowbase + t0 - 64 + orow) * 2048 + h * 512 + es * 64 + och * 8) = ov; }
        if (c + 1 < 32) RET_LOAD(t0 + 64);
        f32x4 accS[2], accO[2];
#pragma unroll
        for (int t = 0; t < 2; ++t) { accS[t] = (f32x4){0.f, 0.f, 0.f, 0.f}; accO[t] = (f32x4){0.f, 0.f, 0.f, 0.f}; }
#pragma unroll
        for (int kh = 0; kh < 4; ++kh) {
            bf16x8 fa[2], fs[2][2], fk[2][2];
#pragma unroll
            for (int kk = 0; kk < 2; ++kk) { const int ks = 2 * kh + kk;
                fa[kk] = *(const LAS bf16x8*)(Ql + (16 * ib + li) * RQ_STR + 32 * ks + 8 * lq);
#pragma unroll
                for (int t = 0; t < 2; ++t) { fs[kk][t] = *(const LAS bf16x8*)(ST + (16 * (2 * nh + t) + li) * RQ_STR + 32 * ks + 8 * lq);
                    fk[kk][t] = *(const LAS bf16x8*)(Kl + (16 * (2 * nh + t) + li) * RQ_STR + 32 * ks + 8 * lq); } }
            __builtin_amdgcn_sched_barrier(0);
#pragma unroll
            for (int kk = 0; kk < 2; ++kk)
#pragma unroll
                for (int t = 0; t < 2; ++t) { accO[t] = mfma16(fa[kk], fs[kk][t], accO[t]); accS[t] = mfma16(fa[kk], fk[kk][t], accS[t]); }
            __builtin_amdgcn_sched_barrier(0);
        }
#pragma unroll
        for (int t = 0; t < 2; ++t) { const int jb = 2 * nh + t, j = 16 * jb + li;
#pragma unroll
            for (int r = 0; r < 4; ++r) { const int i = 16 * ib + 4 * lq + r;
                const float val = (j <= i) ? accS[t][r] * __builtin_amdgcn_exp2f((float)(i - j) * lg2) : 0.f;
                PP[i * RV_STR + j] = (bf16)f2bf(val); } }
        __syncthreads();
        f32x4 accA[2];
#pragma unroll
        for (int t = 0; t < 2; ++t) accA[t] = (f32x4){0.f, 0.f, 0.f, 0.f};
#pragma unroll
        for (int ks = 0; ks < 2; ++ks) {
            const bf16x8 a = *(const LAS bf16x8*)(PP + (16 * ib + li) * RV_STR + 32 * ks + 8 * lq);
#pragma unroll
            for (int t = 0; t < 2; ++t) { const bf16x8 bv = *(const LAS bf16x8*)(VT + (16 * (2 * nh + t) + li) * RV_STR + 32 * ks + 8 * lq); accA[t] = mfma16(a, bv, accA[t]); }
        }
#pragma unroll
        for (int r = 0; r < 4; ++r) { const int i = 16 * ib + 4 * lq + r; const float f = __builtin_amdgcn_exp2f((float)(i + 1) * lg2);
            const size_t row = rowbase + t0 + i; float q2 = 0.f;
#pragma unroll
            for (int t = 0; t < 2; ++t) { const float o = accA[t][r] + f * accO[t][r]; q2 += o * o; OL[i * 64 + 16 * (2 * nh + t) + li] = (bf16)f2bf(o * bf2f(GL[i * RV_STR + 16 * (2 * nh + t) + li])); }
            q2 += __shfl_xor(q2, 1); q2 += __shfl_xor(q2, 2); q2 += __shfl_xor(q2, 4); q2 += __shfl_xor(q2, 8);
            if (li == 0 && sso) sso[(row * 4 + h) * 16 + es * 2 + nh] = q2; }
#pragma unroll
        for (int a = 0; a < 2; ++a)
#pragma unroll
            for (int e = 0; e < 4; ++e) S[a][e] = S[a][e] * dS;
#pragma unroll
        for (int ks = 0; ks < 2; ++ks) {
            bf16x8 ka[2];
#pragma unroll
            for (int dm = 0; dm < 2; ++dm)
#pragma unroll
                for (int jj = 0; jj < 8; ++jj) ka[dm][jj] = (short)Kl[(32 * ks + 8 * lq + jj) * RQ_STR + 32 * w + 16 * dm + li];
#pragma unroll
            for (int en = 0; en < 4; ++en) { const bf16x8 bv = *(const LAS bf16x8*)(VD + (16 * en + li) * RV_STR + 32 * ks + 8 * lq);
#pragma unroll
                for (int dm = 0; dm < 2; ++dm) S[dm][en] = mfma16(ka[dm], bv, S[dm][en]); }
        }
#pragma unroll
        for (int dm = 0; dm < 2; ++dm)
#pragma unroll
            for (int en = 0; en < 4; ++en) { u32x2 o; o.x = f2bf(S[dm][en][0]) | (f2bf(S[dm][en][1]) << 16); o.y = f2bf(S[dm][en][2]) | (f2bf(S[dm][en][3]) << 16);
                *(LAS u32x2*)(ST + (16 * en + li) * RQ_STR + 32 * w + 16 * dm + 4 * lq) = o; }
        __syncthreads();
    }
#undef RET_LOAD
    { const u32x4 ov = *(const LAS u32x4*)(OL + orow * 64 + och * 8); *(u32x4*)(OB + (rowbase + 31 * 64 + orow) * 2048 + h * 512 + es * 64 + och * 8) = ov; }
    float* so = state_out + ((size_t)bh * 256) * 512 + es * 64;
#pragma unroll
    for (int dm = 0; dm < 2; ++dm)
#pragma unroll
        for (int en = 0; en < 4; ++en)
#pragma unroll
            for (int r = 0; r < 4; ++r) so[(size_t)(32 * w + 16 * dm + 4 * lq + r) * 512 + 16 * en + li] = S[dm][en][r];
}

__device__ __forceinline__ void ret_sample_unit(LAS unsigned char* lds, const bf16* QKVG, bf16* OB, const float* state_in, float* state_out, int bh, float lg2, int tid) {
    const int lane = tid & 63, w = __builtin_amdgcn_readfirstlane(tid >> 6);
    const int b = bh >> 2, h = bh & 3;
    LAS float* qk8 = (LAS float*)lds;
    LAS float* qkd = qk8 + 2048;
    LAS float* red = qkd + 16;
    LAS float* wsm = red + 8192;
    const size_t r0 = (size_t)(NP + b * 4);
    {
        const int idx = tid * 4, which = idx >> 10, t = (idx >> 8) & 3, d = idx & 255;
        const u32x2 v = *(const u32x2*)(QKVG + (size_t)which * 4 * MT * 256 + ((size_t)h * MT + r0 + t) * 256 + d);
        LAS float* dst = qk8 + d * 8 + which * 4 + t;
        dst[0] = bflo(v.x); dst[8] = bfhi(v.x); dst[16] = bflo(v.y); dst[24] = bfhi(v.y);
    }
    __syncthreads();
    {
#pragma unroll
        for (int pp = 0; pp < 2; ++pp) { const int pr = 2 * w + pp, i = pr >> 2, j = pr & 3; float s = 0.f;
#pragma unroll
            for (int dd = 0; dd < 4; ++dd) { const int d = lane * 4 + dd; s += qk8[d * 8 + i] * qk8[d * 8 + 4 + j]; }
            s = wave_sum(s); if (lane == 0) qkd[pr] = s; }
    }
    const float g1 = __builtin_amdgcn_exp2f(lg2), g2 = g1 * g1, g3 = g2 * g1, g4 = g2 * g2;
    const int ec = tid & 127, dg = tid >> 7;
    f32x4 vv[4];
#pragma unroll
    for (int j = 0; j < 4; ++j) { const u32x2 v = *(const u32x2*)(QKVG + (size_t)8 * MT * 256 + ((size_t)h * MT + r0 + j) * 512 + 4 * ec); vv[j] = (f32x4){bflo(v.x), bfhi(v.x), bflo(v.y), bfhi(v.y)}; }
    vv[0] = vv[0] * g3; vv[1] = vv[1] * g2; vv[2] = vv[2] * g1;
    f32x4 oa[4];
#pragma unroll
    for (int i = 0; i < 4; ++i) oa[i] = (f32x4){0.f, 0.f, 0.f, 0.f};
    const float* sin_ = state_in + ((size_t)bh * 256 + dg * 64) * 512 + 4 * ec;
    float* sout = state_out + ((size_t)bh * 256 + dg * 64) * 512 + 4 * ec;
    f32x4 sb[2][8];
#pragma unroll
    for (int r = 0; r < 8; ++r) sb[0][r] = __builtin_nontemporal_load((const f32x4*)(sin_ + (size_t)r * 512));
#pragma unroll
    for (int bt = 0; bt < 8; ++bt) {
        if (bt + 1 < 8) {
#pragma unroll
            for (int r = 0; r < 8; ++r) sb[(bt + 1) & 1][r] = __builtin_nontemporal_load((const f32x4*)(sin_ + (size_t)((bt + 1) * 8 + r) * 512));
            asm volatile("s_waitcnt vmcnt(8)" ::: "memory");
        } else asm volatile("s_waitcnt vmcnt(0)" ::: "memory");
#pragma unroll
        for (int r = 0; r < 8; ++r) { const int dd = bt * 8 + r; const f32x4 s = sb[bt & 1][r];
            const f32x4 q4 = *(const LAS f32x4*)(qk8 + (dg * 64 + dd) * 8), k4 = *(const LAS f32x4*)(qk8 + (dg * 64 + dd) * 8 + 4);
            const f32x4 sn = s * g4 + vv[0] * k4[0] + vv[1] * k4[1] + vv[2] * k4[2] + vv[3] * k4[3];
            __builtin_nontemporal_store(sn, (f32x4*)(sout + (size_t)dd * 512));
            oa[0] += s * q4[0]; oa[1] += s * q4[1]; oa[2] += s * q4[2]; oa[3] += s * q4[3]; }
    }
#pragma unroll
    for (int i = 0; i < 4; ++i) *(LAS f32x4*)(red + (dg * 4 + i) * 512 + 4 * ec) = oa[i];
    __syncthreads();
    {
        const int e = tid; float vj[4], o[4], q2[4];
#pragma unroll
        for (int j = 0; j < 4; ++j) vj[j] = bf2f(QKVG[(size_t)8 * MT * 256 + ((size_t)h * MT + r0 + j) * 512 + e]);
        const float gp[4] = {1.0f, g1, g2, g3};
#pragma unroll
        for (int i = 0; i < 4; ++i) { float ob = (red[(0 * 4 + i) * 512 + e] + red[(1 * 4 + i) * 512 + e]) + (red[(2 * 4 + i) * 512 + e] + red[(3 * 4 + i) * 512 + e]);
            float acc = ob * gp[i] * g1;
#pragma unroll
            for (int j = 0; j < 4; ++j) if (j <= i) acc += gp[i - j] * qkd[i * 4 + j] * vj[j];
            o[i] = acc; q2[i] = wave_sum(acc * acc); }
        if (lane == 0) {
#pragma unroll
            for (int i = 0; i < 4; ++i) wsm[w * 4 + i] = q2[i]; }
        __syncthreads();
#pragma unroll
        for (int i = 0; i < 4; ++i) { float t = 0.f;
#pragma unroll
            for (int ww = 0; ww < 8; ++ww) t += wsm[ww * 4 + i];
            const float rstd = __builtin_amdgcn_rsqf(t * (1.0f / 512.0f) + EPS);
            const float sg = bf2f(QKVG[(size_t)8 * MT * 256 + (size_t)4 * MT * 512 + ((size_t)h * MT + r0 + i) * 512 + e]);
            OB[(r0 + i) * 2048 + h * 512 + e] = (bf16)f2bf(o[i] * rstd * sg); }
    }
    __syncthreads();
}

__device__ __forceinline__ void ret_norm_pass(const bf16* QKVG, bf16* OB, const float* sso, int gw, int NGW, int lane) {
    for (int m = gw; m < NP; m += NGW) {
#pragma unroll
        for (int j = 0; j < 4; ++j) {
            const f32x4* pp = (const f32x4*)(sso + ((size_t)m * 4 + j) * 16);
            const f32x4 pa = pp[0] + pp[1] + pp[2] + pp[3];
            const float rstd = __builtin_amdgcn_rsqf(((pa[0] + pa[1]) + (pa[2] + pa[3])) * (1.0f / 512.0f) + EPS);
            u32x4 o = *(const u32x4*)(OB + (size_t)m * 2048 + 512 * j + lane * 8); const u32x4 g = *(const u32x4*)(QKVG + (size_t)8 * MT * 256 + (size_t)4 * MT * 512 + ((size_t)j * MT + m) * 512 + lane * 8);
#pragma unroll
            for (int k = 0; k < 4; ++k) o[k] = pk2(bflo(o[k]) * rstd * bflo(g[k]), bfhi(o[k]) * rstd * bfhi(g[k]));
            *(u32x4*)(OB + (size_t)m * 2048 + 512 * j + lane * 8) = o;
        }
    }
}

constexpr int AK_STR = 72, AV_STR = 264, AP_STR = 168;
constexpr int AL_K = 0, AL_VT = 36864, AL_P = 70656;
template <int AVS> __device__ __forceinline__ void attn_item(const LAS bf16* Kl, const LAS bf16* VT, LAS bf16* Pw, const bf16x8 (&qa)[2], int jt0, const int (&lo)[4], const int (&hi)[4], const float (&sink)[4], bf16* obase, int sA, int sB, int li, int lq) {
    f32x4 sc[10];
#pragma unroll
    for (int jt = 0; jt < 10; ++jt) { sc[jt] = (f32x4){0.f, 0.f, 0.f, 0.f};
#pragma unroll
        for (int ks = 0; ks < 2; ++ks) { const bf16x8 bk = *(const LAS bf16x8*)(Kl + (16 * (jt0 + jt) + li) * AK_STR + 32 * ks + 8 * lq); sc[jt] = mfma16(qa[ks], bk, sc[jt]); } }
    float mx[4], den[4];
#pragma unroll
    for (int r = 0; r < 4; ++r) { float m = sink[r];
#pragma unroll
        for (int jt = 0; jt < 10; ++jt) { const int j = 16 * (jt0 + jt) + li; const bool ok = (j >= lo[r]) && (j <= hi[r]); sc[jt][r] = ok ? sc[jt][r] : -INFINITY; m = fmaxf(m, sc[jt][r]); }
        m = fmaxf(m, __shfl_xor(m, 1)); m = fmaxf(m, __shfl_xor(m, 2)); m = fmaxf(m, __shfl_xor(m, 4)); m = fmaxf(m, __shfl_xor(m, 8));
        float s = 0.f;
#pragma unroll
        for (int jt = 0; jt < 10; ++jt) { const float e = __expf(sc[jt][r] - m); sc[jt][r] = e; s += e; }
        s += __shfl_xor(s, 1); s += __shfl_xor(s, 2); s += __shfl_xor(s, 4); s += __shfl_xor(s, 8);
        mx[r] = m; den[r] = __builtin_amdgcn_rcpf(s + __expf(sink[r] - m)); }
#pragma unroll
    for (int jt = 0; jt < 10; ++jt)
#pragma unroll
        for (int r = 0; r < 4; ++r) Pw[(4 * lq + r) * AP_STR + 16 * jt + li] = (bf16)f2bf(sc[jt][r] * den[r]);
    LDS_WAIT();
    f32x4 oc[4];
#pragma unroll
    for (int dn = 0; dn < 4; ++dn) oc[dn] = (f32x4){0.f, 0.f, 0.f, 0.f};
#pragma unroll
    for (int ks = 0; ks < 5; ++ks) { const bf16x8 pa = *(const LAS bf16x8*)(Pw + li * AP_STR + 32 * ks + 8 * lq);
#pragma unroll
        for (int dn = 0; dn < 4; ++dn) { const bf16x8 bv = *(const LAS bf16x8*)(VT + (16 * dn + li) * AVS + 16 * jt0 + 32 * ks + 8 * lq); oc[dn] = mfma16(pa, bv, oc[dn]); } }
#pragma unroll
    for (int r = 0; r < 4; ++r)
#pragma unroll
        for (int dn = 0; dn < 4; ++dn) Pw[(4 * lq + r) * AP_STR + 16 * dn + li] = (bf16)f2bf(oc[dn][r]);
    LDS_WAIT();
    { const int lane_ = lq * 16 + li;
#pragma unroll
      for (int h2 = 0; h2 < 2; ++h2) { const int idx = lane_ + 64 * h2, rr = idx >> 3, ch = idx & 7;
          const u32x4 v = *(const LAS u32x4*)(Pw + rr * AP_STR + ch * 8); *(u32x4*)(obase + (size_t)(rr >> 2) * sA + (size_t)(rr & 3) * sB + ch * 8) = v; } }
    LDS_WAIT();
    (void)mx;
}
__device__ __forceinline__ void attn_prompt_unit(LAS unsigned char* lds, const bf16* QKV, bf16* AO, const float* sinks, int unit, int tid) {
    const int lane = tid & 63, w = __builtin_amdgcn_readfirstlane(tid >> 6), li = lane & 15, lq = lane >> 4;
    const int kvh = unit & 3, nb = (unit >> 2) & 15, b = unit >> 6;
    LAS bf16* Kl = (LAS bf16*)(lds + AL_K); LAS bf16* VT = (LAS bf16*)(lds + AL_VT); LAS bf16* Pw = (LAS bf16*)(lds + AL_P + w * 5376);
    const size_t rowbase = (size_t)b * SEQ; const int tb = nb * 128 - 128;
    bf16x8 qf[4][2];
#pragma unroll
    for (int it = 0; it < 4; ++it) { const int id = w * 4 + it, g = id >> 3, qt = id & 7; const bf16* qp = QKV + (rowbase + nb * 128 + 16 * qt + li) * 1536 + (kvh * 4 + g) * 64;
#pragma unroll
        for (int ks = 0; ks < 2; ++ks) qf[it][ks] = *(const bf16x8*)(qp + 32 * ks + 8 * lq); }
#pragma unroll
    for (int i = 0; i < 4; ++i) { const int id = tid + NTHR * i, j = id >> 3, ch = id & 7; const int t = tb + j;
        u32x4 kv = (u32x4){0u, 0u, 0u, 0u}, vv = (u32x4){0u, 0u, 0u, 0u};
        if (t >= 0) { const bf16* src = QKV + (rowbase + t) * 1536 + 1024 + kvh * 64 + ch * 8; kv = *(const u32x4*)src; vv = *(const u32x4*)(src + 256); }
        *(LAS u32x4*)(Kl + j * AK_STR + ch * 8) = kv;
#pragma unroll
        for (int k = 0; k < 4; ++k) { VT[(ch * 8 + 2 * k) * AV_STR + j] = (bf16)(vv[k] & 0xffffu); VT[(ch * 8 + 2 * k + 1) * AV_STR + j] = (bf16)(vv[k] >> 16); } }
    __syncthreads();
#pragma unroll
    for (int it = 0; it < 4; ++it) { const int id = w * 4 + it, g = id >> 3, qt = id & 7, hq = kvh * 4 + g;
        const size_t qrow0 = rowbase + nb * 128 + 16 * qt;
        int lo[4], hi[4]; float sk[4]; const float sv = sinks[hq];
#pragma unroll
        for (int r = 0; r < 4; ++r) { const int i = 16 * qt + 4 * lq + r; lo[r] = (nb > 0) ? i : (i > 128 ? i : 128); hi[r] = i + 128; sk[r] = sv; }
        attn_item<AV_STR>(Kl, VT, Pw, qf[it], qt & ~1, lo, hi, sk, AO + qrow0 * 1024 + hq * 64, 4 * 1024, 1024, li, lq); }
    __syncthreads();
}
constexpr int AS_VSTR = 168, AS_SLOT = 51200, AS_K = 0, AS_VT = 23040, AS_P = 44544;
__device__ __forceinline__ void attn_sample_pair(LAS unsigned char* lds, const bf16* QKV, bf16* AO, const float* sinks, const float* ck, const float* cv, float* ok, float* ov, int unit0, int unit1, int tid) {
    const int lane = tid & 63, w = __builtin_amdgcn_readfirstlane(tid >> 6), li = lane & 15, lq = lane >> 4;
#pragma unroll 1
    for (int s = 0; s < 2; ++s) {
        const int unit = s ? unit1 : unit0; const int kvh = unit & 3, b = unit >> 2;
        LAS bf16* Kl = (LAS bf16*)(lds + s * AS_SLOT + AS_K); LAS bf16* VT = (LAS bf16*)(lds + s * AS_SLOT + AS_VT);
#pragma unroll
        for (int i = 0; i < 4; ++i) { const int id = tid + NTHR * i, j = id >> 4, ch = id & 15;
            const size_t so = ((size_t)(b * 128 + j) * 4 + kvh) * 64 + ch * 4;
            const f32x4 kf = *(const f32x4*)(ck + so), vf = *(const f32x4*)(cv + so);
            if (j >= 4) { const size_t d_ = ((size_t)(b * 128 + j - 4) * 4 + kvh) * 64 + ch * 4; *(f32x4*)(ok + d_) = kf; *(f32x4*)(ov + d_) = vf; }
            u32x2 kb; kb.x = pk2(kf[0], kf[1]); kb.y = pk2(kf[2], kf[3]); *(LAS u32x2*)(Kl + j * AK_STR + ch * 4) = kb;
#pragma unroll
            for (int k = 0; k < 4; ++k) VT[(ch * 4 + k) * AS_VSTR + j] = (bf16)f2bf(vf[k]); }
        if (tid < 256) { const int j = 128 + (tid >> 3), ch = tid & 7;
            u32x4 kv = (u32x4){0u, 0u, 0u, 0u}, vv = (u32x4){0u, 0u, 0u, 0u};
            if (j < 132) { const bf16* src = QKV + (size_t)(NP + b * 4 + (j - 128)) * 1536 + 1024 + kvh * 64 + ch * 8; kv = *(const u32x4*)src; vv = *(const u32x4*)(src + 256); }
            *(LAS u32x4*)(Kl + j * AK_STR + ch * 8) = kv;
#pragma unroll
            for (int k = 0; k < 4; ++k) { VT[(ch * 8 + 2 * k) * AS_VSTR + j] = (bf16)(vv[k] & 0xffffu); VT[(ch * 8 + 2 * k + 1) * AS_VSTR + j] = (bf16)(vv[k] >> 16); } }
    }
    __syncthreads();
    if (w < 2) {
        const int unit = w ? unit1 : unit0; const int kvh = unit & 3, b = unit >> 2;
        const LAS bf16* Kl = (const LAS bf16*)(lds + w * AS_SLOT + AS_K); const LAS bf16* VT = (const LAS bf16*)(lds + w * AS_SLOT + AS_VT); LAS bf16* Pw = (LAS bf16*)(lds + w * AS_SLOT + AS_P);
        const int gA = li >> 2, tA = li & 3;
        const bf16* qp = QKV + (size_t)(NP + b * 4 + tA) * 1536 + (kvh * 4 + gA) * 64;
        bf16x8 qa[2];
#pragma unroll
        for (int ks = 0; ks < 2; ++ks) qa[ks] = *(const bf16x8*)(qp + 32 * ks + 8 * lq);
        int lo[4], hi[4]; float sk[4];
#pragma unroll
        for (int r = 0; r < 4; ++r) { const int rr = 4 * lq + r, g = rr >> 2, t = rr & 3; lo[r] = t; hi[r] = t + 128; sk[r] = sinks[kvh * 4 + g]; }
        attn_item<AS_VSTR>(Kl, VT, Pw, qa, 0, lo, hi, sk, AO + (size_t)(NP + b * 4) * 1024 + kvh * 4 * 64, 64, 1024, li, lq);
    }
    __syncthreads();
}

#define XB_TMO      128
#define XB_XCNT(j)  (256  + 64 * (j))
#define XB_XSUB(j)  (1280 + 64 * (j))
#define XB_XGEN(j)  (2304 + 64 * (j))
#define XB_TOP      3328
#define XB_TOPGEN   3392
#define XCD_BAR_WORDS 3456
#define XB_SPIN_CAP (1u << 18)

__device__ __forceinline__ unsigned xb_ld(unsigned* p)              { return __hip_atomic_load(p, __ATOMIC_RELAXED, __HIP_MEMORY_SCOPE_AGENT); }
__device__ __forceinline__ unsigned xb_add(unsigned* p, unsigned v) { return __hip_atomic_fetch_add(p, v, __ATOMIC_RELAXED, __HIP_MEMORY_SCOPE_AGENT); }
__device__ __forceinline__ unsigned xb_xcc_id() { return (unsigned)__builtin_amdgcn_s_getreg((3 << 11) | 20) & 0xFu; }
#define XB_SPIN(cond, bar) do { unsigned _sp = 0; while (cond) { __builtin_amdgcn_s_sleep(1); \
    if ((++_sp & 255u) == 0u) { if (xb_ld(&(bar)[XB_TMO])) break; if (_sp > XB_SPIN_CAP) { atomicAdd(&(bar)[XB_TMO], 1u); break; } } } } while (0)

struct XcdBarrier {
    unsigned* bar; unsigned x;
    volatile LAS unsigned* st;
};

__device__ __forceinline__ XcdBarrier xcd_barrier_post(unsigned* bar, volatile LAS unsigned* st) {
    XcdBarrier b; b.bar = bar; b.x = xb_xcc_id(); b.st = st;
    if (threadIdx.x == 0) (void)xb_add(&bar[XB_XCNT(b.x)], 1u);
    return b;
}
__device__ __forceinline__ void xcd_barrier_complete(unsigned* bar, unsigned x, unsigned& nloc, unsigned& nx) {
    const unsigned G = gridDim.x * gridDim.y * gridDim.z;
    unsigned sum, cnt, mine, sp = 0u;
    for (;;) {
        sum = 0u; cnt = 0u; mine = 0u;
#pragma unroll
        for (unsigned j = 0; j < 16; ++j) { const unsigned c = xb_ld(&bar[XB_XCNT(j)]); sum += c; cnt += (c > 0u) ? 1u : 0u; mine = (j == x) ? c : mine; }
        if (sum == G) break;
        __builtin_amdgcn_s_sleep(1);
        if ((++sp & 255u) == 0u) { if (xb_ld(&bar[XB_TMO])) break; if (sp > XB_SPIN_CAP) { atomicAdd(&bar[XB_TMO], 1u); break; } }
    }
    nloc = mine > 0u ? mine : 1u; nx = cnt > 0u ? cnt : 1u;
}

__device__ __forceinline__ void xcd_barrier(const XcdBarrier& b) {
    asm volatile("s_waitcnt vmcnt(0)" ::: "memory");
    __syncthreads();
    if (threadIdx.x == 0) {
        unsigned* bar = b.bar;
        __builtin_amdgcn_s_waitcnt(0);
        unsigned nloc = b.st[0], nx = b.st[1];
        if (nloc == 0u) { xcd_barrier_complete(bar, b.x, nloc, nx); b.st[0] = nloc; b.st[1] = nx; }
        const unsigned old = xb_add(&bar[XB_XSUB(b.x)], 1u);
        const unsigned gen = old / nloc;
        if (old + 1u == (gen + 1u) * nloc) {
            __builtin_amdgcn_fence(__ATOMIC_RELEASE, "agent");
            asm volatile("s_waitcnt vmcnt(0)" ::: "memory");
            const unsigned og = xb_add(&bar[XB_TOP], 1u);
            const unsigned tg = og / nx;
            if (og + 1u == (tg + 1u) * nx) xb_add(&bar[XB_TOPGEN], 1u);
            else XB_SPIN(xb_ld(&bar[XB_TOPGEN]) == tg, bar);
            __builtin_amdgcn_fence(__ATOMIC_ACQUIRE, "agent");
            xb_add(&bar[XB_XGEN(b.x)], 1u);
            asm volatile("s_waitcnt vmcnt(0)" ::: "memory");
        } else {
            XB_SPIN(xb_ld(&bar[XB_XGEN(b.x)]) == gen, bar);
            __builtin_amdgcn_fence(__ATOMIC_ACQUIRE, "agent");
            asm volatile("s_waitcnt vmcnt(0)" ::: "memory");
        }
    }
    __syncthreads();
}

#ifndef PROBE_DUP
#define PROBE_DUP 0
#endif
struct ListOrder {
    int nM, nN, nwg, pm_off, L0, dL, n, extraL;
    __device__ __forceinline__ void init(int Mrows, int N, int pm_off_) { nM = Mrows / 256; nN = N / 256; nwg = nM * nN; pm_off = pm_off_; }
    __device__ __forceinline__ bool next(int i, pg8::Unit& u) const {
        int L; if (i < n) L = L0 + i * dL; else if (i == n && extraL >= 0) L = extraL; else return false;
        if (L >= nwg) return false;
        int wgid = L; { const int q = nwg / 8, r = nwg % 8, xcd = wgid % 8, off = wgid / 8; wgid = (xcd < r ? xcd * (q + 1) : r * (q + 1) + (xcd - r) * q) + off; }
        const int nig = 8 * nN, gid = wgid / nig, fm = gid * 8, gsz = (nM - fm) < 8 ? (nM - fm) : 8;
        u.pm = fm + ((wgid % nig) % gsz) + pm_off; u.pn = (wgid % nig) / gsz; return true;
    }
    __device__ __forceinline__ void a_ready(const pg8::Unit&) const {}
    __device__ __forceinline__ void done(const pg8::Unit&) const {}
};
__device__ __forceinline__ void flag_signal(unsigned* f, int tid) {
    asm volatile("s_waitcnt vmcnt(0)" ::: "memory");
    __syncthreads();
    if (tid == 0) { __builtin_amdgcn_fence(__ATOMIC_RELEASE, "agent"); asm volatile("s_waitcnt vmcnt(0)" ::: "memory"); (void)xb_add(f, 1u); }
}
__device__ __forceinline__ void flag_wait(unsigned* f, unsigned n, int tid) {
    if (tid == 0) { unsigned sp = 0u; while (xb_ld(f) < n) { __builtin_amdgcn_s_sleep(4); if (++sp > (1u << 16)) break; }
        __builtin_amdgcn_fence(__ATOMIC_ACQUIRE, "agent"); asm volatile("s_waitcnt vmcnt(0)" ::: "memory"); }
    __syncthreads();
}
enum { K_NONE = 0, K_RETIN, K_RES, K_SWIGLU, K_SWAIN };
constexpr int NSTEPS = 21;
__global__ void __launch_bounds__(NTHR) hybrid_fwd(Params p) {
    extern __shared__ __attribute__((aligned(16))) unsigned char lds_raw[];
    LAS unsigned char* lds = (LAS unsigned char*)lds_raw;
    cg::grid_group grid = cg::this_grid();
    const int tid = threadIdx.x, lane = tid & 63, wave = __builtin_amdgcn_readfirstlane(tid >> 6);
    const int G = gridDim.x, c = blockIdx.x, vcu = (c % 8) * (G / 8) + c / 8;
    unsigned char* ws = p.ws; float* out = p.out;
    bf16* XB = (bf16*)(ws + WS_XB); bf16* BIG = (bf16*)(ws + WS_BIG); bf16* OB = (bf16*)(ws + WS_OB);
    float* ss = (float*)(ws + WS_SS); float* sso = (float*)(ws + WS_SSO);
    unsigned* ctl = (unsigned*)(ws + WS_CTL);
    unsigned* F1 = ctl + 4096; unsigned* F3 = ctl + 4096 + 64; unsigned* F4 = ctl + 4096 + 128; unsigned* F5 = ctl + 4096 + 192;
    volatile LAS unsigned* bst = (volatile LAS unsigned*)(lds + LDS_BYTES - 64);
    if (tid < 2) bst[tid] = 0u;
    __syncthreads();
    XcdBarrier bar = xcd_barrier_post(ctl, bst);
    const bool hi8 = (c >= 248), mid44 = (c >= 144 && c < 188);
    float* outS = out + (size_t)NP * DM;
#define GEMM_RES(Aptr, Wptr, Kc, E_)   do { pg8::Gemm g_{Aptr, (const bf16*)(ws + Wptr), MT, 1024, Kc}; pg8::gemm_phase<pg8::EpiRes, ListOrder, true, true>(lds, g_, S, E_); } while (0)
#define GEMM_SWIGLU(Wptr, ssp)         do { pg8::Gemm g_{XB, (const bf16*)(ws + Wptr), MT, 5632, 1024}; pg8::EpiSwiglu E_{BIG, ssp}; pg8::gemm_phase<pg8::EpiSwiglu, ListOrder, true, true>(lds, g_, S, E_); } while (0)
#define GEMM_SWAIN()                   do { pg8::Gemm g_{XB, (const bf16*)(ws + WS_WSI), MT, 1536, 1024}; \
        pg8::EpiSwaIn E_{BIG, ss + 2 * MT, (const float*)(ws + WS_TSC), (const float*)(ws + WS_TSS), p.in[11], p.in[12], out + OUT_KP, out + OUT_VP, out + OUT_KS, out + OUT_VS}; \
        pg8::gemm_phase<pg8::EpiSwaIn, ListOrder, true, true>(lds, g_, S, E_); } while (0)
    const int lo_ = p.ph_lo, hi_ = p.ph_hi;
#if defined(PROBE_T)
    unsigned long long pt0 = 0, pt1 = 0;
#endif
#define IN(k) (lo_ <= (k) && (k) < hi_)
#define SEAM(k, kind) do { if (IN((k) + 1)) { if ((kind) == 2 && G != 256) grid.sync(); else if ((kind) >= 1) xcd_barrier(bar); } } while (0)
#if defined(PROBE_T)
    if (PROBE_T == 0 && c == 0 && tid == 0) pt0 = __builtin_amdgcn_s_memrealtime();
#endif
    if (IN(0)) { ListOrder S; S.init(NP, 1024, 0); S.L0 = c; S.dL = 256; S.n = 0; S.extraL = -1;
       p0_prologue(p, lds, tid, lane, wave, vcu, G, 0, 0, 0);
#if PROBE_DUP & 1
            __syncthreads(); p0_prologue(p, lds, tid, lane, wave, vcu, G, 0, 0, 0);
#endif
        SEAM(0, 2); }
#if defined(PROBE_T)
    if (PROBE_T == 0 && c == 0 && tid == 0) pt1 = __builtin_amdgcn_s_memrealtime();
#endif
#if defined(PROBE_T)
    if (PROBE_T == 1 && c == 0 && tid == 0) pt0 = __builtin_amdgcn_s_memrealtime();
#endif
    if (IN(1)) { ListOrder S; S.init(NP, 1024, 0); S.L0 = c; S.dL = 256; S.n = 0; S.extraL = -1;
       { pg8::Gemm g_{XB, (const bf16*)(ws + WS_WRI), MT, 6144, 1024};
                  pg8::EpiRetIn E_{BIG, ss, (const float*)(ws + WS_TRC), (const float*)(ws + WS_TRS)};
                  if (c >= 208) { S.init(NS, 6144, 64); S.L0 = c - 208; S.n = 1; pg8::gemm_phase<pg8::EpiRetIn, ListOrder, true, true>(lds, g_, S, E_); }
                  else { p0_prologue(p, lds, tid, lane, wave, vcu, G, 1, c, 208); __syncthreads(); }
                  S.init(NP, 6144, 0); S.L0 = c; S.n = 6;
                  pg8::gemm_phase<pg8::EpiRetIn, ListOrder, true, true>(lds, g_, S, E_); }
        SEAM(1, 1); }
#if defined(PROBE_T)
    if (PROBE_T == 1 && c == 0 && tid == 0) pt1 = __builtin_amdgcn_s_memrealtime();
#endif
#if defined(PROBE_T)
    if (PROBE_T == 2 && c == 0 && tid == 0) pt0 = __builtin_amdgcn_s_memrealtime();
#endif
    if (IN(2)) { ListOrder S; S.init(NP, 1024, 0); S.L0 = c; S.dL = 256; S.n = 0; S.extraL = -1;

#if defined(PROBE_T)
            if (PROBE_T == 102 && c == 0 && tid == 0) pt0 = __builtin_amdgcn_s_memrealtime();
#endif
            for (int u = vcu; u < 256; u += G) ret_prompt_unit(lds, BIG, OB, (float*)(ws + WS_SSOP), out + OUT_SP, u >> 3, u & 7, p.lg2[(u >> 3) & 3], tid);
            __syncthreads();
#if defined(PROBE_T)
            if (PROBE_T == 102 && c == 0 && tid == 0) pt1 = __builtin_amdgcn_s_memrealtime();
            if (PROBE_T == 103 && c == 0 && tid == 0) pt0 = __builtin_amdgcn_s_memrealtime();
#endif
            for (int u = vcu; u < 512; u += G) ret_sample_unit(lds, BIG, OB, p.in[2], out + OUT_SS, u, p.lg2[u & 3], tid);
#if defined(PROBE_T)
            if (PROBE_T == 103 && c == 0 && tid == 0) pt1 = __builtin_amdgcn_s_memrealtime();
#endif


        SEAM(2, 1); }
#if defined(PROBE_T)
    if (PROBE_T == 2 && c == 0 && tid == 0) pt1 = __builtin_amdgcn_s_memrealtime();
#endif
#if defined(PROBE_T)
    if (PROBE_T == 3 && c == 0 && tid == 0) pt0 = __builtin_amdgcn_s_memrealtime();
#endif
    if (IN(3)) { ListOrder S; S.init(NP, 1024, 0); S.L0 = c; S.dL = 256; S.n = 0; S.extraL = -1;
        SEAM(3, 0); }
#if defined(PROBE_T)
    if (PROBE_T == 3 && c == 0 && tid == 0) pt1 = __builtin_amdgcn_s_memrealtime();
#endif
#if defined(PROBE_T)
    if (PROBE_T == 4 && c == 0 && tid == 0) pt0 = __builtin_amdgcn_s_memrealtime();
#endif
    if (IN(4)) { ListOrder S; S.init(NP, 1024, 0); S.L0 = c; S.dL = 256; S.n = 0; S.extraL = -1;
       { S.n = 1; LAS float* HT = (LAS float*)(lds + 131072); LAS float* HS4 = HT + 1024;
         { pg8::Unit u0; S.next(0, u0); const float* pp = (const float*)(ws + WS_SSOP) + ((size_t)(u0.pm * 256 + (tid >> 1)) * 4 + (tid & 1) * 2) * 16;
#pragma unroll
           for (int hh = 0; hh < 2; ++hh) { const f32x4* q4 = (const f32x4*)(pp + hh * 16); const f32x4 a = (q4[0] + q4[1]) + (q4[2] + q4[3]);
               HS4[(tid >> 1) * 4 + (tid & 1) * 2 + hh] = __builtin_amdgcn_rsqf(((a[0] + a[1]) + (a[2] + a[3])) * (1.0f / 512.0f) + EPS); }
           __syncthreads();
           if (tid < 256) { const f32x4 s4 = *(const LAS f32x4*)(HS4 + tid * 4); *(LAS f32x4*)(HT + tid * 4) = (f32x4){s4[0] / s4[1], s4[1] / s4[2], s4[2] / s4[3], s4[3]}; }
           __syncthreads(); }
         pg8::EpiRes E_{XB, nullptr, ss + MT, HT}; pg8::Gemm g_{OB, (const bf16*)(ws + WS_WRO), MT, 1024, 2048};
         pg8::gemm_phase<pg8::EpiRes, ListOrder, true, true, true>(lds, g_, S, E_, HT); }
        SEAM(4, 1); }
#if defined(PROBE_T)
    if (PROBE_T == 4 && c == 0 && tid == 0) pt1 = __builtin_amdgcn_s_memrealtime();
#endif
#if defined(PROBE_T)
    if (PROBE_T == 5 && c == 0 && tid == 0) pt0 = __builtin_amdgcn_s_memrealtime();
#endif
    if (IN(5)) { ListOrder S; S.init(NP, 1024, 0); S.L0 = c; S.dL = 256; S.n = 0; S.extraL = -1;
       { S.init(NS, 1024, 64); S.L0 = c - 248; S.n = hi8 ? 1 : 0; pg8::EpiRes E_{XB, nullptr, ss + MT, nullptr}; GEMM_RES(OB, WS_WRO, 2048, E_); if (hi8) flag_signal(F1, tid); }
        SEAM(5, 0); }
#if defined(PROBE_T)
    if (PROBE_T == 5 && c == 0 && tid == 0) pt1 = __builtin_amdgcn_s_memrealtime();
#endif
#if defined(PROBE_T)
    if (PROBE_T == 6 && c == 0 && tid == 0) pt0 = __builtin_amdgcn_s_memrealtime();
#endif
    if (IN(6)) { ListOrder S; S.init(NP, 1024, 0); S.L0 = c; S.dL = 256; S.n = 0; S.extraL = -1;
       { S.init(NP, 5632, 0);
                  if (hi8) S.n = 3; else if (c >= 128 && c < 144) { S.n = 5; S.extraL = (3 + (c - 128) / 8) * 256 + 248 + (c - 128) % 8; } else S.n = (c < 128) ? 6 : 5;
                  GEMM_SWIGLU(WS_WFI0, ss + MT); }
        SEAM(6, 0); }
#if defined(PROBE_T)
    if (PROBE_T == 6 && c == 0 && tid == 0) pt1 = __builtin_amdgcn_s_memrealtime();
#endif
#if defined(PROBE_T)
    if (PROBE_T == 7 && c == 0 && tid == 0) pt0 = __builtin_amdgcn_s_memrealtime();
#endif
    if (IN(7)) { ListOrder S; S.init(NP, 1024, 0); S.L0 = c; S.dL = 256; S.n = 0; S.extraL = -1;
       { S.init(NS, 5632, 64); S.L0 = c - 144; S.n = mid44 ? 1 : 0; if (mid44) flag_wait(F1, 8u, tid); GEMM_SWIGLU(WS_WFI0, ss + MT); }
        SEAM(7, 1); }
#if defined(PROBE_T)
    if (PROBE_T == 7 && c == 0 && tid == 0) pt1 = __builtin_amdgcn_s_memrealtime();
#endif
#if defined(PROBE_T)
    if (PROBE_T == 8 && c == 0 && tid == 0) pt0 = __builtin_amdgcn_s_memrealtime();
#endif
    if (IN(8)) { ListOrder S; S.init(NP, 1024, 0); S.L0 = c; S.dL = 256; S.n = 0; S.extraL = -1;
       { S.n = 1; pg8::EpiRes E_{XB, nullptr, ss + 2 * MT, nullptr}; GEMM_RES(BIG, WS_WFO0, 2816, E_); }
        SEAM(8, 1); }
#if defined(PROBE_T)
    if (PROBE_T == 8 && c == 0 && tid == 0) pt1 = __builtin_amdgcn_s_memrealtime();
#endif
#if defined(PROBE_T)
    if (PROBE_T == 9 && c == 0 && tid == 0) pt0 = __builtin_amdgcn_s_memrealtime();
#endif
    if (IN(9)) { ListOrder S; S.init(NP, 1024, 0); S.L0 = c; S.dL = 256; S.n = 0; S.extraL = -1;
       { S.init(NS, 1024, 64); S.L0 = c - 248; S.n = hi8 ? 1 : 0; pg8::EpiRes E_{XB, nullptr, ss + 2 * MT, nullptr}; GEMM_RES(BIG, WS_WFO0, 2816, E_); }
        SEAM(9, 0); }
#if defined(PROBE_T)
    if (PROBE_T == 9 && c == 0 && tid == 0) pt1 = __builtin_amdgcn_s_memrealtime();
#endif
#if defined(PROBE_T)
    if (PROBE_T == 10 && c == 0 && tid == 0) pt0 = __builtin_amdgcn_s_memrealtime();
#endif
    if (IN(10)) { ListOrder S; S.init(NP, 1024, 0); S.L0 = c; S.dL = 256; S.n = 0; S.extraL = -1;
       { S.init(NP, 1536, 0);
                   if (hi8) S.n = 0; else if (c < 128) S.n = 2; else { S.n = 1; if (c < 136) S.extraL = 248 + (c - 128); }
                   GEMM_SWAIN(); }
        SEAM(10, 1); }
#if defined(PROBE_T)
    if (PROBE_T == 10 && c == 0 && tid == 0) pt1 = __builtin_amdgcn_s_memrealtime();
#endif
#if defined(PROBE_T)
    if (PROBE_T == 11 && c == 0 && tid == 0) pt0 = __builtin_amdgcn_s_memrealtime();
#endif
    if (IN(11)) { ListOrder S; S.init(NP, 1024, 0); S.L0 = c; S.dL = 256; S.n = 0; S.extraL = -1;
       { const bool m12 = (c >= 236 && c < 248); S.init(NS, 1536, 64); S.L0 = c - 236; S.n = m12 ? 1 : 0; GEMM_SWAIN(); if (m12) flag_signal(F3, tid); }
        SEAM(11, 0); }
#if defined(PROBE_T)
    if (PROBE_T == 11 && c == 0 && tid == 0) pt1 = __builtin_amdgcn_s_memrealtime();
#endif
#if defined(PROBE_T)
    if (PROBE_T == 12 && c == 0 && tid == 0) pt0 = __builtin_amdgcn_s_memrealtime();
#endif
    if (IN(12)) { ListOrder S; S.init(NP, 1024, 0); S.L0 = c; S.dL = 256; S.n = 0; S.extraL = -1;
       for (int u = vcu; u < 512; u += G) attn_prompt_unit(lds, BIG, OB, p.in[13], u, tid);
        SEAM(12, 0); }
#if defined(PROBE_T)
    if (PROBE_T == 12 && c == 0 && tid == 0) pt1 = __builtin_amdgcn_s_memrealtime();
#endif
#if defined(PROBE_T)
    if (PROBE_T == 13 && c == 0 && tid == 0) pt0 = __builtin_amdgcn_s_memrealtime();
#endif
    if (IN(13)) { ListOrder S; S.init(NP, 1024, 0); S.L0 = c; S.dL = 256; S.n = 0; S.extraL = -1;
       flag_wait(F3, 12u, tid);
                 if (!(c >= 236 && c < 248)) {
                     attn_sample_pair(lds, BIG, OB, p.in[13], p.in[3], p.in[4], out + OUT_KS, out + OUT_VS, vcu, vcu + 256, tid);
                     if (c < 12) { const int c2 = 236 + c, v2 = (c2 % 8) * (G / 8) + c2 / 8; attn_sample_pair(lds, BIG, OB, p.in[13], p.in[3], p.in[4], out + OUT_KS, out + OUT_VS, v2, v2 + 256, tid); } }
        SEAM(13, 1); }
#if defined(PROBE_T)
    if (PROBE_T == 13 && c == 0 && tid == 0) pt1 = __builtin_amdgcn_s_memrealtime();
#endif
#if defined(PROBE_T)
    if (PROBE_T == 14 && c == 0 && tid == 0) pt0 = __builtin_amdgcn_s_memrealtime();
#endif
    if (IN(14)) { ListOrder S; S.init(NP, 1024, 0); S.L0 = c; S.dL = 256; S.n = 0; S.extraL = -1;
       { S.n = 1; pg8::EpiRes E_{XB, nullptr, ss + 3 * MT, nullptr}; GEMM_RES(OB, WS_WSO, 1024, E_); }
        SEAM(14, 1); }
#if defined(PROBE_T)
    if (PROBE_T == 14 && c == 0 && tid == 0) pt1 = __builtin_amdgcn_s_memrealtime();
#endif
#if defined(PROBE_T)
    if (PROBE_T == 15 && c == 0 && tid == 0) pt0 = __builtin_amdgcn_s_memrealtime();
#endif
    if (IN(15)) { ListOrder S; S.init(NP, 1024, 0); S.L0 = c; S.dL = 256; S.n = 0; S.extraL = -1;
       { S.init(NS, 1024, 64); S.L0 = c - 248; S.n = hi8 ? 1 : 0; pg8::EpiRes E_{XB, nullptr, ss + 3 * MT, nullptr}; GEMM_RES(OB, WS_WSO, 1024, E_); if (hi8) flag_signal(F4, tid); }
        SEAM(15, 0); }
#if defined(PROBE_T)
    if (PROBE_T == 15 && c == 0 && tid == 0) pt1 = __builtin_amdgcn_s_memrealtime();
#endif
#if defined(PROBE_T)
    if (PROBE_T == 16 && c == 0 && tid == 0) pt0 = __builtin_amdgcn_s_memrealtime();
#endif
    if (IN(16)) { ListOrder S; S.init(NP, 1024, 0); S.L0 = c; S.dL = 256; S.n = 0; S.extraL = -1;
       { S.init(NP, 5632, 0);
                   if (hi8 || mid44) S.n = 1; else if (c < 128) S.n = 6; else { S.n = 5; int j = -1; if (c < 144) j = c - 128; else if (c >= 188 && c < 204) j = 16 + (c - 188); if (j >= 0) S.extraL = (1 + j / 8) * 256 + 248 + j % 8; }
                   GEMM_SWIGLU(WS_WFI1, ss + 3 * MT); }
        SEAM(16, 0); }
#if defined(PROBE_T)
    if (PROBE_T == 16 && c == 0 && tid == 0) pt1 = __builtin_amdgcn_s_memrealtime();
#endif
#if defined(PROBE_T)
    if (PROBE_T == 17 && c == 0 && tid == 0) pt0 = __builtin_amdgcn_s_memrealtime();
#endif
    if (IN(17)) { ListOrder S; S.init(NP, 1024, 0); S.L0 = c; S.dL = 256; S.n = 0; S.extraL = -1;
       { S.init(NS, 5632, 64); S.L0 = c - 144; S.n = mid44 ? 1 : 0; if (mid44) flag_wait(F4, 8u, tid); GEMM_SWIGLU(WS_WFI1, ss + 3 * MT); if (mid44) flag_signal(F5, tid); }
        SEAM(17, 0); }
#if defined(PROBE_T)
    if (PROBE_T == 17 && c == 0 && tid == 0) pt1 = __builtin_amdgcn_s_memrealtime();
#endif
#if defined(PROBE_T)
    if (PROBE_T == 18 && c == 0 && tid == 0) pt0 = __builtin_amdgcn_s_memrealtime();
#endif
    if (IN(18)) { ListOrder S; S.init(NP, 1024, 0); S.L0 = c; S.dL = 256; S.n = 0; S.extraL = -1;
       { S.init(NS, 1024, 64); S.L0 = c - 248; S.n = hi8 ? 1 : 0; if (hi8) flag_wait(F5, 44u, tid); pg8::EpiRes E_{XB, out, nullptr, nullptr}; GEMM_RES(BIG, WS_WFO1, 2816, E_); }
        SEAM(18, 0); }
#if defined(PROBE_T)
    if (PROBE_T == 18 && c == 0 && tid == 0) pt1 = __builtin_amdgcn_s_memrealtime();
#endif
#if defined(PROBE_T)
    if (PROBE_T == 19 && c == 0 && tid == 0) pt0 = __builtin_amdgcn_s_memrealtime();
#endif
    if (IN(19)) { ListOrder S; S.init(NP, 1024, 0); S.L0 = c; S.dL = 256; S.n = 0; S.extraL = -1;
       { S.init(NP, 5632, 0); S.L0 = 256 + c; S.n = mid44 ? 4 : 0; GEMM_SWIGLU(WS_WFI1, ss + 3 * MT); }
        SEAM(19, 1); }
#if defined(PROBE_T)
    if (PROBE_T == 19 && c == 0 && tid == 0) pt1 = __builtin_amdgcn_s_memrealtime();
#endif
#if defined(PROBE_T)
    if (PROBE_T == 20 && c == 0 && tid == 0) pt0 = __builtin_amdgcn_s_memrealtime();
#endif
    if (IN(20)) { ListOrder S; S.init(NP, 1024, 0); S.L0 = c; S.dL = 256; S.n = 0; S.extraL = -1;
       { S.n = 1; pg8::EpiRes E_{XB, out, nullptr, nullptr}; GEMM_RES(BIG, WS_WFO1, 2816, E_); }
        SEAM(20, 0); }
#if defined(PROBE_T)
    if (PROBE_T == 20 && c == 0 && tid == 0) pt1 = __builtin_amdgcn_s_memrealtime();
#endif
#undef IN
#undef SEAM
#if defined(PROBE_T)
    if (c == 0 && tid == 0) { const unsigned long long te = __builtin_amdgcn_s_memrealtime(), d = (pt1 - pt0) * 4ull; while (__builtin_amdgcn_s_memrealtime() - te < d) __builtin_amdgcn_s_sleep(8); }
#endif
}

#ifndef N_LAUNCHES
#define N_LAUNCHES 1
#endif
extern "C" void kernel_launch(void* const* d_in, const int* in_sizes, int n_in, void* d_out, int out_size, void* d_ws, size_t ws_size, hipStream_t stream) {
    static int grid = 0;
    if (grid == 0) {
        if (n_in != 16 || (size_t)out_size != OUT_END || ws_size < WS_TOTAL) { fprintf(stderr, "kernel_launch: unexpected shapes (n_in %d out %d ws %zu need %zu)\n", n_in, out_size, ws_size, (size_t)WS_TOTAL); grid = -1; return; }
        int dev = 0, cus = 0, per_cu = 0;
        (void)hipGetDevice(&dev); (void)hipDeviceGetAttribute(&cus, hipDeviceAttributeMultiprocessorCount, dev);
        if (hipFuncSetAttribute((const void*)hybrid_fwd, hipFuncAttributeMaxDynamicSharedMemorySize, LDS_BYTES) != hipSuccess) { fprintf(stderr, "kernel_launch: hipFuncSetAttribute failed\n"); grid = -1; return; }
        if (hipOccupancyMaxActiveBlocksPerMultiprocessor(&per_cu, (const void*)hybrid_fwd, NTHR, LDS_BYTES) != hipSuccess || per_cu < 1) { fprintf(stderr, "kernel_launch: occupancy query says %d\n", per_cu); per_cu = 1; }
        (void)hipGetLastError();
        grid = cus * 1;
        if (grid != 256) { fprintf(stderr, "kernel_launch: built for a 256-CU device (got %d)\n", cus); grid = -1; return; }
    }
    if (grid < 0) return;
    if (hipMemsetAsync((char*)d_ws + WS_CTL, 0, CTL_BYTES, stream) != hipSuccess) { fprintf(stderr, "kernel_launch: memset failed\n"); return; }
    Params p; memset(&p, 0, sizeof(p));
    for (int i = 0; i < 16; ++i) p.in[i] = (const float*)d_in[i];
    p.out = (float*)d_out; p.ws = (unsigned char*)d_ws;
    const double two_pi = 6.283185307179586476925286766559;
    for (int i = 0; i < 128; ++i) p.invR[i] = 1.0 / std::pow(10000.0, (double)i / 127.0) / two_pi;
    for (int i = 0; i < 32; ++i) p.invS[i] = 1.0 / std::pow(10000.0, (double)(2 * i) / 64.0) / two_pi;
    for (int h = 0; h < 4; ++h) p.lg2[h] = (float)std::log2(1.0 - std::ldexp(1.0, -5 - h));
#if N_LAUNCHES == 1
    p.ph_lo = 0; p.ph_hi = NSTEPS;
    void* args[] = {&p};
    hipError_t e = hipLaunchCooperativeKernel((const void*)hybrid_fwd, dim3(grid), dim3(NTHR), args, LDS_BYTES, stream);
    if (e != hipSuccess) fprintf(stderr, "kernel_launch: cooperative launch failed: %s (grid %d)\n", hipGetErrorString(e), grid);
#else
    for (int ph = 0; ph < NSTEPS; ++ph) { p.ph_lo = ph; p.ph_hi = ph + 1; hipLaunchKernelGGL(hybrid_fwd, dim3(grid), dim3(NTHR), LDS_BYTES, stream, p); }
#endif
}
```

```cpp
#include <hip/hip_runtime.h>
#include <hip/hip_cooperative_groups.h>
#include <cstdio>
#include <cstdint>
#include <cmath>
#include <cstring>
namespace cg = cooperative_groups;
namespace pg8 {
#define PG8_LAS __attribute__((address_space(3)))
typedef unsigned short bf16_t;
typedef short bf16x8 __attribute__((ext_vector_type(8)));
typedef float f32x4 __attribute__((ext_vector_type(4)));
typedef unsigned u32x4 __attribute__((ext_vector_type(4)));
constexpr int BM = 256, BK = 64, HALF = 128, HTB = HALF * BK * 2  , STAGE_BYTES = 8 * HTB, NXCD = 8, WGM = 8;

__host__ __device__ __forceinline__ int lds_byte(int r, int c) { const int st = (r >> 4) * 2 + (c >> 5), rr = r & 15, cc = c & 31, ob = rr * 64 + cc * 2; return st * 1024 + (ob ^ (((ob >> 9) & 1) << 5)); }
__host__ __device__ __forceinline__ void stage_rc(int b, int& R, int& C) { const int st = b / 1024, sb = b % 1024, swz = sb ^ (((sb >> 9) & 1) << 5); R = (st >> 1) * 16 + swz / 64; C = (st & 1) * 32 + (swz % 64) / 2; }
__host__ __device__ __forceinline__ int perm32(int rho) { const int n = rho >> 4, i = rho & 15; return 8 * (i >> 2) + 4 * n + (i & 3); }

struct Unit { int pm, pn; };
struct Gemm { const bf16_t* A; const bf16_t* Bt; int M, N, K; };

struct StaticOrder {
    int nM, nN, nwg, G, c;
    __host__ __device__ void init(int M, int N, int G_, int c_) { nM = M / BM; nN = N / BM; nwg = nM * nN; G = G_; c = c_; }
    __host__ __device__ bool next(int i, Unit& u) const {
        const long L = (long)i * G + c; if (L >= nwg) return false;
        int wgid = (int)L; { const int q = nwg / NXCD, r = nwg % NXCD, xcd = wgid % NXCD, off = wgid / NXCD; wgid = (xcd < r ? xcd * (q + 1) : r * (q + 1) + (xcd - r) * q) + off; }
        const int nig = WGM * nN, gid = wgid / nig, fm = gid * WGM, gsz = (nM - fm) < WGM ? (nM - fm) : WGM;
        u.pm = fm + ((wgid % nig) % gsz); u.pn = (wgid % nig) / gsz; return true;
    }
    __device__ __forceinline__ void a_ready(const Unit&) const {}
    __device__ __forceinline__ void done(const Unit&) const {}
};

__device__ __forceinline__ unsigned cvt_pk_bf16(float lo, float hi) { unsigned r; asm volatile("v_cvt_pk_bf16_f32 %0, %1, %2" : "=v"(r) : "v"(lo), "v"(hi)); return r; }
typedef float f32x2 __attribute__((ext_vector_type(2)));
constexpr int P_NP = 16384, P_D = 1024, P_MT = 16896;
constexpr float P_EPS = 1e-6f;
__device__ __forceinline__ float silu_f(float x) { return x * __builtin_amdgcn_rcpf(1.0f + __expf(-x)); }
__device__ __forceinline__ float row_rstd(const float* ssp, int row) {
    const f32x4* pp = (const f32x4*)(ssp + (size_t)row * 16); const f32x4 a = (pp[0] + pp[1]) + (pp[2] + pp[3]);
    return __builtin_amdgcn_rsqf(((a[0] + a[1]) + (a[2] + a[3])) * (1.0f / 1024.0f) + P_EPS);
}
__device__ __forceinline__ int pos_index(int row) { return row < P_NP ? (row & 2047) : 2048 + (row & 3); }
__device__ __forceinline__ u32x4 pack8(const f32x4 a, const f32x4 b) { u32x4 w; w.x = cvt_pk_bf16(a[0], a[1]); w.y = cvt_pk_bf16(a[2], a[3]); w.z = cvt_pk_bf16(b[0], b[1]); w.w = cvt_pk_bf16(b[2], b[3]); return w; }

struct EpiRetIn {
    static constexpr bool PERM = true, AFTER_DRAIN = false;
    bf16_t* O; const float* ss; const float* cosT; const float* sinT;
    __device__ __forceinline__ void operator()(const f32x4 (&acc)[2][2][4][2], const Unit& u, int wr, int wc, int fr, int fq) const {
        const int pn = u.pn, ci = wc * 32 + 8 * fq;
#pragma unroll
        for (int ai = 0; ai < 2; ++ai)
#pragma unroll
            for (int m = 0; m < 4; ++m) {
                const int row = u.pm * BM + ai * HALF + wr * 64 + m * 16 + fr;
                const float rstd = __builtin_amdgcn_rsqf(ss[row] * (1.0f / 1024.0f) + P_EPS);
                bf16_t* rowp;
                if (pn < 8) rowp = O + ((size_t)pn * P_MT + row) * 256 + ci;
                else { const int q_ = pn - 8; rowp = O + (size_t)8 * P_MT * 256 + ((size_t)(q_ >> 1) * P_MT + row) * 512 + (q_ & 1) * 256 + ci; }
                if (pn < 8) {
                    const int pidx = pos_index(row);
                    const f32x4* cp = (const f32x4*)(cosT + pidx * 128 + ci); const f32x4* sp = (const f32x4*)(sinT + pidx * 128 + ci);
                    const float sc = (pn >= 4) ? rstd * 0.0625f : rstd;
                    f32x4 o1[2], o2[2];
#pragma unroll
                    for (int n = 0; n < 2; ++n) { const f32x4 c = cp[n], s = sp[n]; const f32x4 x1 = acc[ai][0][m][n] * sc, x2 = acc[ai][1][m][n] * sc; o1[n] = x1 * c - x2 * s; o2[n] = x2 * c + x1 * s; }
                    *(u32x4*)(rowp) = pack8(o1[0], o1[1]); *(u32x4*)(rowp + HALF) = pack8(o2[0], o2[1]);
                } else if (pn < 16) {
#pragma unroll
                    for (int bj = 0; bj < 2; ++bj) *(u32x4*)(rowp + bj * HALF) = pack8(acc[ai][bj][m][0] * rstd, acc[ai][bj][m][1] * rstd);
                } else {
#pragma unroll
                    for (int bj = 0; bj < 2; ++bj) { f32x4 a = acc[ai][bj][m][0] * rstd, b = acc[ai][bj][m][1] * rstd;
#pragma unroll
                        for (int j = 0; j < 4; ++j) { a[j] = silu_f(a[j]); b[j] = silu_f(b[j]); }
                        *(u32x4*)(rowp + bj * HALF) = pack8(a, b); }
                }
            }
    }
};
struct EpiRes {
    static constexpr bool PERM = true, AFTER_DRAIN = false;
    bf16_t* xb; float* outF; float* ssn; const PG8_LAS float* hs;
    __device__ __forceinline__ void operator()(const f32x4 (&acc)[2][2][4][2], const Unit& u, int wr, int wc, int fr, int fq) const {
        const int col0 = u.pn * BM + wc * 32 + 8 * fq;
#pragma unroll
        for (int ai = 0; ai < 2; ++ai)
#pragma unroll
            for (int m = 0; m < 4; ++m) {
                const int row = u.pm * BM + ai * HALF + wr * 64 + m * 16 + fr;
                bf16_t* xp = xb + (size_t)row * P_D + col0; float s = 0.f;
                const float hsc = hs ? hs[(ai * HALF + wr * 64 + m * 16 + fr) * 4 + 3] : 1.0f;
#pragma unroll
                for (int bj = 0; bj < 2; ++bj) {
                    const u32x4 rw = *(const u32x4*)(xp + bj * HALF);
                    const f32x4 r0 = (f32x4){__builtin_bit_cast(float, rw.x << 16), __builtin_bit_cast(float, rw.x & 0xffff0000u), __builtin_bit_cast(float, rw.y << 16), __builtin_bit_cast(float, rw.y & 0xffff0000u)};
                    const f32x4 r1 = (f32x4){__builtin_bit_cast(float, rw.z << 16), __builtin_bit_cast(float, rw.z & 0xffff0000u), __builtin_bit_cast(float, rw.w << 16), __builtin_bit_cast(float, rw.w & 0xffff0000u)};
                    const f32x4 v0 = r0 + acc[ai][bj][m][0] * hsc, v1 = r1 + acc[ai][bj][m][1] * hsc;
                    s += (v0[0] * v0[0] + v0[1] * v0[1]) + (v0[2] * v0[2] + v0[3] * v0[3]) + (v1[0] * v1[0] + v1[1] * v1[1]) + (v1[2] * v1[2] + v1[3] * v1[3]);
                    if (outF) { float* op = outF + (size_t)row * P_D + col0 + bj * HALF; *(f32x4*)(op) = v0; *(f32x4*)(op + 4) = v1; }
                    else *(u32x4*)(xp + bj * HALF) = pack8(v0, v1);
                }
                if (ssn) { s += __shfl_xor(s, 16); s += __shfl_xor(s, 32); if (fq == 0) atomicAdd(ssn + row, s); }
            }
    }
};
struct EpiSwiglu {
    static constexpr bool PERM = true, AFTER_DRAIN = false;
    bf16_t* H; const float* ss;
    __device__ __forceinline__ void operator()(const f32x4 (&acc)[2][2][4][2], const Unit& u, int wr, int wc, int fr, int fq) const {
        const int col0 = u.pn * HALF + wc * 32 + 8 * fq;
#pragma unroll
        for (int ai = 0; ai < 2; ++ai)
#pragma unroll
            for (int m = 0; m < 4; ++m) {
                const int row = u.pm * BM + ai * HALF + wr * 64 + m * 16 + fr;
                const float rstd = __builtin_amdgcn_rsqf(ss[row] * (1.0f / 1024.0f) + P_EPS);
                f32x4 h[2];
#pragma unroll
                for (int n = 0; n < 2; ++n) { const f32x4 g = acc[ai][0][m][n] * rstd, uu = acc[ai][1][m][n] * rstd;
#pragma unroll
                    for (int j = 0; j < 4; ++j) h[n][j] = silu_f(g[j]) * uu[j]; }
                *(u32x4*)(H + (size_t)row * 2816 + col0) = pack8(h[0], h[1]);
            }
    }
};
struct EpiSwaIn {
    static constexpr bool PERM = true, AFTER_DRAIN = false;
    bf16_t* O; const float* ss; const float* cosT; const float* sinT; const float* qg; const float* kg; float* kc_p; float* vc_p; float* kc_s; float* vc_s;
    __device__ __forceinline__ void operator()(const f32x4 (&acc)[2][2][4][2], const Unit& u, int wr, int wc, int fr, int fq) const {
        const int pn = u.pn;
        const float* G = (pn < 4) ? qg : kg;
        f32x4 g1[2], g2[2];
#pragma unroll
        for (int n = 0; n < 2; ++n) { g1[n] = *(const f32x4*)(G + 8 * fq + 4 * n); g2[n] = *(const f32x4*)(G + 32 + 8 * fq + 4 * n); }
        const int cbase = (pn < 4 ? (pn * 4 + wc) * 64 : (pn == 4 ? 1024 : 1280) + wc * 64) + 8 * fq;
#pragma unroll
        for (int ai = 0; ai < 2; ++ai)
#pragma unroll
            for (int m = 0; m < 4; ++m) {
                const int row = u.pm * BM + ai * HALF + wr * 64 + m * 16 + fr;
                const float rstd = __builtin_amdgcn_rsqf(ss[row] * (1.0f / 1024.0f) + P_EPS);
                bf16_t* rowp = O + (size_t)row * 1536 + cbase;
                float* cdst = nullptr;
                if (pn >= 4) {
                    float* cp_ = (pn == 4) ? kc_p : vc_p; float* cs_ = (pn == 4) ? kc_s : vc_s;
                    if (row < P_NP) { const int b = row >> 11, t = row & 2047; if (t >= 1920) cdst = cp_ + ((size_t)(b * 128 + (t - 1920)) * 4 + wc) * 64 + 8 * fq; }
                    else { const int s_ = row - P_NP, b = s_ >> 2, t = s_ & 3; cdst = cs_ + ((size_t)(b * 128 + 124 + t) * 4 + wc) * 64 + 8 * fq; }
                }
                f32x4 o1[2], o2[2];
                if (pn < 5) {
                    f32x4 x1[2], x2[2]; float q = 0.f;
#pragma unroll
                    for (int n = 0; n < 2; ++n) { x1[n] = acc[ai][0][m][n] * rstd; x2[n] = acc[ai][1][m][n] * rstd;
                        q += (x1[n][0] * x1[n][0] + x1[n][1] * x1[n][1]) + (x1[n][2] * x1[n][2] + x1[n][3] * x1[n][3]) + (x2[n][0] * x2[n][0] + x2[n][1] * x2[n][1]) + (x2[n][2] * x2[n][2] + x2[n][3] * x2[n][3]); }
                    q += __shfl_xor(q, 16); q += __shfl_xor(q, 32);
                    const float hr = __builtin_amdgcn_rsqf(q * (1.0f / 64.0f) + P_EPS);
                    const int pidx = pos_index(row);
                    const f32x4* cp = (const f32x4*)(cosT + pidx * 32 + 8 * fq); const f32x4* sp = (const f32x4*)(sinT + pidx * 32 + 8 * fq);
                    const float osc = (pn < 4) ? 0.125f : 1.0f;
#pragma unroll
                    for (int n = 0; n < 2; ++n) { const f32x4 c = cp[n], s = sp[n]; const f32x4 a = x1[n] * hr * g1[n], b = x2[n] * hr * g2[n]; o1[n] = (a * c - b * s) * osc; o2[n] = (b * c + a * s) * osc; }
                } else {
#pragma unroll
                    for (int n = 0; n < 2; ++n) { o1[n] = acc[ai][0][m][n] * rstd; o2[n] = acc[ai][1][m][n] * rstd; }
                }
                *(u32x4*)(rowp) = pack8(o1[0], o1[1]); *(u32x4*)(rowp + 32) = pack8(o2[0], o2[1]);
                if (cdst) { *(f32x4*)(cdst) = o1[0]; *(f32x4*)(cdst + 4) = o1[1]; *(f32x4*)(cdst + 32) = o2[0]; *(f32x4*)(cdst + 36) = o2[1]; }
            }
    }
};

template <class Epi, class Sched, bool ALIGN_EPI = false, bool SP2 = false, bool HS = false>
__device__ __forceinline__ void gemm_phase(PG8_LAS unsigned char* lds, const Gemm g, const Sched& S, const Epi& E, const PG8_LAS float* hs = nullptr) {
    const int tid = threadIdx.x, wid = __builtin_amdgcn_readfirstlane(tid >> 6), lane = tid & 63, wr = wid >> 2, wc = wid & 3, fr = lane & 15, fq = lane >> 4;
    const int K = g.K, nt = K / BK;
    unsigned voffA[2], voffB[2];
#pragma unroll
    for (int i = 0; i < 2; ++i) { int R, C; stage_rc(tid * 16 + i * 8192, R, C); const int Rb = Epi::PERM ? ((R & ~31) + perm32(R & 31)) : R;
        voffA[i] = (unsigned)(R * K + C) * 2u; voffB[i] = (unsigned)(Rb * K + C) * 2u; }
    const size_t kstep = (size_t)(BK * 2);
    const size_t hstep = (size_t)HALF * K * 2;
    const size_t tstep = 2 * hstep;
    const unsigned ldsw = (unsigned)wid * 1024u;
    const int aoff = lds_byte(wr * 64 + fr, fq * 8), boff = lds_byte(wc * 32 + fr, fq * 8);
#define PG8_SA(b, h) (((b) * 2 + (h)) * HTB)
#define PG8_SB(b, h) ((4 + (b) * 2 + (h)) * HTB)
#define PG8_STAGE(bufoff, gbase, voff) do { _Pragma("unroll") for (int _i = 0; _i < 2; ++_i) \
        __builtin_amdgcn_global_load_lds((const unsigned*)((const char*)(gbase) + (voff)[_i]), (PG8_LAS unsigned*)(lds + (bufoff) + ldsw + _i * 8192), 16, 0, 0); } while (0)
#define PG8_LDA(dst, b, h) do { _Pragma("unroll") for (int m = 0; m < 4; ++m) _Pragma("unroll") for (int k = 0; k < 2; ++k) dst[m][k] = *(const PG8_LAS bf16x8*)(lds + PG8_SA(b, h) + aoff + m * 2048 + k * 1024); } while (0)
#define PG8_LDB(dst, b, h) do { _Pragma("unroll") for (int n = 0; n < 2; ++n) _Pragma("unroll") for (int k = 0; k < 2; ++k) dst[n][k] = *(const PG8_LAS bf16x8*)(lds + PG8_SB(b, h) + boff + n * 2048 + k * 1024); } while (0)
#define PG8_MMA(ai, bj, At, Bt) do { __builtin_amdgcn_s_setprio(1); _Pragma("unroll") for (int m = 0; m < 4; ++m) _Pragma("unroll") for (int n = 0; n < 2; ++n) _Pragma("unroll") for (int k = 0; k < 2; ++k) \
        acc[ai][bj][m][n] = __builtin_amdgcn_mfma_f32_16x16x32_bf16(Bt[n][k], At[m][k], acc[ai][bj][m][n], 0, 0, 0); __builtin_amdgcn_s_setprio(0); } while (0)
#define PG8_WAIT_V(n) asm volatile("s_waitcnt vmcnt(" #n ")" ::: "memory")
#define PG8_WAIT_L(n) asm volatile("s_waitcnt lgkmcnt(" #n ")" ::: "memory")
#define PG8_BAR __builtin_amdgcn_s_barrier()
#define PG8_SCHED __builtin_amdgcn_sched_barrier(0)
    Unit cur, nxt; int ui = 0;
    if (!S.next(0, cur)) return;
    f32x4 acc[2][2][4][2];
#pragma unroll
    for (int a = 0; a < 2; ++a)
#pragma unroll
        for (int b = 0; b < 2; ++b)
#pragma unroll
            for (int m = 0; m < 4; ++m)
#pragma unroll
                for (int n = 0; n < 2; ++n) acc[a][b][m][n] = (f32x4){0.f, 0.f, 0.f, 0.f};
    bf16x8 At[4][2], B0[2][2], B1[2][2];
    const char* cA = (const char*)g.A + (size_t)cur.pm * tstep; const char* cB = (const char*)g.Bt + (size_t)cur.pn * tstep;
    S.a_ready(cur);
    if constexpr (SP2) {
        PG8_STAGE(PG8_SB(0, 0), cB, voffB); PG8_STAGE(PG8_SB(0, 1), cB + hstep, voffB); PG8_STAGE(PG8_SA(0, 0), cA, voffA); PG8_STAGE(PG8_SA(0, 1), cA + hstep, voffA);
        if (wr == 1) PG8_BAR;
        PG8_WAIT_V(2); PG8_BAR;
        PG8_STAGE(PG8_SB(1, 0), cB + kstep, voffB); PG8_STAGE(PG8_SA(1, 0), cA + kstep, voffA); PG8_STAGE(PG8_SB(1, 1), cB + hstep + kstep, voffB);
        PG8_WAIT_V(6); PG8_BAR;
    } else {
        PG8_STAGE(PG8_SB(0, 0), cB, voffB); PG8_STAGE(PG8_SA(0, 0), cA, voffA); PG8_STAGE(PG8_SB(0, 1), cB + hstep, voffB); PG8_STAGE(PG8_SA(0, 1), cA + hstep, voffA);
        if (wr == 1) PG8_BAR;
        PG8_WAIT_V(4); PG8_BAR;
        PG8_STAGE(PG8_SB(1, 0), cB + kstep, voffB); PG8_STAGE(PG8_SA(1, 0), cA + kstep, voffA); PG8_STAGE(PG8_SB(1, 1), cB + hstep + kstep, voffB);
        PG8_WAIT_V(6); PG8_BAR;
    }
    for (;;) {
        const bool has_next = S.next(ui + 1, nxt);
        const char* nA = has_next ? (const char*)g.A + (size_t)nxt.pm * tstep : cA; const char* nB = has_next ? (const char*)g.Bt + (size_t)nxt.pn * tstep : cB;
        for (int t = 0; t < nt; t += 2) {
            if constexpr (HS) { if (t == 8 || t == 16 || t == 24) { const int hb_ = (t >> 3) - 1;
#pragma unroll
                for (int ai = 0; ai < 2; ++ai)
#pragma unroll
                    for (int m = 0; m < 4; ++m) { const float rt_ = hs[(ai * HALF + wr * 64 + m * 16 + fr) * 4 + hb_];
#pragma unroll
                        for (int bj = 0; bj < 2; ++bj)
#pragma unroll
                            for (int n = 0; n < 2; ++n) acc[ai][bj][m][n] = acc[ai][bj][m][n] * rt_; } } }
            const bool last = (t == nt - 2);
            const char* a1 = cA + (size_t)(t + 1) * kstep;
            const char* a2 = last ? nA : cA + (size_t)(t + 2) * kstep; const char* b2 = last ? nB : cB + (size_t)(t + 2) * kstep;
            const char* a3 = a2 + kstep; const char* b3 = b2 + kstep;
            if (last && has_next) S.a_ready(nxt);
            if constexpr (SP2) {
            PG8_LDB(B0, 0, 0); PG8_LDB(B1, 0, 1); PG8_SCHED; PG8_LDA(At, 0, 0); PG8_STAGE(PG8_SA(1, 1), a1 + hstep, voffA);
            PG8_WAIT_V(8); PG8_WAIT_L(0); PG8_BAR; PG8_MMA(0, 0, At, B0); PG8_MMA(0, 1, At, B1); PG8_BAR; PG8_SCHED;
            PG8_LDA(At, 0, 1); PG8_STAGE(PG8_SB(0, 0), b2, voffB); PG8_STAGE(PG8_SB(0, 1), b2 + hstep, voffB); PG8_STAGE(PG8_SA(0, 0), a2, voffA);
            PG8_WAIT_V(8); PG8_WAIT_L(0); PG8_BAR; PG8_MMA(1, 0, At, B0); PG8_MMA(1, 1, At, B1); PG8_BAR; PG8_SCHED;
            PG8_LDB(B0, 1, 0); PG8_LDB(B1, 1, 1); PG8_SCHED; PG8_LDA(At, 1, 0); PG8_STAGE(PG8_SA(0, 1), a2 + hstep, voffA);
            PG8_WAIT_V(8); PG8_WAIT_L(0); PG8_BAR; PG8_MMA(0, 0, At, B0); PG8_MMA(0, 1, At, B1); PG8_BAR; PG8_SCHED;
            PG8_LDA(At, 1, 1); PG8_STAGE(PG8_SB(1, 0), b3, voffB); PG8_STAGE(PG8_SB(1, 1), b3 + hstep, voffB); PG8_STAGE(PG8_SA(1, 0), a3, voffA);
            PG8_WAIT_V(8); PG8_WAIT_L(0); PG8_BAR; PG8_MMA(1, 0, At, B0); PG8_MMA(1, 1, At, B1); PG8_BAR; PG8_SCHED;
            } else {
            PG8_LDB(B0, 0, 0); PG8_SCHED; PG8_LDA(At, 0, 0); PG8_STAGE(PG8_SA(1, 1), a1 + hstep, voffA);
            PG8_WAIT_L(8); PG8_BAR; PG8_WAIT_L(0); PG8_MMA(0, 0, At, B0); PG8_BAR; PG8_SCHED;
            PG8_LDB(B1, 0, 1); PG8_STAGE(PG8_SB(0, 0), b2, voffB);
            PG8_BAR; PG8_WAIT_L(0); PG8_MMA(0, 1, At, B1); PG8_BAR;
            PG8_LDA(At, 0, 1); PG8_STAGE(PG8_SA(0, 0), a2, voffA);
            PG8_BAR; PG8_WAIT_L(0); PG8_MMA(1, 0, At, B0); PG8_BAR; PG8_SCHED;
            PG8_STAGE(PG8_SB(0, 1), b2 + hstep, voffB);
            PG8_WAIT_V(6); PG8_BAR; PG8_MMA(1, 1, At, B1); PG8_BAR;
            PG8_LDB(B0, 1, 0); PG8_SCHED; PG8_LDA(At, 1, 0); PG8_STAGE(PG8_SA(0, 1), a2 + hstep, voffA);
            PG8_WAIT_L(8); PG8_BAR; PG8_WAIT_L(0); PG8_MMA(0, 0, At, B0); PG8_BAR; PG8_SCHED;
            PG8_LDB(B1, 1, 1); PG8_STAGE(PG8_SB(1, 0), b3, voffB);
            PG8_BAR; PG8_WAIT_L(0); PG8_MMA(0, 1, At, B1); PG8_BAR;
            PG8_LDA(At, 1, 1); PG8_STAGE(PG8_SA(1, 0), a3, voffA);
            PG8_BAR; PG8_WAIT_L(0); PG8_MMA(1, 0, At, B0); PG8_BAR; PG8_SCHED;
            PG8_STAGE(PG8_SB(1, 1), b3 + hstep, voffB);
            PG8_WAIT_V(6); PG8_BAR; PG8_MMA(1, 1, At, B1); PG8_BAR;
            }
        }
        if constexpr (ALIGN_EPI) { if (wr == 0) PG8_BAR; }
        if constexpr (!Epi::AFTER_DRAIN) { E(acc, cur, wr, wc, fr, fq); S.done(cur); }
        if (!has_next) break;
#pragma unroll
        for (int a = 0; a < 2; ++a)
#pragma unroll
            for (int b = 0; b < 2; ++b)
#pragma unroll
                for (int m = 0; m < 4; ++m)
#pragma unroll
                    for (int n = 0; n < 2; ++n) acc[a][b][m][n] = (f32x4){0.f, 0.f, 0.f, 0.f};
        cur = nxt; cA = nA; cB = nB; ++ui;
        if constexpr (ALIGN_EPI) { if (wr == 1) PG8_BAR; }
    }
    PG8_WAIT_V(0);
    if constexpr (!ALIGN_EPI) { if (wr == 0) PG8_BAR; }
    PG8_BAR;
    if constexpr (Epi::AFTER_DRAIN) { E.fused(acc, cur, wr, wc, fr, fq, lds, wid, lane); S.done(cur); }
#undef PG8_SA
#undef PG8_SB
#undef PG8_STAGE
#undef PG8_LDA
#undef PG8_LDB
#undef PG8_MMA
#undef PG8_WAIT_V
#undef PG8_WAIT_L
#undef PG8_BAR
#undef PG8_SCHED
}
}
#define LAS __attribute__((address_space(3)))
typedef unsigned short bf16;
typedef unsigned u32x4 __attribute__((ext_vector_type(4)));
typedef unsigned u32x2 __attribute__((ext_vector_type(2)));
typedef float f32x4 __attribute__((ext_vector_type(4)));
typedef short bf16x8 __attribute__((ext_vector_type(8)));
#define LDS_WAIT() asm volatile("s_waitcnt lgkmcnt(0)" ::: "memory")

constexpr int NWAVES = 8, NTHR = 512;
constexpr int DM = 1024, NP = 16384, NS = 512, MT = NP + NS, SEQ = 2048, DFF = 2816;
constexpr float EPS = 1e-6f;
constexpr int LDS_BYTES = 147456;

constexpr size_t al256(size_t x) { return (x + 255) & ~(size_t)255; }
constexpr size_t WS_WRI = 0;
constexpr size_t WS_WRO = WS_WRI + al256(6144ull * 1024 * 2);
constexpr size_t WS_WFI0 = WS_WRO + al256(1024ull * 2048 * 2);
constexpr size_t WS_WFO0 = WS_WFI0 + al256(5632ull * 1024 * 2);
constexpr size_t WS_WFI1 = WS_WFO0 + al256(1024ull * 2816 * 2);
constexpr size_t WS_WFO1 = WS_WFI1 + al256(5632ull * 1024 * 2);
constexpr size_t WS_WSI = WS_WFO1 + al256(1024ull * 2816 * 2);
constexpr size_t WS_WSO = WS_WSI + al256(1536ull * 1024 * 2);
constexpr size_t WS_XB = WS_WSO + al256(1024ull * 1024 * 2);
constexpr size_t WS_BIG = WS_XB + al256((size_t)MT * 1024 * 2);
constexpr size_t WS_OB = WS_BIG + al256((size_t)MT * 6144 * 2);
constexpr size_t WS_SS = WS_OB + al256((size_t)MT * 2048 * 2);
constexpr size_t WS_SSO = WS_SS + al256(4ull * MT * 4);
constexpr size_t WS_TRC = WS_SSO + al256((size_t)MT * 4 * 4);
constexpr size_t WS_TRS = WS_TRC + al256(2052ull * 128 * 4);
constexpr size_t WS_TSC = WS_TRS + al256(2052ull * 128 * 4);
constexpr size_t WS_TSS = WS_TSC + al256(2052ull * 32 * 4);
constexpr size_t WS_END = WS_TSS + al256(2052ull * 32 * 4);
constexpr size_t WS_SSOP = WS_END;
constexpr size_t WS_CTL = WS_SSOP + al256((size_t)NP * 64 * 4), CTL_BYTES = 65536;
constexpr size_t WS_SCR = WS_CTL + CTL_BYTES;
constexpr size_t WS_TOTAL = WS_SCR;
constexpr size_t OUT_Y = 0, OUT_SP = (size_t)MT * 1024, OUT_SS = OUT_SP + 8ull * 4 * 256 * 512, OUT_KP = OUT_SS + 128ull * 4 * 256 * 512,
                 OUT_VP = OUT_KP + 8ull * 128 * 256, OUT_KS = OUT_VP + 8ull * 128 * 256, OUT_VS = OUT_KS + 128ull * 128 * 256, OUT_END = OUT_VS + 128ull * 128 * 256;

struct Params {
    const float* in[16]; float* out; unsigned char* ws;
    double invR[128]; double invS[32];
    float lg2[4];
    int ph_lo, ph_hi;
};

__device__ __forceinline__ unsigned f2bf(float f) { unsigned u = __builtin_bit_cast(unsigned, f); return (u + 0x7fffu + ((u >> 16) & 1u)) >> 16; }
__device__ __forceinline__ unsigned pk2(float lo, float hi) { return pg8::cvt_pk_bf16(lo, hi); }
__device__ __forceinline__ float bf2f(unsigned short b) { return __builtin_bit_cast(float, (unsigned)b << 16); }
__device__ __forceinline__ float bflo(unsigned w) { return __builtin_bit_cast(float, w << 16); }
__device__ __forceinline__ float bfhi(unsigned w) { return __builtin_bit_cast(float, w & 0xffff0000u); }
__device__ __forceinline__ float wave_sum(float v) {
#pragma unroll
    for (int o = 1; o < 64; o <<= 1) v += __shfl_xor(v, o);
    return v;
}
__device__ __forceinline__ f32x4 mfma16(bf16x8 a, bf16x8 b, f32x4 c) { return __builtin_amdgcn_mfma_f32_16x16x32_bf16(a, b, c, 0, 0, 0); }

__device__ __forceinline__ void transpose_item(const float* W, int K, int N, const float* gain, bf16* WT, int n0, int d0a, int d0b, int k0, LAS float* scr, int lane) {
    f32x4 wv[16];
#pragma unroll
    for (int i = 0; i < 16; ++i) { const int kk = 4 * i + (lane >> 4); wv[i] = __builtin_nontemporal_load((const f32x4*)(W + (size_t)(k0 + kk) * N + n0 + 4 * (lane & 15))); }
#pragma unroll
    for (int i = 0; i < 16; ++i) { const int kk = 4 * i + (lane >> 4); const float g = gain ? gain[k0 + kk] : 1.0f; LAS float* d = scr + kk * 65 + 4 * (lane & 15);
        d[0] = wv[i][0] * g; d[1] = wv[i][1] * g; d[2] = wv[i][2] * g; d[3] = wv[i][3] * g; }
    LDS_WAIT();
    const int c = lane & 7;
#pragma unroll
    for (int j = 0; j < 8; ++j) { const int n = (lane >> 3) + 8 * j; const LAS float* s = scr + (8 * c) * 65 + n;
        u32x4 o; o.x = pk2(s[0 * 65], s[1 * 65]); o.y = pk2(s[2 * 65], s[3 * 65]); o.z = pk2(s[4 * 65], s[5 * 65]); o.w = pk2(s[6 * 65], s[7 * 65]);
        const int drow = (n < 32) ? d0a + n : d0b + n - 32;
        *(u32x4*)(WT + (size_t)drow * K + k0 + 8 * c) = o; }
    LDS_WAIT();
}
__device__ __forceinline__ int dmap32(int mode, int n0) {
    if (mode == 1) return (n0 < DFF) ? (n0 / 128) * 256 + (n0 % 128) : ((n0 - DFF) / 128) * 256 + 128 + ((n0 - DFF) % 128);
    if (mode == 2) { const int pn = n0 / 256, r256 = n0 % 256, wc = r256 / 64, bj = (r256 % 64) / 32; return 256 * pn + 128 * bj + 32 * wc; }
    return n0;
}
__device__ __forceinline__ void transpose_mat(const float* W, int K, int N, const float* gain, bf16* WT, int mode, int r, LAS float* scr, int lane) {
    const int nblk = N / 64, kb = r / nblk, nb = r % nblk, n0 = 64 * nb;
    transpose_item(W, K, N, gain, WT, n0, dmap32(mode, n0), dmap32(mode, n0 + 32), 64 * kb, scr, lane);
}
__device__ __forceinline__ void p0_prologue(const Params& p, LAS unsigned char* lds, int tid, int lane, int wave, int vcu, int G, int part, int wid1, int nwg1) {
    unsigned char* ws = p.ws;
    LAS float* scr = (LAS float*)(lds + wave * 16896);
    const int gw = part ? wid1 * NWAVES + wave : vcu * NWAVES + wave, NGW = (part ? nwg1 : G) * NWAVES;
    constexpr int I_RI = 16 * 96, I_RO = 32 * 16, I_FI = 16 * 88, I_FO = 44 * 16, I_SI = 16 * 24, I_SO = 16 * 16;
    constexpr int NITEMS = I_RI + I_RO + 2 * I_FI + 2 * I_FO + I_SI + I_SO;
    const float* nmix = p.in[5]; const float* nffn = p.in[6];
    for (int it = (part ? I_RI + gw : gw); it < (part ? NITEMS : I_RI); it += NGW) {
        int r = it;
        if (r < I_RI) { transpose_mat(p.in[7], 1024, 6144, nmix, (bf16*)(ws + WS_WRI), 0, r, scr, lane); continue; } r -= I_RI;
        if (r < I_RO) { transpose_mat(p.in[8], 2048, 1024, nullptr, (bf16*)(ws + WS_WRO), 0, r, scr, lane); continue; } r -= I_RO;
        if (r < I_FI) { transpose_mat(p.in[14], 1024, 5632, nffn, (bf16*)(ws + WS_WFI0), 1, r, scr, lane); continue; } r -= I_FI;
        if (r < I_FO) { transpose_mat(p.in[15], 2816, 1024, nullptr, (bf16*)(ws + WS_WFO0), 0, r, scr, lane); continue; } r -= I_FO;
        if (r < I_SI) { transpose_mat(p.in[9], 1024, 1536, nmix + 1024, (bf16*)(ws + WS_WSI), 2, r, scr, lane); continue; } r -= I_SI;
        if (r < I_SO) { transpose_mat(p.in[10], 1024, 1024, nullptr, (bf16*)(ws + WS_WSO), 0, r, scr, lane); continue; } r -= I_SO;
        if (r < I_FI) { transpose_mat(p.in[14] + (size_t)1024 * 5632, 1024, 5632, nffn + 1024, (bf16*)(ws + WS_WFI1), 1, r, scr, lane); continue; } r -= I_FI;
        transpose_mat(p.in[15] + (size_t)2816 * 1024, 2816, 1024, nullptr, (bf16*)(ws + WS_WFO1), 0, r, scr, lane);
    }
    if (part) return;
    float* cR = (float*)(ws + WS_TRC); float* sR = (float*)(ws + WS_TRS); float* cS = (float*)(ws + WS_TSC); float* sS = (float*)(ws + WS_TSS);
    for (int idx = vcu * NTHR + tid; idx < 2052 * 160; idx += G * NTHR) {
        const int pi = idx / 160, c = idx % 160; const double pos = (pi < 2048) ? (double)pi : (double)(16384 + (pi - 2048));
        double rev = pos * ((c < 128) ? p.invR[c] : p.invS[c - 128]); rev -= __builtin_rint(rev);
        const float cv = __builtin_amdgcn_cosf((float)rev), sv = __builtin_amdgcn_sinf((float)rev);
        if (c < 128) { cR[pi * 128 + c] = cv; sR[pi * 128 + c] = sv; } else { cS[pi * 32 + c - 128] = cv; sS[pi * 32 + c - 128] = sv; }
    }
    bf16* XB = (bf16*)(ws + WS_XB); float* ss = (float*)(ws + WS_SS); float* sso = (float*)(ws + WS_SSO);
#pragma unroll 2
    for (int m = gw; m < MT; m += NGW) {
        const float* xr = (m < NP) ? p.in[0] + (size_t)m * DM : p.in[1] + (size_t)(m - NP) * DM;
        f32x4 v[4]; float s = 0.f;
#pragma unroll
        for (int j = 0; j < 4; ++j) { v[j] = __builtin_nontemporal_load((const f32x4*)xr + lane + 64 * j); s += (v[j][0] * v[j][0] + v[j][1] * v[j][1]) + (v[j][2] * v[j][2] + v[j][3] * v[j][3]); }
        s = wave_sum(s);
#pragma unroll
        for (int j = 0; j < 4; ++j) { u32x2 o; o.x = pk2(v[j][0], v[j][1]); o.y = pk2(v[j][2], v[j][3]); ((u32x2*)(XB + (size_t)m * DM))[lane + 64 * j] = o; }
        if (lane == 0) { ss[m] = s; ss[MT + m] = 0.f; ss[2 * MT + m] = 0.f; ss[3 * MT + m] = 0.f; }
    }
}

constexpr int RQ_STR = 264, RV_STR = 72;
constexpr int RL_Q = 0, RL_K = 33792, RL_VT = 67584, RL_VD = 76800, RL_P = 86016, RL_ST = 95232, RL_GL = 129024;
__device__ __forceinline__ void ret_prompt_unit(LAS unsigned char* lds, const bf16* QKVG, bf16* OB, float* sso, float* state_out, int bh, int es, float lg2, int tid) {
    const int lane = tid & 63, w = __builtin_amdgcn_readfirstlane(tid >> 6), li = lane & 15, lq = lane >> 4;
    const int b = bh >> 2, h = bh & 3;
    LAS bf16* Ql = (LAS bf16*)(lds + RL_Q); LAS bf16* Kl = (LAS bf16*)(lds + RL_K); LAS bf16* VT = (LAS bf16*)(lds + RL_VT);
    LAS bf16* VD = (LAS bf16*)(lds + RL_VD); LAS bf16* PP = (LAS bf16*)(lds + RL_P); LAS bf16* ST = (LAS bf16*)(lds + RL_ST);
    for (int i = tid; i < 33792 / 16; i += NTHR) ((LAS u32x4*)ST)[i] = (u32x4){0u, 0u, 0u, 0u};
    f32x4 S[2][4];
#pragma unroll
    for (int a = 0; a < 2; ++a)
#pragma unroll
        for (int e = 0; e < 4; ++e) S[a][e] = (f32x4){0.f, 0.f, 0.f, 0.f};
    const size_t rowbase = (size_t)b * SEQ;
    const bf16* qg = QKVG + ((size_t)h * MT + rowbase) * 256;
    const bf16* kg = qg + (size_t)4 * MT * 256;
    const bf16* vg = QKVG + (size_t)8 * MT * 256 + ((size_t)h * MT + rowbase) * 512 + es * 64;
    const int srow = tid >> 5, sch = tid & 31;
    const int vrow = tid & 63, vch = tid >> 6;
    const bf16* gg = vg + (size_t)4 * MT * 512;
    LAS bf16* OL = (LAS bf16*)(lds + RL_GL + 9216);
    const int orow = tid >> 3, och = tid & 7;
    LAS bf16* GL = (LAS bf16*)(lds + RL_GL);
    u32x4 rq[4], rk[4], rv, rg;
#define RET_LOAD(t0_) do { _Pragma("unroll") for (int i_ = 0; i_ < 4; ++i_) { const size_t o_ = (size_t)((t0_) + srow + 16 * i_) * 256 + sch * 8; rq[i_] = *(const u32x4*)(qg + o_); rk[i_] = *(const u32x4*)(kg + o_); } \
        rv = *(const u32x4*)(vg + (size_t)((t0_) + vrow) * 512 + vch * 8); rg = *(const u32x4*)(gg + (size_t)((t0_) + vrow) * 512 + vch * 8); } while (0)
    RET_LOAD(0);
    const int ib = w >> 1, nh = w & 1;
    const float dS = __builtin_amdgcn_exp2f(64.0f * lg2);
    for (int c = 0; c < 32; ++c) {
        const int t0 = c * 64;
        asm volatile("s_waitcnt vmcnt(0)" ::: "memory");
#pragma unroll
        for (int i = 0; i < 4; ++i) { *(LAS u32x4*)(Ql + (srow + 16 * i) * RQ_STR + sch * 8) = rq[i]; *(LAS u32x4*)(Kl + (srow + 16 * i) * RQ_STR + sch * 8) = rk[i]; }
        *(LAS u32x4*)(GL + vrow * RV_STR + vch * 8) = rg;
        { const float dec = __builtin_amdgcn_exp2f((float)(63 - vrow) * lg2);
#pragma unroll
          for (int j = 0; j < 4; ++j) { const unsigned wv = rv[j]; const int e0 = vch * 8 + 2 * j;
              VT[e0 * RV_STR + vrow] = (bf16)(wv & 0xffffu); VT[(e0 + 1) * RV_STR + vrow] = (bf16)(wv >> 16);
              VD[e0 * RV_STR + vrow] = (bf16)f2bf(bflo(wv) * dec); VD[(e0 + 1) * RV_STR + vrow] = (bf16)f2bf(bfhi(wv) * dec); } }
        __syncthreads();
        if (c > 0) { const u32x4 ov = *(const LAS u32x4*)(OL + orow * 64 + och * 8); *(u32x4*)(OB + (rowbase + t0 - 64 + orow) * 2048 + h * 512 + es * 64 + och * 8) = ov; }
        if (c + 1 < 32) RET_LOAD(t0 + 64);
        f32x4 accS[2], accO[2];
#pragma unroll
        for (int t = 0; t < 2; ++t) { accS[t] = (f32x4){0.f, 0.f, 0.f, 0.f}; accO[t] = (f32x4){0.f, 0.f, 0.f, 0.f}; }
#pragma unroll
        for (int kh = 0; kh < 4; ++kh) {
            bf16x8 fa[2], fs[2][2], fk[2][2];
#pragma unroll
            for (int kk = 0; kk < 2; ++kk) { const int ks = 2 * kh + kk;
                fa[kk] = *(const LAS bf16x8*)(Ql + (16 * ib + li) * RQ_STR + 32 * ks + 8 * lq);
#pragma unroll
                for (int t = 0; t < 2; ++t) { fs[kk][t] = *(const LAS bf16x8*)(ST + (16 * (2 * nh + t) + li) * RQ_STR + 32 * ks + 8 * lq);
                    fk[kk][t] = *(const LAS bf16x8*)(Kl + (16 * (2 * nh + t) + li) * RQ_STR + 32 * ks + 8 * lq); } }
            __builtin_amdgcn_sched_barrier(0);
#pragma unroll
            for (int kk = 0; kk < 2; ++kk)
#pragma unroll
                for (int t = 0; t < 2; ++t) { accO[t] = mfma16(fa[kk], fs[kk][t], accO[t]); accS[t] = mfma16(fa[kk], fk[kk][t], accS[t]); }
            __builtin_amdgcn_sched_barrier(0);
        }
#pragma unroll
        for (int t = 0; t < 2; ++t) { const int jb = 2 * nh + t, j = 16 * jb + li;
#pragma unroll
            for (int r = 0; r < 4; ++r) { const int i = 16 * ib + 4 * lq + r;
                const float val = (j <= i) ? accS[t][r] * __builtin_amdgcn_exp2f((float)(i - j) * lg2) : 0.f;
                PP[i * RV_STR + j] = (bf16)f2bf(val); } }
        __syncthreads();
        f32x4 accA[2];
#pragma unroll
        for (int t = 0; t < 2; ++t) accA[t] = (f32x4){0.f, 0.f, 0.f, 0.f};
#pragma unroll
        for (int ks = 0; ks < 2; ++ks) {
            const bf16x8 a = *(const LAS bf16x8*)(PP + (16 * ib + li) * RV_STR + 32 * ks + 8 * lq);
#pragma unroll
            for (int t = 0; t < 2; ++t) { const bf16x8 bv = *(const LAS bf16x8*)(VT + (16 * (2 * nh + t) + li) * RV_STR + 32 * ks + 8 * lq); accA[t] = mfma16(a, bv, accA[t]); }
        }
#pragma unroll
        for (int r = 0; r < 4; ++r) { const int i = 16 * ib + 4 * lq + r; const float f = __builtin_amdgcn_exp2f((float)(i + 1) * lg2);
            const size_t row = rowbase + t0 + i; float q2 = 0.f;
#pragma unroll
            for (int t = 0; t < 2; ++t) { const float o = accA[t][r] + f * accO[t][r]; q2 += o * o; OL[i * 64 + 16 * (2 * nh + t) + li] = (bf16)f2bf(o * bf2f(GL[i * RV_STR + 16 * (2 * nh + t) + li])); }
            q2 += __shfl_xor(q2, 1); q2 += __shfl_xor(q2, 2); q2 += __shfl_xor(q2, 4); q2 += __shfl_xor(q2, 8);
            if (li == 0 && sso) sso[(row * 4 + h) * 16 + es * 2 + nh] = q2; }
#pragma unroll
        for (int a = 0; a < 2; ++a)
#pragma unroll
            for (int e = 0; e < 4; ++e) S[a][e] = S[a][e] * dS;
#pragma unroll
        for (int ks = 0; ks < 2; ++ks) {
            bf16x8 ka[2];
#pragma unroll
            for (int dm = 0; dm < 2; ++dm)
#pragma unroll
                for (int jj = 0; jj < 8; ++jj) ka[dm][jj] = (short)Kl[(32 * ks + 8 * lq + jj) * RQ_STR + 32 * w + 16 * dm + li];
#pragma unroll
            for (int en = 0; en < 4; ++en) { const bf16x8 bv = *(const LAS bf16x8*)(VD + (16 * en + li) * RV_STR + 32 * ks + 8 * lq);
#pragma unroll
                for (int dm = 0; dm < 2; ++dm) S[dm][en] = mfma16(ka[dm], bv, S[dm][en]); }
        }
#pragma unroll
        for (int dm = 0; dm < 2; ++dm)
#pragma unroll
            for (int en = 0; en < 4; ++en) { u32x2 o; o.x = f2bf(S[dm][en][0]) | (f2bf(S[dm][en][1]) << 16); o.y = f2bf(S[dm][en][2]) | (f2bf(S[dm][en][3]) << 16);
                *(LAS u32x2*)(ST + (16 * en + li) * RQ_STR + 32 * w + 16 * dm + 4 * lq) = o; }
        __syncthreads();
    }
#undef RET_LOAD
    { const u32x4 ov = *(const LAS u32x4*)(OL + orow * 64 + och * 8); *(u32x4*)(OB + (rowbase + 31 * 64 + orow) * 2048 + h * 512 + es * 64 + och * 8) = ov; }
    float* so = state_out + ((size_t)bh * 256) * 512 + es * 64;
#pragma unroll
    for (int dm = 0; dm < 2; ++dm)
#pragma unroll
        for (int en = 0; en < 4; ++en)
#pragma unroll
            for (int r = 0; r < 4; ++r) so[(size_t)(32 * w + 16 * dm + 4 * lq + r) * 512 + 16 * en + li] = S[dm][en][r];
}

__device__ __forceinline__ void ret_sample_unit(LAS unsigned char* lds, const bf16* QKVG, bf16* OB, const float* state_in, float* state_out, int bh, float lg2, int tid) {
    const int lane = tid & 63, w = __builtin_amdgcn_readfirstlane(tid >> 6);
    const int b = bh >> 2, h = bh & 3;
    LAS float* qk8 = (LAS float*)lds;
    LAS float* qkd = qk8 + 2048;
    LAS float* red = qkd + 16;
    LAS float* wsm = red + 8192;
    const size_t r0 = (size_t)(NP + b * 4);
    {
        const int idx = tid * 4, which = idx >> 10, t = (idx >> 8) & 3, d = idx & 255;
        const u32x2 v = *(const u32x2*)(QKVG + (size_t)which * 4 * MT * 256 + ((size_t)h * MT + r0 + t) * 256 + d);
        LAS float* dst = qk8 + d * 8 + which * 4 + t;
        dst[0] = bflo(v.x); dst[8] = bfhi(v.x); dst[16] = bflo(v.y); dst[24] = bfhi(v.y);
    }
    __syncthreads();
    {
#pragma unroll
        for (int pp = 0; pp < 2; ++pp) { const int pr = 2 * w + pp, i = pr >> 2, j = pr & 3; float s = 0.f;
#pragma unroll
            for (int dd = 0; dd < 4; ++dd) { const int d = lane * 4 + dd; s += qk8[d * 8 + i] * qk8[d * 8 + 4 + j]; }
            s = wave_sum(s); if (lane == 0) qkd[pr] = s; }
    }
    const float g1 = __builtin_amdgcn_exp2f(lg2), g2 = g1 * g1, g3 = g2 * g1, g4 = g2 * g2;
    const int ec = tid & 127, dg = tid >> 7;
    f32x4 vv[4];
#pragma unroll
    for (int j = 0; j < 4; ++j) { const u32x2 v = *(const u32x2*)(QKVG + (size_t)8 * MT * 256 + ((size_t)h * MT + r0 + j) * 512 + 4 * ec); vv[j] = (f32x4){bflo(v.x), bfhi(v.x), bflo(v.y), bfhi(v.y)}; }
    vv[0] = vv[0] * g3; vv[1] = vv[1] * g2; vv[2] = vv[2] * g1;
    f32x4 oa[4];
#pragma unroll
    for (int i = 0; i < 4; ++i) oa[i] = (f32x4){0.f, 0.f, 0.f, 0.f};
    const float* sin_ = state_in + ((size_t)bh * 256 + dg * 64) * 512 + 4 * ec;
    float* sout = state_out + ((size_t)bh * 256 + dg * 64) * 512 + 4 * ec;
    f32x4 sb[2][8];
#pragma unroll
    for (int r = 0; r < 8; ++r) sb[0][r] = __builtin_nontemporal_load((const f32x4*)(sin_ + (size_t)r * 512));
#pragma unroll
    for (int bt = 0; bt < 8; ++bt) {
        if (bt + 1 < 8) {
#pragma unroll
            for (int r = 0; r < 8; ++r) sb[(bt + 1) & 1][r] = __builtin_nontemporal_load((const f32x4*)(sin_ + (size_t)((bt + 1) * 8 + r) * 512));
            asm volatile("s_waitcnt vmcnt(8)" ::: "memory");
        } else asm volatile("s_waitcnt vmcnt(0)" ::: "memory");
#pragma unroll
        for (int r = 0; r < 8; ++r) { const int dd = bt * 8 + r; const f32x4 s = sb[bt & 1][r];
            const f32x4 q4 = *(const LAS f32x4*)(qk8 + (dg * 64 + dd) * 8), k4 = *(const LAS f32x4*)(qk8 + (dg * 64 + dd) * 8 + 4);
            const f32x4 sn = s * g4 + vv[0] * k4[0] + vv[1] * k4[1] + vv[2] * k4[2] + vv[3] * k4[3];
            __builtin_nontemporal_store(sn, (f32x4*)(sout + (size_t)dd * 512));
            oa[0] += s * q4[0]; oa[1] += s * q4[1]; oa[2] += s * q4[2]; oa[3] += s * q4[3]; }
    }
#pragma unroll
    for (int i = 0; i < 4; ++i) *(LAS f32x4*)(red + (dg * 4 + i) * 512 + 4 * ec) = oa[i];
    __syncthreads();
    {
        const int e = tid; float vj[4], o[4], q2[4];
#pragma unroll
        for (int j = 0; j < 4; ++j) vj[j] = bf2f(QKVG[(size_t)8 * MT * 256 + ((size_t)h * MT + r0 + j) * 512 + e]);
        const float gp[4] = {1.0f, g1, g2, g3};
#pragma unroll
        for (int i = 0; i < 4; ++i) { float ob = (red[(0 * 4 + i) * 512 + e] + red[(1 * 4 + i) * 512 + e]) + (red[(2 * 4 + i) * 512 + e] + red[(3 * 4 + i) * 512 + e]);
            float acc = ob * gp[i] * g1;
#pragma unroll
            for (int j = 0; j < 4; ++j) if (j <= i) acc += gp[i - j] * qkd[i * 4 + j] * vj[j];
            o[i] = acc; q2[i] = wave_sum(acc * acc); }
        if (lane == 0) {
#pragma unroll
            for (int i = 0; i < 4; ++i) wsm[w * 4 + i] = q2[i]; }
        __syncthreads();
#pragma unroll
        for (int i = 0; i < 4; ++i) { float t = 0.f;
#pragma unroll
            for (int ww = 0; ww < 8; ++ww) t += wsm[ww * 4 + i];
            const float rstd = __builtin_amdgcn_rsqf(t * (1.0f / 512.0f) + EPS);
            const float sg = bf2f(QKVG[(size_t)8 * MT * 256 + (size_t)4 * MT * 512 + ((size_t)h * MT + r0 + i) * 512 + e]);
            OB[(r0 + i) * 2048 + h * 512 + e] = (bf16)f2bf(o[i] * rstd * sg); }
    }
    __syncthreads();
}

__device__ __forceinline__ void ret_norm_pass(const bf16* QKVG, bf16* OB, const float* sso, int gw, int NGW, int lane) {
    for (int m = gw; m < NP; m += NGW) {
#pragma unroll
        for (int j = 0; j < 4; ++j) {
            const f32x4* pp = (const f32x4*)(sso + ((size_t)m * 4 + j) * 16);
            const f32x4 pa = pp[0] + pp[1] + pp[2] + pp[3];
            const float rstd = __builtin_amdgcn_rsqf(((pa[0] + pa[1]) + (pa[2] + pa[3])) * (1.0f / 512.0f) + EPS);
            u32x4 o = *(const u32x4*)(OB + (size_t)m * 2048 + 512 * j + lane * 8); const u32x4 g = *(const u32x4*)(QKVG + (size_t)8 * MT * 256 + (size_t)4 * MT * 512 + ((size_t)j * MT + m) * 512 + lane * 8);
#pragma unroll
            for (int k = 0; k < 4; ++k) o[k] = pk2(bflo(o[k]) * rstd * bflo(g[k]), bfhi(o[k]) * rstd * bfhi(g[k]));
            *(u32x4*)(OB + (size_t)m * 2048 + 512 * j + lane * 8) = o;
        }
    }
}

constexpr int AK_STR = 72, AV_STR = 264, AP_STR = 168;
constexpr int AL_K = 0, AL_VT = 36864, AL_P = 70656;
template <int AVS> __device__ __forceinline__ void attn_item(const LAS bf16* Kl, const LAS bf16* VT, LAS bf16* Pw, const bf16x8 (&qa)[2], int jt0, const int (&lo)[4], const int (&hi)[4], const float (&sink)[4], bf16* obase, int sA, int sB, int li, int lq) {
    f32x4 sc[10];
#pragma unroll
    for (int jt = 0; jt < 10; ++jt) { sc[jt] = (f32x4){0.f, 0.f, 0.f, 0.f};
#pragma unroll
        for (int ks = 0; ks < 2; ++ks) { const bf16x8 bk = *(const LAS bf16x8*)(Kl + (16 * (jt0 + jt) + li) * AK_STR + 32 * ks + 8 * lq); sc[jt] = mfma16(qa[ks], bk, sc[jt]); } }
    float mx[4], den[4];
#pragma unroll
    for (int r = 0; r < 4; ++r) { float m = sink[r];
#pragma unroll
        for (int jt = 0; jt < 10; ++jt) { const int j = 16 * (jt0 + jt) + li; const bool ok = (j >= lo[r]) && (j <= hi[r]); sc[jt][r] = ok ? sc[jt][r] : -INFINITY; m = fmaxf(m, sc[jt][r]); }
        m = fmaxf(m, __shfl_xor(m, 1)); m = fmaxf(m, __shfl_xor(m, 2)); m = fmaxf(m, __shfl_xor(m, 4)); m = fmaxf(m, __shfl_xor(m, 8));
        float s = 0.f;
#pragma unroll
        for (int jt = 0; jt < 10; ++jt) { const float e = __expf(sc[jt][r] - m); sc[jt][r] = e; s += e; }
        s += __shfl_xor(s, 1); s += __shfl_xor(s, 2); s += __shfl_xor(s, 4); s += __shfl_xor(s, 8);
        mx[r] = m; den[r] = __builtin_amdgcn_rcpf(s + __expf(sink[r] - m)); }
#pragma unroll
    for (int jt = 0; jt < 10; ++jt)
#pragma unroll
        for (int r = 0; r < 4; ++r) Pw[(4 * lq + r) * AP_STR + 16 * jt + li] = (bf16)f2bf(sc[jt][r] * den[r]);
    LDS_WAIT();
    f32x4 oc[4];
#pragma unroll
    for (int dn = 0; dn < 4; ++dn) oc[dn] = (f32x4){0.f, 0.f, 0.f, 0.f};
#pragma unroll
    for (int ks = 0; ks < 5; ++ks) { const bf16x8 pa = *(const LAS bf16x8*)(Pw + li * AP_STR + 32 * ks + 8 * lq);
#pragma unroll
        for (int dn = 0; dn < 4; ++dn) { const bf16x8 bv = *(const LAS bf16x8*)(VT + (16 * dn + li) * AVS + 16 * jt0 + 32 * ks + 8 * lq); oc[dn] = mfma16(pa, bv, oc[dn]); } }
#pragma unroll
    for (int r = 0; r < 4; ++r)
#pragma unroll
        for (int dn = 0; dn < 4; ++dn) Pw[(4 * lq + r) * AP_STR + 16 * dn + li] = (bf16)f2bf(oc[dn][r]);
    LDS_WAIT();
    { const int lane_ = lq * 16 + li;
#pragma unroll
      for (int h2 = 0; h2 < 2; ++h2) { const int idx = lane_ + 64 * h2, rr = idx >> 3, ch = idx & 7;
          const u32x4 v = *(const LAS u32x4*)(Pw + rr * AP_STR + ch * 8); *(u32x4*)(obase + (size_t)(rr >> 2) * sA + (size_t)(rr & 3) * sB + ch * 8) = v; } }
    LDS_WAIT();
    (void)mx;
}
__device__ __forceinline__ void attn_prompt_unit(LAS unsigned char* lds, const bf16* QKV, bf16* AO, const float* sinks, int unit, int tid) {
    const int lane = tid & 63, w = __builtin_amdgcn_readfirstlane(tid >> 6), li = lane & 15, lq = lane >> 4;
    const int kvh = unit & 3, nb = (unit >> 2) & 15, b = unit >> 6;
    LAS bf16* Kl = (LAS bf16*)(lds + AL_K); LAS bf16* VT = (LAS bf16*)(lds + AL_VT); LAS bf16* Pw = (LAS bf16*)(lds + AL_P + w * 5376);
    const size_t rowbase = (size_t)b * SEQ; const int tb = nb * 128 - 128;
    bf16x8 qf[4][2];
#pragma unroll
    for (int it = 0; it < 4; ++it) { const int id = w * 4 + it, g = id >> 3, qt = id & 7; const bf16* qp = QKV + (rowbase + nb * 128 + 16 * qt + li) * 1536 + (kvh * 4 + g) * 64;
#pragma unroll
        for (int ks = 0; ks < 2; ++ks) qf[it][ks] = *(const bf16x8*)(qp + 32 * ks + 8 * lq); }
#pragma unroll
    for (int i = 0; i < 4; ++i) { const int id = tid + NTHR * i, j = id >> 3, ch = id & 7; const int t = tb + j;
        u32x4 kv = (u32x4){0u, 0u, 0u, 0u}, vv = (u32x4){0u, 0u, 0u, 0u};
        if (t >= 0) { const bf16* src = QKV + (rowbase + t) * 1536 + 1024 + kvh * 64 + ch * 8; kv = *(const u32x4*)src; vv = *(const u32x4*)(src + 256); }
        *(LAS u32x4*)(Kl + j * AK_STR + ch * 8) = kv;
#pragma unroll
        for (int k = 0; k < 4; ++k) { VT[(ch * 8 + 2 * k) * AV_STR + j] = (bf16)(vv[k] & 0xffffu); VT[(ch * 8 + 2 * k + 1) * AV_STR + j] = (bf16)(vv[k] >> 16); } }
    __syncthreads();
#pragma unroll
    for (int it = 0; it < 4; ++it) { const int id = w * 4 + it, g = id >> 3, qt = id & 7, hq = kvh * 4 + g;
        const size_t qrow0 = rowbase + nb * 128 + 16 * qt;
        int lo[4], hi[4]; float sk[4]; const float sv = sinks[hq];
#pragma unroll
        for (int r = 0; r < 4; ++r) { const int i = 16 * qt + 4 * lq + r; lo[r] = (nb > 0) ? i : (i > 128 ? i : 128); hi[r] = i + 128; sk[r] = sv; }
        attn_item<AV_STR>(Kl, VT, Pw, qf[it], qt & ~1, lo, hi, sk, AO + qrow0 * 1024 + hq * 64, 4 * 1024, 1024, li, lq); }
    __syncthreads();
}
constexpr int AS_VSTR = 168, AS_SLOT = 51200, AS_K = 0, AS_VT = 23040, AS_P = 44544;
__device__ __forceinline__ void attn_sample_pair(LAS unsigned char* lds, const bf16* QKV, bf16* AO, const float* sinks, const float* ck, const float* cv, float* ok, float* ov, int unit0, int unit1, int tid) {
    const int lane = tid & 63, w = __builtin_amdgcn_readfirstlane(tid >> 6), li = lane & 15, lq = lane >> 4;
#pragma unroll 1
    for (int s = 0; s < 2; ++s) {
        const int unit = s ? unit1 : unit0; const int kvh = unit & 3, b = unit >> 2;
        LAS bf16* Kl = (LAS bf16*)(lds + s * AS_SLOT + AS_K); LAS bf16* VT = (LAS bf16*)(lds + s * AS_SLOT + AS_VT);
#pragma unroll
        for (int i = 0; i < 4; ++i) { const int id = tid + NTHR * i, j = id >> 4, ch = id & 15;
            const size_t so = ((size_t)(b * 128 + j) * 4 + kvh) * 64 + ch * 4;
            const f32x4 kf = *(const f32x4*)(ck + so), vf = *(const f32x4*)(cv + so);
            if (j >= 4) { const size_t d_ = ((size_t)(b * 128 + j - 4) * 4 + kvh) * 64 + ch * 4; *(f32x4*)(ok + d_) = kf; *(f32x4*)(ov + d_) = vf; }
            u32x2 kb; kb.x = pk2(kf[0], kf[1]); kb.y = pk2(kf[2], kf[3]); *(LAS u32x2*)(Kl + j * AK_STR + ch * 4) = kb;
#pragma unroll
            for (int k = 0; k < 4; ++k) VT[(ch * 4 + k) * AS_VSTR + j] = (bf16)f2bf(vf[k]); }
        if (tid < 256) { const int j = 128 + (tid >> 3), ch = tid & 7;
            u32x4 kv = (u32x4){0u, 0u, 0u, 0u}, vv = (u32x4){0u, 0u, 0u, 0u};
            if (j < 132) { const bf16* src = QKV + (size_t)(NP + b * 4 + (j - 128)) * 1536 + 1024 + kvh * 64 + ch * 8; kv = *(const u32x4*)src; vv = *(const u32x4*)(src + 256); }
            *(LAS u32x4*)(Kl + j * AK_STR + ch * 8) = kv;
#pragma unroll
            for (int k = 0; k < 4; ++k) { VT[(ch * 8 + 2 * k) * AS_VSTR + j] = (bf16)(vv[k] & 0xffffu); VT[(ch * 8 + 2 * k + 1) * AS_VSTR + j] = (bf16)(vv[k] >> 16); } }
    }
    __syncthreads();
    if (w < 2) {
        const int unit = w ? unit1 : unit0; const int kvh = unit & 3, b = unit >> 2;
        const LAS bf16* Kl = (const LAS bf16*)(lds + w * AS_SLOT + AS_K); const LAS bf16* VT = (const LAS bf16*)(lds + w * AS_SLOT + AS_VT); LAS bf16* Pw = (LAS bf16*)(lds + w * AS_SLOT + AS_P);
        const int gA = li >> 2, tA = li & 3;
        const bf16* qp = QKV + (size_t)(NP + b * 4 + tA) * 1536 + (kvh * 4 + gA) * 64;
        bf16x8 qa[2];
#pragma unroll
        for (int ks = 0; ks < 2; ++ks) qa[ks] = *(const bf16x8*)(qp + 32 * ks + 8 * lq);
        int lo[4], hi[4]; float sk[4];
#pragma unroll
        for (int r = 0; r < 4; ++r) { const int rr = 4 * lq + r, g = rr >> 2, t = rr & 3; lo[r] = t; hi[r] = t + 128; sk[r] = sinks[kvh * 4 + g]; }
        attn_item<AS_VSTR>(Kl, VT, Pw, qa, 0, lo, hi, sk, AO + (size_t)(NP + b * 4) * 1024 + kvh * 4 * 64, 64, 1024, li, lq);
    }
    __syncthreads();
}

#define XB_TMO      128
#define XB_XCNT(j)  (256  + 64 * (j))
#define XB_XSUB(j)  (1280 + 64 * (j))
#define XB_XGEN(j)  (2304 + 64 * (j))
#define XB_TOP      3328
#define XB_TOPGEN   3392
#define XCD_BAR_WORDS 3456
#define XB_SPIN_CAP (1u << 18)

__device__ __forceinline__ unsigned xb_ld(unsigned* p)              { return __hip_atomic_load(p, __ATOMIC_RELAXED, __HIP_MEMORY_SCOPE_AGENT); }
__device__ __forceinline__ unsigned xb_add(unsigned* p, unsigned v) { return __hip_atomic_fetch_add(p, v, __ATOMIC_RELAXED, __HIP_MEMORY_SCOPE_AGENT); }
__device__ __forceinline__ unsigned xb_xcc_id() { return (unsigned)__builtin_amdgcn_s_getreg((3 << 11) | 20) & 0xFu; }
#define XB_SPIN(cond, bar) do { unsigned _sp = 0; while (cond) { __builtin_amdgcn_s_sleep(1); \
    if ((++_sp & 255u) == 0u) { if (xb_ld(&(bar)[XB_TMO])) break; if (_sp > XB_SPIN_CAP) { atomicAdd(&(bar)[XB_TMO], 1u); break; } } } } while (0)

struct XcdBarrier {
    unsigned* bar; unsigned x;
    volatile LAS unsigned* st;
};

__device__ __forceinline__ XcdBarrier xcd_barrier_post(unsigned* bar, volatile LAS unsigned* st) {
    XcdBarrier b; b.bar = bar; b.x = xb_xcc_id(); b.st = st;
    if (threadIdx.x == 0) (void)xb_add(&bar[XB_XCNT(b.x)], 1u);
    return b;
}
__device__ __forceinline__ void xcd_barrier_complete(unsigned* bar, unsigned x, unsigned& nloc, unsigned& nx) {
    const unsigned G = gridDim.x * gridDim.y * gridDim.z;
    unsigned sum, cnt, mine, sp = 0u;
    for (;;) {
        sum = 0u; cnt = 0u; mine = 0u;
#pragma unroll
        for (unsigned j = 0; j < 16; ++j) { const unsigned c = xb_ld(&bar[XB_XCNT(j)]); sum += c; cnt += (c > 0u) ? 1u : 0u; mine = (j == x) ? c : mine; }
        if (sum == G) break;
        __builtin_amdgcn_s_sleep(1);
        if ((++sp & 255u) == 0u) { if (xb_ld(&bar[XB_TMO])) break; if (sp > XB_SPIN_CAP) { atomicAdd(&bar[XB_TMO], 1u); break; } }
    }
    nloc = mine > 0u ? mine : 1u; nx = cnt > 0u ? cnt : 1u;
}

__device__ __forceinline__ void xcd_barrier(const XcdBarrier& b) {
    asm volatile("s_waitcnt vmcnt(0)" ::: "memory");
    __syncthreads();
    if (threadIdx.x == 0) {
        unsigned* bar = b.bar;
        __builtin_amdgcn_s_waitcnt(0);
        unsigned nloc = b.st[0], nx = b.st[1];
        if (nloc == 0u) { xcd_barrier_complete(bar, b.x, nloc, nx); b.st[0] = nloc; b.st[1] = nx; }
        const unsigned old = xb_add(&bar[XB_XSUB(b.x)], 1u);
        const unsigned gen = old / nloc;
        if (old + 1u == (gen + 1u) * nloc) {
            __builtin_amdgcn_fence(__ATOMIC_RELEASE, "agent");
            asm volatile("s_waitcnt vmcnt(0)" ::: "memory");
            const unsigned og = xb_add(&bar[XB_TOP], 1u);
            const unsigned tg = og / nx;
            if (og + 1u == (tg + 1u) * nx) xb_add(&bar[XB_TOPGEN], 1u);
            else XB_SPIN(xb_ld(&bar[XB_TOPGEN]) == tg, bar);
            __builtin_amdgcn_fence(__ATOMIC_ACQUIRE, "agent");
            xb_add(&bar[XB_XGEN(b.x)], 1u);
            asm volatile("s_waitcnt vmcnt(0)" ::: "memory");
        } else {
            XB_SPIN(xb_ld(&bar[XB_XGEN(b.x)]) == gen, bar);
            __builtin_amdgcn_fence(__ATOMIC_ACQUIRE, "agent");
            asm volatile("s_waitcnt vmcnt(0)" ::: "memory");
        }
    }
    __syncthreads();
}

#ifndef PROBE_DUP
#define PROBE_DUP 0
#endif
struct ListOrder {
    int nM, nN, nwg, pm_off, L0, dL, n, extraL;
    __device__ __forceinline__ void init(int Mrows, int N, int pm_off_) { nM = Mrows / 256; nN = N / 256; nwg = nM * nN; pm_off = pm_off_; }
    __device__ __forceinline__ bool next(int i, pg8::Unit& u) const {
        int L; if (i < n) L = L0 + i * dL; else if (i == n && extraL >= 0) L = extraL; else return false;
        if (L >= nwg) return false;
        int wgid = L; { const int q = nwg / 8, r = nwg % 8, xcd = wgid % 8, off = wgid / 8; wgid = (xcd < r ? xcd * (q + 1) : r * (q + 1) + (xcd - r) * q) + off; }
        const int nig = 8 * nN, gid = wgid / nig, fm = gid * 8, gsz = (nM - fm) < 8 ? (nM - fm) : 8;
        u.pm = fm + ((wgid % nig) % gsz) + pm_off; u.pn = (wgid % nig) / gsz; return true;
    }
    __device__ __forceinline__ void a_ready(const pg8::Unit&) const {}
    __device__ __forceinline__ void done(const pg8::Unit&) const {}
};
__device__ __forceinline__ void flag_signal(unsigned* f, int tid) {
    asm volatile("s_waitcnt vmcnt(0)" ::: "memory");
    __syncthreads();
    if (tid == 0) { __builtin_amdgcn_fence(__ATOMIC_RELEASE, "agent"); asm volatile("s_waitcnt vmcnt(0)" ::: "memory"); (void)xb_add(f, 1u); }
}
__device__ __forceinline__ void flag_wait(unsigned* f, unsigned n, int tid) {
    if (tid == 0) { unsigned sp = 0u; while (xb_ld(f) < n) { __builtin_amdgcn_s_sleep(4); if (++sp > (1u << 16)) break; }
        __builtin_amdgcn_fence(__ATOMIC_ACQUIRE, "agent"); asm volatile("s_waitcnt vmcnt(0)" ::: "memory"); }
    __syncthreads();
}
enum { K_NONE = 0, K_RETIN, K_RES, K_SWIGLU, K_SWAIN };
constexpr int NSTEPS = 21;
__global__ void __launch_bounds__(NTHR) hybrid_fwd(Params p) {
    extern __shared__ __attribute__((aligned(16))) unsigned char lds_raw[];
    LAS unsigned char* lds = (LAS unsigned char*)lds_raw;
    cg::grid_group grid = cg::this_grid();
    const int tid = threadIdx.x, lane = tid & 63, wave = __builtin_amdgcn_readfirstlane(tid >> 6);
    const int G = gridDim.x, c = blockIdx.x, vcu = (c % 8) * (G / 8) + c / 8;
    unsigned char* ws = p.ws; float* out = p.out;
    bf16* XB = (bf16*)(ws + WS_XB); bf16* BIG = (bf16*)(ws + WS_BIG); bf16* OB = (bf16*)(ws + WS_OB);
    float* ss = (float*)(ws + WS_SS); float* sso = (float*)(ws + WS_SSO);
    unsigned* ctl = (unsigned*)(ws + WS_CTL);
    unsigned* F1 = ctl + 4096; unsigned* F3 = ctl + 4096 + 64; unsigned* F4 = ctl + 4096 + 128; unsigned* F5 = ctl + 4096 + 192;
    volatile LAS unsigned* bst = (volatile LAS unsigned*)(lds + LDS_BYTES - 64);
    if (tid < 2) bst[tid] = 0u;
    __syncthreads();
    XcdBarrier bar = xcd_barrier_post(ctl, bst);
    const bool hi8 = (c >= 248), mid44 = (c >= 144 && c < 188);
    float* outS = out + (size_t)NP * DM;
#define GEMM_RES(Aptr, Wptr, Kc, E_)   do { pg8::Gemm g_{Aptr, (const bf16*)(ws + Wptr), MT, 1024, Kc}; pg8::gemm_phase<pg8::EpiRes, ListOrder, true, true>(lds, g_, S, E_); } while (0)
#define GEMM_SWIGLU(Wptr, ssp)         do { pg8::Gemm g_{XB, (const bf16*)(ws + Wptr), MT, 5632, 1024}; pg8::EpiSwiglu E_{BIG, ssp}; pg8::gemm_phase<pg8::EpiSwiglu, ListOrder, true, true>(lds, g_, S, E_); } while (0)
#define GEMM_SWAIN()                   do { pg8::Gemm g_{XB, (const bf16*)(ws + WS_WSI), MT, 1536, 1024}; \
        pg8::EpiSwaIn E_{BIG, ss + 2 * MT, (const float*)(ws + WS_TSC), (const float*)(ws + WS_TSS), p.in[11], p.in[12], out + OUT_KP, out + OUT_VP, out + OUT_KS, out + OUT_VS}; \
        pg8::gemm_phase<pg8::EpiSwaIn, ListOrder, true, true>(lds, g_, S, E_); } while (0)
    const int lo_ = p.ph_lo, hi_ = p.ph_hi;
#if defined(PROBE_T)
    unsigned long long pt0 = 0, pt1 = 0;
#endif
#define IN(k) (lo_ <= (k) && (k) < hi_)
#define SEAM(k, kind) do { if (IN((k) + 1)) { if ((kind) == 2 && G != 256) grid.sync(); else if ((kind) >= 1) xcd_barrier(bar); } } while (0)
#if defined(PROBE_T)
    if (PROBE_T == 0 && c == 0 && tid == 0) pt0 = __builtin_amdgcn_s_memrealtime();
#endif
    if (IN(0)) { ListOrder S; S.init(NP, 1024, 0); S.L0 = c; S.dL = 256; S.n = 0; S.extraL = -1;
       p0_prologue(p, lds, tid, lane, wave, vcu, G, 0, 0, 0);
#if PROBE_DUP & 1
            __syncthreads(); p0_prologue(p, lds, tid, lane, wave, vcu, G, 0, 0, 0);
#endif
        SEAM(0, 2); }
#if defined(PROBE_T)
    if (PROBE_T == 0 && c == 0 && tid == 0) pt1 = __builtin_amdgcn_s_memrealtime();
#endif
#if defined(PROBE_T)
    if (PROBE_T == 1 && c == 0 && tid == 0) pt0 = __builtin_amdgcn_s_memrealtime();
#endif
    if (IN(1)) { ListOrder S; S.init(NP, 1024, 0); S.L0 = c; S.dL = 256; S.n = 0; S.extraL = -1;
       { pg8::Gemm g_{XB, (const bf16*)(ws + WS_WRI), MT, 6144, 1024};
                  pg8::EpiRetIn E_{BIG, ss, (const float*)(ws + WS_TRC), (const float*)(ws + WS_TRS)};
                  if (c >= 208) { S.init(NS, 6144, 64); S.L0 = c - 208; S.n = 1; pg8::gemm_phase<pg8::EpiRetIn, ListOrder, true, true>(lds, g_, S, E_); }
                  else { p0_prologue(p, lds, tid, lane, wave, vcu, G, 1, c, 208); __syncthreads(); }
                  S.init(NP, 6144, 0); S.L0 = c; S.n = 6;
                  pg8::gemm_phase<pg8::EpiRetIn, ListOrder, true, true>(lds, g_, S, E_); }
        SEAM(1, 1); }
#if defined(PROBE_T)
    if (PROBE_T == 1 && c == 0 && tid == 0) pt1 = __builtin_amdgcn_s_memrealtime();
#endif
#if defined(PROBE_T)
    if (PROBE_T == 2 && c == 0 && tid == 0) pt0 = __builtin_amdgcn_s_memrealtime();
#endif
    if (IN(2)) { ListOrder S; S.init(NP, 1024, 0); S.L0 = c; S.dL = 256; S.n = 0; S.extraL = -1;

#if defined(PROBE_T)
            if (PROBE_T == 102 && c == 0 && tid == 0) pt0 = __builtin_amdgcn_s_memrealtime();
#endif
            for (int u = vcu; u < 256; u += G) ret_prompt_unit(lds, BIG, OB, (float*)(ws + WS_SSOP), out + OUT_SP, u >> 3, u & 7, p.lg2[(u >> 3) & 3], tid);
            __syncthreads();
#if defined(PROBE_T)
            if (PROBE_T == 102 && c == 0 && tid == 0) pt1 = __builtin_amdgcn_s_memrealtime();
            if (PROBE_T == 103 && c == 0 && tid == 0) pt0 = __builtin_amdgcn_s_memrealtime();
#endif
            for (int u = vcu; u < 512; u += G) ret_sample_unit(lds, BIG, OB, p.in[2], out + OUT_SS, u, p.lg2[u & 3], tid);
#if defined(PROBE_T)
            if (PROBE_T == 103 && c == 0 && tid == 0) pt1 = __builtin_amdgcn_s_memrealtime();
#endif


        SEAM(2, 1); }
#if defined(PROBE_T)
    if (PROBE_T == 2 && c == 0 && tid == 0) pt1 = __builtin_amdgcn_s_memrealtime();
#endif
#if defined(PROBE_T)
    if (PROBE_T == 3 && c == 0 && tid == 0) pt0 = __builtin_amdgcn_s_memrealtime();
#endif
    if (IN(3)) { ListOrder S; S.init(NP, 1024, 0); S.L0 = c; S.dL = 256; S.n = 0; S.extraL = -1;
        SEAM(3, 0); }
#if defined(PROBE_T)
    if (PROBE_T == 3 && c == 0 && tid == 0) pt1 = __builtin_amdgcn_s_memrealtime();
#endif
#if defined(PROBE_T)
    if (PROBE_T == 4 && c == 0 && tid == 0) pt0 = __builtin_amdgcn_s_memrealtime();
#endif
    if (IN(4)) { ListOrder S; S.init(NP, 1024, 0); S.L0 = c; S.dL = 256; S.n = 0; S.extraL = -1;
       { S.n = 1; LAS float* HT = (LAS float*)(lds + 131072); LAS float* HS4 = HT + 1024;
         { pg8::Unit u0; S.next(0, u0); const float* pp = (const float*)(ws + WS_SSOP) + ((size_t)(u0.pm * 256 + (tid >> 1)) * 4 + (tid & 1) * 2) * 16;
#pragma unroll
           for (int hh = 0; hh < 2; ++hh) { const f32x4* q4 = (const f32x4*)(pp + hh * 16); const f32x4 a = (q4[0] + q4[1]) + (q4[2] + q4[3]);
               HS4[(tid >> 1) * 4 + (tid & 1) * 2 + hh] = __builtin_amdgcn_rsqf(((a[0] + a[1]) + (a[2] + a[3])) * (1.0f / 512.0f) + EPS); }
           __syncthreads();
           if (tid < 256) { const f32x4 s4 = *(const LAS f32x4*)(HS4 + tid * 4); *(LAS f32x4*)(HT + tid * 4) = (f32x4){s4[0] / s4[1], s4[1] / s4[2], s4[2] / s4[3], s4[3]}; }
           __syncthreads(); }
         pg8::EpiRes E_{XB, nullptr, ss + MT, HT}; pg8::Gemm g_{OB, (const bf16*)(ws + WS_WRO), MT, 1024, 2048};
         pg8::gemm_phase<pg8::EpiRes, ListOrder, true, true, true>(lds, g_, S, E_, HT); }
        SEAM(4, 1); }
#if defined(PROBE_T)
    if (PROBE_T == 4 && c == 0 && tid == 0) pt1 = __builtin_amdgcn_s_memrealtime();
#endif
#if defined(PROBE_T)
    if (PROBE_T == 5 && c == 0 && tid == 0) pt0 = __builtin_amdgcn_s_memrealtime();
#endif
    if (IN(5)) { ListOrder S; S.init(NP, 1024, 0); S.L0 = c; S.dL = 256; S.n = 0; S.extraL = -1;
       { S.init(NS, 1024, 64); S.L0 = c - 248; S.n = hi8 ? 1 : 0; pg8::EpiRes E_{XB, nullptr, ss + MT, nullptr}; GEMM_RES(OB, WS_WRO, 2048, E_); if (hi8) flag_signal(F1, tid); }
        SEAM(5, 0); }
#if defined(PROBE_T)
    if (PROBE_T == 5 && c == 0 && tid == 0) pt1 = __builtin_amdgcn_s_memrealtime();
#endif
#if defined(PROBE_T)
    if (PROBE_T == 6 && c == 0 && tid == 0) pt0 = __builtin_amdgcn_s_memrealtime();
#endif
    if (IN(6)) { ListOrder S; S.init(NP, 1024, 0); S.L0 = c; S.dL = 256; S.n = 0; S.extraL = -1;
       { S.init(NP, 5632, 0);
                  if (hi8) S.n = 3; else if (c >= 128 && c < 144) { S.n = 5; S.extraL = (3 + (c - 128) / 8) * 256 + 248 + (c - 128) % 8; } else S.n = (c < 128) ? 6 : 5;
                  GEMM_SWIGLU(WS_WFI0, ss + MT); }
        SEAM(6, 0); }
#if defined(PROBE_T)
    if (PROBE_T == 6 && c == 0 && tid == 0) pt1 = __builtin_amdgcn_s_memrealtime();
#endif
#if defined(PROBE_T)
    if (PROBE_T == 7 && c == 0 && tid == 0) pt0 = __builtin_amdgcn_s_memrealtime();
#endif
    if (IN(7)) { ListOrder S; S.init(NP, 1024, 0); S.L0 = c; S.dL = 256; S.n = 0; S.extraL = -1;
       { S.init(NS, 5632, 64); S.L0 = c - 144; S.n = mid44 ? 1 : 0; if (mid44) flag_wait(F1, 8u, tid); GEMM_SWIGLU(WS_WFI0, ss + MT); }
        SEAM(7, 1); }
#if defined(PROBE_T)
    if (PROBE_T == 7 && c == 0 && tid == 0) pt1 = __builtin_amdgcn_s_memrealtime();
#endif
#if defined(PROBE_T)
    if (PROBE_T == 8 && c == 0 && tid == 0) pt0 = __builtin_amdgcn_s_memrealtime();
#endif
    if (IN(8)) { ListOrder S; S.init(NP, 1024, 0); S.L0 = c; S.dL = 256; S.n = 0; S.extraL = -1;
       { S.n = 1; pg8::EpiRes E_{XB, nullptr, ss + 2 * MT, nullptr}; GEMM_RES(BIG, WS_WFO0, 2816, E_); }
        SEAM(8, 1); }
#if defined(PROBE_T)
    if (PROBE_T == 8 && c == 0 && tid == 0) pt1 = __builtin_amdgcn_s_memrealtime();
#endif
#if defined(PROBE_T)
    if (PROBE_T == 9 && c == 0 && tid == 0) pt0 = __builtin_amdgcn_s_memrealtime();
#endif
    if (IN(9)) { ListOrder S; S.init(NP, 1024, 0); S.L0 = c; S.dL = 256; S.n = 0; S.extraL = -1;
       { S.init(NS, 1024, 64); S.L0 = c - 248; S.n = hi8 ? 1 : 0; pg8::EpiRes E_{XB, nullptr, ss + 2 * MT, nullptr}; GEMM_RES(BIG, WS_WFO0, 2816, E_); }
        SEAM(9, 0); }
#if defined(PROBE_T)
    if (PROBE_T == 9 && c == 0 && tid == 0) pt1 = __builtin_amdgcn_s_memrealtime();
#endif
#if defined(PROBE_T)
    if (PROBE_T == 10 && c == 0 && tid == 0) pt0 = __builtin_amdgcn_s_memrealtime();
#endif
    if (IN(10)) { ListOrder S; S.init(NP, 1024, 0); S.L0 = c; S.dL = 256; S.n = 0; S.extraL = -1;
       { S.init(NP, 1536, 0);
                   if (hi8) S.n = 0; else if (c < 128) S.n = 2; else { S.n = 1; if (c < 136) S.extraL = 248 + (c - 128); }
                   GEMM_SWAIN(); }
        SEAM(10, 1); }
#if defined(PROBE_T)
    if (PROBE_T == 10 && c == 0 && tid == 0) pt1 = __builtin_amdgcn_s_memrealtime();
#endif
#if defined(PROBE_T)
    if (PROBE_T == 11 && c == 0 && tid == 0) pt0 = __builtin_amdgcn_s_memrealtime();
#endif
    if (IN(11)) { ListOrder S; S.init(NP, 1024, 0); S.L0 = c; S.dL = 256; S.n = 0; S.extraL = -1;
       { const bool m12 = (c >= 236 && c < 248); S.init(NS, 1536, 64); S.L0 = c - 236; S.n = m12 ? 1 : 0; GEMM_SWAIN(); if (m12) flag_signal(F3, tid); }
        SEAM(11, 0); }
#if defined(PROBE_T)
    if (PROBE_T == 11 && c == 0 && tid == 0) pt1 = __builtin_amdgcn_s_memrealtime();
#endif
#if defined(PROBE_T)
    if (PROBE_T == 12 && c == 0 && tid == 0) pt0 = __builtin_amdgcn_s_memrealtime();
#endif
    if (IN(12)) { ListOrder S; S.init(NP, 1024, 0); S.L0 = c; S.dL = 256; S.n = 0; S.extraL = -1;
       for (int u = vcu; u < 512; u += G) attn_prompt_unit(lds, BIG, OB, p.in[13], u, tid);
        SEAM(12, 0); }
#if defined(PROBE_T)
    if (PROBE_T == 12 && c == 0 && tid == 0) pt1 = __builtin_amdgcn_s_memrealtime();
#endif
#if defined(PROBE_T)
    if (PROBE_T == 13 && c == 0 && tid == 0) pt0 = __builtin_amdgcn_s_memrealtime();
#endif
    if (IN(13)) { ListOrder S; S.init(NP, 1024, 0); S.L0 = c; S.dL = 256; S.n = 0; S.extraL = -1;
       flag_wait(F3, 12u, tid);
                 if (!(c >= 236 && c < 248)) {
                     attn_sample_pair(lds, BIG, OB, p.in[13], p.in[3], p.in[4], out + OUT_KS, out + OUT_VS, vcu, vcu + 256, tid);
                     if (c < 12) { const int c2 = 236 + c, v2 = (c2 % 8) * (G / 8) + c2 / 8; attn_sample_pair(lds, BIG, OB, p.in[13], p.in[3], p.in[4], out + OUT_KS, out + OUT_VS, v2, v2 + 256, tid); } }
        SEAM(13, 1); }
#if defined(PROBE_T)
    if (PROBE_T == 13 && c == 0 && tid == 0) pt1 = __builtin_amdgcn_s_memrealtime();
#endif
#if defined(PROBE_T)
    if (PROBE_T == 14 && c == 0 && tid == 0) pt0 = __builtin_amdgcn_s_memrealtime();
#endif
    if (IN(14)) { ListOrder S; S.init(NP, 1024, 0); S.L0 = c; S.dL = 256; S.n = 0; S.extraL = -1;
       { S.n = 1; pg8::EpiRes E_{XB, nullptr, ss + 3 * MT, nullptr}; GEMM_RES(OB, WS_WSO, 1024, E_); }
        SEAM(14, 1); }
#if defined(PROBE_T)
    if (PROBE_T == 14 && c == 0 && tid == 0) pt1 = __builtin_amdgcn_s_memrealtime();
#endif
#if defined(PROBE_T)
    if (PROBE_T == 15 && c == 0 && tid == 0) pt0 = __builtin_amdgcn_s_memrealtime();
#endif
    if (IN(15)) { ListOrder S; S.init(NP, 1024, 0); S.L0 = c; S.dL = 256; S.n = 0; S.extraL = -1;
       { S.init(NS, 1024, 64); S.L0 = c - 248; S.n = hi8 ? 1 : 0; pg8::EpiRes E_{XB, nullptr, ss + 3 * MT, nullptr}; GEMM_RES(OB, WS_WSO, 1024, E_); if (hi8) flag_signal(F4, tid); }
        SEAM(15, 0); }
#if defined(PROBE_T)
    if (PROBE_T == 15 && c == 0 && tid == 0) pt1 = __builtin_amdgcn_s_memrealtime();
#endif
#if defined(PROBE_T)
    if (PROBE_T == 16 && c == 0 && tid == 0) pt0 = __builtin_amdgcn_s_memrealtime();
#endif
    if (IN(16)) { ListOrder S; S.init(NP, 1024, 0); S.L0 = c; S.dL = 256; S.n = 0; S.extraL = -1;
       { S.init(NP, 5632, 0);
                   if (hi8 || mid44) S.n = 1; else if (c < 128) S.n = 6; else { S.n = 5; int j = -1; if (c < 144) j = c - 128; else if (c >= 188 && c < 204) j = 16 + (c - 188); if (j >= 0) S.extraL = (1 + j / 8) * 256 + 248 + j % 8; }
                   GEMM_SWIGLU(WS_WFI1, ss + 3 * MT); }
        SEAM(16, 0); }
#if defined(PROBE_T)
    if (PROBE_T == 16 && c == 0 && tid == 0) pt1 = __builtin_amdgcn_s_memrealtime();
#endif
#if defined(PROBE_T)
    if (PROBE_T == 17 && c == 0 && tid == 0) pt0 = __builtin_amdgcn_s_memrealtime();
#endif
    if (IN(17)) { ListOrder S; S.init(NP, 1024, 0); S.L0 = c; S.dL = 256; S.n = 0; S.extraL = -1;
       { S.init(NS, 5632, 64); S.L0 = c - 144; S.n = mid44 ? 1 : 0; if (mid44) flag_wait(F4, 8u, tid); GEMM_SWIGLU(WS_WFI1, ss + 3 * MT); if (mid44) flag_signal(F5, tid); }
        SEAM(17, 0); }
#if defined(PROBE_T)
    if (PROBE_T == 17 && c == 0 && tid == 0) pt1 = __builtin_amdgcn_s_memrealtime();
#endif
#if defined(PROBE_T)
    if (PROBE_T == 18 && c == 0 && tid == 0) pt0 = __builtin_amdgcn_s_memrealtime();
#endif
    if (IN(18)) { ListOrder S; S.init(NP, 1024, 0); S.L0 = c; S.dL = 256; S.n = 0; S.extraL = -1;
       { S.init(NS, 1024, 64); S.L0 = c - 248; S.n = hi8 ? 1 : 0; if (hi8) flag_wait(F5, 44u, tid); pg8::EpiRes E_{XB, out, nullptr, nullptr}; GEMM_RES(BIG, WS_WFO1, 2816, E_); }
        SEAM(18, 0); }
#if defined(PROBE_T)
    if (PROBE_T == 18 && c == 0 && tid == 0) pt1 = __builtin_amdgcn_s_memrealtime();
#endif
#if defined(PROBE_T)
    if (PROBE_T == 19 && c == 0 && tid == 0) pt0 = __builtin_amdgcn_s_memrealtime();
#endif
    if (IN(19)) { ListOrder S; S.init(NP, 1024, 0); S.L0 = c; S.dL = 256; S.n = 0; S.extraL = -1;
       { S.init(NP, 5632, 0); S.L0 = 256 + c; S.n = mid44 ? 4 : 0; GEMM_SWIGLU(WS_WFI1, ss + 3 * MT); }
        SEAM(19, 1); }
#if defined(PROBE_T)
    if (PROBE_T == 19 && c == 0 && tid == 0) pt1 = __builtin_amdgcn_s_memrealtime();
#endif
#if defined(PROBE_T)
    if (PROBE_T == 20 && c == 0 && tid == 0) pt0 = __builtin_amdgcn_s_memrealtime();
#endif
    if (IN(20)) { ListOrder S; S.init(NP, 1024, 0); S.L0 = c; S.dL = 256; S.n = 0; S.extraL = -1;
       { S.n = 1; pg8::EpiRes E_{XB, out, nullptr, nullptr}; GEMM_RES(BIG, WS_WFO1, 2816, E_); }
        SEAM(20, 0); }
#if defined(PROBE_T)
    if (PROBE_T == 20 && c == 0 && tid == 0) pt1 = __builtin_amdgcn_s_memrealtime();
#endif
#undef IN
#undef SEAM
#if defined(PROBE_T)
    if (c == 0 && tid == 0) { const unsigned long long te = __builtin_amdgcn_s_memrealtime(), d = (pt1 - pt0) * 4ull; while (__builtin_amdgcn_s_memrealtime() - te < d) __builtin_amdgcn_s_sleep(8); }
#endif
}

#ifndef N_LAUNCHES
#define N_LAUNCHES 1
#endif
extern "C" void kernel_launch(void* const* d_in, const int* in_sizes, int n_in, void* d_out, int out_size, void* d_ws, size_t ws_size, hipStream_t stream) {
    static int grid = 0;
    if (grid == 0) {
        if (n_in != 16 || (size_t)out_size != OUT_END || ws_size < WS_TOTAL) { fprintf(stderr, "kernel_launch: unexpected shapes (n_in %d out %d ws %zu need %zu)\n", n_in, out_size, ws_size, (size_t)WS_TOTAL); grid = -1; return; }
        int dev = 0, cus = 0, per_cu = 0;
        (void)hipGetDevice(&dev); (void)hipDeviceGetAttribute(&cus, hipDeviceAttributeMultiprocessorCount, dev);
        if (hipFuncSetAttribute((const void*)hybrid_fwd, hipFuncAttributeMaxDynamicSharedMemorySize, LDS_BYTES) != hipSuccess) { fprintf(stderr, "kernel_launch: hipFuncSetAttribute failed\n"); grid = -1; return; }
        if (hipOccupancyMaxActiveBlocksPerMultiprocessor(&per_cu, (const void*)hybrid_fwd, NTHR, LDS_BYTES) != hipSuccess || per_cu < 1) { fprintf(stderr, "kernel_launch: occupancy query says %d\n", per_cu); per_cu = 1; }
        (void)hipGetLastError();
        grid = cus * 1;
        if (grid != 256) { fprintf(stderr, "kernel_launch: built for a 256-CU device (got %d)\n", cus); grid = -1; return; }
    }
    if (grid < 0) return;
    if (hipMemsetAsync((char*)d_ws + WS_CTL, 0, CTL_BYTES, stream) != hipSuccess) { fprintf(stderr, "kernel_launch: memset failed\n"); return; }
    Params p; memset(&p, 0, sizeof(p));
    for (int i = 0; i < 16; ++i) p.in[i] = (const float*)d_in[i];
    p.out = (float*)d_out; p.ws = (unsigned char*)d_ws;
    const double two_pi = 6.283185307179586476925286766559;
    for (int i = 0; i < 128; ++i) p.invR[i] = 1.0 / std::pow(10000.0, (double)i / 127.0) / two_pi;
    for (int i = 0; i < 32; ++i) p.invS[i] = 1.0 / std::pow(10000.0, (double)(2 * i) / 64.0) / two_pi;
    for (int h = 0; h < 4; ++h) p.lg2[h] = (float)std::log2(1.0 - std::ldexp(1.0, -5 - h));
#if N_LAUNCHES == 1
    p.ph_lo = 0; p.ph_hi = NSTEPS;
    void* args[] = {&p};
    hipError_t e = hipLaunchCooperativeKernel((const void*)hybrid_fwd, dim3(grid), dim3(NTHR), args, LDS_BYTES, stream);
    if (e != hipSuccess) fprintf(stderr, "kernel_launch: cooperative launch failed: %s (grid %d)\n", hipGetErrorString(e), grid);
#else
    for (int ph = 0; ph < NSTEPS; ++ph) { p.ph_lo = ph; p.ph_hi = ph + 1; hipLaunchKernelGGL(hybrid_fwd, dim3(grid), dim3(NTHR), LDS_BYTES, stream, p); }
#endif
}
```

```cpp
#include <hip/hip_runtime.h>
#include <hip/hip_cooperative_groups.h>
#include <cstdio>
#include <cstdint>
#include <cmath>
#include <cstring>
namespace cg = cooperative_groups;
namespace pg8 {
#define PG8_LAS __attribute__((address_space(3)))
typedef unsigned short bf16_t;
typedef short bf16x8 __attribute__((ext_vector_type(8)));
typedef float f32x4 __attribute__((ext_vector_type(4)));
typedef unsigned u32x4 __attribute__((ext_vector_type(4)));
constexpr int BM = 256, BK = 64, HALF = 128, HTB = HALF * BK * 2  , STAGE_BYTES = 8 * HTB, NXCD = 8, WGM = 8;

__host__ __device__ __forceinline__ int lds_byte(int r, int c) { const int st = (r >> 4) * 2 + (c >> 5), rr = r & 15, cc = c & 31, ob = rr * 64 + cc * 2; return st * 1024 + (ob ^ (((ob >> 9) & 1) << 5)); }
__host__ __device__ __forceinline__ void stage_rc(int b, int& R, int& C) { const int st = b / 1024, sb = b % 1024, swz = sb ^ (((sb >> 9) & 1) << 5); R = (st >> 1) * 16 + swz / 64; C = (st & 1) * 32 + (swz % 64) / 2; }
__host__ __device__ __forceinline__ int perm32(int rho) { const int n = rho >> 4, i = rho & 15; return 8 * (i >> 2) + 4 * n + (i & 3); }

struct Unit { int pm, pn; };
struct Gemm { const bf16_t* A; const bf16_t* Bt; int M, N, K; };

struct StaticOrder {
    int nM, nN, nwg, G, c;
    __host__ __device__ void init(int M, int N, int G_, int c_) { nM = M / BM; nN = N / BM; nwg = nM * nN; G = G_; c = c_; }
    __host__ __device__ bool next(int i, Unit& u) const {
        const long L = (long)i * G + c; if (L >= nwg) return false;
        int wgid = (int)L; { const int q = nwg / NXCD, r = nwg % NXCD, xcd = wgid % NXCD, off = wgid / NXCD; wgid = (xcd < r ? xcd * (q + 1) : r * (q + 1) + (xcd - r) * q) + off; }
        const int nig = WGM * nN, gid = wgid / nig, fm = gid * WGM, gsz = (nM - fm) < WGM ? (nM - fm) : WGM;
        u.pm = fm + ((wgid % nig) % gsz); u.pn = (wgid % nig) / gsz; return true;
    }
    __device__ __forceinline__ void a_ready(const Unit&) const {}
    __device__ __forceinline__ void done(const Unit&) const {}
};

__device__ __forceinline__ unsigned cvt_pk_bf16(float lo, float hi) { unsigned r; asm volatile("v_cvt_pk_bf16_f32 %0, %1, %2" : "=v"(r) : "v"(lo), "v"(hi)); return r; }
typedef float f32x2 __attribute__((ext_vector_type(2)));
constexpr int P_NP = 16384, P_D = 1024, P_MT = 16896;
constexpr float P_EPS = 1e-6f;
__device__ __forceinline__ float silu_f(float x) { return x * __builtin_amdgcn_rcpf(1.0f + __expf(-x)); }
__device__ __forceinline__ float row_rstd(const float* ssp, int row) {
    const f32x4* pp = (const f32x4*)(ssp + (size_t)row * 16); const f32x4 a = (pp[0] + pp[1]) + (pp[2] + pp[3]);
    return __builtin_amdgcn_rsqf(((a[0] + a[1]) + (a[2] + a[3])) * (1.0f / 1024.0f) + P_EPS);
}
__device__ __forceinline__ int pos_index(int row) { return row < P_NP ? (row & 2047) : 2048 + (row & 3); }
__device__ __forceinline__ u32x4 pack8(const f32x4 a, const f32x4 b) { u32x4 w; w.x = cvt_pk_bf16(a[0], a[1]); w.y = cvt_pk_bf16(a[2], a[3]); w.z = cvt_pk_bf16(b[0], b[1]); w.w = cvt_pk_bf16(b[2], b[3]); return w; }

struct EpiRetIn {
    static constexpr bool PERM = true, AFTER_DRAIN = false;
    bf16_t* O; const float* ss; const float* cosT; const float* sinT;
    __device__ __forceinline__ void operator()(const f32x4 (&acc)[2][2][4][2], const Unit& u, int wr, int wc, int fr, int fq) const {
        const int pn = u.pn, ci = wc * 32 + 8 * fq;
#pragma unroll
        for (int ai = 0; ai < 2; ++ai)
#pragma unroll
            for (int m = 0; m < 4; ++m) {
                const int row = u.pm * BM + ai * HALF + wr * 64 + m * 16 + fr;
                const float rstd = __builtin_amdgcn_rsqf(ss[row] * (1.0f / 1024.0f) + P_EPS);
                bf16_t* rowp;
                if (pn < 8) rowp = O + ((size_t)pn * P_MT + row) * 256 + ci;
                else { const int q_ = pn - 8; rowp = O + (size_t)8 * P_MT * 256 + ((size_t)(q_ >> 1) * P_MT + row) * 512 + (q_ & 1) * 256 + ci; }
                if (pn < 8) {
                    const int pidx = pos_index(row);
                    const f32x4* cp = (const f32x4*)(cosT + pidx * 128 + ci); const f32x4* sp = (const f32x4*)(sinT + pidx * 128 + ci);
                    const float sc = (pn >= 4) ? rstd * 0.0625f : rstd;
                    f32x4 o1[2], o2[2];
#pragma unroll
                    for (int n = 0; n < 2; ++n) { const f32x4 c = cp[n], s = sp[n]; const f32x4 x1 = acc[ai][0][m][n] * sc, x2 = acc[ai][1][m][n] * sc; o1[n] = x1 * c - x2 * s; o2[n] = x2 * c + x1 * s; }
                    *(u32x4*)(rowp) = pack8(o1[0], o1[1]); *(u32x4*)(rowp + HALF) = pack8(o2[0], o2[1]);
                } else if (pn < 16) {
#pragma unroll
                    for (int bj = 0; bj < 2; ++bj) *(u32x4*)(rowp + bj * HALF) = pack8(acc[ai][bj][m][0] * rstd, acc[ai][bj][m][1] * rstd);
                } else {
#pragma unroll
                    for (int bj = 0; bj < 2; ++bj) { f32x4 a = acc[ai][bj][m][0] * rstd, b = acc[ai][bj][m][1] * rstd;
#pragma unroll
                        for (int j = 0; j < 4; ++j) { a[j] = silu_f(a[j]); b[j] = silu_f(b[j]); }
                        *(u32x4*)(rowp + bj * HALF) = pack8(a, b); }
                }
            }
    }
};
struct EpiRes {
    static constexpr bool PERM = true, AFTER_DRAIN = false;
    bf16_t* xb; float* outF; float* ssn; const PG8_LAS float* hs;
    __device__ __forceinline__ void operator()(const f32x4 (&acc)[2][2][4][2], const Unit& u, int wr, int wc, int fr, int fq) const {
        const int col0 = u.pn * BM + wc * 32 + 8 * fq;
#pragma unroll
        for (int ai = 0; ai < 2; ++ai)
#pragma unroll
            for (int m = 0; m < 4; ++m) {
                const int row = u.pm * BM + ai * HALF + wr * 64 + m * 16 + fr;
                bf16_t* xp = xb + (size_t)row * P_D + col0; float s = 0.f;
                const float hsc = hs ? hs[(ai * HALF + wr * 64 + m * 16 + fr) * 4 + 3] : 1.0f;
#pragma unroll
                for (int bj = 0; bj < 2; ++bj) {
                    const u32x4 rw = *(const u32x4*)(xp + bj * HALF);
                    const f32x4 r0 = (f32x4){__builtin_bit_cast(float, rw.x << 16), __builtin_bit_cast(float, rw.x & 0xffff0000u), __builtin_bit_cast(float, rw.y << 16), __builtin_bit_cast(float, rw.y & 0xffff0000u)};
                    const f32x4 r1 = (f32x4){__builtin_bit_cast(float, rw.z << 16), __builtin_bit_cast(float, rw.z & 0xffff0000u), __builtin_bit_cast(float, rw.w << 16), __builtin_bit_cast(float, rw.w & 0xffff0000u)};
                    const f32x4 v0 = r0 + acc[ai][bj][m][0] * hsc, v1 = r1 + acc[ai][bj][m][1] * hsc;
                    s += (v0[0] * v0[0] + v0[1] * v0[1]) + (v0[2] * v0[2] + v0[3] * v0[3]) + (v1[0] * v1[0] + v1[1] * v1[1]) + (v1[2] * v1[2] + v1[3] * v1[3]);
                    if (outF) { float* op = outF + (size_t)row * P_D + col0 + bj * HALF; *(f32x4*)(op) = v0; *(f32x4*)(op + 4) = v1; }
                    else *(u32x4*)(xp + bj * HALF) = pack8(v0, v1);
                }
                if (ssn) { s += __shfl_xor(s, 16); s += __shfl_xor(s, 32); if (fq == 0) atomicAdd(ssn + row, s); }
            }
    }
};
struct EpiSwiglu {
    static constexpr bool PERM = true, AFTER_DRAIN = false;
    bf16_t* H; const float* ss;
    __device__ __forceinline__ void operator()(const f32x4 (&acc)[2][2][4][2], const Unit& u, int wr, int wc, int fr, int fq) const {
        const int col0 = u.pn * HALF + wc * 32 + 8 * fq;
#pragma unroll
        for (int ai = 0; ai < 2; ++ai)
#pragma unroll
            for (int m = 0; m < 4; ++m) {
                const int row = u.pm * BM + ai * HALF + wr * 64 + m * 16 + fr;
                const float rstd = __builtin_amdgcn_rsqf(ss[row] * (1.0f / 1024.0f) + P_EPS);
                f32x4 h[2];
#pragma unroll
                for (int n = 0; n < 2; ++n) { const f32x4 g = acc[ai][0][m][n] * rstd, uu = acc[ai][1][m][n] * rstd;
#pragma unroll
                    for (int j = 0; j < 4; ++j) h[n][j] = silu_f(g[j]) * uu[j]; }
                *(u32x4*)(H + (size_t)row * 2816 + col0) = pack8(h[0], h[1]);
            }
    }
};
struct EpiSwaIn {
    static constexpr bool PERM = true, AFTER_DRAIN = false;
    bf16_t* O; const float* ss; const float* cosT; const float* sinT; const float* qg; const float* kg; float* kc_p; float* vc_p; float* kc_s; float* vc_s;
    __device__ __forceinline__ void operator()(const f32x4 (&acc)[2][2][4][2], const Unit& u, int wr, int wc, int fr, int fq) const {
        const int pn = u.pn;
        const float* G = (pn < 4) ? qg : kg;
        f32x4 g1[2], g2[2];
#pragma unroll
        for (int n = 0; n < 2; ++n) { g1[n] = *(const f32x4*)(G + 8 * fq + 4 * n); g2[n] = *(const f32x4*)(G + 32 + 8 * fq + 4 * n); }
        const int cbase = (pn < 4 ? (pn * 4 + wc) * 64 : (pn == 4 ? 1024 : 1280) + wc * 64) + 8 * fq;
#pragma unroll
        for (int ai = 0; ai < 2; ++ai)
#pragma unroll
            for (int m = 0; m < 4; ++m) {
                const int row = u.pm * BM + ai * HALF + wr * 64 + m * 16 + fr;
                const float rstd = __builtin_amdgcn_rsqf(ss[row] * (1.0f / 1024.0f) + P_EPS);
                bf16_t* rowp = O + (size_t)row * 1536 + cbase;
                float* cdst = nullptr;
                if (pn >= 4) {
                    float* cp_ = (pn == 4) ? kc_p : vc_p; float* cs_ = (pn == 4) ? kc_s : vc_s;
                    if (row < P_NP) { const int b = row >> 11, t = row & 2047; if (t >= 1920) cdst = cp_ + ((size_t)(b * 128 + (t - 1920)) * 4 + wc) * 64 + 8 * fq; }
                    else { const int s_ = row - P_NP, b = s_ >> 2, t = s_ & 3; cdst = cs_ + ((size_t)(b * 128 + 124 + t) * 4 + wc) * 64 + 8 * fq; }
                }
                f32x4 o1[2], o2[2];
                if (pn < 5) {
                    f32x4 x1[2], x2[2]; float q = 0.f;
#pragma unroll
                    for (int n = 0; n < 2; ++n) { x1[n] = acc[ai][0][m][n] * rstd; x2[n] = acc[ai][1][m][n] * rstd;
                        q += (x1[n][0] * x1[n][0] + x1[n][1] * x1[n][1]) + (x1[n][2] * x1[n][2] + x1[n][3] * x1[n][3]) + (x2[n][0] * x2[n][0] + x2[n][1] * x2[n][1]) + (x2[n][2] * x2[n][2] + x2[n][3] * x2[n][3]); }
                    q += __shfl_xor(q, 16); q += __shfl_xor(q, 32);
                    const float hr = __builtin_amdgcn_rsqf(q * (1.0f / 64.0f) + P_EPS);
                    const int pidx = pos_index(row);
                    const f32x4* cp = (const f32x4*)(cosT + pidx * 32 + 8 * fq); const f32x4* sp = (const f32x4*)(sinT + pidx * 32 + 8 * fq);
                    const float osc = (pn < 4) ? 0.125f : 1.0f;
#pragma unroll
                    for (int n = 0; n < 2; ++n) { const f32x4 c = cp[n], s = sp[n]; const f32x4 a = x1[n] * hr * g1[n], b = x2[n] * hr * g2[n]; o1[n] = (a * c - b * s) * osc; o2[n] = (b * c + a * s) * osc; }
                } else {
#pragma unroll
                    for (int n = 0; n < 2; ++n) { o1[n] = acc[ai][0][m][n] * rstd; o2[n] = acc[ai][1][m][n] * rstd; }
                }
                *(u32x4*)(rowp) = pack8(o1[0], o1[1]); *(u32x4*)(rowp + 32) = pack8(o2[0], o2[1]);
                if (cdst) { *(f32x4*)(cdst) = o1[0]; *(f32x4*)(cdst + 4) = o1[1]; *(f32x4*)(cdst + 32) = o2[0]; *(f32x4*)(cdst + 36) = o2[1]; }
            }
    }
};

template <class Epi, class Sched, bool ALIGN_EPI = false, bool SP2 = false, bool HS = false>
__device__ __forceinline__ void gemm_phase(PG8_LAS unsigned char* lds, const Gemm g, const Sched& S, const Epi& E, const PG8_LAS float* hs = nullptr) {
    const int tid = threadIdx.x, wid = __builtin_amdgcn_readfirstlane(tid >> 6), lane = tid & 63, wr = wid >> 2, wc = wid & 3, fr = lane & 15, fq = lane >> 4;
    const int K = g.K, nt = K / BK;
    unsigned voffA[2], voffB[2];
#pragma unroll
    for (int i = 0; i < 2; ++i) { int R, C; stage_rc(tid * 16 + i * 8192, R, C); const int Rb = Epi::PERM ? ((R & ~31) + perm32(R & 31)) : R;
        voffA[i] = (unsigned)(R * K + C) * 2u; voffB[i] = (unsigned)(Rb * K + C) * 2u; }
    const size_t kstep = (size_t)(BK * 2);
    const size_t hstep = (size_t)HALF * K * 2;
    const size_t tstep = 2 * hstep;
    const unsigned ldsw = (unsigned)wid * 1024u;
    const int aoff = lds_byte(wr * 64 + fr, fq * 8), boff = lds_byte(wc * 32 + fr, fq * 8);
#define PG8_SA(b, h) (((b) * 2 + (h)) * HTB)
#define PG8_SB(b, h) ((4 + (b) * 2 + (h)) * HTB)
#define PG8_STAGE(bufoff, gbase, voff) do { _Pragma("unroll") for (int _i = 0; _i < 2; ++_i) \
        __builtin_amdgcn_global_load_lds((const unsigned*)((const char*)(gbase) + (voff)[_i]), (PG8_LAS unsigned*)(lds + (bufoff) + ldsw + _i * 8192), 16, 0, 0); } while (0)
#define PG8_LDA(dst, b, h) do { _Pragma("unroll") for (int m = 0; m < 4; ++m) _Pragma("unroll") for (int k = 0; k < 2; ++k) dst[m][k] = *(const PG8_LAS bf16x8*)(lds + PG8_SA(b, h) + aoff + m * 2048 + k * 1024); } while (0)
#define PG8_LDB(dst, b, h) do { _Pragma("unroll") for (int n = 0; n < 2; ++n) _Pragma("unroll") for (int k = 0; k < 2; ++k) dst[n][k] = *(const PG8_LAS bf16x8*)(lds + PG8_SB(b, h) + boff + n * 2048 + k * 1024); } while (0)
#define PG8_MMA(ai, bj, At, Bt) do { __builtin_amdgcn_s_setprio(1); _Pragma("unroll") for (int m = 0; m < 4; ++m) _Pragma("unroll") for (int n = 0; n < 2; ++n) _Pragma("unroll") for (int k = 0; k < 2; ++k) \
        acc[ai][bj][m][n] = __builtin_amdgcn_mfma_f32_16x16x32_bf16(Bt[n][k], At[m][k], acc[ai][bj][m][n], 0, 0, 0); __builtin_amdgcn_s_setprio(0); } while (0)
#define PG8_WAIT_V(n) asm volatile("s_waitcnt vmcnt(" #n ")" ::: "memory")
#define PG8_WAIT_L(n) asm volatile("s_waitcnt lgkmcnt(" #n ")" ::: "memory")
#define PG8_BAR __builtin_amdgcn_s_barrier()
#define PG8_SCHED __builtin_amdgcn_sched_barrier(0)
    Unit cur, nxt; int ui = 0;
    if (!S.next(0, cur)) return;
    f32x4 acc[2][2][4][2];
#pragma unroll
    for (int a = 0; a < 2; ++a)
#pragma unroll
        for (int b = 0; b < 2; ++b)
#pragma unroll
            for (int m = 0; m < 4; ++m)
#pragma unroll
                for (int n = 0; n < 2; ++n) acc[a][b][m][n] = (f32x4){0.f, 0.f, 0.f, 0.f};
    bf16x8 At[4][2], B0[2][2], B1[2][2];
    const char* cA = (const char*)g.A + (size_t)cur.pm * tstep; const char* cB = (const char*)g.Bt + (size_t)cur.pn * tstep;
    S.a_ready(cur);
    if constexpr (SP2) {
        PG8_STAGE(PG8_SB(0, 0), cB, voffB); PG8_STAGE(PG8_SB(0, 1), cB + hstep, voffB); PG8_STAGE(PG8_SA(0, 0), cA, voffA); PG8_STAGE(PG8_SA(0, 1), cA + hstep, voffA);
        if (wr == 1) PG8_BAR;
        PG8_WAIT_V(2); PG8_BAR;
        PG8_STAGE(PG8_SB(1, 0), cB + kstep, voffB); PG8_STAGE(PG8_SA(1, 0), cA + kstep, voffA); PG8_STAGE(PG8_SB(1, 1), cB + hstep + kstep, voffB);
        PG8_WAIT_V(6); PG8_BAR;
    } else {
        PG8_STAGE(PG8_SB(0, 0), cB, voffB); PG8_STAGE(PG8_SA(0, 0), cA, voffA); PG8_STAGE(PG8_SB(0, 1), cB + hstep, voffB); PG8_STAGE(PG8_SA(0, 1), cA + hstep, voffA);
        if (wr == 1) PG8_BAR;
        PG8_WAIT_V(4); PG8_BAR;
        PG8_STAGE(PG8_SB(1, 0), cB + kstep, voffB); PG8_STAGE(PG8_SA(1, 0), cA + kstep, voffA); PG8_STAGE(PG8_SB(1, 1), cB + hstep + kstep, voffB);
        PG8_WAIT_V(6); PG8_BAR;
    }
    for (;;) {
        const bool has_next = S.next(ui + 1, nxt);
        const char* nA = has_next ? (const char*)g.A + (size_t)nxt.pm * tstep : cA; const char* nB = has_next ? (const char*)g.Bt + (size_t)nxt.pn * tstep : cB;
        for (int t = 0; t < nt; t += 2) {
            if constexpr (HS) { if (t == 8 || t == 16 || t == 24) { const int hb_ = (t >> 3) - 1;
#pragma unroll
                for (int ai = 0; ai < 2; ++ai)
#pragma unroll
                    for (int m = 0; m < 4; ++m) { const float rt_ = hs[(ai * HALF + wr * 64 + m * 16 + fr) * 4 + hb_];
#pragma unroll
                        for (int bj = 0; bj < 2; ++bj)
#pragma unroll
                            for (int n = 0; n < 2; ++n) acc[ai][bj][m][n] = acc[ai][bj][m][n] * rt_; } } }
            const bool last = (t == nt - 2);
            const char* a1 = cA + (size_t)(t + 1) * kstep;
            const char* a2 = last ? nA : cA + (size_t)(t + 2) * kstep; const char* b2 = last ? nB : cB + (size_t)(t + 2) * kstep;
            const char* a3 = a2 + kstep; const char* b3 = b2 + kstep;
            if (last && has_next) S.a_ready(nxt);
            if constexpr (SP2) {
            PG8_LDB(B0, 0, 0); PG8_LDB(B1, 0, 1); PG8_SCHED; PG8_LDA(At, 0, 0); PG8_STAGE(PG8_SA(1, 1), a1 + hstep, voffA);
            PG8_WAIT_V(8); PG8_WAIT_L(0); PG8_BAR; PG8_MMA(0, 0, At, B0); PG8_MMA(0, 1, At, B1); PG8_BAR; PG8_SCHED;
            PG8_LDA(At, 0, 1); PG8_STAGE(PG8_SB(0, 0), b2, voffB); PG8_STAGE(PG8_SB(0, 1), b2 + hstep, voffB); PG8_STAGE(PG8_SA(0, 0), a2, voffA);
            PG8_WAIT_V(8); PG8_WAIT_L(0); PG8_BAR; PG8_MMA(1, 0, At, B0); PG8_MMA(1, 1, At, B1); PG8_BAR; PG8_SCHED;
            PG8_LDB(B0, 1, 0); PG8_LDB(B1, 1, 1); PG8_SCHED; PG8_LDA(At, 1, 0); PG8_STAGE(PG8_SA(0, 1), a2 + hstep, voffA);
            PG8_WAIT_V(8); PG8_WAIT_L(0); PG8_BAR; PG8_MMA(0, 0, At, B0); PG8_MMA(0, 1, At, B1); PG8_BAR; PG8_SCHED;
            PG8_LDA(At, 1, 1); PG8_STAGE(PG8_SB(1, 0), b3, voffB); PG8_STAGE(PG8_SB(1, 1), b3 + hstep, voffB); PG8_STAGE(PG8_SA(1, 0), a3, voffA);
            PG8_WAIT_V(8); PG8_WAIT_L(0); PG8_BAR; PG8_MMA(1, 0, At, B0); PG8_MMA(1, 1, At, B1); PG8_BAR; PG8_SCHED;
            } else {
            PG8_LDB(B0, 0, 0); PG8_SCHED; PG8_LDA(At, 0, 0); PG8_STAGE(PG8_SA(1, 1), a1 + hstep, voffA);
            PG8_WAIT_L(8); PG8_BAR; PG8_WAIT_L(0); PG8_MMA(0, 0, At, B0); PG8_BAR; PG8_SCHED;
            PG8_LDB(B1, 0, 1); PG8_STAGE(PG8_SB(0, 0), b2, voffB);
            PG8_BAR; PG8_WAIT_L(0); PG8_MMA(0, 1, At, B1); PG8_BAR;
            PG8_LDA(At, 0, 1); PG8_STAGE(PG8_SA(0, 0), a2, voffA);
            PG8_BAR; PG8_WAIT_L(0); PG8_MMA(1, 0, At, B0); PG8_BAR; PG8_SCHED;
            PG8_STAGE(PG8_SB(0, 1), b2 + hstep, voffB);
            PG8_WAIT_V(6); PG8_BAR; PG8_MMA(1, 1, At, B1); PG8_BAR;
            PG8_LDB(B0, 1, 0); PG8_SCHED; PG8_LDA(At, 1, 0); PG8_STAGE(PG8_SA(0, 1), a2 + hstep, voffA);
            PG8_WAIT_L(8); PG8_BAR; PG8_WAIT_L(0); PG8_MMA(0, 0, At, B0); PG8_BAR; PG8_SCHED;
            PG8_LDB(B1, 1, 1); PG8_STAGE(PG8_SB(1, 0), b3, voffB);
            PG8_BAR; PG8_WAIT_L(0); PG8_MMA(0, 1, At, B1); PG8_BAR;
            PG8_LDA(At, 1, 1); PG8_STAGE(PG8_SA(1, 0), a3, voffA);
            PG8_BAR; PG8_WAIT_L(0); PG8_MMA(1, 0, At, B0); PG8_BAR; PG8_SCHED;
            PG8_STAGE(PG8_SB(1, 1), b3 + hstep, voffB);
            PG8_WAIT_V(6); PG8_BAR; PG8_MMA(1, 1, At, B1); PG8_BAR;
            }
        }
        if constexpr (ALIGN_EPI) { if (wr == 0) PG8_BAR; }
        if constexpr (!Epi::AFTER_DRAIN) { E(acc, cur, wr, wc, fr, fq); S.done(cur); }
        if (!has_next) break;
#pragma unroll
        for (int a = 0; a < 2; ++a)
#pragma unroll
            for (int b = 0; b < 2; ++b)
#pragma unroll
                for (int m = 0; m < 4; ++m)
#pragma unroll
                    for (int n = 0; n < 2; ++n) acc[a][b][m][n] = (f32x4){0.f, 0.f, 0.f, 0.f};
        cur = nxt; cA = nA; cB = nB; ++ui;
        if constexpr (ALIGN_EPI) { if (wr == 1) PG8_BAR; }
    }
    PG8_WAIT_V(0);
    if constexpr (!ALIGN_EPI) { if (wr == 0) PG8_BAR; }
    PG8_BAR;
    if constexpr (Epi::AFTER_DRAIN) { E.fused(acc, cur, wr, wc, fr, fq, lds, wid, lane); S.done(cur); }
#undef PG8_SA
#undef PG8_SB
#undef PG8_STAGE
#undef PG8_LDA
#undef PG8_LDB
#undef PG8_MMA
#undef PG8_WAIT_V
#undef PG8_WAIT_L
#undef PG8_BAR
#undef PG8_SCHED
}
}
#define LAS __attribute__((address_space(3)))
typedef unsigned short bf16;
typedef unsigned u32x4 __attribute__((ext_vector_type(4)));
typedef unsigned u32x2 __attribute__((ext_vector_type(2)));
typedef float f32x4 __attribute__((ext_vector_type(4)));
typedef short bf16x8 __attribute__((ext_vector_type(8)));
#define LDS_WAIT() asm volatile("s_waitcnt lgkmcnt(0)" ::: "memory")

constexpr int NWAVES = 8, NTHR = 512;
constexpr int DM = 1024, NP = 16384, NS = 512, MT = NP + NS, SEQ = 2048, DFF = 2816;
constexpr float EPS = 1e-6f;
constexpr int LDS_BYTES = 147456;

constexpr size_t al256(size_t x) { return (x + 255) & ~(size_t)255; }
constexpr size_t WS_WRI = 0;
constexpr size_t WS_WRO = WS_WRI + al256(6144ull * 1024 * 2);
constexpr size_t WS_WFI0 = WS_WRO + al256(1024ull * 2048 * 2);
constexpr size_t WS_WFO0 = WS_WFI0 + al256(5632ull * 1024 * 2);
constexpr size_t WS_WFI1 = WS_WFO0 + al256(1024ull * 2816 * 2);
constexpr size_t WS_WFO1 = WS_WFI1 + al256(5632ull * 1024 * 2);
constexpr size_t WS_WSI = WS_WFO1 + al256(1024ull * 2816 * 2);
constexpr size_t WS_WSO = WS_WSI + al256(1536ull * 1024 * 2);
constexpr size_t WS_XB = WS_WSO + al256(1024ull * 1024 * 2);
constexpr size_t WS_BIG = WS_XB + al256((size_t)MT * 1024 * 2);
constexpr size_t WS_OB = WS_BIG + al256((size_t)MT * 6144 * 2);
constexpr size_t WS_SS = WS_OB + al256((size_t)MT * 2048 * 2);
constexpr size_t WS_SSO = WS_SS + al256(4ull * MT * 4);
constexpr size_t WS_TRC = WS_SSO + al256((size_t)MT * 4 * 4);
constexpr size_t WS_TRS = WS_TRC + al256(2052ull * 128 * 4);
constexpr size_t WS_TSC = WS_TRS + al256(2052ull * 128 * 4);
constexpr size_t WS_TSS = WS_TSC + al256(2052ull * 32 * 4);
constexpr size_t WS_END = WS_TSS + al256(2052ull * 32 * 4);
constexpr size_t WS_SSOP = WS_END;
constexpr size_t WS_CTL = WS_SSOP + al256((size_t)NP * 64 * 4), CTL_BYTES = 65536;
constexpr size_t WS_SCR = WS_CTL + CTL_BYTES;
constexpr size_t WS_TOTAL = WS_SCR;
constexpr size_t OUT_Y = 0, OUT_SP = (size_t)MT * 1024, OUT_SS = OUT_SP + 8ull * 4 * 256 * 512, OUT_KP = OUT_SS + 128ull * 4 * 256 * 512,
                 OUT_VP = OUT_KP + 8ull * 128 * 256, OUT_KS = OUT_VP + 8ull * 128 * 256, OUT_VS = OUT_KS + 128ull * 128 * 256, OUT_END = OUT_VS + 128ull * 128 * 256;

struct Params {
    const float* in[16]; float* out; unsigned char* ws;
    double invR[128]; double invS[32];
    float lg2[4];
    int ph_lo, ph_hi;
};

__device__ __forceinline__ unsigned f2bf(float f) { unsigned u = __builtin_bit_cast(unsigned, f); return (u + 0x7fffu + ((u >> 16) & 1u)) >> 16; }
__device__ __forceinline__ unsigned pk2(float lo, float hi) { return pg8::cvt_pk_bf16(lo, hi); }
__device__ __forceinline__ float bf2f(unsigned short b) { return __builtin_bit_cast(float, (unsigned)b << 16); }
__device__ __forceinline__ float bflo(unsigned w) { return __builtin_bit_cast(float, w << 16); }
__device__ __forceinline__ float bfhi(unsigned w) { return __builtin_bit_cast(float, w & 0xffff0000u); }
__device__ __forceinline__ float wave_sum(float v) {
#pragma unroll
    for (int o = 1; o < 64; o <<= 1) v += __shfl_xor(v, o);
    return v;
}
__device__ __forceinline__ f32x4 mfma16(bf16x8 a, bf16x8 b, f32x4 c) { return __builtin_amdgcn_mfma_f32_16x16x32_bf16(a, b, c, 0, 0, 0); }

__device__ __forceinline__ void transpose_item(const float* W, int K, int N, const float* gain, bf16* WT, int n0, int d0a, int d0b, int k0, LAS float* scr, int lane) {
    f32x4 wv[16];
#pragma unroll
    for (int i = 0; i < 16; ++i) { const int kk = 4 * i + (lane >> 4); wv[i] = __builtin_nontemporal_load((const f32x4*)(W + (size_t)(k0 + kk) * N + n0 + 4 * (lane & 15))); }
#pragma unroll
    for (int i = 0; i < 16; ++i) { const int kk = 4 * i + (lane >> 4); const float g = gain ? gain[k0 + kk] : 1.0f; LAS float* d = scr + kk * 65 + 4 * (lane & 15);
        d[0] = wv[i][0] * g; d[1] = wv[i][1] * g; d[2] = wv[i][2] * g; d[3] = wv[i][3] * g; }
    LDS_WAIT();
    const int c = lane & 7;
#pragma unroll
    for (int j = 0; j < 8; ++j) { const int n = (lane >> 3) + 8 * j; const LAS float* s = scr + (8 * c) * 65 + n;
        u32x4 o; o.x = pk2(s[0 * 65], s[1 * 65]); o.y = pk2(s[2 * 65], s[3 * 65]); o.z = pk2(s[4 * 65], s[5 * 65]); o.w = pk2(s[6 * 65], s[7 * 65]);
        const int drow = (n < 32) ? d0a + n : d0b + n - 32;
        *(u32x4*)(WT + (size_t)drow * K + k0 + 8 * c) = o; }
    LDS_WAIT();
}
__device__ __forceinline__ int dmap32(int mode, int n0) {
    if (mode == 1) return (n0 < DFF) ? (n0 / 128) * 256 + (n0 % 128) : ((n0 - DFF) / 128) * 256 + 128 + ((n0 - DFF) % 128);
    if (mode == 2) { const int pn = n0 / 256, r256 = n0 % 256, wc = r256 / 64, bj = (r256 % 64) / 32; return 256 * pn + 128 * bj + 32 * wc; }
    return n0;
}
__device__ __forceinline__ void transpose_mat(const float* W, int K, int N, const float* gain, bf16* WT, int mode, int r, LAS float* scr, int lane) {
    const int nblk = N / 64, kb = r / nblk, nb = r % nblk, n0 = 64 * nb;
    transpose_item(W, K, N, gain, WT, n0, dmap32(mode, n0), dmap32(mode, n0 + 32), 64 * kb, scr, lane);
}
__device__ __forceinline__ void p0_prologue(const Params& p, LAS unsigned char* lds, int tid, int lane, int wave, int vcu, int G, int part, int wid1, int nwg1) {
    unsigned char* ws = p.ws;
    LAS float* scr = (LAS float*)(lds + wave * 16896);
    const int gw = part ? wid1 * NWAVES + wave : vcu * NWAVES + wave, NGW = (part ? nwg1 : G) * NWAVES;
    constexpr int I_RI = 16 * 96, I_RO = 32 * 16, I_FI = 16 * 88, I_FO = 44 * 16, I_SI = 16 * 24, I_SO = 16 * 16;
    constexpr int NITEMS = I_RI + I_RO + 2 * I_FI + 2 * I_FO + I_SI + I_SO;
    const float* nmix = p.in[5]; const float* nffn = p.in[6];
    for (int it = (part ? I_RI + gw : gw); it < (part ? NITEMS : I_RI); it += NGW) {
        int r = it;
        if (r < I_RI) { transpose_mat(p.in[7], 1024, 6144, nmix, (bf16*)(ws + WS_WRI), 0, r, scr, lane); continue; } r -= I_RI;
        if (r < I_RO) { transpose_mat(p.in[8], 2048, 1024, nullptr, (bf16*)(ws + WS_WRO), 0, r, scr, lane); continue; } r -= I_RO;
        if (r < I_FI) { transpose_mat(p.in[14], 1024, 5632, nffn, (bf16*)(ws + WS_WFI0), 1, r, scr, lane); continue; } r -= I_FI;
        if (r < I_FO) { transpose_mat(p.in[15], 2816, 1024, nullptr, (bf16*)(ws + WS_WFO0), 0, r, scr, lane); continue; } r -= I_FO;
        if (r < I_SI) { transpose_mat(p.in[9], 1024, 1536, nmix + 1024, (bf16*)(ws + WS_WSI), 2, r, scr, lane); continue; } r -= I_SI;
        if (r < I_SO) { transpose_mat(p.in[10], 1024, 1024, nullptr, (bf16*)(ws + WS_WSO), 0, r, scr, lane); continue; } r -= I_SO;
        if (r < I_FI) { transpose_mat(p.in[14] + (size_t)1024 * 5632, 1024, 5632, nffn + 1024, (bf16*)(ws + WS_WFI1), 1, r, scr, lane); continue; } r -= I_FI;
        transpose_mat(p.in[15] + (size_t)2816 * 1024, 2816, 1024, nullptr, (bf16*)(ws + WS_WFO1), 0, r, scr, lane);
    }
    if (part) return;
    float* cR = (float*)(ws + WS_TRC); float* sR = (float*)(ws + WS_TRS); float* cS = (float*)(ws + WS_TSC); float* sS = (float*)(ws + WS_TSS);
    for (int idx = vcu * NTHR + tid; idx < 2052 * 160; idx += G * NTHR) {
        const int pi = idx / 160, c = idx % 160; const double pos = (pi < 2048) ? (double)pi : (double)(16384 + (pi - 2048));
        double rev = pos * ((c < 128) ? p.invR[c] : p.invS[c - 128]); rev -= __builtin_rint(rev);
        const float cv = __builtin_amdgcn_cosf((float)rev), sv = __builtin_amdgcn_sinf((float)rev);
        if (c < 128) { cR[pi * 128 + c] = cv; sR[pi * 128 + c] = sv; } else { cS[pi * 32 + c - 128] = cv; sS[pi * 32 + c - 128] = sv; }
    }
    bf16* XB = (bf16*)(ws + WS_XB); float* ss = (float*)(ws + WS_SS); float* sso = (float*)(ws + WS_SSO);
#pragma unroll 2
    for (int m = gw; m < MT; m += NGW) {
        const float* xr = (m < NP) ? p.in[0] + (size_t)m * DM : p.in[1] + (size_t)(m - NP) * DM;
        f32x4 v[4]; float s = 0.f;
#pragma unroll
        for (int j = 0; j < 4; ++j) { v[j] = __builtin_nontemporal_load((const f32x4*)xr + lane + 64 * j); s += (v[j][0] * v[j][0] + v[j][1] * v[j][1]) + (v[j][2] * v[j][2] + v[j][3] * v[j][3]); }
        s = wave_sum(s);
#pragma unroll
        for (int j = 0; j < 4; ++j) { u32x2 o; o.x = pk2(v[j][0], v[j][1]); o.y = pk2(v[j][2], v[j][3]); ((u32x2*)(XB + (size_t)m * DM))[lane + 64 * j] = o; }
        if (lane == 0) { ss[m] = s; ss[MT + m] = 0.f; ss[2 * MT + m] = 0.f; ss[3 * MT + m] = 0.f; }
    }
}

constexpr int RQ_STR = 264, RV_STR = 72;
constexpr int RL_Q = 0, RL_K = 33792, RL_VT = 67584, RL_VD = 76800, RL_P = 86016, RL_ST = 95232, RL_GL = 129024;
__device__ __forceinline__ void ret_prompt_unit(LAS unsigned char* lds, const bf16* QKVG, bf16* OB, float* sso, float* state_out, int bh, int es, float lg2, int tid) {
    const int lane = tid & 63, w = __builtin_amdgcn_readfirstlane(tid >> 6), li = lane & 15, lq = lane >> 4;
    const int b = bh >> 2, h = bh & 3;
    LAS bf16* Ql = (LAS bf16*)(lds + RL_Q); LAS bf16* Kl = (LAS bf16*)(lds + RL_K); LAS bf16* VT = (LAS bf16*)(lds + RL_VT);
    LAS bf16* VD = (LAS bf16*)(lds + RL_VD); LAS bf16* PP = (LAS bf16*)(lds + RL_P); LAS bf16* ST = (LAS bf16*)(lds + RL_ST);
    for (int i = tid; i < 33792 / 16; i += NTHR) ((LAS u32x4*)ST)[i] = (u32x4){0u, 0u, 0u, 0u};
    f32x4 S[2][4];
#pragma unroll
    for (int a = 0; a < 2; ++a)
#pragma unroll
        for (int e = 0; e < 4; ++e) S[a][e] = (f32x4){0.f, 0.f, 0.f, 0.f};
    const size_t rowbase = (size_t)b * SEQ;
    const bf16* qg = QKVG + ((size_t)h * MT + rowbase) * 256;
    const bf16* kg = qg + (size_t)4 * MT * 256;
    const bf16* vg = QKVG + (size_t)8 * MT * 256 + ((size_t)h * MT + rowbase) * 512 + es * 64;
    const int srow = tid >> 5, sch = tid & 31;
    const int vrow = tid & 63, vch = tid >> 6;
    const bf16* gg = vg + (size_t)4 * MT * 512;
    LAS bf16* OL = (LAS bf16*)(lds + RL_GL + 9216);
    const int orow = tid >> 3, och = tid & 7;
    LAS bf16* GL = (LAS bf16*)(lds + RL_GL);
    u32x4 rq[4], rk[4], rv, rg;
#define RET_LOAD(t0_) do { _Pragma("unroll") for (int i_ = 0; i_ < 4; ++i_) { const size_t o_ = (size_t)((t0_) + srow + 16 * i_) * 256 + sch * 8; rq[i_] = *(const u32x4*)(qg + o_); rk[i_] = *(const u32x4*)(kg + o_); } \
        rv = *(const u32x4*)(vg + (size_t)((t0_) + vrow) * 512 + vch * 8); rg = *(const u32x4*)(gg + (size_t)((t0_) + vrow) * 512 + vch * 8); } while (0)
    RET_LOAD(0);
    const int ib = w >> 1, nh = w & 1;
    const float dS = __builtin_amdgcn_exp2f(64.0f * lg2);
    for (int c = 0; c < 32; ++c) {
        const int t0 = c * 64;
        asm volatile("s_waitcnt vmcnt(0)" ::: "memory");
#pragma unroll
        for (int i = 0; i < 4; ++i) { *(LAS u32x4*)(Ql + (srow + 16 * i) * RQ_STR + sch * 8) = rq[i]; *(LAS u32x4*)(Kl + (srow + 16 * i) * RQ_STR + sch * 8) = rk[i]; }
        *(LAS u32x4*)(GL + vrow * RV_STR + vch * 8) = rg;
        { const float dec = __builtin_amdgcn_exp2f((float)(63 - vrow) * lg2);
#pragma unroll
          for (int j = 0; j < 4; ++j) { const unsigned wv = rv[j]; const int e0 = vch * 8 + 2 * j;
              VT[e0 * RV_STR + vrow] = (bf16)(wv & 0xffffu); VT[(e0 + 1) * RV_STR + vrow] = (bf16)(wv >> 16);
              VD[e0 * RV_STR + vrow] = (bf16)f2bf(bflo(wv) * dec); VD[(e0 + 1) * RV_STR + vrow] = (bf16)f2bf(bfhi(wv) * dec); } }
        __syncthreads();
        if (c > 0) { const u32x4 ov = *(const LAS u32x4*)(OL + orow * 64 + och * 8); *(u32x4*)(OB + (rowbase + t0 - 64 + orow) * 2048 + h * 512 + es * 64 + och * 8) = ov; }
        if (c + 1 < 32) RET_LOAD(t0 + 64);
        f32x4 accS[2], accO[2];
#pragma unroll
        for (int t = 0; t < 2; ++t) { accS[t] = (f32x4){0.f, 0.f, 0.f, 0.f}; accO[t] = (f32x4){0.f, 0.f, 0.f, 0.f}; }
#pragma unroll
        for (int kh = 0; kh < 4; ++kh) {
            bf16x8 fa[2], fs[2][2], fk[2][2];
#pragma unroll
            for (int kk = 0; kk < 2; ++kk) { const int ks = 2 * kh + kk;
                fa[kk] = *(const LAS bf16x8*)(Ql + (16 * ib + li) * RQ_STR + 32 * ks + 8 * lq);
#pragma unroll
                for (int t = 0; t < 2; ++t) { fs[kk][t] = *(const LAS bf16x8*)(ST + (16 * (2 * nh + t) + li) * RQ_STR + 32 * ks + 8 * lq);
                    fk[kk][t] = *(const LAS bf16x8*)(Kl + (16 * (2 * nh + t) + li) * RQ_STR + 32 * ks + 8 * lq); } }
            __builtin_amdgcn_sched_barrier(0);
#pragma unroll
            for (int kk = 0; kk < 2; ++kk)
#pragma unroll
                for (int t = 0; t < 2; ++t) { accO[t] = mfma16(fa[kk], fs[kk][t], accO[t]); accS[t] = mfma16(fa[kk], fk[kk][t], accS[t]); }
            __builtin_amdgcn_sched_barrier(0);
        }
#pragma unroll
        for (int t = 0; t < 2; ++t) { const int jb = 2 * nh + t, j = 16 * jb + li;
#pragma unroll
            for (int r = 0; r < 4; ++r) { const int i = 16 * ib + 4 * lq + r;
                const float val = (j <= i) ? accS[t][r] * __builtin_amdgcn_exp2f((float)(i - j) * lg2) : 0.f;
                PP[i * RV_STR + j] = (bf16)f2bf(val); } }
        __syncthreads();
        f32x4 accA[2];
#pragma unroll
        for (int t = 0; t < 2; ++t) accA[t] = (f32x4){0.f, 0.f, 0.f, 0.f};
#pragma unroll
        for (int ks = 0; ks < 2; ++ks) {
            const bf16x8 a = *(const LAS bf16x8*)(PP + (16 * ib + li) * RV_STR + 32 * ks + 8 * lq);
#pragma unroll
            for (int t = 0; t < 2; ++t) { const bf16x8 bv = *(const LAS bf16x8*)(VT + (16 * (2 * nh + t) + li) * RV_STR + 32 * ks + 8 * lq); accA[t] = mfma16(a, bv, accA[t]); }
        }
#pragma unroll
        for (int r = 0; r < 4; ++r) { const int i = 16 * ib + 4 * lq + r; const float f = __builtin_amdgcn_exp2f((float)(i + 1) * lg2);
            const size_t row = rowbase + t0 + i; float q2 = 0.f;
#pragma unroll
            for (int t = 0; t < 2; ++t) { const float o = accA[t][r] + f * accO[t][r]; q2 += o * o; OL[i * 64 + 16 * (2 * nh + t) + li] = (bf16)f2bf(o * bf2f(GL[i * RV_STR + 16 * (2 * nh + t) + li])); }
            q2 += __shfl_xor(q2, 1); q2 += __shfl_xor(q2, 2); q2 += __shfl_xor(q2, 4); q2 += __shfl_xor(q2, 8);
            if (li == 0 && sso) sso[(row * 4 + h) * 16 + es * 2 + nh] = q2; }
#pragma unroll
        for (int a = 0; a < 2; ++a)
#pragma unroll
            for (int e = 0; e < 4; ++e) S[a][e] = S[a][e] * dS;
#pragma unroll
        for (int ks = 0; ks < 2; ++ks) {
            bf16x8 ka[2];
#pragma unroll
            for (int dm = 0; dm < 2; ++dm)
#pragma unroll
                for (int jj = 0; jj < 8; ++jj) ka[dm][jj] = (short)Kl[(32 * ks + 8 * lq + jj) * RQ_STR + 32 * w + 16 * dm + li];
#pragma unroll
            for (int en = 0; en < 4; ++en) { const bf16x8 bv = *(const LAS bf16x8*)(VD + (16 * en + li) * RV_STR + 32 * ks + 8 * lq);
#pragma unroll
                for (int dm = 0; dm < 2; ++dm) S[dm][en] = mfma16(ka[dm], bv, S[dm][en]); }
        }
#pragma unroll
        for (int dm = 0; dm < 2; ++dm)
#pragma unroll
            for (int en = 0; en < 4; ++en) { u32x2 o; o.x = f2bf(S[dm][en][0]) | (f2bf(S[dm][en][1]) << 16); o.y = f2bf(S[dm][en][2]) | (f2bf(S[dm][en][3]) << 16);
                *(LAS u32x2*)(ST + (16 * en + li) * RQ_STR + 32 * w + 16 * dm + 4 * lq) = o; }
        __syncthreads();
    }
#undef RET_LOAD
    { const u32x4 ov = *(const LAS u32x4*)(OL + orow * 64 + och * 8); *(u32x4*)(OB + (rowbase + 31 * 64 + orow) * 2048 + h * 512 + es * 64 + och * 8) = ov; }
    float* so = state_out + ((size_t)bh * 256) * 512 + es * 64;
#pragma unroll
    for (int dm = 0; dm < 2; ++dm)
#pragma unroll
        for (int en = 0; en < 4; ++en)
#pragma unroll
            for (int r = 0; r < 4; ++r) so[(size_t)(32 * w + 16 * dm + 4 * lq + r) * 512 + 16 * en + li] = S[dm][en][r];
}

__device__ __forceinline__ void ret_sample_unit(LAS unsigned char* lds, const bf16* QKVG, bf16* OB, const float* state_in, float* state_out, int bh, float lg2, int tid) {
    const int lane = tid & 63, w = __builtin_amdgcn_readfirstlane(tid >> 6);
    const int b = bh >> 2, h = bh & 3;
    LAS float* qk8 = (LAS float*)lds;
    LAS float* qkd = qk8 + 2048;
    LAS float* red = qkd + 16;
    LAS float* wsm = red + 8192;
    const size_t r0 = (size_t)(NP + b * 4);
    {
        const int idx = tid * 4, which = idx >> 10, t = (idx >> 8) & 3, d = idx & 255;
        const u32x2 v = *(const u32x2*)(QKVG + (size_t)which * 4 * MT * 256 + ((size_t)h * MT + r0 + t) * 256 + d);
        LAS float* dst = qk8 + d * 8 + which * 4 + t;
        dst[0] = bflo(v.x); dst[8] = bfhi(v.x); dst[16] = bflo(v.y); dst[24] = bfhi(v.y);
    }
    __syncthreads();
    {
#pragma unroll
        for (int pp = 0; pp < 2; ++pp) { const int pr = 2 * w + pp, i = pr >> 2, j = pr & 3; float s = 0.f;
#pragma unroll
            for (int dd = 0; dd < 4; ++dd) { const int d = lane * 4 + dd; s += qk8[d * 8 + i] * qk8[d * 8 + 4 + j]; }
            s = wave_sum(s); if (lane == 0) qkd[pr] = s; }
    }
    const float g1 = __builtin_amdgcn_exp2f(lg2), g2 = g1 * g1, g3 = g2 * g1, g4 = g2 * g2;
    const int ec = tid & 127, dg = tid >> 7;
    f32x4 vv[4];
#pragma unroll
    for (int j = 0; j < 4; ++j) { const u32x2 v = *(const u32x2*)(QKVG + (size_t)8 * MT * 256 + ((size_t)h * MT + r0 + j) * 512 + 4 * ec); vv[j] = (f32x4){bflo(v.x), bfhi(v.x), bflo(v.y), bfhi(v.y)}; }
    vv[0] = vv[0] * g3; vv[1] = vv[1] * g2; vv[2] = vv[2] * g1;
    f32x4 oa[4];
#pragma unroll
    for (int i = 0; i < 4; ++i) oa[i] = (f32x4){0.f, 0.f, 0.f, 0.f};
    const float* sin_ = state_in + ((size_t)bh * 256 + dg * 64) * 512 + 4 * ec;
    float* sout = state_out + ((size_t)bh * 256 + dg * 64) * 512 + 4 * ec;
    f32x4 sb[2][8];
#pragma unroll
    for (int r = 0; r < 8; ++r) sb[0][r] = __builtin_nontemporal_load((const f32x4*)(sin_ + (size_t)r * 512));
#pragma unroll
    for (int bt = 0; bt < 8; ++bt) {
        if (bt + 1 < 8) {
#pragma unroll
            for (int r = 0; r < 8; ++r) sb[(bt + 1) & 1][r] = __builtin_nontemporal_load((const f32x4*)(sin_ + (size_t)((bt + 1) * 8 + r) * 512));
            asm volatile("s_waitcnt vmcnt(8)" ::: "memory");
        } else asm volatile("s_waitcnt vmcnt(0)" ::: "memory");
#pragma unroll
        for (int r = 0; r < 8; ++r) { const int dd = bt * 8 + r; const f32x4 s = sb[bt & 1][r];
            const f32x4 q4 = *(const LAS f32x4*)(qk8 + (dg * 64 + dd) * 8), k4 = *(const LAS f32x4*)(qk8 + (dg * 64 + dd) * 8 + 4);
            const f32x4 sn = s * g4 + vv[0] * k4[0] + vv[1] * k4[1] + vv[2] * k4[2] + vv[3] * k4[3];
            __builtin_nontemporal_store(sn, (f32x4*)(sout + (size_t)dd * 512));
            oa[0] += s * q4[0]; oa[1] += s * q4[1]; oa[2] += s * q4[2]; oa[3] += s * q4[3]; }
    }
#pragma unroll
    for (int i = 0; i < 4; ++i) *(LAS f32x4*)(red + (dg * 4 + i) * 512 + 4 * ec) = oa[i];
    __syncthreads();
    {
        const int e = tid; float vj[4], o[4], q2[4];
#pragma unroll
        for (int j = 0; j < 4; ++j) vj[j] = bf2f(QKVG[(size_t)8 * MT * 256 + ((size_t)h * MT + r0 + j) * 512 + e]);
        const float gp[4] = {1.0f, g1, g2, g3};
#pragma unroll
        for (int i = 0; i < 4; ++i) { float ob = (red[(0 * 4 + i) * 512 + e] + red[(1 * 4 + i) * 512 + e]) + (red[(2 * 4 + i) * 512 + e] + red[(3 * 4 + i) * 512 + e]);
            float acc = ob * gp[i] * g1;
#pragma unroll
            for (int j = 0; j < 4; ++j) if (j <= i) acc += gp[i - j] * qkd[i * 4 + j] * vj[j];
            o[i] = acc; q2[i] = wave_sum(acc * acc); }
        if (lane == 0) {
#pragma unroll
            for (int i = 0; i < 4; ++i) wsm[w * 4 + i] = q2[i]; }
        __syncthreads();
#pragma unroll
        for (int i = 0; i < 4; ++i) { float t = 0.f;
#pragma unroll
            for (int ww = 0; ww < 8; ++ww) t += wsm[ww * 4 + i];
            const float rstd = __builtin_amdgcn_rsqf(t * (1.0f / 512.0f) + EPS);
            const float sg = bf2f(QKVG[(size_t)8 * MT * 256 + (size_t)4 * MT * 512 + ((size_t)h * MT + r0 + i) * 512 + e]);
            OB[(r0 + i) * 2048 + h * 512 + e] = (bf16)f2bf(o[i] * rstd * sg); }
    }
    __syncthreads();
}

__device__ __forceinline__ void ret_norm_pass(const bf16* QKVG, bf16* OB, const float* sso, int gw, int NGW, int lane) {
    for (int m = gw; m < NP; m += NGW) {
#pragma unroll
        for (int j = 0; j < 4; ++j) {
            const f32x4* pp = (const f32x4*)(sso + ((size_t)m * 4 + j) * 16);
            const f32x4 pa = pp[0] + pp[1] + pp[2] + pp[3];
            const float rstd = __builtin_amdgcn_rsqf(((pa[0] + pa[1]) + (pa[2] + pa[3])) * (1.0f / 512.0f) + EPS);
            u32x4 o = *(const u32x4*)(OB + (size_t)m * 2048 + 512 * j + lane * 8); const u32x4 g = *(const u32x4*)(QKVG + (size_t)8 * MT * 256 + (size_t)4 * MT * 512 + ((size_t)j * MT + m) * 512 + lane * 8);
#pragma unroll
            for (int k = 0; k < 4; ++k) o[k] = pk2(bflo(o[k]) * rstd * bflo(g[k]), bfhi(o[k]) * rstd * bfhi(g[k]));
            *(u32x4*)(OB + (size_t)m * 2048 + 512 * j + lane * 8) = o;
        }
    }
}

constexpr int AK_STR = 72, AV_STR = 264, AP_STR = 168;
constexpr int AL_K = 0, AL_VT = 36864, AL_P = 70656;
template <int AVS> __device__ __forceinline__ void attn_item(const LAS bf16* Kl, const LAS bf16* VT, LAS bf16* Pw, const bf16x8 (&qa)[2], int jt0, const int (&lo)[4], const int (&hi)[4], const float (&sink)[4], bf16* obase, int sA, int sB, int li, int lq) {
    f32x4 sc[10];
#pragma unroll
    for (int jt = 0; jt < 10; ++jt) { sc[jt] = (f32x4){0.f, 0.f, 0.f, 0.f};
#pragma unroll
        for (int ks = 0; ks < 2; ++ks) { const bf16x8 bk = *(const LAS bf16x8*)(Kl + (16 * (jt0 + jt) + li) * AK_STR + 32 * ks + 8 * lq); sc[jt] = mfma16(qa[ks], bk, sc[jt]); } }
    float mx[4], den[4];
#pragma unroll
    for (int r = 0; r < 4; ++r) { float m = sink[r];
#pragma unroll
        for (int jt = 0; jt < 10; ++jt) { const int j = 16 * (jt0 + jt) + li; const bool ok = (j >= lo[r]) && (j <= hi[r]); sc[jt][r] = ok ? sc[jt][r] : -INFINITY; m = fmaxf(m, sc[jt][r]); }
        m = fmaxf(m, __shfl_xor(m, 1)); m = fmaxf(m, __shfl_xor(m, 2)); m = fmaxf(m, __shfl_xor(m, 4)); m = fmaxf(m, __shfl_xor(m, 8));
        float s = 0.f;
#pragma unroll
        for (int jt = 0; jt < 10; ++jt) { const float e = __expf(sc[jt][r] - m); sc[jt][r] = e; s += e; }
        s += __shfl_xor(s, 1); s += __shfl_xor(s, 2); s += __shfl_xor(s, 4); s += __shfl_xor(s, 8);
        mx[r] = m; den[r] = __builtin_amdgcn_rcpf(s + __expf(sink[r] - m)); }
#pragma unroll
    for (int jt = 0; jt < 10; ++jt)
#pragma unroll
        for (int r = 0; r < 4; ++r) Pw[(4 * lq + r) * AP_STR + 16 * jt + li] = (bf16)f2bf(sc[jt][r] * den[r]);
    LDS_WAIT();
    f32x4 oc[4];
#pragma unroll
    for (int dn = 0; dn < 4; ++dn) oc[dn] = (f32x4){0.f, 0.f, 0.f, 0.f};
#pragma unroll
    for (int ks = 0; ks < 5; ++ks) { const bf16x8 pa = *(const LAS bf16x8*)(Pw + li * AP_STR + 32 * ks + 8 * lq);
#pragma unroll
        for (int dn = 0; dn < 4; ++dn) { const bf16x8 bv = *(const LAS bf16x8*)(VT + (16 * dn + li) * AVS + 16 * jt0 + 32 * ks + 8 * lq); oc[dn] = mfma16(pa, bv, oc[dn]); } }
#pragma unroll
    for (int r = 0; r < 4; ++r)
#pragma unroll
        for (int dn = 0; dn < 4; ++dn) Pw[(4 * lq + r) * AP_STR + 16 * dn + li] = (bf16)f2bf(oc[dn][r]);
    LDS_WAIT();
    { const int lane_ = lq * 16 + li;
#pragma unroll
      for (int h2 = 0; h2 < 2; ++h2) { const int idx = lane_ + 64 * h2, rr = idx >> 3, ch = idx & 7;
          const u32x4 v = *(const LAS u32x4*)(Pw + rr * AP_STR + ch * 8); *(u32x4*)(obase + (size_t)(rr >> 2) * sA + (size_t)(rr & 3) * sB + ch * 8) = v; } }
    LDS_WAIT();
    (void)mx;
}
__device__ __forceinline__ void attn_prompt_unit(LAS unsigned char* lds, const bf16* QKV, bf16* AO, const float* sinks, int unit, int tid) {
    const int lane = tid & 63, w = __builtin_amdgcn_readfirstlane(tid >> 6), li = lane & 15, lq = lane >> 4;
    const int kvh = unit & 3, nb = (unit >> 2) & 15, b = unit >> 6;
    LAS bf16* Kl = (LAS bf16*)(lds + AL_K); LAS bf16* VT = (LAS bf16*)(lds + AL_VT); LAS bf16* Pw = (LAS bf16*)(lds + AL_P + w * 5376);
    const size_t rowbase = (size_t)b * SEQ; const int tb = nb * 128 - 128;
    bf16x8 qf[4][2];
#pragma unroll
    for (int it = 0; it < 4; ++it) { const int id = w * 4 + it, g = id >> 3, qt = id & 7; const bf16* qp = QKV + (rowbase + nb * 128 + 16 * qt + li) * 1536 + (kvh * 4 + g) * 64;
#pragma unroll
        for (int ks = 0; ks < 2; ++ks) qf[it][ks] = *(const bf16x8*)(qp + 32 * ks + 8 * lq); }
#pragma unroll
    for (int i = 0; i < 4; ++i) { const int id = tid + NTHR * i, j = id >> 3, ch = id & 7; const int t = tb + j;
        u32x4 kv = (u32x4){0u, 0u, 0u, 0u}, vv = (u32x4){0u, 0u, 0u, 0u};
        if (t >= 0) { const bf16* src = QKV + (rowbase + t) * 1536 + 1024 + kvh * 64 + ch * 8; kv = *(const u32x4*)src; vv = *(const u32x4*)(src + 256); }
        *(LAS u32x4*)(Kl + j * AK_STR + ch * 8) = kv;
#pragma unroll
        for (int k = 0; k < 4; ++k) { VT[(ch * 8 + 2 * k) * AV_STR + j] = (bf16)(vv[k] & 0xffffu); VT[(ch * 8 + 2 * k + 1) * AV_STR + j] = (bf16)(vv[k] >> 16); } }
    __syncthreads();
#pragma unroll
    for (int it = 0; it < 4; ++it) { const int id = w * 4 + it, g = id >> 3, qt = id & 7, hq = kvh * 4 + g;
        const size_t qrow0 = rowbase + nb * 128 + 16 * qt;
        int lo[4], hi[4]; float sk[4]; const float sv = sinks[hq];
#pragma unroll
        for (int r = 0; r < 4; ++r) { const int i = 16 * qt + 4 * lq + r; lo[r] = (nb > 0) ? i : (i > 128 ? i : 128); hi[r] = i + 128; sk[r] = sv; }
        attn_item<AV_STR>(Kl, VT, Pw, qf[it], qt & ~1, lo, hi, sk, AO + qrow0 * 1024 + hq * 64, 4 * 1024, 1024, li, lq); }
    __syncthreads();
}
constexpr int AS_VSTR = 168, AS_SLOT = 51200, AS_K = 0, AS_VT = 23040, AS_P = 44544;
__device__ __forceinline__ void attn_sample_pair(LAS unsigned char* lds, const bf16* QKV, bf16* AO, const float* sinks, const float* ck, const float* cv, float* ok, float* ov, int unit0, int unit1, int tid) {
    const int lane = tid & 63, w = __builtin_amdgcn_readfirstlane(tid >> 6), li = lane & 15, lq = lane >> 4;
#pragma unroll 1
    for (int s = 0; s < 2; ++s) {
        const int unit = s ? unit1 : unit0; const int kvh = unit & 3, b = unit >> 2;
        LAS bf16* Kl = (LAS bf16*)(lds + s * AS_SLOT + AS_K); LAS bf16* VT = (LAS bf16*)(lds + s * AS_SLOT + AS_VT);
        f32x4 kfa[4], vfa[4];
#pragma unroll
        for (int i = 0; i < 4; ++i) { const int id = tid + NTHR * i, j = id >> 4, ch = id & 15;
            const size_t so = ((size_t)(b * 128 + j) * 4 + kvh) * 64 + ch * 4;
            kfa[i] = __builtin_nontemporal_load((const f32x4*)(ck + so)); vfa[i] = __builtin_nontemporal_load((const f32x4*)(cv + so)); }
#pragma unroll
        for (int i = 0; i < 4; ++i) { const int id = tid + NTHR * i, j = id >> 4, ch = id & 15; const f32x4 kf = kfa[i], vf = vfa[i];
            if (j >= 4) { const size_t d_ = ((size_t)(b * 128 + j - 4) * 4 + kvh) * 64 + ch * 4; *(f32x4*)(ok + d_) = kf; *(f32x4*)(ov + d_) = vf; }
            u32x2 kb; kb.x = pk2(kf[0], kf[1]); kb.y = pk2(kf[2], kf[3]); *(LAS u32x2*)(Kl + j * AK_STR + ch * 4) = kb;
#pragma unroll
            for (int k = 0; k < 4; ++k) VT[(ch * 4 + k) * AS_VSTR + j] = (bf16)f2bf(vf[k]); }
        if (tid < 256) { const int j = 128 + (tid >> 3), ch = tid & 7;
            u32x4 kv = (u32x4){0u, 0u, 0u, 0u}, vv = (u32x4){0u, 0u, 0u, 0u};
            if (j < 132) { const bf16* src = QKV + (size_t)(NP + b * 4 + (j - 128)) * 1536 + 1024 + kvh * 64 + ch * 8; kv = *(const u32x4*)src; vv = *(const u32x4*)(src + 256); }
            *(LAS u32x4*)(Kl + j * AK_STR + ch * 8) = kv;
#pragma unroll
            for (int k = 0; k < 4; ++k) { VT[(ch * 8 + 2 * k) * AS_VSTR + j] = (bf16)(vv[k] & 0xffffu); VT[(ch * 8 + 2 * k + 1) * AS_VSTR + j] = (bf16)(vv[k] >> 16); } }
    }
    __syncthreads();
    if (w < 2) {
        const int unit = w ? unit1 : unit0; const int kvh = unit & 3, b = unit >> 2;
        const LAS bf16* Kl = (const LAS bf16*)(lds + w * AS_SLOT + AS_K); const LAS bf16* VT = (const LAS bf16*)(lds + w * AS_SLOT + AS_VT); LAS bf16* Pw = (LAS bf16*)(lds + w * AS_SLOT + AS_P);
        const int gA = li >> 2, tA = li & 3;
        const bf16* qp = QKV + (size_t)(NP + b * 4 + tA) * 1536 + (kvh * 4 + gA) * 64;
        bf16x8 qa[2];
#pragma unroll
        for (int ks = 0; ks < 2; ++ks) qa[ks] = *(const bf16x8*)(qp + 32 * ks + 8 * lq);
        int lo[4], hi[4]; float sk[4];
#pragma unroll
        for (int r = 0; r < 4; ++r) { const int rr = 4 * lq + r, g = rr >> 2, t = rr & 3; lo[r] = t; hi[r] = t + 128; sk[r] = sinks[kvh * 4 + g]; }
        attn_item<AS_VSTR>(Kl, VT, Pw, qa, 0, lo, hi, sk, AO + (size_t)(NP + b * 4) * 1024 + kvh * 4 * 64, 64, 1024, li, lq);
    }
    __syncthreads();
}

#define XB_TMO      128
#define XB_XCNT(j)  (256  + 64 * (j))
#define XB_XSUB(j)  (1280 + 64 * (j))
#define XB_XGEN(j)  (2304 + 64 * (j))
#define XB_TOP      3328
#define XB_TOPGEN   3392
#define XCD_BAR_WORDS 3456
#define XB_SPIN_CAP (1u << 18)

__device__ __forceinline__ unsigned xb_ld(unsigned* p)              { return __hip_atomic_load(p, __ATOMIC_RELAXED, __HIP_MEMORY_SCOPE_AGENT); }
__device__ __forceinline__ unsigned xb_add(unsigned* p, unsigned v) { return __hip_atomic_fetch_add(p, v, __ATOMIC_RELAXED, __HIP_MEMORY_SCOPE_AGENT); }
__device__ __forceinline__ unsigned xb_xcc_id() { return (unsigned)__builtin_amdgcn_s_getreg((3 << 11) | 20) & 0xFu; }
#define XB_SPIN(cond, bar) do { unsigned _sp = 0; while (cond) { __builtin_amdgcn_s_sleep(1); \
    if ((++_sp & 255u) == 0u) { if (xb_ld(&(bar)[XB_TMO])) break; if (_sp > XB_SPIN_CAP) { atomicAdd(&(bar)[XB_TMO], 1u); break; } } } } while (0)

struct XcdBarrier {
    unsigned* bar; unsigned x;
    volatile LAS unsigned* st;
};

__device__ __forceinline__ XcdBarrier xcd_barrier_post(unsigned* bar, volatile LAS unsigned* st) {
    XcdBarrier b; b.bar = bar; b.x = xb_xcc_id(); b.st = st;
    if (threadIdx.x == 0) (void)xb_add(&bar[XB_XCNT(b.x)], 1u);
    return b;
}
__device__ __forceinline__ void xcd_barrier_complete(unsigned* bar, unsigned x, unsigned& nloc, unsigned& nx) {
    const unsigned G = gridDim.x * gridDim.y * gridDim.z;
    unsigned sum, cnt, mine, sp = 0u;
    for (;;) {
        sum = 0u; cnt = 0u; mine = 0u;
#pragma unroll
        for (unsigned j = 0; j < 16; ++j) { const unsigned c = xb_ld(&bar[XB_XCNT(j)]); sum += c; cnt += (c > 0u) ? 1u : 0u; mine = (j == x) ? c : mine; }
        if (sum == G) break;
        __builtin_amdgcn_s_sleep(1);
        if ((++sp & 255u) == 0u) { if (xb_ld(&bar[XB_TMO])) break; if (sp > XB_SPIN_CAP) { atomicAdd(&bar[XB_TMO], 1u); break; } }
    }
    nloc = mine > 0u ? mine : 1u; nx = cnt > 0u ? cnt : 1u;
}

__device__ __forceinline__ void xcd_barrier(const XcdBarrier& b) {
    asm volatile("s_waitcnt vmcnt(0)" ::: "memory");
    __syncthreads();
    if (threadIdx.x == 0) {
        unsigned* bar = b.bar;
        __builtin_amdgcn_s_waitcnt(0);
        unsigned nloc = b.st[0], nx = b.st[1];
        if (nloc == 0u) { xcd_barrier_complete(bar, b.x, nloc, nx); b.st[0] = nloc; b.st[1] = nx; }
        const unsigned old = xb_add(&bar[XB_XSUB(b.x)], 1u);
        const unsigned gen = old / nloc;
        if (old + 1u == (gen + 1u) * nloc) {
            __builtin_amdgcn_fence(__ATOMIC_RELEASE, "agent");
            asm volatile("s_waitcnt vmcnt(0)" ::: "memory");
            const unsigned og = xb_add(&bar[XB_TOP], 1u);
            const unsigned tg = og / nx;
            if (og + 1u == (tg + 1u) * nx) xb_add(&bar[XB_TOPGEN], 1u);
            else XB_SPIN(xb_ld(&bar[XB_TOPGEN]) == tg, bar);
            __builtin_amdgcn_fence(__ATOMIC_ACQUIRE, "agent");
            xb_add(&bar[XB_XGEN(b.x)], 1u);
            asm volatile("s_waitcnt vmcnt(0)" ::: "memory");
        } else {
            XB_SPIN(xb_ld(&bar[XB_XGEN(b.x)]) == gen, bar);
            __builtin_amdgcn_fence(__ATOMIC_ACQUIRE, "agent");
            asm volatile("s_waitcnt vmcnt(0)" ::: "memory");
        }
    }
    __syncthreads();
}

#ifndef PROBE_DUP
#define PROBE_DUP 0
#endif
struct ListOrder {
    int nM, nN, nwg, pm_off, L0, dL, n, extraL;
    __device__ __forceinline__ void init(int Mrows, int N, int pm_off_) { nM = Mrows / 256; nN = N / 256; nwg = nM * nN; pm_off = pm_off_; }
    __device__ __forceinline__ bool next(int i, pg8::Unit& u) const {
        int L; if (i < n) L = L0 + i * dL; else if (i == n && extraL >= 0) L = extraL; else return false;
        if (L >= nwg) return false;
        int wgid = L; { const int q = nwg / 8, r = nwg % 8, xcd = wgid % 8, off = wgid / 8; wgid = (xcd < r ? xcd * (q + 1) : r * (q + 1) + (xcd - r) * q) + off; }
        const int nig = 8 * nN, gid = wgid / nig, fm = gid * 8, gsz = (nM - fm) < 8 ? (nM - fm) : 8;
        u.pm = fm + ((wgid % nig) % gsz) + pm_off; u.pn = (wgid % nig) / gsz; return true;
    }
    __device__ __forceinline__ void a_ready(const pg8::Unit&) const {}
    __device__ __forceinline__ void done(const pg8::Unit&) const {}
};
__device__ __forceinline__ void flag_signal(unsigned* f, int tid) {
    asm volatile("s_waitcnt vmcnt(0)" ::: "memory");
    __syncthreads();
    if (tid == 0) { __builtin_amdgcn_fence(__ATOMIC_RELEASE, "agent"); asm volatile("s_waitcnt vmcnt(0)" ::: "memory"); (void)xb_add(f, 1u); }
}
__device__ __forceinline__ void flag_wait(unsigned* f, unsigned n, int tid) {
    if (tid == 0) { unsigned sp = 0u; while (xb_ld(f) < n) { __builtin_amdgcn_s_sleep(4); if (++sp > (1u << 16)) break; }
        __builtin_amdgcn_fence(__ATOMIC_ACQUIRE, "agent"); asm volatile("s_waitcnt vmcnt(0)" ::: "memory"); }
    __syncthreads();
}
enum { K_NONE = 0, K_RETIN, K_RES, K_SWIGLU, K_SWAIN };
constexpr int NSTEPS = 21;
__global__ void __launch_bounds__(NTHR) hybrid_fwd(Params p) {
    extern __shared__ __attribute__((aligned(16))) unsigned char lds_raw[];
    LAS unsigned char* lds = (LAS unsigned char*)lds_raw;
    cg::grid_group grid = cg::this_grid();
    const int tid = threadIdx.x, lane = tid & 63, wave = __builtin_amdgcn_readfirstlane(tid >> 6);
    const int G = gridDim.x, c = blockIdx.x, vcu = (c % 8) * (G / 8) + c / 8;
    unsigned char* ws = p.ws; float* out = p.out;
    bf16* XB = (bf16*)(ws + WS_XB); bf16* BIG = (bf16*)(ws + WS_BIG); bf16* OB = (bf16*)(ws + WS_OB);
    float* ss = (float*)(ws + WS_SS); float* sso = (float*)(ws + WS_SSO);
    unsigned* ctl = (unsigned*)(ws + WS_CTL);
    unsigned* F1 = ctl + 4096; unsigned* F3 = ctl + 4096 + 64; unsigned* F4 = ctl + 4096 + 128; unsigned* F5 = ctl + 4096 + 192;
    volatile LAS unsigned* bst = (volatile LAS unsigned*)(lds + LDS_BYTES - 64);
    if (tid < 2) bst[tid] = 0u;
    __syncthreads();
    XcdBarrier bar = xcd_barrier_post(ctl, bst);
    const bool hi8 = (c >= 248), mid44 = (c >= 144 && c < 188);
    float* outS = out + (size_t)NP * DM;
#define GEMM_RES(Aptr, Wptr, Kc, E_)   do { pg8::Gemm g_{Aptr, (const bf16*)(ws + Wptr), MT, 1024, Kc}; pg8::gemm_phase<pg8::EpiRes, ListOrder, true, true>(lds, g_, S, E_); } while (0)
#define GEMM_SWIGLU(Wptr, ssp)         do { pg8::Gemm g_{XB, (const bf16*)(ws + Wptr), MT, 5632, 1024}; pg8::EpiSwiglu E_{BIG, ssp}; pg8::gemm_phase<pg8::EpiSwiglu, ListOrder, true, true>(lds, g_, S, E_); } while (0)
#define GEMM_SWAIN()                   do { pg8::Gemm g_{XB, (const bf16*)(ws + WS_WSI), MT, 1536, 1024}; \
        pg8::EpiSwaIn E_{BIG, ss + 2 * MT, (const float*)(ws + WS_TSC), (const float*)(ws + WS_TSS), p.in[11], p.in[12], out + OUT_KP, out + OUT_VP, out + OUT_KS, out + OUT_VS}; \
        pg8::gemm_phase<pg8::EpiSwaIn, ListOrder, true, true>(lds, g_, S, E_); } while (0)
    const int lo_ = p.ph_lo, hi_ = p.ph_hi;
#if defined(PROBE_T)
    unsigned long long pt0 = 0, pt1 = 0;
#endif
#define IN(k) (lo_ <= (k) && (k) < hi_)
#define SEAM(k, kind) do { if (IN((k) + 1)) { if ((kind) == 2 && G != 256) grid.sync(); else if ((kind) >= 1) xcd_barrier(bar); } } while (0)
#if defined(PROBE_T)
    if (PROBE_T == 0 && c == 0 && tid == 0) pt0 = __builtin_amdgcn_s_memrealtime();
#endif
    if (IN(0)) { ListOrder S; S.init(NP, 1024, 0); S.L0 = c; S.dL = 256; S.n = 0; S.extraL = -1;
       p0_prologue(p, lds, tid, lane, wave, vcu, G, 0, 0, 0);
#if PROBE_DUP & 1
            __syncthreads(); p0_prologue(p, lds, tid, lane, wave, vcu, G, 0, 0, 0);
#endif
        SEAM(0, 2); }
#if defined(PROBE_T)
    if (PROBE_T == 0 && c == 0 && tid == 0) pt1 = __builtin_amdgcn_s_memrealtime();
#endif
#if defined(PROBE_T)
    if (PROBE_T == 1 && c == 0 && tid == 0) pt0 = __builtin_amdgcn_s_memrealtime();
#endif
    if (IN(1)) { ListOrder S; S.init(NP, 1024, 0); S.L0 = c; S.dL = 256; S.n = 0; S.extraL = -1;
       { pg8::Gemm g_{XB, (const bf16*)(ws + WS_WRI), MT, 6144, 1024};
                  pg8::EpiRetIn E_{BIG, ss, (const float*)(ws + WS_TRC), (const float*)(ws + WS_TRS)};
                  if (c >= 208) { S.init(NS, 6144, 64); S.L0 = c - 208; S.n = 1; pg8::gemm_phase<pg8::EpiRetIn, ListOrder, true, true>(lds, g_, S, E_); }
                  else { p0_prologue(p, lds, tid, lane, wave, vcu, G, 1, c, 208); __syncthreads(); }
                  S.init(NP, 6144, 0); S.L0 = c; S.n = 6;
                  pg8::gemm_phase<pg8::EpiRetIn, ListOrder, true, true>(lds, g_, S, E_); }
        SEAM(1, 1); }
#if defined(PROBE_T)
    if (PROBE_T == 1 && c == 0 && tid == 0) pt1 = __builtin_amdgcn_s_memrealtime();
#endif
#if defined(PROBE_T)
    if (PROBE_T == 2 && c == 0 && tid == 0) pt0 = __builtin_amdgcn_s_memrealtime();
#endif
    if (IN(2)) { ListOrder S; S.init(NP, 1024, 0); S.L0 = c; S.dL = 256; S.n = 0; S.extraL = -1;

#if defined(PROBE_T)
            if (PROBE_T == 102 && c == 0 && tid == 0) pt0 = __builtin_amdgcn_s_memrealtime();
#endif
            for (int u = vcu; u < 256; u += G) ret_prompt_unit(lds, BIG, OB, (float*)(ws + WS_SSOP), out + OUT_SP, u >> 3, u & 7, p.lg2[(u >> 3) & 3], tid);
            __syncthreads();
#if defined(PROBE_T)
            if (PROBE_T == 102 && c == 0 && tid == 0) pt1 = __builtin_amdgcn_s_memrealtime();
            if (PROBE_T == 103 && c == 0 && tid == 0) pt0 = __builtin_amdgcn_s_memrealtime();
#endif
            for (int u = vcu; u < 512; u += G) ret_sample_unit(lds, BIG, OB, p.in[2], out + OUT_SS, u, p.lg2[u & 3], tid);
#if defined(PROBE_T)
            if (PROBE_T == 103 && c == 0 && tid == 0) pt1 = __builtin_amdgcn_s_memrealtime();
#endif


        SEAM(2, 1); }
#if defined(PROBE_T)
    if (PROBE_T == 2 && c == 0 && tid == 0) pt1 = __builtin_amdgcn_s_memrealtime();
#endif
#if defined(PROBE_T)
    if (PROBE_T == 3 && c == 0 && tid == 0) pt0 = __builtin_amdgcn_s_memrealtime();
#endif
    if (IN(3)) { ListOrder S; S.init(NP, 1024, 0); S.L0 = c; S.dL = 256; S.n = 0; S.extraL = -1;
        SEAM(3, 0); }
#if defined(PROBE_T)
    if (PROBE_T == 3 && c == 0 && tid == 0) pt1 = __builtin_amdgcn_s_memrealtime();
#endif
#if defined(PROBE_T)
    if (PROBE_T == 4 && c == 0 && tid == 0) pt0 = __builtin_amdgcn_s_memrealtime();
#endif
    if (IN(4)) { ListOrder S; S.init(NP, 1024, 0); S.L0 = c; S.dL = 256; S.n = 0; S.extraL = -1;
       { S.n = 1; LAS float* HT = (LAS float*)(lds + 131072); LAS float* HS4 = HT + 1024;
         { pg8::Unit u0; S.next(0, u0); const float* pp = (const float*)(ws + WS_SSOP) + ((size_t)(u0.pm * 256 + (tid >> 1)) * 4 + (tid & 1) * 2) * 16;
#pragma unroll
           for (int hh = 0; hh < 2; ++hh) { const f32x4* q4 = (const f32x4*)(pp + hh * 16); const f32x4 a = (q4[0] + q4[1]) + (q4[2] + q4[3]);
               HS4[(tid >> 1) * 4 + (tid & 1) * 2 + hh] = __builtin_amdgcn_rsqf(((a[0] + a[1]) + (a[2] + a[3])) * (1.0f / 512.0f) + EPS); }
           __syncthreads();
           if (tid < 256) { const f32x4 s4 = *(const LAS f32x4*)(HS4 + tid * 4); *(LAS f32x4*)(HT + tid * 4) = (f32x4){s4[0] / s4[1], s4[1] / s4[2], s4[2] / s4[3], s4[3]}; }
           __syncthreads(); }
         pg8::EpiRes E_{XB, nullptr, ss + MT, HT}; pg8::Gemm g_{OB, (const bf16*)(ws + WS_WRO), MT, 1024, 2048};
         pg8::gemm_phase<pg8::EpiRes, ListOrder, true, true, true>(lds, g_, S, E_, HT); }
        SEAM(4, 1); }
#if defined(PROBE_T)
    if (PROBE_T == 4 && c == 0 && tid == 0) pt1 = __builtin_amdgcn_s_memrealtime();
#endif
#if defined(PROBE_T)
    if (PROBE_T == 5 && c == 0 && tid == 0) pt0 = __builtin_amdgcn_s_memrealtime();
#endif
    if (IN(5)) { ListOrder S; S.init(NP, 1024, 0); S.L0 = c; S.dL = 256; S.n = 0; S.extraL = -1;
       { S.init(NS, 1024, 64); S.L0 = c - 248; S.n = hi8 ? 1 : 0; pg8::EpiRes E_{XB, nullptr, ss + MT, nullptr}; GEMM_RES(OB, WS_WRO, 2048, E_); if (hi8) flag_signal(F1, tid); }
        SEAM(5, 0); }
#if defined(PROBE_T)
    if (PROBE_T == 5 && c == 0 && tid == 0) pt1 = __builtin_amdgcn_s_memrealtime();
#endif
#if defined(PROBE_T)
    if (PROBE_T == 6 && c == 0 && tid == 0) pt0 = __builtin_amdgcn_s_memrealtime();
#endif
    if (IN(6)) { ListOrder S; S.init(NP, 1024, 0); S.L0 = c; S.dL = 256; S.n = 0; S.extraL = -1;
       { S.init(NP, 5632, 0);
                  if (hi8) S.n = 3; else if (c >= 128 && c < 144) { S.n = 5; S.extraL = (3 + (c - 128) / 8) * 256 + 248 + (c - 128) % 8; } else S.n = (c < 128) ? 6 : 5;
                  GEMM_SWIGLU(WS_WFI0, ss + MT); }
        SEAM(6, 0); }
#if defined(PROBE_T)
    if (PROBE_T == 6 && c == 0 && tid == 0) pt1 = __builtin_amdgcn_s_memrealtime();
#endif
#if defined(PROBE_T)
    if (PROBE_T == 7 && c == 0 && tid == 0) pt0 = __builtin_amdgcn_s_memrealtime();
#endif
    if (IN(7)) { ListOrder S; S.init(NP, 1024, 0); S.L0 = c; S.dL = 256; S.n = 0; S.extraL = -1;
       { S.init(NS, 5632, 64); S.L0 = c - 144; S.n = mid44 ? 1 : 0; if (mid44) flag_wait(F1, 8u, tid); GEMM_SWIGLU(WS_WFI0, ss + MT); }
        SEAM(7, 1); }
#if defined(PROBE_T)
    if (PROBE_T == 7 && c == 0 && tid == 0) pt1 = __builtin_amdgcn_s_memrealtime();
#endif
#if defined(PROBE_T)
    if (PROBE_T == 8 && c == 0 && tid == 0) pt0 = __builtin_amdgcn_s_memrealtime();
#endif
    if (IN(8)) { ListOrder S; S.init(NP, 1024, 0); S.L0 = c; S.dL = 256; S.n = 0; S.extraL = -1;
       { S.n = 1; pg8::EpiRes E_{XB, nullptr, ss + 2 * MT, nullptr}; GEMM_RES(BIG, WS_WFO0, 2816, E_); }
        SEAM(8, 1); }
#if defined(PROBE_T)
    if (PROBE_T == 8 && c == 0 && tid == 0) pt1 = __builtin_amdgcn_s_memrealtime();
#endif
#if defined(PROBE_T)
    if (PROBE_T == 9 && c == 0 && tid == 0) pt0 = __builtin_amdgcn_s_memrealtime();
#endif
    if (IN(9)) { ListOrder S; S.init(NP, 1024, 0); S.L0 = c; S.dL = 256; S.n = 0; S.extraL = -1;
       { S.init(NS, 1024, 64); S.L0 = c - 248; S.n = hi8 ? 1 : 0; pg8::EpiRes E_{XB, nullptr, ss + 2 * MT, nullptr}; GEMM_RES(BIG, WS_WFO0, 2816, E_); }
        SEAM(9, 0); }
#if defined(PROBE_T)
    if (PROBE_T == 9 && c == 0 && tid == 0) pt1 = __builtin_amdgcn_s_memrealtime();
#endif
#if defined(PROBE_T)
    if (PROBE_T == 10 && c == 0 && tid == 0) pt0 = __builtin_amdgcn_s_memrealtime();
#endif
    if (IN(10)) { ListOrder S; S.init(NP, 1024, 0); S.L0 = c; S.dL = 256; S.n = 0; S.extraL = -1;
       { S.init(NP, 1536, 0);
                   if (hi8) S.n = 0; else if (c < 128) S.n = 2; else { S.n = 1; if (c < 136) S.extraL = 248 + (c - 128); }
                   GEMM_SWAIN(); }
        SEAM(10, 1); }
#if defined(PROBE_T)
    if (PROBE_T == 10 && c == 0 && tid == 0) pt1 = __builtin_amdgcn_s_memrealtime();
#endif
#if defined(PROBE_T)
    if (PROBE_T == 11 && c == 0 && tid == 0) pt0 = __builtin_amdgcn_s_memrealtime();
#endif
    if (IN(11)) { ListOrder S; S.init(NP, 1024, 0); S.L0 = c; S.dL = 256; S.n = 0; S.extraL = -1;
       { const bool m12 = (c >= 236 && c < 248); S.init(NS, 1536, 64); S.L0 = c - 236; S.n = m12 ? 1 : 0; GEMM_SWAIN(); if (m12) flag_signal(F3, tid); }
        SEAM(11, 0); }
#if defined(PROBE_T)
    if (PROBE_T == 11 && c == 0 && tid == 0) pt1 = __builtin_amdgcn_s_memrealtime();
#endif
#if defined(PROBE_T)
    if (PROBE_T == 12 && c == 0 && tid == 0) pt0 = __builtin_amdgcn_s_memrealtime();
#endif
    if (IN(12)) { ListOrder S; S.init(NP, 1024, 0); S.L0 = c; S.dL = 256; S.n = 0; S.extraL = -1;
       for (int u = vcu; u < 512; u += G) attn_prompt_unit(lds, BIG, OB, p.in[13], u, tid);
        SEAM(12, 0); }
#if defined(PROBE_T)
    if (PROBE_T == 12 && c == 0 && tid == 0) pt1 = __builtin_amdgcn_s_memrealtime();
#endif
#if defined(PROBE_T)
    if (PROBE_T == 13 && c == 0 && tid == 0) pt0 = __builtin_amdgcn_s_memrealtime();
#endif
    if (IN(13)) { ListOrder S; S.init(NP, 1024, 0); S.L0 = c; S.dL = 256; S.n = 0; S.extraL = -1;
       flag_wait(F3, 12u, tid);
                 if (!(c >= 236 && c < 248)) {
                     attn_sample_pair(lds, BIG, OB, p.in[13], p.in[3], p.in[4], out + OUT_KS, out + OUT_VS, vcu, vcu + 256, tid);
                     if (c < 12) { const int c2 = 236 + c, v2 = (c2 % 8) * (G / 8) + c2 / 8; attn_sample_pair(lds, BIG, OB, p.in[13], p.in[3], p.in[4], out + OUT_KS, out + OUT_VS, v2, v2 + 256, tid); } }
        SEAM(13, 1); }
#if defined(PROBE_T)
    if (PROBE_T == 13 && c == 0 && tid == 0) pt1 = __builtin_amdgcn_s_memrealtime();
#endif
#if defined(PROBE_T)
    if (PROBE_T == 14 && c == 0 && tid == 0) pt0 = __builtin_amdgcn_s_memrealtime();
#endif
    if (IN(14)) { ListOrder S; S.init(NP, 1024, 0); S.L0 = c; S.dL = 256; S.n = 0; S.extraL = -1;
       { S.n = 1; pg8::EpiRes E_{XB, nullptr, ss + 3 * MT, nullptr}; GEMM_RES(OB, WS_WSO, 1024, E_); }
        SEAM(14, 1); }
#if defined(PROBE_T)
    if (PROBE_T == 14 && c == 0 && tid == 0) pt1 = __builtin_amdgcn_s_memrealtime();
#endif
#if defined(PROBE_T)
    if (PROBE_T == 15 && c == 0 && tid == 0) pt0 = __builtin_amdgcn_s_memrealtime();
#endif
    if (IN(15)) { ListOrder S; S.init(NP, 1024, 0); S.L0 = c; S.dL = 256; S.n = 0; S.extraL = -1;
       { S.init(NS, 1024, 64); S.L0 = c - 248; S.n = hi8 ? 1 : 0; pg8::EpiRes E_{XB, nullptr, ss + 3 * MT, nullptr}; GEMM_RES(OB, WS_WSO, 1024, E_); if (hi8) flag_signal(F4, tid); }
        SEAM(15, 0); }
#if defined(PROBE_T)
    if (PROBE_T == 15 && c == 0 && tid == 0) pt1 = __builtin_amdgcn_s_memrealtime();
#endif
#if defined(PROBE_T)
    if (PROBE_T == 16 && c == 0 && tid == 0) pt0 = __builtin_amdgcn_s_memrealtime();
#endif
    if (IN(16)) { ListOrder S; S.init(NP, 1024, 0); S.L0 = c; S.dL = 256; S.n = 0; S.extraL = -1;
       { S.init(NP, 5632, 0);
                   if (hi8 || mid44) S.n = 1; else if (c < 128) S.n = 6; else { S.n = 5; int j = -1; if (c < 144) j = c - 128; else if (c >= 188 && c < 204) j = 16 + (c - 188); if (j >= 0) S.extraL = (1 + j / 8) * 256 + 248 + j % 8; }
                   GEMM_SWIGLU(WS_WFI1, ss + 3 * MT); }
        SEAM(16, 0); }
#if defined(PROBE_T)
    if (PROBE_T == 16 && c == 0 && tid == 0) pt1 = __builtin_amdgcn_s_memrealtime();
#endif
#if defined(PROBE_T)
    if (PROBE_T == 17 && c == 0 && tid == 0) pt0 = __builtin_amdgcn_s_memrealtime();
#endif
    if (IN(17)) { ListOrder S; S.init(NP, 1024, 0); S.L0 = c; S.dL = 256; S.n = 0; S.extraL = -1;
       { S.init(NS, 5632, 64); S.L0 = c - 144; S.n = mid44 ? 1 : 0; if (mid44) flag_wait(F4, 8u, tid); GEMM_SWIGLU(WS_WFI1, ss + 3 * MT); if (mid44) flag_signal(F5, tid); }
        SEAM(17, 0); }
#if defined(PROBE_T)
    if (PROBE_T == 17 && c == 0 && tid == 0) pt1 = __builtin_amdgcn_s_memrealtime();
#endif
#if defined(PROBE_T)
    if (PROBE_T == 18 && c == 0 && tid == 0) pt0 = __builtin_amdgcn_s_memrealtime();
#endif
    if (IN(18)) { ListOrder S; S.init(NP, 1024, 0); S.L0 = c; S.dL = 256; S.n = 0; S.extraL = -1;
       { S.init(NS, 1024, 64); S.L0 = c - 248; S.n = hi8 ? 1 : 0; if (hi8) flag_wait(F5, 44u, tid); pg8::EpiRes E_{XB, out, nullptr, nullptr}; GEMM_RES(BIG, WS_WFO1, 2816, E_); }
        SEAM(18, 0); }
#if defined(PROBE_T)
    if (PROBE_T == 18 && c == 0 && tid == 0) pt1 = __builtin_amdgcn_s_memrealtime();
#endif
#if defined(PROBE_T)
    if (PROBE_T == 19 && c == 0 && tid == 0) pt0 = __builtin_amdgcn_s_memrealtime();
#endif
    if (IN(19)) { ListOrder S; S.init(NP, 1024, 0); S.L0 = c; S.dL = 256; S.n = 0; S.extraL = -1;
       { S.init(NP, 5632, 0); S.L0 = 256 + c; S.n = mid44 ? 4 : 0; GEMM_SWIGLU(WS_WFI1, ss + 3 * MT); }
        SEAM(19, 1); }
#if defined(PROBE_T)
    if (PROBE_T == 19 && c == 0 && tid == 0) pt1 = __builtin_amdgcn_s_memrealtime();
#endif
#if defined(PROBE_T)
    if (PROBE_T == 20 && c == 0 && tid == 0) pt0 = __builtin_amdgcn_s_memrealtime();
#endif
    if (IN(20)) { ListOrder S; S.init(NP, 1024, 0); S.L0 = c; S.dL = 256; S.n = 0; S.extraL = -1;
       { S.n = 1; pg8::EpiRes E_{XB, out, nullptr, nullptr}; GEMM_RES(BIG, WS_WFO1, 2816, E_); }
        SEAM(20, 0); }
#if defined(PROBE_T)
    if (PROBE_T == 20 && c == 0 && tid == 0) pt1 = __builtin_amdgcn_s_memrealtime();
#endif
#undef IN
#undef SEAM
#if defined(PROBE_T)
    if (c == 0 && tid == 0) { const unsigned long long te = __builtin_amdgcn_s_memrealtime(), d = (pt1 - pt0) * 4ull; while (__builtin_amdgcn_s_memrealtime() - te < d) __builtin_amdgcn_s_sleep(8); }
#endif
}

#ifndef N_LAUNCHES
#define N_LAUNCHES 1
#endif
extern "C" void kernel_launch(void* const* d_in, const int* in_sizes, int n_in, void* d_out, int out_size, void* d_ws, size_t ws_size, hipStream_t stream) {
    static int grid = 0;
    if (grid == 0) {
        if (n_in != 16 || (size_t)out_size != OUT_END || ws_size < WS_TOTAL) { fprintf(stderr, "kernel_launch: unexpected shapes (n_in %d out %d ws %zu need %zu)\n", n_in, out_size, ws_size, (size_t)WS_TOTAL); grid = -1; return; }
        int dev = 0, cus = 0, per_cu = 0;
        (void)hipGetDevice(&dev); (void)hipDeviceGetAttribute(&cus, hipDeviceAttributeMultiprocessorCount, dev);
        if (hipFuncSetAttribute((const void*)hybrid_fwd, hipFuncAttributeMaxDynamicSharedMemorySize, LDS_BYTES) != hipSuccess) { fprintf(stderr, "kernel_launch: hipFuncSetAttribute failed\n"); grid = -1; return; }
        if (hipOccupancyMaxActiveBlocksPerMultiprocessor(&per_cu, (const void*)hybrid_fwd, NTHR, LDS_BYTES) != hipSuccess || per_cu < 1) { fprintf(stderr, "kernel_launch: occupancy query says %d\n", per_cu); per_cu = 1; }
        (void)hipGetLastError();
        grid = cus * 1;
        if (grid != 256) { fprintf(stderr, "kernel_launch: built for a 256-CU device (got %d)\n", cus); grid = -1; return; }
    }
    if (grid < 0) return;
    if (hipMemsetAsync((char*)d_ws + WS_CTL, 0, CTL_BYTES, stream) != hipSuccess) { fprintf(stderr, "kernel_launch: memset failed\n"); return; }
    Params p; memset(&p, 0, sizeof(p));
    for (int i = 0; i < 16; ++i) p.in[i] = (const float*)d_in[i];
    p.out = (float*)d_out; p.ws = (unsigned char*)d_ws;
    const double two_pi = 6.283185307179586476925286766559;
    for (int i = 0; i < 128; ++i) p.invR[i] = 1.0 / std::pow(10000.0, (double)i / 127.0) / two_pi;
    for (int i = 0; i < 32; ++i) p.invS[i] = 1.0 / std::pow(10000.0, (double)(2 * i) / 64.0) / two_pi;
    for (int h = 0; h < 4; ++h) p.lg2[h] = (float)std::log2(1.0 - std::ldexp(1.0, -5 - h));
#if N_LAUNCHES == 1
    p.ph_lo = 0; p.ph_hi = NSTEPS;
    void* args[] = {&p};
    hipError_t e = hipLaunchCooperativeKernel((const void*)hybrid_fwd, dim3(grid), dim3(NTHR), args, LDS_BYTES, stream);
    if (e != hipSuccess) fprintf(stderr, "kernel_launch: cooperative launch failed: %s (grid %d)\n", hipGetErrorString(e), grid);
#else
    for (int ph = 0; ph < NSTEPS; ++ph) { p.ph_lo = ph; p.ph_hi = ph + 1; hipLaunchKernelGGL(hybrid_fwd, dim3(grid), dim3(NTHR), LDS_BYTES, stream, p); }
#endif
}
```
